# Optimizing an MI355X kernel written in HIP

```python
import jax, jax.numpy as jnp
from jax import lax
import numpy as np

D_MODEL = 1024
BATCH = 8
SEQ = 4096
DEPTH = 1

MEM_LEN = 256
SGU_GROUPS = 4
SGU_GROUP_DIM = 128
SGU_WIDTH = SGU_GROUPS * SGU_GROUP_DIM
SGU_CHUNK = 128
MOBA_HEADS = 8
MOBA_HEAD_DIM = 64
MOBA_WIDTH = MOBA_HEADS * MOBA_HEAD_DIM
MOBA_BLOCK = 256
MOBA_TOPK = 3
Q_BLOCK = 128
MEM_HEADS = 4
MEM_HEAD_DIM = 128
MEM_WIDTH = MEM_HEADS * MEM_HEAD_DIM
N_BRANCHES = 3
SPLIT_SIZES = (SGU_WIDTH, SGU_WIDTH, MOBA_WIDTH, MOBA_WIDTH, MOBA_WIDTH, MEM_WIDTH, N_BRANCHES * D_MODEL)
IN_WIDTH = sum(SPLIT_SIZES)
N_EXPERTS = 32
TOP_K = 4
D_FF = D_MODEL
SWIGLU_ALPHA = 1.702
SWIGLU_LIMIT = 7.0
EXPERT_BLOCK = 128
EPS = 1e-6
NEG_INF = -1e30

kernel_name = 'hybrid_sgu_moba_memxattn_moe_block'


def rms_norm(x, g):
    xf = x.astype(jnp.float32)
    y = xf * lax.rsqrt(jnp.mean(xf * xf, axis=-1, keepdims=True) + EPS)
    return (y * g.astype(jnp.float32)).astype(x.dtype)


def alibi_slopes(n):
    return jnp.asarray(2.0 ** (-8.0 * np.arange(1, n + 1, dtype=np.float32) / n), dtype=jnp.float32)


def sgu_mixer(u, v, g_v, w_spatial, b_spatial):
    B, S, _ = u.shape
    nc = S // SGU_CHUNK
    v = rms_norm(v, g_v)
    vc = v.reshape(B, nc, SGU_CHUNK, SGU_GROUPS, SGU_GROUP_DIM)
    causal = jnp.tril(jnp.ones((SGU_CHUNK, SGU_CHUNK), dtype=bool))
    ws = jnp.where(causal[None], w_spatial, 0.0).astype(v.dtype)
    mixed = jnp.einsum('gts,bcsgd->bctgd', ws, vc) + b_spatial.T[None, None, :, :, None].astype(v.dtype)
    return u * mixed.reshape(B, S, SGU_WIDTH)


def moba_attention(q, k, v, g_q, g_k, slopes):
    B, S, _ = q.shape
    H, Dh, BS = MOBA_HEADS, MOBA_HEAD_DIM, MOBA_BLOCK
    scale = Dh ** -0.5
    q = rms_norm(q.reshape(B, S, H, Dh), g_q).transpose(0, 2, 1, 3)
    k = rms_norm(k.reshape(B, S, H, Dh), g_k).transpose(0, 2, 1, 3)
    v = v.reshape(B, S, H, Dh).transpose(0, 2, 1, 3)
    nb = -(-S // BS)
    pad = nb * BS - S
    k_blocks = jnp.pad(k, ((0, 0), (0, 0), (0, pad), (0, 0))).reshape(B, H, nb, BS, Dh)
    v_blocks = jnp.pad(v, ((0, 0), (0, 0), (0, pad), (0, 0))).reshape(B, H, nb, BS, Dh)
    k_mean = jnp.mean(k_blocks.astype(jnp.float32), axis=3)
    gate = jnp.einsum('bhtd,bhnd->bhtn', q.astype(jnp.float32), k_mean)
    t_all = jnp.arange(S)
    eligible = jnp.arange(nb)[None, :] < (t_all // BS)[:, None]
    gate = jnp.where(eligible, gate, NEG_INF)
    k_sel = min(MOBA_TOPK, nb)
    top_val, top_idx = lax.top_k(gate, k_sel)
    top_valid = top_val > 0.5 * NEG_INF
    nq = S // Q_BLOCK
    h_ix = jnp.arange(H)[:, None, None]

    def step(bc):
        b = bc // nq
        t0 = (bc % nq) * Q_BLOCK
        t = t0 + jnp.arange(Q_BLOCK)
        qb = lax.dynamic_slice_in_dim(lax.dynamic_index_in_dim(q, b, 0, keepdims=False), t0, Q_BLOCK, axis=1)
        idx = lax.dynamic_slice_in_dim(lax.dynamic_index_in_dim(top_idx, b, 0, keepdims=False), t0, Q_BLOCK, axis=1)
        valid = lax.dynamic_slice_in_dim(lax.dynamic_index_in_dim(top_valid, b, 0, keepdims=False), t0, Q_BLOCK, axis=1)
        kb = lax.dynamic_index_in_dim(k_blocks, b, 0, keepdims=False)
        vb = lax.dynamic_index_in_dim(v_blocks, b, 0, keepdims=False)
        k_g = kb[h_ix, idx]
        v_g = vb[h_ix, idx]
        s_sel = jnp.einsum('hqd,hqnkd->hqnk', qb, k_g).astype(jnp.float32) * scale
        key_pos = idx[..., None] * BS + jnp.arange(BS)
        s_sel = s_sel - slopes[:, None, None, None] * (t[None, :, None, None] - key_pos)
        s_sel = jnp.where(valid[..., None], s_sel, NEG_INF)
        own = t0 // BS
        k_own = lax.dynamic_index_in_dim(kb, own, 1, keepdims=False)
        v_own = lax.dynamic_index_in_dim(vb, own, 1, keepdims=False)
        s_own = jnp.einsum('hqd,hkd->hqk', qb, k_own).astype(jnp.float32) * scale
        own_pos = own * BS + jnp.arange(BS)
        s_own = s_own - slopes[:, None, None] * (t[:, None] - own_pos[None, :])
        s_own = jnp.where(own_pos[None, None, :] <= t[None, :, None], s_own, NEG_INF)
        logits = jnp.concatenate([s_sel.reshape(H, Q_BLOCK, k_sel * BS), s_own], axis=-1)
        p = jax.nn.softmax(logits, axis=-1).astype(v.dtype)
        p_sel = p[..., :k_sel * BS].reshape(H, Q_BLOCK, k_sel, BS)
        p_own = p[..., k_sel * BS:]
        return jnp.einsum('hqnk,hqnkd->hqd', p_sel, v_g) + jnp.einsum('hqk,hkd->hqd', p_own, v_own)

    out = lax.map(step, jnp.arange(B * nq))
    out = out.reshape(B, nq, H, Q_BLOCK, Dh).transpose(0, 1, 3, 2, 4)
    return out.reshape(B, S, MOBA_WIDTH)


def memory_attention(q, mem_n, w_mem_kv, g_q, g_k):
    B, S, _ = q.shape
    M = mem_n.shape[1]
    k, v = jnp.split(mem_n @ w_mem_kv, 2, axis=-1)
    q = rms_norm(q.reshape(B, S, MEM_HEADS, MEM_HEAD_DIM), g_q)
    k = rms_norm(k.reshape(B, M, MEM_HEADS, MEM_HEAD_DIM), g_k)
    v = v.reshape(B, M, MEM_HEADS, MEM_HEAD_DIM)
    s = jnp.einsum('bthd,bmhd->bhtm', q, k).astype(jnp.float32) * (MEM_HEAD_DIM ** -0.5)
    p = jax.nn.softmax(s, axis=-1).astype(v.dtype)
    return jnp.einsum('bhtm,bmhd->bthd', p, v).reshape(B, S, MEM_WIDTH)


def swiglu_clamped(hh):
    glu, lin = jnp.split(hh, 2, axis=-1)
    glu = jnp.minimum(glu, SWIGLU_LIMIT)
    lin = jnp.clip(lin, -SWIGLU_LIMIT, SWIGLU_LIMIT)
    return glu * jax.nn.sigmoid(SWIGLU_ALPHA * glu) * (lin + 1.0)


def moe_ffn(h, w_router, b_router, w_gate_up, b_gate_up, w_down, b_down):
    B, S, D = h.shape
    T = B * S
    TK = T * TOP_K
    Mb = EXPERT_BLOCK
    xt = h.reshape(T, D)
    logits = (xt @ w_router + b_router).astype(jnp.float32)
    top_logit, top_e = lax.top_k(logits, TOP_K)
    top_w = jax.nn.softmax(top_logit, axis=-1)
    flat_e = top_e.reshape(TK)
    flat_tok = (jnp.arange(TK) // TOP_K).astype(jnp.int32)
    flat_w = top_w.reshape(TK)
    order = jnp.argsort(flat_e)
    sorted_e = flat_e[order]
    counts = jnp.bincount(flat_e, length=N_EXPERTS)
    starts = jnp.cumsum(counts) - counts
    padded = (counts + Mb - 1) // Mb * Mb
    pad_ends = jnp.cumsum(padded)
    pad_starts = pad_ends - padded
    dest = pad_starts[sorted_e] + (jnp.arange(TK) - starts[sorted_e])
    n_blocks = -(-(TK + N_EXPERTS * (Mb - 1)) // Mb)
    P = n_blocks * Mb
    buf_tok = jnp.full((P,), T, jnp.int32).at[dest].set(flat_tok[order])
    buf_w = jnp.zeros((P,), jnp.float32).at[dest].set(flat_w[order])
    block_e = jnp.minimum(jnp.searchsorted(pad_ends, jnp.arange(n_blocks) * Mb, side='right'), N_EXPERTS - 1)
    x_pad = jnp.concatenate([xt, jnp.zeros((1, D), xt.dtype)], axis=0)

    def expert_block(args):
        tok, e = args
        xb = x_pad[tok]
        w1 = lax.dynamic_index_in_dim(w_gate_up, e, 0, keepdims=False)
        b1 = lax.dynamic_index_in_dim(b_gate_up, e, 0, keepdims=False)
        w2 = lax.dynamic_index_in_dim(w_down, e, 0, keepdims=False)
        b2 = lax.dynamic_index_in_dim(b_down, e, 0, keepdims=False)
        return swiglu_clamped(xb @ w1 + b1) @ w2 + b2

    y = lax.map(expert_block, (buf_tok.reshape(n_blocks, Mb), block_e)).reshape(P, D)
    y = y * buf_w[:, None].astype(y.dtype)
    out = jnp.zeros((T + 1, D), y.dtype).at[buf_tok].add(y)[:T]
    return out.reshape(B, S, D)


def setup_inputs(seed: int = 0) -> dict:
    key = jax.random.key(seed)
    ks = jax.random.split(key, 26)
    L, D, E, F = DEPTH, D_MODEL, N_EXPERTS, D_FF
    nrm = lambda k, shape, fan_in: jax.random.normal(k, shape, jnp.float32) * (fan_in ** -0.5)
    gain = lambda k, shape: 1.0 + 0.02 * jax.random.normal(k, shape, jnp.float32)
    small = lambda k, shape: 0.01 * jax.random.normal(k, shape, jnp.float32)
    return {
        'x': jax.random.normal(ks[0], (BATCH, SEQ, D), jnp.float32),
        'mem': jax.random.normal(ks[1], (BATCH, MEM_LEN, D), jnp.float32),
        'g_mix': gain(ks[2], (L, D)),
        'w_in': nrm(ks[3], (L, D, IN_WIDTH), D),
        'g_sgu_v': gain(ks[4], (L, SGU_WIDTH)),
        'w_spatial': nrm(ks[5], (L, SGU_GROUPS, SGU_CHUNK, SGU_CHUNK), SGU_CHUNK),
        'b_spatial': 1.0 + 0.1 * jax.random.normal(ks[6], (L, SGU_GROUPS, SGU_CHUNK), jnp.float32),
        'g_q_moba': gain(ks[7], (L, MOBA_HEAD_DIM)),
        'g_k_moba': gain(ks[8], (L, MOBA_HEAD_DIM)),
        'g_mem': gain(ks[9], (L, D)),
        'w_mem_kv': nrm(ks[10], (L, D, 2 * MEM_WIDTH), D),
        'g_q_mem': gain(ks[11], (L, MEM_HEAD_DIM)),
        'g_k_mem': gain(ks[12], (L, MEM_HEAD_DIM)),
        'w_br_sgu': nrm(ks[13], (L, SGU_WIDTH, D), SGU_WIDTH),
        'w_br_moba': nrm(ks[14], (L, MOBA_WIDTH, D), MOBA_WIDTH),
        'w_br_mem': nrm(ks[15], (L, MEM_WIDTH, D), MEM_WIDTH),
        'w_out': nrm(ks[16], (L, D, D), D),
        'g_ffn': gain(ks[17], (L, D)),
        'w_router': nrm(ks[18], (L, D, E), D),
        'b_router': small(ks[19], (L, E)),
        'w_gate_up': nrm(ks[20], (L, E, D, 2 * F), D),
        'b_gate_up': small(ks[21], (L, E, 2 * F)),
        'w_down': nrm(ks[22], (L, E, F, D), F),
        'b_down': small(ks[23], (L, E, D)),
    }


def reference(x, mem, g_mix, w_in, g_sgu_v, w_spatial, b_spatial, g_q_moba, g_k_moba,
              g_mem, w_mem_kv, g_q_mem, g_k_mem, w_br_sgu, w_br_moba, w_br_mem, w_out,
              g_ffn, w_router, b_router, w_gate_up, b_gate_up, w_down, b_down):
    slopes = alibi_slopes(MOBA_HEADS)
    offsets = [int(o) for o in np.cumsum(SPLIT_SIZES)[:-1]]
    for l in range(DEPTH):
        h = rms_norm(x, g_mix[l])
        proj = h @ w_in[l]
        u, v_s, q_b, k_b, v_b, q_m, gate_logits = jnp.split(proj, offsets, axis=-1)
        y_a = sgu_mixer(jax.nn.gelu(u, approximate=False), jax.nn.gelu(v_s, approximate=False),
                        g_sgu_v[l], w_spatial[l], b_spatial[l])
        y_b = moba_attention(q_b, k_b, v_b, g_q_moba[l], g_k_moba[l], slopes)
        y_c = memory_attention(q_m, rms_norm(mem, g_mem[l]), w_mem_kv[l], g_q_mem[l], g_k_mem[l])
        g_a, g_b, g_c = jnp.split(jax.nn.sigmoid(gate_logits), N_BRANCHES, axis=-1)
        merged = g_a * (y_a @ w_br_sgu[l]) + g_b * (y_b @ w_br_moba[l]) + g_c * (y_c @ w_br_mem[l])
        x = x + merged @ w_out[l]
        x = x + moe_ffn(rms_norm(x, g_ffn[l]), w_router[l], b_router[l], w_gate_up[l],
                        b_gate_up[l], w_down[l], b_down[l])
    return x
```

```cpp
#include <hip/hip_runtime.h>
#include <stdint.h>
#include <cstdio>

typedef unsigned short bf16_t;
typedef short bf16x8 __attribute__((ext_vector_type(8)));
typedef float f32x4 __attribute__((ext_vector_type(4)));
typedef unsigned u32x4 __attribute__((ext_vector_type(4)));

constexpr int NBATCH = 8, SEQ = 4096, DM = 1024, T_TOK = NBATCH * SEQ, INW = 6144, MEML = 256;
constexpr int OFF_U = 0, OFF_V = 512, OFF_QB = 1024, OFF_KB = 1536, OFF_VB = 2048, OFF_QM = 2560, OFF_G = 3072;
constexpr int NEXP = 32, TOPK = 4, DFF = 1024;
constexpr float EPS = 1e-6f;
constexpr int ACT_ROWS = T_TOK * TOPK + NEXP * 256;

constexpr size_t MiB = 1ull << 20;
constexpr size_t WS_CTL = 0;
constexpr size_t WS_WIN = 1 * MiB;
constexpr size_t WS_WBR = 13 * MiB;
constexpr size_t WS_WOUT = 16 * MiB;
constexpr size_t WS_WMEM = 18 * MiB;
constexpr size_t WS_WR = 20 * MiB;
constexpr size_t WS_RSTD2 = 21 * MiB;
constexpr size_t WS_KMP = 22 * MiB;
constexpr size_t WS_TOPW = 23 * MiB;
constexpr size_t WS_LIST = 26 * MiB;
constexpr size_t WS_MEMN = 30 * MiB;
constexpr size_t WS_MKV = 34 * MiB;
constexpr size_t WS_W1 = 40 * MiB;
constexpr size_t WS_W2 = 168 * MiB;
constexpr size_t WS_MERGED = 232 * MiB;
constexpr size_t WS_X1B = 296 * MiB;
constexpr size_t WS_HB = 360 * MiB;
constexpr size_t WS_PROJ = 424 * MiB;
constexpr size_t WS_Y = 808 * MiB;
constexpr size_t WS_ACT = 360 * MiB;
constexpr size_t WS_YS = 632 * MiB;
constexpr size_t WS_SCR = 904 * MiB;
constexpr size_t WS_END = 1024 * MiB;
constexpr int CW_CNT = 64;

__device__ __forceinline__ float bf2f(bf16_t b) { return __uint_as_float(((unsigned)b) << 16); }
__device__ __forceinline__ bf16_t f2bf(float f) { unsigned u = __float_as_uint(f); u += 0x7fffu + ((u >> 16) & 1u); return (bf16_t)(u >> 16); }
__device__ __forceinline__ float wave_sum(float v) {
#pragma unroll
    for (int o = 1; o < 64; o <<= 1) v += __shfl_xor(v, o);
    return v;
}
__device__ __forceinline__ float wave_max(float v) {
#pragma unroll
    for (int o = 1; o < 64; o <<= 1) v = fmaxf(v, __shfl_xor(v, o));
    return v;
}
__device__ __forceinline__ float gelu_exact(float v) { return 0.5f * v * (1.0f + erff(v * 0.70710678118654752f)); }
__device__ __forceinline__ float sigmoidf_(float v) { return 1.0f / (1.0f + __expf(-v)); }

__global__ __launch_bounds__(256) void n_rmsnorm_rows(const float* x, const float* g, bf16_t* out, int rows) {
    const int row = blockIdx.x * 4 + (threadIdx.x >> 6), lane = threadIdx.x & 63;
    if (row >= rows) return;
    const f32x4* xr = (const f32x4*)(x + (size_t)row * DM);
    f32x4 v[4]; float s = 0.f;
#pragma unroll
    for (int j = 0; j < 4; ++j) { v[j] = xr[lane + 64 * j]; s += v[j].x * v[j].x + v[j].y * v[j].y + v[j].z * v[j].z + v[j].w * v[j].w; }
    const float rstd = rsqrtf(wave_sum(s) * (1.0f / DM) + EPS);
#pragma unroll
    for (int j = 0; j < 4; ++j) {
        const f32x4 gv = ((const f32x4*)g)[lane + 64 * j];
        bf16_t* o = out + (size_t)row * DM + (lane + 64 * j) * 4;
        o[0] = f2bf(v[j].x * rstd * gv.x); o[1] = f2bf(v[j].y * rstd * gv.y); o[2] = f2bf(v[j].z * rstd * gv.z); o[3] = f2bf(v[j].w * rstd * gv.w);
    }
}

struct MapId { __device__ int operator()(int n) const { return n; } };
struct MapW1 { __device__ int operator()(int n) const { const int m = n & 1023; return (m >> 7) * 256 + (n >> 10) * 128 + (m & 127); } };
template <class Map> __global__ __launch_bounds__(256) void n_transpose(const float* W, int K, int N, bf16_t* WT, int ldo, int koff, const float* gk, size_t sstride, size_t dstride, Map map) {
    __shared__ float t[32][33];
    const int tx = threadIdx.x & 31, ty = threadIdx.x >> 5;
    const int k0 = blockIdx.y * 32, n0 = blockIdx.x * 32;
    W += (size_t)blockIdx.z * sstride; WT += (size_t)blockIdx.z * dstride;
    for (int i = ty; i < 32; i += 8) t[i][tx] = W[(size_t)(k0 + i) * N + n0 + tx] * (gk ? gk[k0 + i] : 1.0f);
    __syncthreads();
    for (int i = ty; i < 32; i += 8) WT[(size_t)map(n0 + i) * ldo + koff + k0 + tx] = f2bf(t[tx][i]);
}
__global__ void n_router_w(const float* wr, const float* g, float* WrT) {
    const int i = blockIdx.x * blockDim.x + threadIdx.x; if (i >= 32 * 1024) return;
    const int e = i >> 10, k = i & 1023; WrT[i] = wr[k * 32 + e] * g[k];
}

struct ARowId { __device__ long operator()(int r) const { return r; } };
template <class ARow, class Epi, bool DUAL>
__global__ __launch_bounds__(256) void n_gemm(const bf16_t* A, int lda, const bf16_t* Bt, int ldb, int K, ARow arow, Epi E) {
    const int wid = threadIdx.x >> 6, lane = threadIdx.x & 63, fr = lane & 15, fq = lane >> 4;
    const int z = blockIdx.z;
    if (!E.active(z, blockIdx.y * 64)) return;
    const int row0 = blockIdx.y * 64 + (wid >> 1) * 32, col0 = blockIdx.x * 64 + (wid & 1) * 32;
    const bf16_t* Bz = Bt + E.boff(z);
    const bf16_t* ap[2]; const bf16_t* bp[2]; const bf16_t* bp2[2];
#pragma unroll
    for (int i = 0; i < 2; ++i) {
        ap[i] = A + (size_t)arow(E.arow(z, row0 + 16 * i + fr)) * lda + fq * 8;
        const int c = col0 + 16 * i + fr;
        if (DUAL) { const int br = (c >> 7) * 256 + (c & 127); bp[i] = Bz + (size_t)br * ldb + fq * 8; bp2[i] = bp[i] + (size_t)128 * ldb; }
        else { bp[i] = Bz + (size_t)c * ldb + fq * 8; bp2[i] = bp[i]; }
    }
    f32x4 acc[2][2], acc2[2][2];
#pragma unroll
    for (int i = 0; i < 2; ++i)
#pragma unroll
        for (int j = 0; j < 2; ++j) { acc[i][j] = (f32x4){0.f, 0.f, 0.f, 0.f}; acc2[i][j] = acc[i][j]; }
    for (int k = 0; k < K; k += 32) {
        bf16x8 af[2], bf[2], bf2[2];
#pragma unroll
        for (int i = 0; i < 2; ++i) { af[i] = *(const bf16x8*)(ap[i] + k); bf[i] = *(const bf16x8*)(bp[i] + k); if (DUAL) bf2[i] = *(const bf16x8*)(bp2[i] + k); }
#pragma unroll
        for (int i = 0; i < 2; ++i)
#pragma unroll
            for (int j = 0; j < 2; ++j) {
                acc[i][j] = __builtin_amdgcn_mfma_f32_16x16x32_bf16(af[i], bf[j], acc[i][j], 0, 0, 0);
                if (DUAL) acc2[i][j] = __builtin_amdgcn_mfma_f32_16x16x32_bf16(af[i], bf2[j], acc2[i][j], 0, 0, 0);
            }
    }
#pragma unroll
    for (int i = 0; i < 2; ++i)
#pragma unroll
        for (int j = 0; j < 2; ++j)
#pragma unroll
            for (int r = 0; r < 4; ++r) E(z, row0 + 16 * i + fq * 4 + r, col0 + 16 * j + fr, acc[i][j][r], acc2[i][j][r]);
}

struct EpiBase { __device__ bool active(int, int) const { return true; } __device__ size_t boff(int) const { return 0; } __device__ int arow(int, int r) const { return r; } };
struct EpiProj : EpiBase { bf16_t* P;
    __device__ void operator()(int, int r, int c, float v, float) const {
        if (c < 1024) v = gelu_exact(v); else if (c >= OFF_G) v = sigmoidf_(v);
        P[(size_t)r * INW + c] = f2bf(v); } };
struct EpiF32 : EpiBase { float* C; int ldc; __device__ void operator()(int, int r, int c, float v, float) const { C[(size_t)r * ldc + c] = v; } };
struct EpiX1 : EpiBase { const float* x; float* out; bf16_t* x1b;
    __device__ void operator()(int, int r, int c, float v, float) const { const size_t i = (size_t)r * DM + c; const float o = x[i] + v; out[i] = o; x1b[i] = f2bf(o); } };

__global__ __launch_bounds__(256) void n_merged(const bf16_t* Y, const bf16_t* WbrT, const bf16_t* PROJ, bf16_t* MERGED) {
    const int wid = threadIdx.x >> 6, lane = threadIdx.x & 63, fr = lane & 15, fq = lane >> 4;
    const int row0 = blockIdx.y * 64 + (wid >> 1) * 32, col0 = blockIdx.x * 64 + (wid & 1) * 32;
    f32x4 tot[2][2];
#pragma unroll
    for (int i = 0; i < 2; ++i)
#pragma unroll
        for (int j = 0; j < 2; ++j) tot[i][j] = (f32x4){0.f, 0.f, 0.f, 0.f};
    for (int br = 0; br < 3; ++br) {
        f32x4 acc[2][2];
#pragma unroll
        for (int i = 0; i < 2; ++i)
#pragma unroll
            for (int j = 0; j < 2; ++j) acc[i][j] = (f32x4){0.f, 0.f, 0.f, 0.f};
        for (int k = br * 512; k < br * 512 + 512; k += 32) {
            bf16x8 af[2], bf[2];
#pragma unroll
            for (int i = 0; i < 2; ++i) { af[i] = *(const bf16x8*)(Y + (size_t)(row0 + 16 * i + fr) * 1536 + fq * 8 + k); bf[i] = *(const bf16x8*)(WbrT + (size_t)(col0 + 16 * i + fr) * 1536 + fq * 8 + k); }
#pragma unroll
            for (int i = 0; i < 2; ++i)
#pragma unroll
                for (int j = 0; j < 2; ++j) acc[i][j] = __builtin_amdgcn_mfma_f32_16x16x32_bf16(af[i], bf[j], acc[i][j], 0, 0, 0);
        }
#pragma unroll
        for (int i = 0; i < 2; ++i)
#pragma unroll
            for (int j = 0; j < 2; ++j)
#pragma unroll
                for (int r = 0; r < 4; ++r) { const int row = row0 + 16 * i + fq * 4 + r, col = col0 + 16 * j + fr; tot[i][j][r] += bf2f(PROJ[(size_t)row * INW + OFF_G + br * 1024 + col]) * acc[i][j][r]; }
    }
#pragma unroll
    for (int i = 0; i < 2; ++i)
#pragma unroll
        for (int j = 0; j < 2; ++j)
#pragma unroll
            for (int r = 0; r < 4; ++r) MERGED[(size_t)(row0 + 16 * i + fq * 4 + r) * DM + col0 + 16 * j + fr] = f2bf(tot[i][j][r]);
}

__global__ __launch_bounds__(256) void n_norm_heads64(bf16_t* PROJ, int off, const float* g) {
    const int w = blockIdx.x * 4 + (threadIdx.x >> 6), lane = threadIdx.x & 63;
    const int t = w >> 3, h = w & 7;
    bf16_t* p = PROJ + (size_t)t * INW + off + h * 64 + lane;
    const float v = bf2f(*p); const float rstd = rsqrtf(wave_sum(v * v) * (1.0f / 64.0f) + EPS);
    *p = f2bf(v * rstd * g[lane]);
}
__global__ __launch_bounds__(512) void n_kmean(const bf16_t* PROJ, float* KMP) {
    const int bb = blockIdx.x, c = threadIdx.x;
    float s = 0.f; for (int r = 0; r < 256; ++r) s += bf2f(PROJ[((size_t)bb * 256 + r) * INW + OFF_KB + c]);
    KMP[((size_t)bb * 2 + 0) * 512 + c] = s; KMP[((size_t)bb * 2 + 1) * 512 + c] = 0.f;
}
__global__ __launch_bounds__(256) void n_memkv_norm(const float* raw, const float* g, bf16_t* MKV) {
    const int w = blockIdx.x * 4 + (threadIdx.x >> 6), lane = threadIdx.x & 63;
    const int r = w >> 2, h = w & 3;
    const float* p = raw + (size_t)r * 1024 + h * 128;
    const float a = p[lane], b = p[lane + 64];
    const float rstd = rsqrtf(wave_sum(a * a + b * b) * (1.0f / 128.0f) + EPS);
    bf16_t* o = MKV + (size_t)r * 1024 + h * 128;
    o[lane] = f2bf(a * rstd * g[lane]); o[lane + 64] = f2bf(b * rstd * g[lane + 64]);
    o[512 + lane] = f2bf(p[512 + lane]); o[512 + lane + 64] = f2bf(p[512 + lane + 64]);
}
__global__ __launch_bounds__(256) void n_sgu_prep(const bf16_t* PROJ, const float* g, float* VN) {
    const int t = blockIdx.x * 4 + (threadIdx.x >> 6), lane = threadIdx.x & 63;
    float v[8]; float s = 0.f;
#pragma unroll
    for (int j = 0; j < 8; ++j) { v[j] = bf2f(PROJ[(size_t)t * INW + OFF_V + lane + 64 * j]); s += v[j] * v[j]; }
    const float rstd = rsqrtf(wave_sum(s) * (1.0f / 512.0f) + EPS);
#pragma unroll
    for (int j = 0; j < 8; ++j) VN[(size_t)t * 512 + lane + 64 * j] = v[j] * rstd * g[lane + 64 * j];
}
__global__ __launch_bounds__(256) void n_sgu(const bf16_t* PROJ, const float* VN, const float* ws, const float* bs, bf16_t* Y) {
    const int i = blockIdx.x * 256 + threadIdx.x; const int t = i >> 9, c = i & 511, g = c >> 7;
    const int tl = t & 127, t0 = t - tl;
    float s = bs[g * 128 + tl];
    const float* w = ws + ((size_t)g * 128 + tl) * 128;
    for (int sidx = 0; sidx <= tl; ++sidx) s += w[sidx] * VN[(size_t)(t0 + sidx) * 512 + c];
    Y[(size_t)t * 1536 + c] = f2bf(bf2f(PROJ[(size_t)t * INW + OFF_U + c]) * s);
}
__global__ __launch_bounds__(64) void n_moba(const bf16_t* PROJ, const float* KMP, bf16_t* Y) {
    const int idx = blockIdx.x; const int t = idx & (SEQ - 1), h = (idx >> 12) & 7, b = idx >> 15;
    const int lane = threadIdx.x;
    __shared__ float qs[64]; __shared__ float ps[1024];
    const size_t rowq = (size_t)b * SEQ + t;
    qs[lane] = bf2f(PROJ[rowq * INW + OFF_QB + h * 64 + lane]);
    __syncthreads();
    const int jb = t >> 8;
    float gate = -1e30f;
    if (lane < 16 && lane < jb) {
        float s = 0.f; const float* k0 = KMP + ((size_t)(b * 16 + lane) * 2) * 512 + h * 64;
        for (int d = 0; d < 64; ++d) s += qs[d] * ((k0[d] + k0[512 + d]) * (1.0f / 256.0f));
        gate = s;
    }
    int blk[4];
#pragma unroll
    for (int i = 0; i < 3; ++i) {
        float m = gate; int mi = lane;
#pragma unroll
        for (int o = 1; o < 64; o <<= 1) { const float om = __shfl_xor(m, o); const int oi = __shfl_xor(mi, o); if (om > m || (om == m && oi < mi)) { m = om; mi = oi; } }
        blk[i] = (m > -5e29f) ? mi : -1;
        if (lane == mi) gate = -3e38f;
    }
    blk[3] = jb;
    const float slope = exp2f(-(float)(h + 1));
    float mx = -3e38f;
#pragma unroll
    for (int i = 0; i < 4; ++i) {
        for (int r = 0; r < 4; ++r) {
            const int j = lane + 64 * r; float s = -1e30f;
            if (blk[i] >= 0) {
                const int key = blk[i] * 256 + j;
                if (i < 3 || key <= t) {
                    const bf16_t* kp = PROJ + ((size_t)b * SEQ + key) * INW + OFF_KB + h * 64; float d = 0.f;
                    for (int e = 0; e < 64; ++e) d += qs[e] * bf2f(kp[e]);
                    s = d * 0.125f - slope * (float)(t - key);
                }
            }
            ps[i * 256 + j] = s; mx = fmaxf(mx, s);
        }
    }
    mx = wave_max(mx);
    float sum = 0.f;
    for (int i = lane; i < 1024; i += 64) { const float p = __expf(ps[i] - mx); ps[i] = p; sum += p; }
    sum = wave_sum(sum);
    __syncthreads();
    float o = 0.f;
#pragma unroll
    for (int i = 0; i < 4; ++i) {
        if (blk[i] < 0) continue;
        for (int j = 0; j < 256; ++j) { const float p = ps[i * 256 + j]; if (p != 0.f) o += p * bf2f(PROJ[((size_t)b * SEQ + blk[i] * 256 + j) * INW + OFF_VB + h * 64 + lane]); }
    }
    Y[rowq * 1536 + 512 + h * 64 + lane] = f2bf(o / sum);
}
__global__ __launch_bounds__(64) void n_memattn(const bf16_t* PROJ, const bf16_t* MKV, const float* gq, bf16_t* Y) {
    const int idx = blockIdx.x; const int h = idx & 3, tt = idx >> 2, b = tt >> 12;
    const int lane = threadIdx.x;
    __shared__ float qs[128]; __shared__ float ps[256];
    const float a = bf2f(PROJ[(size_t)tt * INW + OFF_QM + h * 128 + lane]), c = bf2f(PROJ[(size_t)tt * INW + OFF_QM + h * 128 + 64 + lane]);
    const float rstd = rsqrtf(wave_sum(a * a + c * c) * (1.0f / 128.0f) + EPS);
    qs[lane] = a * rstd * gq[lane]; qs[lane + 64] = c * rstd * gq[lane + 64];
    __syncthreads();
    float mx = -3e38f;
    for (int r = 0; r < 4; ++r) {
        const int m = lane + 64 * r; const bf16_t* kp = MKV + ((size_t)b * MEML + m) * 1024 + h * 128; float d = 0.f;
        for (int e = 0; e < 128; ++e) d += qs[e] * bf2f(kp[e]);
        d *= 0.08838834764831845f; ps[m] = d; mx = fmaxf(mx, d);
    }
    mx = wave_max(mx);
    float sum = 0.f;
    for (int i = lane; i < 256; i += 64) { const float p = __expf(ps[i] - mx); ps[i] = p; sum += p; }
    sum = wave_sum(sum);
    __syncthreads();
    float o0 = 0.f, o1 = 0.f;
    for (int m = 0; m < 256; ++m) { const float p = ps[m]; const bf16_t* vp = MKV + ((size_t)b * MEML + m) * 1024 + 512 + h * 128; o0 += p * bf2f(vp[lane]); o1 += p * bf2f(vp[lane + 64]); }
    Y[(size_t)tt * 1536 + 1024 + h * 128 + lane] = f2bf(o0 / sum); Y[(size_t)tt * 1536 + 1024 + h * 128 + 64 + lane] = f2bf(o1 / sum);
}
__global__ __launch_bounds__(256) void n_router(const float* X1, const float* WrT, const float* br, float* RSTD2, float* TOPW, int* LIST, unsigned* cnt) {
    const int tl = threadIdx.x >> 5, e = threadIdx.x & 31; const int t = blockIdx.x * 8 + tl;
    const float* xr = X1 + (size_t)t * DM; const float* w = WrT + (size_t)e * DM;
    float ss = 0.f, acc = 0.f;
    for (int k = 0; k < DM; ++k) { const float xv = xr[k]; ss += xv * xv; acc += xv * w[k]; }
    const float rstd = rsqrtf(ss * (1.0f / DM) + EPS);
    float logit = acc * rstd + br[e];
    if (e == 0) RSTD2[t] = rstd;
    float sel_l[4]; int sel_e[4]; float cur = logit;
#pragma unroll
    for (int i = 0; i < 4; ++i) {
        float m = cur; int mi = e;
#pragma unroll
        for (int o = 1; o < 32; o <<= 1) { const float om = __shfl_xor(m, o); const int oi = __shfl_xor(mi, o); if (om > m || (om == m && oi < mi)) { m = om; mi = oi; } }
        sel_l[i] = m; sel_e[i] = mi; if (e == mi) cur = -3e38f;
    }
    if (e < 4) {
        float den = 0.f;
#pragma unroll
        for (int i = 0; i < 4; ++i) den += __expf(sel_l[i] - sel_l[0]);
        float myl = sel_l[0]; int mye = sel_e[0];
#pragma unroll
        for (int i = 1; i < 4; ++i) if (e == i) { myl = sel_l[i]; mye = sel_e[i]; }
        const float wgt = __expf(myl - sel_l[0]) / den;
        const unsigned pos = atomicAdd(cnt + mye, 1u);
        LIST[mye * 32768 + pos] = t * 4 + e; TOPW[t * 4 + e] = wgt;
    }
}
__device__ __forceinline__ int expert_base(const unsigned* cnt, int e) { int b = 0; for (int i = 0; i < e; ++i) b += (int)((cnt[i] + 255u) & ~255u); return b; }
struct EpiExp1 { const unsigned* cnt; const int* LIST; const float* RSTD2; const float* b1; bf16_t* ACT;
    __device__ bool active(int z, int r0) const { return r0 < (int)cnt[z]; }
    __device__ size_t boff(int z) const { return (size_t)z * 2048 * 1024; }
    __device__ int arow(int z, int r) const { return r < (int)cnt[z] ? (LIST[z * 32768 + r] >> 2) : 0; }
    __device__ void operator()(int z, int r, int c, float vg, float vl) const {
        if (r >= (int)cnt[z]) return;
        const int tok = LIST[z * 32768 + r] >> 2; const float rs = RSTD2[tok];
        float g = rs * vg + b1[z * 2048 + c], l = rs * vl + b1[z * 2048 + 1024 + c];
        g = fminf(g, 7.0f); l = fminf(fmaxf(l, -7.0f), 7.0f);
        ACT[(size_t)(expert_base(cnt, z) + r) * DFF + c] = f2bf(g * sigmoidf_(1.702f * g) * (l + 1.0f)); } };
struct EpiExp2 { const unsigned* cnt; const int* LIST; const float* TOPW; const float* b2; bf16_t* YS;
    __device__ bool active(int z, int r0) const { return r0 < (int)cnt[z]; }
    __device__ size_t boff(int z) const { return (size_t)z * 1024 * 1024; }
    __device__ int arow(int z, int r) const { return expert_base(cnt, z) + r; }
    __device__ void operator()(int z, int r, int c, float v, float) const {
        if (r >= (int)cnt[z]) return;
        const int slot = LIST[z * 32768 + r];
        YS[(size_t)slot * DM + c] = f2bf((v + b2[z * 1024 + c]) * TOPW[slot]); } };
__global__ __launch_bounds__(256) void n_combine(float* out, const bf16_t* YS) {
    const size_t i = (size_t)blockIdx.x * 256 + threadIdx.x; const size_t t = i >> 10, c = i & 1023;
    float s = out[i];
#pragma unroll
    for (int k = 0; k < 4; ++k) s += bf2f(YS[(t * 4 + k) * DM + c]);
    out[i] = s;
}

extern "C" void kernel_launch(void* const* d_in, const int* in_sizes, int n_in, void* d_out, int out_size, void* d_ws, size_t ws_size, hipStream_t stream) {
    if (n_in != 24 || ws_size < WS_END) { fprintf(stderr, "kernel_launch: unexpected n_in %d or ws %zu\n", n_in, ws_size); return; }
    const float* x = (const float*)d_in[0];        const float* mem = (const float*)d_in[1];     const float* g_mix = (const float*)d_in[2];
    const float* w_in = (const float*)d_in[3];     const float* g_sgu_v = (const float*)d_in[4]; const float* w_spatial = (const float*)d_in[5];
    const float* b_spatial = (const float*)d_in[6]; const float* g_q_moba = (const float*)d_in[7]; const float* g_k_moba = (const float*)d_in[8];
    const float* g_mem = (const float*)d_in[9];    const float* w_mem_kv = (const float*)d_in[10]; const float* g_q_mem = (const float*)d_in[11];
    const float* g_k_mem = (const float*)d_in[12]; const float* w_br_sgu = (const float*)d_in[13]; const float* w_br_moba = (const float*)d_in[14];
    const float* w_br_mem = (const float*)d_in[15]; const float* w_out = (const float*)d_in[16];  const float* g_ffn = (const float*)d_in[17];
    const float* w_router = (const float*)d_in[18]; const float* b_router = (const float*)d_in[19]; const float* w_gate_up = (const float*)d_in[20];
    const float* b_gate_up = (const float*)d_in[21]; const float* w_down = (const float*)d_in[22]; const float* b_down = (const float*)d_in[23];
    float* out = (float*)d_out; unsigned char* ws = (unsigned char*)d_ws;
    unsigned* ctl = (unsigned*)(ws + WS_CTL);
    bf16_t *WinT = (bf16_t*)(ws + WS_WIN), *WbrT = (bf16_t*)(ws + WS_WBR), *WoutT = (bf16_t*)(ws + WS_WOUT), *WmemT = (bf16_t*)(ws + WS_WMEM);
    float* WrT = (float*)(ws + WS_WR); float* RSTD2 = (float*)(ws + WS_RSTD2); float* KMP = (float*)(ws + WS_KMP); float* TOPW = (float*)(ws + WS_TOPW);
    int* LIST = (int*)(ws + WS_LIST);
    bf16_t *MEMN = (bf16_t*)(ws + WS_MEMN), *MKV = (bf16_t*)(ws + WS_MKV), *W1T = (bf16_t*)(ws + WS_W1), *W2T = (bf16_t*)(ws + WS_W2);
    bf16_t *MERGED = (bf16_t*)(ws + WS_MERGED), *X1B = (bf16_t*)(ws + WS_X1B), *HB = (bf16_t*)(ws + WS_HB), *PROJ = (bf16_t*)(ws + WS_PROJ), *Y = (bf16_t*)(ws + WS_Y);
    bf16_t *ACT = (bf16_t*)(ws + WS_ACT), *YS = (bf16_t*)(ws + WS_YS);
    float* SCR = (float*)(ws + WS_SCR);

    hipMemsetAsync(ws + WS_CTL, 0, 1 * MiB, stream);
    n_rmsnorm_rows<<<T_TOK / 4, 256, 0, stream>>>(x, g_mix, HB, T_TOK);
    n_rmsnorm_rows<<<NBATCH * MEML / 4, 256, 0, stream>>>(mem, g_mem, MEMN, NBATCH * MEML);
    n_transpose<MapId><<<dim3(INW / 32, DM / 32, 1), 256, 0, stream>>>(w_in, DM, INW, WinT, DM, 0, nullptr, 0, 0, MapId());
    n_transpose<MapId><<<dim3(DM / 32, 512 / 32, 1), 256, 0, stream>>>(w_br_sgu, 512, DM, WbrT, 1536, 0, nullptr, 0, 0, MapId());
    n_transpose<MapId><<<dim3(DM / 32, 512 / 32, 1), 256, 0, stream>>>(w_br_moba, 512, DM, WbrT, 1536, 512, nullptr, 0, 0, MapId());
    n_transpose<MapId><<<dim3(DM / 32, 512 / 32, 1), 256, 0, stream>>>(w_br_mem, 512, DM, WbrT, 1536, 1024, nullptr, 0, 0, MapId());
    n_transpose<MapId><<<dim3(DM / 32, DM / 32, 1), 256, 0, stream>>>(w_out, DM, DM, WoutT, DM, 0, nullptr, 0, 0, MapId());
    n_transpose<MapId><<<dim3(DM / 32, DM / 32, 1), 256, 0, stream>>>(w_mem_kv, DM, DM, WmemT, DM, 0, nullptr, 0, 0, MapId());
    n_transpose<MapW1><<<dim3(2048 / 32, DM / 32, NEXP), 256, 0, stream>>>(w_gate_up, DM, 2048, W1T, DM, 0, g_ffn, (size_t)DM * 2048, (size_t)2048 * DM, MapW1());
    n_transpose<MapId><<<dim3(DM / 32, DFF / 32, NEXP), 256, 0, stream>>>(w_down, DFF, DM, W2T, DFF, 0, nullptr, (size_t)DFF * DM, (size_t)DM * DFF, MapId());
    n_router_w<<<128, 256, 0, stream>>>(w_router, g_ffn, WrT);
    { EpiProj E; E.P = PROJ; n_gemm<ARowId, EpiProj, false><<<dim3(INW / 64, T_TOK / 64, 1), 256, 0, stream>>>(HB, DM, WinT, DM, DM, ARowId(), E); }
    { EpiF32 E; E.C = SCR; E.ldc = 1024; n_gemm<ARowId, EpiF32, false><<<dim3(1024 / 64, 2048 / 64, 1), 256, 0, stream>>>(MEMN, DM, WmemT, DM, DM, ARowId(), E); }
    n_memkv_norm<<<2048 * 4 / 4, 256, 0, stream>>>(SCR, g_k_mem, MKV);
    n_norm_heads64<<<T_TOK * 8 / 4, 256, 0, stream>>>(PROJ, OFF_QB, g_q_moba);
    n_norm_heads64<<<T_TOK * 8 / 4, 256, 0, stream>>>(PROJ, OFF_KB, g_k_moba);
    n_kmean<<<NBATCH * 16, 512, 0, stream>>>(PROJ, KMP);
    n_sgu_prep<<<T_TOK / 4, 256, 0, stream>>>(PROJ, g_sgu_v, SCR);
    n_sgu<<<T_TOK * 512 / 256, 256, 0, stream>>>(PROJ, SCR, w_spatial, b_spatial, Y);
    n_moba<<<NBATCH * 8 * SEQ, 64, 0, stream>>>(PROJ, KMP, Y);
    n_memattn<<<T_TOK * 4, 64, 0, stream>>>(PROJ, MKV, g_q_mem, Y);
    n_merged<<<dim3(DM / 64, T_TOK / 64), 256, 0, stream>>>(Y, WbrT, PROJ, MERGED);
    { EpiX1 E; E.x = x; E.out = out; E.x1b = X1B; n_gemm<ARowId, EpiX1, false><<<dim3(DM / 64, T_TOK / 64, 1), 256, 0, stream>>>(MERGED, DM, WoutT, DM, DM, ARowId(), E); }
    n_router<<<T_TOK / 8, 256, 0, stream>>>(out, WrT, b_router, RSTD2, TOPW, LIST, ctl + CW_CNT);
    { EpiExp1 E; E.cnt = ctl + CW_CNT; E.LIST = LIST; E.RSTD2 = RSTD2; E.b1 = b_gate_up; E.ACT = ACT;
      n_gemm<ARowId, EpiExp1, true><<<dim3(DFF / 64, T_TOK / 64, NEXP), 256, 0, stream>>>(X1B, DM, W1T, DM, DM, ARowId(), E); }
    { EpiExp2 E; E.cnt = ctl + CW_CNT; E.LIST = LIST; E.TOPW = TOPW; E.b2 = b_down; E.YS = YS;
      n_gemm<ARowId, EpiExp2, false><<<dim3(DM / 64, T_TOK / 64, NEXP), 256, 0, stream>>>(ACT, DFF, W2T, DFF, DFF, ARowId(), E); }
    n_combine<<<T_TOK * DM / 256, 256, 0, stream>>>(out, YS);
}
```

```cpp
#include <hip/hip_runtime.h>
#include <stdint.h>
#include <cstdio>

typedef unsigned short bf16_t;
typedef short bf16x8 __attribute__((ext_vector_type(8)));
typedef float f32x4 __attribute__((ext_vector_type(4)));
typedef unsigned u32x4 __attribute__((ext_vector_type(4)));

constexpr int NBATCH = 8, SEQ = 4096, DM = 1024, T_TOK = NBATCH * SEQ, INW = 6144, MEML = 256;
constexpr int OFF_U = 0, OFF_V = 512, OFF_QB = 1024, OFF_KB = 1536, OFF_VB = 2048, OFF_QM = 2560, OFF_G = 3072;
constexpr int NEXP = 32, TOPK = 4, DFF = 1024;
constexpr float EPS = 1e-6f;
constexpr int ACT_ROWS = T_TOK * TOPK + NEXP * 256;

constexpr size_t MiB = 1ull << 20;
constexpr size_t WS_CTL = 0;
constexpr size_t WS_WIN = 1 * MiB;
constexpr size_t WS_WBR = 13 * MiB;
constexpr size_t WS_WOUT = 16 * MiB;
constexpr size_t WS_WMEM = 18 * MiB;
constexpr size_t WS_WR = 20 * MiB;
constexpr size_t WS_RSTD2 = 21 * MiB;
constexpr size_t WS_WSB = 21 * MiB + 256 * 1024;
constexpr size_t WS_KMP = 22 * MiB;
constexpr size_t WS_TOPW = 23 * MiB;
constexpr size_t WS_LIST = 24 * MiB;
constexpr size_t WS_RSTDS = 28 * MiB;
constexpr size_t WS_TOPWS = 32 * MiB;
constexpr size_t WS_MEMN = 36 * MiB;
constexpr size_t WS_MKV = 40 * MiB;
constexpr size_t WS_W1 = 44 * MiB;
constexpr size_t WS_W2 = 172 * MiB;
constexpr size_t WS_MERGED = 236 * MiB;
constexpr size_t WS_X1B = 300 * MiB;
constexpr size_t WS_HB = 364 * MiB;
constexpr size_t WS_PROJ = 428 * MiB;
constexpr size_t WS_Y = 812 * MiB;
constexpr size_t WS_ACT = 364 * MiB;
constexpr size_t WS_YS = 636 * MiB;
constexpr size_t WS_SCR = 908 * MiB;
constexpr size_t WS_END = 1024 * MiB;
constexpr int CW_CNT = 64;

__device__ __forceinline__ float bf2f(bf16_t b) { return __uint_as_float(((unsigned)b) << 16); }
__device__ __forceinline__ bf16_t f2bf(float f) { unsigned u = __float_as_uint(f); u += 0x7fffu + ((u >> 16) & 1u); return (bf16_t)(u >> 16); }
__device__ __forceinline__ float wave_sum(float v) {
#pragma unroll
    for (int o = 1; o < 64; o <<= 1) v += __shfl_xor(v, o);
    return v;
}
__device__ __forceinline__ float wave_max(float v) {
#pragma unroll
    for (int o = 1; o < 64; o <<= 1) v = fmaxf(v, __shfl_xor(v, o));
    return v;
}
__device__ __forceinline__ float gelu_exact(float v) { return 0.5f * v * (1.0f + erff(v * 0.70710678118654752f)); }
__device__ __forceinline__ float sigmoidf_(float v) { return 1.0f / (1.0f + __expf(-v)); }

__global__ __launch_bounds__(256) void n_rmsnorm_rows(const float* x, const float* g, bf16_t* out, int rows) {
    const int row = blockIdx.x * 4 + (threadIdx.x >> 6), lane = threadIdx.x & 63;
    if (row >= rows) return;
    const f32x4* xr = (const f32x4*)(x + (size_t)row * DM);
    f32x4 v[4]; float s = 0.f;
#pragma unroll
    for (int j = 0; j < 4; ++j) { v[j] = xr[lane + 64 * j]; s += v[j].x * v[j].x + v[j].y * v[j].y + v[j].z * v[j].z + v[j].w * v[j].w; }
    const float rstd = rsqrtf(wave_sum(s) * (1.0f / DM) + EPS);
#pragma unroll
    for (int j = 0; j < 4; ++j) {
        const f32x4 gv = ((const f32x4*)g)[lane + 64 * j];
        bf16_t* o = out + (size_t)row * DM + (lane + 64 * j) * 4;
        o[0] = f2bf(v[j].x * rstd * gv.x); o[1] = f2bf(v[j].y * rstd * gv.y); o[2] = f2bf(v[j].z * rstd * gv.z); o[3] = f2bf(v[j].w * rstd * gv.w);
    }
}

struct MapId { __device__ int operator()(int n) const { return n; } };
struct MapWin { __device__ int operator()(int n) const { return (n >= 1024 && n < 2048) ? (n & ~255) + 128 * ((n >> 5) & 1) + 32 * ((n >> 6) & 3) + (n & 31) : n; } };
struct MapW1 { __device__ int operator()(int n) const { const int m = n & 1023; return (m >> 7) * 256 + (n >> 10) * 128 + (m & 127); } };
template <class Map> __global__ __launch_bounds__(256) void n_transpose(const float* W, int K, int N, bf16_t* WT, int ldo, int koff, const float* gk, size_t sstride, size_t dstride) {
    const Map map;
    __shared__ float t[32][33];
    const int tx = threadIdx.x & 31, ty = threadIdx.x >> 5;
    const int k0 = blockIdx.y * 32, n0 = blockIdx.x * 32;
    W += (size_t)blockIdx.z * sstride; WT += (size_t)blockIdx.z * dstride;
    for (int i = ty; i < 32; i += 8) t[i][tx] = W[(size_t)(k0 + i) * N + n0 + tx] * (gk ? gk[k0 + i] : 1.0f);
    __syncthreads();
    for (int i = ty; i < 32; i += 8) WT[(size_t)map(n0 + i) * ldo + koff + k0 + tx] = f2bf(t[tx][i]);
}
__global__ void n_router_w(const float* wr, const float* g, float* WrT) {
    const int i = blockIdx.x * blockDim.x + threadIdx.x; if (i >= 32 * 1024) return;
    const int e = i >> 10, k = i & 1023; WrT[i] = wr[k * 32 + e] * g[k];
}

template <class Epi, bool DUAL>
__global__ __launch_bounds__(256) void n_gemm(const bf16_t* A, int lda, const bf16_t* Bt, int ldb, int K, Epi E) {
    const int wid = threadIdx.x >> 6, lane = threadIdx.x & 63, fr = lane & 15, fq = lane >> 4;
    const int z = blockIdx.z;
    if (!E.active(z, blockIdx.y * 64)) return;
    const int row0 = blockIdx.y * 64 + (wid >> 1) * 32, col0 = blockIdx.x * 64 + (wid & 1) * 32;
    const bf16_t* Bz = Bt + E.boff(z);
    const bf16_t* ap[2]; const bf16_t* bp[2]; const bf16_t* bp2[2];
#pragma unroll
    for (int i = 0; i < 2; ++i) {
        ap[i] = A + (size_t)E.arow(z, row0 + 16 * i + fr) * lda + fq * 8;
        const int c = col0 + 16 * i + fr;
        if (DUAL) { const int br = (c >> 7) * 256 + (c & 127); bp[i] = Bz + (size_t)br * ldb + fq * 8; bp2[i] = bp[i] + (size_t)128 * ldb; }
        else { bp[i] = Bz + (size_t)c * ldb + fq * 8; bp2[i] = bp[i]; }
    }
    f32x4 acc[2][2], acc2[2][2];
#pragma unroll
    for (int i = 0; i < 2; ++i)
#pragma unroll
        for (int j = 0; j < 2; ++j) { acc[i][j] = (f32x4){0.f, 0.f, 0.f, 0.f}; acc2[i][j] = acc[i][j]; }
    for (int k = 0; k < K; k += 32) {
        bf16x8 af[2], bf[2], bf2[2];
#pragma unroll
        for (int i = 0; i < 2; ++i) { af[i] = *(const bf16x8*)(ap[i] + k); bf[i] = *(const bf16x8*)(bp[i] + k); if (DUAL) bf2[i] = *(const bf16x8*)(bp2[i] + k); }
#pragma unroll
        for (int i = 0; i < 2; ++i)
#pragma unroll
            for (int j = 0; j < 2; ++j) {
                acc[i][j] = __builtin_amdgcn_mfma_f32_16x16x32_bf16(af[i], bf[j], acc[i][j], 0, 0, 0);
                if (DUAL) acc2[i][j] = __builtin_amdgcn_mfma_f32_16x16x32_bf16(af[i], bf2[j], acc2[i][j], 0, 0, 0);
            }
    }
#pragma unroll
    for (int i = 0; i < 2; ++i)
#pragma unroll
        for (int j = 0; j < 2; ++j)
#pragma unroll
            for (int r = 0; r < 4; ++r) E(z, row0 + 16 * i + fq * 4 + r, col0 + 16 * j + fr, acc[i][j][r], acc2[i][j][r]);
}

struct EpiBase { __device__ bool active(int, int) const { return true; } __device__ size_t boff(int) const { return 0; } __device__ int arow(int, int r) const { return r; } };
struct EpiProj : EpiBase { bf16_t* P;
    __device__ void operator()(int, int r, int c, float v, float) const {
        if (c < 1024) v = gelu_exact(v); else if (c >= OFF_G) v = sigmoidf_(v);
        if (c >= 1024 && c < 2048) { const int cl = c & 255; c = (c & ~255) + 64 * ((cl >> 5) & 3) + 32 * (cl >> 7) + (cl & 31); }
        P[(size_t)r * INW + c] = f2bf(v); } };
struct EpiF32 : EpiBase { float* C; int ldc; int pad; __device__ void operator()(int, int r, int c, float v, float) const { C[(size_t)r * ldc + c] = v; } };
struct EpiX1 : EpiBase { const float* x; float* out; bf16_t* x1b;
    __device__ void operator()(int, int r, int c, float v, float) const { const size_t i = (size_t)r * DM + c; const float o = x[i] + v; out[i] = o; x1b[i] = f2bf(o); } };

__global__ __launch_bounds__(256) void n_merged(const bf16_t* Y, const bf16_t* WbrT, const bf16_t* PROJ, bf16_t* MERGED) {
    const int wid = threadIdx.x >> 6, lane = threadIdx.x & 63, fr = lane & 15, fq = lane >> 4;
    const int row0 = blockIdx.y * 64 + (wid >> 1) * 32, col0 = blockIdx.x * 64 + (wid & 1) * 32;
    f32x4 tot[2][2];
#pragma unroll
    for (int i = 0; i < 2; ++i)
#pragma unroll
        for (int j = 0; j < 2; ++j) tot[i][j] = (f32x4){0.f, 0.f, 0.f, 0.f};
    for (int br = 0; br < 3; ++br) {
        f32x4 acc[2][2];
#pragma unroll
        for (int i = 0; i < 2; ++i)
#pragma unroll
            for (int j = 0; j < 2; ++j) acc[i][j] = (f32x4){0.f, 0.f, 0.f, 0.f};
        for (int k = br * 512; k < br * 512 + 512; k += 32) {
            bf16x8 af[2], bf[2];
#pragma unroll
            for (int i = 0; i < 2; ++i) { af[i] = *(const bf16x8*)(Y + (size_t)(row0 + 16 * i + fr) * 1536 + fq * 8 + k); bf[i] = *(const bf16x8*)(WbrT + (size_t)(col0 + 16 * i + fr) * 1536 + fq * 8 + k); }
#pragma unroll
            for (int i = 0; i < 2; ++i)
#pragma unroll
                for (int j = 0; j < 2; ++j) acc[i][j] = __builtin_amdgcn_mfma_f32_16x16x32_bf16(af[i], bf[j], acc[i][j], 0, 0, 0);
        }
#pragma unroll
        for (int i = 0; i < 2; ++i)
#pragma unroll
            for (int j = 0; j < 2; ++j)
#pragma unroll
                for (int r = 0; r < 4; ++r) { const int row = row0 + 16 * i + fq * 4 + r, col = col0 + 16 * j + fr; tot[i][j][r] += bf2f(PROJ[(size_t)row * INW + OFF_G + br * 1024 + col]) * acc[i][j][r]; }
    }
#pragma unroll
    for (int i = 0; i < 2; ++i)
#pragma unroll
        for (int j = 0; j < 2; ++j)
#pragma unroll
            for (int r = 0; r < 4; ++r) MERGED[(size_t)(row0 + 16 * i + fq * 4 + r) * DM + col0 + 16 * j + fr] = f2bf(tot[i][j][r]);
}

__global__ __launch_bounds__(256) void n_norm_heads64(bf16_t* PROJ, int off, const float* g) {
    const int w = blockIdx.x * 4 + (threadIdx.x >> 6), lane = threadIdx.x & 63;
    const int t = w >> 3, h = w & 7;
    bf16_t* p = PROJ + (size_t)t * INW + off + h * 64 + lane;
    const float v = bf2f(*p); const float rstd = rsqrtf(wave_sum(v * v) * (1.0f / 64.0f) + EPS);
    *p = f2bf(v * rstd * g[lane]);
}
__global__ __launch_bounds__(512) void n_kmean(const bf16_t* PROJ, float* KMP) {
    const int bb = blockIdx.x, c = threadIdx.x;
    float s = 0.f; for (int r = 0; r < 256; ++r) s += bf2f(PROJ[((size_t)bb * 256 + r) * INW + OFF_KB + c]);
    KMP[((size_t)bb * 2 + 0) * 512 + c] = s; KMP[((size_t)bb * 2 + 1) * 512 + c] = 0.f;
}
__global__ __launch_bounds__(256) void n_memkv_norm(const float* raw, const float* g, bf16_t* MKV) {
    const int w = blockIdx.x * 4 + (threadIdx.x >> 6), lane = threadIdx.x & 63;
    const int r = w >> 2, h = w & 3;
    const float* p = raw + (size_t)r * 1024 + h * 128;
    const float a = p[lane], b = p[lane + 64];
    const float rstd = rsqrtf(wave_sum(a * a + b * b) * (1.0f / 128.0f) + EPS);
    bf16_t* o = MKV + (size_t)r * 1024 + h * 128;
    o[lane] = f2bf(a * rstd * g[lane]); o[lane + 64] = f2bf(b * rstd * g[lane + 64]);
    o[512 + lane] = f2bf(p[512 + lane]); o[512 + lane + 64] = f2bf(p[512 + lane + 64]);
}
__global__ __launch_bounds__(256) void n_sgu_prep(const bf16_t* PROJ, const float* g, float* VN) {
    const int t = blockIdx.x * 4 + (threadIdx.x >> 6), lane = threadIdx.x & 63;
    float v[8]; float s = 0.f;
#pragma unroll
    for (int j = 0; j < 8; ++j) { v[j] = bf2f(PROJ[(size_t)t * INW + OFF_V + lane + 64 * j]); s += v[j] * v[j]; }
    const float rstd = rsqrtf(wave_sum(s) * (1.0f / 512.0f) + EPS);
#pragma unroll
    for (int j = 0; j < 8; ++j) VN[(size_t)t * 512 + lane + 64 * j] = v[j] * rstd * g[lane + 64 * j];
}
__global__ __launch_bounds__(256) void n_sgu(const bf16_t* PROJ, const float* VN, const float* ws, const float* bs, bf16_t* Y) {
    const int i = blockIdx.x * 256 + threadIdx.x; const int t = i >> 9, c = i & 511, g = c >> 7;
    const int tl = t & 127, t0 = t - tl;
    float s = bs[g * 128 + tl];
    const float* w = ws + ((size_t)g * 128 + tl) * 128;
    for (int sidx = 0; sidx <= tl; ++sidx) s += w[sidx] * VN[(size_t)(t0 + sidx) * 512 + c];
    Y[(size_t)t * 1536 + c] = f2bf(bf2f(PROJ[(size_t)t * INW + OFF_U + c]) * s);
}
__global__ __launch_bounds__(64) void n_moba(const bf16_t* PROJ, const float* KMP, bf16_t* Y) {
    const int idx = blockIdx.x; const int t = idx & (SEQ - 1), h = (idx >> 12) & 7, b = idx >> 15;
    const int lane = threadIdx.x;
    __shared__ float qs[64]; __shared__ float ps[1024];
    const size_t rowq = (size_t)b * SEQ + t;
    qs[lane] = bf2f(PROJ[rowq * INW + OFF_QB + h * 64 + lane]);
    __syncthreads();
    const int jb = t >> 8;
    float gate = -1e30f;
    if (lane < 16 && lane < jb) {
        float s = 0.f; const float* k0 = KMP + ((size_t)(b * 16 + lane) * 2) * 512 + h * 64;
        for (int d = 0; d < 64; ++d) s += qs[d] * ((k0[d] + k0[512 + d]) * (1.0f / 256.0f));
        gate = s;
    }
    int blk[4];
#pragma unroll
    for (int i = 0; i < 3; ++i) {
        float m = gate; int mi = lane;
#pragma unroll
        for (int o = 1; o < 64; o <<= 1) { const float om = __shfl_xor(m, o); const int oi = __shfl_xor(mi, o); if (om > m || (om == m && oi < mi)) { m = om; mi = oi; } }
        blk[i] = (m > -5e29f) ? mi : -1;
        if (lane == mi) gate = -3e38f;
    }
    blk[3] = jb;
    const float slope = exp2f(-(float)(h + 1));
    float mx = -3e38f;
#pragma unroll
    for (int i = 0; i < 4; ++i) {
        for (int r = 0; r < 4; ++r) {
            const int j = lane + 64 * r; float s = -1e30f;
            if (blk[i] >= 0) {
                const int key = blk[i] * 256 + j;
                if (i < 3 || key <= t) {
                    const bf16_t* kp = PROJ + ((size_t)b * SEQ + key) * INW + OFF_KB + h * 64; float d = 0.f;
                    for (int e = 0; e < 64; ++e) d += qs[e] * bf2f(kp[e]);
                    s = d * 0.125f - slope * (float)(t - key);
                }
            }
            ps[i * 256 + j] = s; mx = fmaxf(mx, s);
        }
    }
    mx = wave_max(mx);
    float sum = 0.f;
    for (int i = lane; i < 1024; i += 64) { const float p = __expf(ps[i] - mx); ps[i] = p; sum += p; }
    sum = wave_sum(sum);
    __syncthreads();
    float o = 0.f;
#pragma unroll
    for (int i = 0; i < 4; ++i) {
        if (blk[i] < 0) continue;
        for (int j = 0; j < 256; ++j) { const float p = ps[i * 256 + j]; if (p != 0.f) o += p * bf2f(PROJ[((size_t)b * SEQ + blk[i] * 256 + j) * INW + OFF_VB + h * 64 + lane]); }
    }
    Y[rowq * 1536 + 512 + h * 64 + lane] = f2bf(o / sum);
}
__global__ __launch_bounds__(64) void n_memattn(const bf16_t* PROJ, const bf16_t* MKV, const float* gq, bf16_t* Y) {
    const int idx = blockIdx.x; const int h = idx & 3, tt = idx >> 2, b = tt >> 12;
    const int lane = threadIdx.x;
    __shared__ float qs[128]; __shared__ float ps[256];
    const float a = bf2f(PROJ[(size_t)tt * INW + OFF_QM + h * 128 + lane]), c = bf2f(PROJ[(size_t)tt * INW + OFF_QM + h * 128 + 64 + lane]);
    const float rstd = rsqrtf(wave_sum(a * a + c * c) * (1.0f / 128.0f) + EPS);
    qs[lane] = a * rstd * gq[lane]; qs[lane + 64] = c * rstd * gq[lane + 64];
    __syncthreads();
    float mx = -3e38f;
    for (int r = 0; r < 4; ++r) {
        const int m = lane + 64 * r; const bf16_t* kp = MKV + ((size_t)b * MEML + m) * 1024 + h * 128; float d = 0.f;
        for (int e = 0; e < 128; ++e) d += qs[e] * bf2f(kp[e]);
        d *= 0.08838834764831845f; ps[m] = d; mx = fmaxf(mx, d);
    }
    mx = wave_max(mx);
    float sum = 0.f;
    for (int i = lane; i < 256; i += 64) { const float p = __expf(ps[i] - mx); ps[i] = p; sum += p; }
    sum = wave_sum(sum);
    __syncthreads();
    float o0 = 0.f, o1 = 0.f;
    for (int m = 0; m < 256; ++m) { const float p = ps[m]; const bf16_t* vp = MKV + ((size_t)b * MEML + m) * 1024 + 512 + h * 128; o0 += p * bf2f(vp[lane]); o1 += p * bf2f(vp[lane + 64]); }
    Y[(size_t)tt * 1536 + 1024 + h * 128 + lane] = f2bf(o0 / sum); Y[(size_t)tt * 1536 + 1024 + h * 128 + 64 + lane] = f2bf(o1 / sum);
}
__global__ __launch_bounds__(256) void n_router(const float* X1, const float* WrT, const float* br, float* RSTD2, float* TOPW, int* LIST, float* RSTDS, float* TOPWS, unsigned* cnt) {
    const int tl = threadIdx.x >> 5, e = threadIdx.x & 31; const int t = blockIdx.x * 8 + tl;
    const float* xr = X1 + (size_t)t * DM; const float* w = WrT + (size_t)e * DM;
    float ss = 0.f, acc = 0.f;
    for (int k = 0; k < DM; ++k) { const float xv = xr[k]; ss += xv * xv; acc += xv * w[k]; }
    const float rstd = rsqrtf(ss * (1.0f / DM) + EPS);
    float logit = acc * rstd + br[e];
    if (e == 0) RSTD2[t] = rstd;
    float sel_l[4]; int sel_e[4]; float cur = logit;
#pragma unroll
    for (int i = 0; i < 4; ++i) {
        float m = cur; int mi = e;
#pragma unroll
        for (int o = 1; o < 32; o <<= 1) { const float om = __shfl_xor(m, o); const int oi = __shfl_xor(mi, o); if (om > m || (om == m && oi < mi)) { m = om; mi = oi; } }
        sel_l[i] = m; sel_e[i] = mi; if (e == mi) cur = -3e38f;
    }
    if (e < 4) {
        float den = 0.f;
#pragma unroll
        for (int i = 0; i < 4; ++i) den += __expf(sel_l[i] - sel_l[0]);
        float myl = sel_l[0]; int mye = sel_e[0];
#pragma unroll
        for (int i = 1; i < 4; ++i) if (e == i) { myl = sel_l[i]; mye = sel_e[i]; }
        const float wgt = __expf(myl - sel_l[0]) / den;
        const unsigned pos = atomicAdd(cnt + mye, 1u);
        LIST[mye * 32768 + pos] = t * 4 + e; TOPW[t * 4 + e] = wgt; RSTDS[mye * 32768 + pos] = rstd; TOPWS[mye * 32768 + pos] = wgt;
    }
}
__device__ __forceinline__ int expert_base(const unsigned* cnt, int e) { int b = 0; for (int i = 0; i < e; ++i) b += (int)((cnt[i] + 255u) & ~255u); return b; }
struct EpiExp1 { const unsigned* cnt; const int* LIST; const float* RSTD2; const float* b1; bf16_t* ACT;
    __device__ bool active(int z, int r0) const { return r0 < (int)cnt[z]; }
    __device__ size_t boff(int z) const { return (size_t)z * 2048 * 1024; }
    __device__ int arow(int z, int r) const { return r < (int)cnt[z] ? (LIST[z * 32768 + r] >> 2) : 0; }
    __device__ void operator()(int z, int r, int c, float vg, float vl) const {
        if (r >= (int)cnt[z]) return;
        const int tok = LIST[z * 32768 + r] >> 2; const float rs = RSTD2[tok];
        float g = rs * vg + b1[z * 2048 + c], l = rs * vl + b1[z * 2048 + 1024 + c];
        g = fminf(g, 7.0f); l = fminf(fmaxf(l, -7.0f), 7.0f);
        ACT[(size_t)(expert_base(cnt, z) + r) * DFF + c] = f2bf(g * sigmoidf_(1.702f * g) * (l + 1.0f)); } };
struct EpiExp2 { const unsigned* cnt; const int* LIST; const float* TOPW; const float* b2; bf16_t* YS;
    __device__ bool active(int z, int r0) const { return r0 < (int)cnt[z]; }
    __device__ size_t boff(int z) const { return (size_t)z * 1024 * 1024; }
    __device__ int arow(int z, int r) const { return expert_base(cnt, z) + r; }
    __device__ void operator()(int z, int r, int c, float v, float) const {
        if (r >= (int)cnt[z]) return;
        const int slot = LIST[z * 32768 + r];
        YS[(size_t)slot * DM + c] = f2bf((v + b2[z * 1024 + c]) * TOPW[slot]); } };
__global__ __launch_bounds__(256) void n_combine(float* out, const bf16_t* YS) {
    const size_t i = (size_t)blockIdx.x * 256 + threadIdx.x; const size_t t = i >> 10, c = i & 1023;
    float s = out[i];
#pragma unroll
    for (int k = 0; k < 4; ++k) s += bf2f(YS[(t * 4 + k) * DM + c]);
    out[i] = s;
}

#define LAS __attribute__((address_space(3)))
typedef float f32x2 __attribute__((ext_vector_type(2)));
constexpr int NWAVES = 8;
constexpr int RING_BYTES = 131072;
constexpr int LDSCTL_OFF = RING_BYTES;
constexpr int TAB_OFF = RING_BYTES + 64;
constexpr int TAB_CNT = 0, TAB_TST = 32, TAB_TE = 96, TAB_WORDS = 96 + 576;
constexpr int LDS_BYTES = 147456;
static_assert(TAB_OFF + TAB_WORDS * 4 <= LDS_BYTES, "LDS map");
constexpr int CW_BAR = 4096;

#define XB_TMO      128
#define XB_XCNT(j)  (256  + 64 * (j))
#define XB_XSUB(j)  (1280 + 64 * (j))
#define XB_XGEN(j)  (2304 + 64 * (j))
#define XB_TOP      3328
#define XB_TOPGEN   3392
#define XCD_BAR_WORDS 3456
#define XB_SPIN_CAP (1u << 18)
__device__ __forceinline__ unsigned xb_ld(unsigned* p)              { return __hip_atomic_load(p, __ATOMIC_RELAXED, __HIP_MEMORY_SCOPE_AGENT); }
__device__ __forceinline__ unsigned xb_add(unsigned* p, unsigned v) { return __hip_atomic_fetch_add(p, v, __ATOMIC_RELAXED, __HIP_MEMORY_SCOPE_AGENT); }
__device__ __forceinline__ unsigned xb_xcc_id() { return (unsigned)__builtin_amdgcn_s_getreg((3 << 11) | 20) & 0xFu; }
#define XB_SPIN(cond, bar) do { unsigned _sp = 0; while (cond) { __builtin_amdgcn_s_sleep(1); \
    if ((++_sp & 255u) == 0u) { if (xb_ld(&(bar)[XB_TMO])) break; if (_sp > XB_SPIN_CAP) { atomicAdd(&(bar)[XB_TMO], 1u); break; } } } } while (0)
struct XcdBarrier { unsigned* bar; unsigned x; volatile LAS unsigned* st; };
__device__ __forceinline__ XcdBarrier xcd_barrier_post(unsigned* bar, volatile LAS unsigned* st) {
    XcdBarrier b; b.bar = bar; b.x = xb_xcc_id(); b.st = st;
    if (threadIdx.x == 0) (void)xb_add(&bar[XB_XCNT(b.x)], 1u);
    return b;
}
__device__ __forceinline__ void xcd_barrier_complete(unsigned* bar, unsigned x, unsigned& nloc, unsigned& nx) {
    const unsigned G = gridDim.x * gridDim.y * gridDim.z;
    unsigned sum, cnt, mine, sp = 0u;
    for (;;) {
        sum = 0u; cnt = 0u; mine = 0u;
#pragma unroll
        for (unsigned j = 0; j < 16; ++j) { const unsigned c = xb_ld(&bar[XB_XCNT(j)]); sum += c; cnt += (c > 0u) ? 1u : 0u; mine = (j == x) ? c : mine; }
        if (sum == G) break;
        __builtin_amdgcn_s_sleep(1);
        if ((++sp & 255u) == 0u) { if (xb_ld(&bar[XB_TMO])) break; if (sp > XB_SPIN_CAP) { atomicAdd(&bar[XB_TMO], 1u); break; } }
    }
    nloc = mine > 0u ? mine : 1u; nx = cnt > 0u ? cnt : 1u;
}
__device__ __forceinline__ void xcd_barrier(const XcdBarrier& b) {
    asm volatile("s_waitcnt vmcnt(0)" ::: "memory");
    __syncthreads();
    if (threadIdx.x == 0) {
        unsigned* bar = b.bar;
        __builtin_amdgcn_s_waitcnt(0);
        unsigned nloc = b.st[0], nx = b.st[1];
        if (nloc == 0u) { xcd_barrier_complete(bar, b.x, nloc, nx); b.st[0] = nloc; b.st[1] = nx; }
        const unsigned old = xb_add(&bar[XB_XSUB(b.x)], 1u);
        const unsigned gen = old / nloc;
        if (old + 1u == (gen + 1u) * nloc) {
            __builtin_amdgcn_fence(__ATOMIC_RELEASE, "agent");
            asm volatile("s_waitcnt vmcnt(0)" ::: "memory");
            const unsigned og = xb_add(&bar[XB_TOP], 1u);
            const unsigned tg = og / nx;
            if (og + 1u == (tg + 1u) * nx) xb_add(&bar[XB_TOPGEN], 1u);
            else XB_SPIN(xb_ld(&bar[XB_TOPGEN]) == tg, bar);
            __builtin_amdgcn_fence(__ATOMIC_ACQUIRE, "agent");
            xb_add(&bar[XB_XGEN(b.x)], 1u);
            asm volatile("s_waitcnt vmcnt(0)" ::: "memory");
        } else {
            XB_SPIN(xb_ld(&bar[XB_XGEN(b.x)]) == gen, bar);
            __builtin_amdgcn_fence(__ATOMIC_ACQUIRE, "agent");
            asm volatile("s_waitcnt vmcnt(0)" ::: "memory");
        }
    }
    __syncthreads();
}

namespace pg {
constexpr int BM = 256, BK = 64, HALF = 128, HTB = HALF * BK * 2, STAGE_BYTES = 8 * HTB, NXCD = 8, WGM = 8;
__host__ __device__ __forceinline__ int lds_byte(int r, int c) { const int st = (r >> 4) * 2 + (c >> 5), rr = r & 15, cc = c & 31, ob = rr * 64 + cc * 2; return st * 1024 + (ob ^ (((ob >> 9) & 1) << 5)); }
__host__ __device__ __forceinline__ void stage_rc(int b, int& R, int& C) { const int st = b / 1024, sb = b % 1024, swz = sb ^ (((sb >> 9) & 1) << 5); R = (st >> 1) * 16 + swz / 64; C = (st & 1) * 32 + (swz % 64) / 2; }
__host__ __device__ __forceinline__ int perm32(int rho) { const int n = rho >> 4, i = rho & 15; return 8 * (i >> 2) + 4 * n + (i & 3); }
struct Unit { int pm, pn, e, mt; };
__device__ __forceinline__ bool static_unit(long L, int nM, int nN, int& pm, int& pn) {
    const int nwg = nM * nN; if (L >= nwg) return false;
    int wgid = (int)L; { const int q = nwg / NXCD, r = nwg % NXCD, xcd = wgid % NXCD, off = wgid / NXCD; wgid = (xcd < r ? xcd * (q + 1) : r * (q + 1) + (xcd - r) * q) + off; }
    const int nig = WGM * nN, gid = wgid / nig, fm = gid * WGM, gsz = (nM - fm) < WGM ? (nM - fm) : WGM;
    pm = fm + ((wgid % nig) % gsz); pn = (wgid % nig) / gsz; return true;
}
__device__ __forceinline__ unsigned cvt_pk_bf16(float lo, float hi) { unsigned r; asm volatile("v_cvt_pk_bf16_f32 %0, %1, %2" : "=v"(r) : "v"(lo), "v"(hi)); return r; }
__device__ __forceinline__ u32x4 pack8(const f32x4 v0, const f32x4 v1) { u32x4 w; w.x = cvt_pk_bf16(v0[0], v0[1]); w.y = cvt_pk_bf16(v0[2], v0[3]); w.z = cvt_pk_bf16(v1[0], v1[1]); w.w = cvt_pk_bf16(v1[2], v1[3]); return w; }
__device__ __forceinline__ void unpack8(const u32x4 w, f32x4& v0, f32x4& v1) {
    v0[0] = __uint_as_float(w.x << 16); v0[1] = __uint_as_float(w.x & 0xffff0000u); v0[2] = __uint_as_float(w.y << 16); v0[3] = __uint_as_float(w.y & 0xffff0000u);
    v1[0] = __uint_as_float(w.z << 16); v1[1] = __uint_as_float(w.z & 0xffff0000u); v1[2] = __uint_as_float(w.w << 16); v1[3] = __uint_as_float(w.w & 0xffff0000u); }
__device__ __forceinline__ f32x2 gelu_pk(f32x2 v) {
    const f32x2 av = __builtin_elementwise_abs(v), d = av * 0.2316418882f + 1.0f;
    f32x2 t; t.x = __builtin_amdgcn_rcpf(d.x); t.y = __builtin_amdgcn_rcpf(d.y);
    f32x2 q = t * 0.5307027145f + (-0.7265760135f); q = q * t + 0.7107068705f; q = q * t + (-0.142248368f); q = q * t + 0.127414796f; q = q * t;
    const f32x2 s = (v * v) * (-0.72134752044f);
    f32x2 e; e.x = __builtin_amdgcn_exp2f(s.x); e.y = __builtin_amdgcn_exp2f(s.y);
    const f32x2 m = v * (q * e), r = v - m;
    f32x2 o; o.x = v.x < 0.f ? m.x : r.x; o.y = v.y < 0.f ? m.y : r.y; return o;
}
__device__ __forceinline__ f32x4 gelu4(f32x4 v) { const f32x2 a = gelu_pk((f32x2){v[0], v[1]}), b = gelu_pk((f32x2){v[2], v[3]}); return (f32x4){a.x, a.y, b.x, b.y}; }
__device__ __forceinline__ float sigm(float v) { return __builtin_amdgcn_rcpf(1.0f + __builtin_amdgcn_exp2f(v * -1.4426950408889634f)); }
__device__ __forceinline__ f32x4 sigm4(f32x4 v) { return (f32x4){sigm(v[0]), sigm(v[1]), sigm(v[2]), sigm(v[3])}; }

template <class Pol>
__device__ __forceinline__ void gemm_run(LAS unsigned char* lds, const Pol& P) {
    constexpr int K = Pol::K, nt = K / BK;
    const int tid = threadIdx.x, wid = __builtin_amdgcn_readfirstlane(tid >> 6), lane = tid & 63, wr = wid >> 2, wc = wid & 3, fr = lane & 15, fq = lane >> 4;
    unsigned voffA[2], voffB[2]; int Rr[2], Cc[2];
#pragma unroll
    for (int i = 0; i < 2; ++i) { int R, C; stage_rc(tid * 16 + i * 8192, R, C); Rr[i] = R; Cc[i] = C; const int Rb = (R & ~31) + perm32(R & 31);
        voffA[i] = (unsigned)(R * K + C) * 2u; voffB[i] = (unsigned)(Rb * K + C) * 2u; }
    constexpr unsigned kstep = BK * 2, hstep = HALF * K * 2;
    const unsigned ldsw = (unsigned)wid * 1024u;
    const int aoff = lds_byte(wr * 64 + fr, fq * 8), boff = lds_byte(wc * 32 + fr, fq * 8);
#define PG_SA(b, h) (((b) * 2 + (h)) * HTB)
#define PG_SB(b, h) ((4 + (b) * 2 + (h)) * HTB)
#define PG_AOFF(nx, h, i) (Pol::GATHER ? ((nx) ? gN[h][i] : gC[h][i]) : (voffA[i] + (unsigned)(h) * hstep))
#define PG_STAGE_A(bufoff, gbase, nx, h) do { _Pragma("unroll") for (int _i = 0; _i < 2; ++_i) \
        __builtin_amdgcn_global_load_lds((const unsigned*)((const char*)(gbase) + PG_AOFF(nx, h, _i)), (LAS unsigned*)(lds + (bufoff) + ldsw + _i * 8192), 16, 0, 0); } while (0)
#define PG_STAGE_B(bufoff, gbase) do { _Pragma("unroll") for (int _i = 0; _i < 2; ++_i) \
        __builtin_amdgcn_global_load_lds((const unsigned*)((const char*)(gbase) + voffB[_i]), (LAS unsigned*)(lds + (bufoff) + ldsw + _i * 8192), 16, 0, 0); } while (0)
#define PG_LDA(dst, b, h) do { _Pragma("unroll") for (int m = 0; m < 4; ++m) _Pragma("unroll") for (int k = 0; k < 2; ++k) dst[m][k] = *(const LAS bf16x8*)(lds + PG_SA(b, h) + aoff + m * 2048 + k * 1024); } while (0)
#define PG_LDB(dst, b, h) do { _Pragma("unroll") for (int n = 0; n < 2; ++n) _Pragma("unroll") for (int k = 0; k < 2; ++k) dst[n][k] = *(const LAS bf16x8*)(lds + PG_SB(b, h) + boff + n * 2048 + k * 1024); } while (0)
#define PG_MMA(ai, bj, At, Bt) do { __builtin_amdgcn_s_setprio(1); _Pragma("unroll") for (int m = 0; m < 4; ++m) _Pragma("unroll") for (int n = 0; n < 2; ++n) _Pragma("unroll") for (int k = 0; k < 2; ++k) \
        acc[ai][bj][m][n] = __builtin_amdgcn_mfma_f32_16x16x32_bf16(Bt[n][k], At[m][k], acc[ai][bj][m][n], 0, 0, 0); __builtin_amdgcn_s_setprio(0); } while (0)
#define PG_WAIT_V(n) asm volatile("s_waitcnt vmcnt(" #n ")" ::: "memory")
#define PG_WAIT_L(n) asm volatile("s_waitcnt lgkmcnt(" #n ")" ::: "memory")
#define PG_BAR __builtin_amdgcn_s_barrier()
#define PG_SCHED __builtin_amdgcn_sched_barrier(0)
    Unit cur, nxt; int ui = 0;
    if (!P.next(0, cur)) return;
    f32x4 acc[2][2][4][2];
#pragma unroll
    for (int a = 0; a < 2; ++a)
#pragma unroll
        for (int b = 0; b < 2; ++b)
#pragma unroll
            for (int m = 0; m < 4; ++m)
#pragma unroll
                for (int n = 0; n < 2; ++n) acc[a][b][m][n] = (f32x4){0.f, 0.f, 0.f, 0.f};
    bf16x8 At[4][2], B0[2][2], B1[2][2];
    unsigned gC[2][2] = {{0u, 0u}, {0u, 0u}}, gN[2][2] = {{0u, 0u}, {0u, 0u}};
    const char* cA = P.a_base(cur); const char* cB = P.b_base(cur);
    if constexpr (Pol::GATHER) P.a_offsets(cur, Rr, Cc, gC);
    PG_STAGE_B(PG_SB(0, 0), cB); PG_STAGE_B(PG_SB(0, 1), cB + hstep); PG_STAGE_A(PG_SA(0, 0), cA, false, 0); PG_STAGE_A(PG_SA(0, 1), cA, false, 1);
    if (wr == 1) PG_BAR;
    PG_WAIT_V(2); PG_BAR;
    PG_STAGE_B(PG_SB(1, 0), cB + kstep); PG_STAGE_A(PG_SA(1, 0), cA + kstep, false, 0); PG_STAGE_B(PG_SB(1, 1), cB + hstep + kstep);
    PG_WAIT_V(6); PG_BAR;
    for (;;) {
        const bool has_next = P.next(ui + 1, nxt);
        const char* nA = has_next ? P.a_base(nxt) : cA; const char* nB = has_next ? P.b_base(nxt) : cB;
#pragma nounroll
        for (int t = 0; t < nt; t += 2) {
            const bool last = (t == nt - 2);
            if constexpr (Pol::GATHER) { if (last) { if (has_next) P.a_offsets(nxt, Rr, Cc, gN); else { gN[0][0] = gC[0][0]; gN[0][1] = gC[0][1]; gN[1][0] = gC[1][0]; gN[1][1] = gC[1][1]; } } }
            if constexpr (Pol::HOOK) { if (t == Pol::H1 || t == Pol::H2) P.khook(t, acc, cur, wr, wc, fr, fq); }
            const char* a1 = cA + (size_t)(t + 1) * kstep;
            const char* a2 = last ? nA : cA + (size_t)(t + 2) * kstep; const char* b2 = last ? nB : cB + (size_t)(t + 2) * kstep;
            const char* a3 = a2 + kstep; const char* b3 = b2 + kstep;
            PG_LDB(B0, 0, 0); PG_LDB(B1, 0, 1); PG_SCHED; PG_LDA(At, 0, 0); PG_STAGE_A(PG_SA(1, 1), a1, false, 1);
            PG_WAIT_V(8); PG_WAIT_L(0); PG_BAR; PG_MMA(0, 0, At, B0); PG_MMA(0, 1, At, B1); PG_BAR; PG_SCHED;
            PG_LDA(At, 0, 1); PG_STAGE_B(PG_SB(0, 0), b2); PG_STAGE_B(PG_SB(0, 1), b2 + hstep); PG_STAGE_A(PG_SA(0, 0), a2, last, 0);
            PG_WAIT_V(8); PG_WAIT_L(0); PG_BAR; PG_MMA(1, 0, At, B0); PG_MMA(1, 1, At, B1); PG_BAR; PG_SCHED;
            PG_LDB(B0, 1, 0); PG_LDB(B1, 1, 1); PG_SCHED; PG_LDA(At, 1, 0); PG_STAGE_A(PG_SA(0, 1), a2, last, 1);
            PG_WAIT_V(8); PG_WAIT_L(0); PG_BAR; PG_MMA(0, 0, At, B0); PG_MMA(0, 1, At, B1); PG_BAR; PG_SCHED;
            PG_LDA(At, 1, 1); PG_STAGE_B(PG_SB(1, 0), b3); PG_STAGE_B(PG_SB(1, 1), b3 + hstep); PG_STAGE_A(PG_SA(1, 0), a3, last, 0);
            PG_WAIT_V(8); PG_WAIT_L(0); PG_BAR; PG_MMA(1, 0, At, B0); PG_MMA(1, 1, At, B1); PG_BAR; PG_SCHED;
        }
        if (wr == 0) PG_BAR;
        P.epi(acc, cur, wr, wc, fr, fq);
        if (!has_next) break;
#pragma unroll
        for (int a = 0; a < 2; ++a)
#pragma unroll
            for (int b = 0; b < 2; ++b)
#pragma unroll
                for (int m = 0; m < 4; ++m)
#pragma unroll
                    for (int n = 0; n < 2; ++n) acc[a][b][m][n] = (f32x4){0.f, 0.f, 0.f, 0.f};
        cur = nxt; cA = nA; cB = nB; ++ui;
        if constexpr (Pol::GATHER) { gC[0][0] = gN[0][0]; gC[0][1] = gN[0][1]; gC[1][0] = gN[1][0]; gC[1][1] = gN[1][1]; }
        if (wr == 1) PG_BAR;
    }
    PG_WAIT_V(0);
    PG_BAR;
#undef PG_SA
#undef PG_SB
#undef PG_AOFF
#undef PG_STAGE_A
#undef PG_STAGE_B
#undef PG_LDA
#undef PG_LDB
#undef PG_MMA
#undef PG_WAIT_V
#undef PG_WAIT_L
#undef PG_BAR
#undef PG_SCHED
}

struct PolBase { static constexpr bool GATHER = false, HOOK = false; static constexpr int H1 = -1, H2 = -1;
    __device__ __forceinline__ void a_offsets(const Unit&, const int (&)[2], const int (&)[2], unsigned (&)[2][2]) const {}
    __device__ __forceinline__ void khook(int, f32x4 (&)[2][2][4][2], const Unit&, int, int, int, int) const {} };

struct PolP1 : PolBase {
    static constexpr int K = 1024;
    const bf16_t* A; const bf16_t* Bt; bf16_t* PROJ; float* KMP; const float* gq; const float* gk; int G, c;
    __device__ __forceinline__ bool next(int i, Unit& u) const { u.e = 0; u.mt = 0; return static_unit((long)i * G + c, T_TOK / 256, INW / 256, u.pm, u.pn); }
    __device__ __forceinline__ const char* a_base(const Unit& u) const { return (const char*)A + (size_t)u.pm * 256 * K * 2; }
    __device__ __forceinline__ const char* b_base(const Unit& u) const { return (const char*)Bt + (size_t)u.pn * 256 * K * 2; }
    __device__ __forceinline__ void epi(const f32x4 (&acc)[2][2][4][2], const Unit& u, int wr, int wc, int fr, int fq) const {
        const int row0 = u.pm * 256 + wr * 64 + fr, pn = u.pn;
        if (pn >= 4 && pn < 8) {
            const float* g = (pn < 6) ? gq : gk;
            f32x4 gv[2][2], cs[2][2];
#pragma unroll
            for (int bj = 0; bj < 2; ++bj)
#pragma unroll
                for (int n = 0; n < 2; ++n) { gv[bj][n] = *(const f32x4*)(g + 32 * bj + 8 * fq + 4 * n); cs[bj][n] = (f32x4){0.f, 0.f, 0.f, 0.f}; }
#pragma unroll
            for (int ai = 0; ai < 2; ++ai)
#pragma unroll
                for (int m = 0; m < 4; ++m) {
                    float ss = 0.f;
#pragma unroll
                    for (int bj = 0; bj < 2; ++bj)
#pragma unroll
                        for (int n = 0; n < 2; ++n) { const f32x4 x = acc[ai][bj][m][n]; ss += (x[0] * x[0] + x[1] * x[1]) + (x[2] * x[2] + x[3] * x[3]); }
                    ss += __shfl_xor(ss, 16); ss += __shfl_xor(ss, 32);
                    const float rstd = rsqrtf(ss * (1.0f / 64.0f) + EPS);
                    bf16_t* rowp = PROJ + (size_t)(row0 + ai * HALF + m * 16) * INW + 1024 + (pn - 4) * 256 + 64 * wc + 8 * fq;
#pragma unroll
                    for (int bj = 0; bj < 2; ++bj) { const f32x4 v0 = acc[ai][bj][m][0] * rstd * gv[bj][0], v1 = acc[ai][bj][m][1] * rstd * gv[bj][1];
                        cs[bj][0] += v0; cs[bj][1] += v1; *(u32x4*)(rowp + 32 * bj) = pack8(v0, v1); }
                }
            if (pn >= 6) {
#pragma unroll
                for (int bj = 0; bj < 2; ++bj)
#pragma unroll
                    for (int n = 0; n < 2; ++n)
#pragma unroll
                        for (int j = 0; j < 4; ++j) { float s = cs[bj][n][j]; s += __shfl_xor(s, 1); s += __shfl_xor(s, 2); s += __shfl_xor(s, 4); s += __shfl_xor(s, 8); cs[bj][n][j] = s; }
                if (fr == 0) {
                    float* kp = KMP + ((size_t)u.pm * 2 + wr) * 512 + (pn - 6) * 256 + 64 * wc + 8 * fq;
#pragma unroll
                    for (int bj = 0; bj < 2; ++bj) { *(f32x4*)(kp + 32 * bj) = cs[bj][0]; *(f32x4*)(kp + 32 * bj + 4) = cs[bj][1]; }
                }
            }
        } else {
            const int col0 = pn * 256 + wc * 32 + 8 * fq;
#pragma unroll
            for (int ai = 0; ai < 2; ++ai)
#pragma unroll
                for (int m = 0; m < 4; ++m) { bf16_t* rowp = PROJ + (size_t)(row0 + ai * HALF + m * 16) * INW + col0;
#pragma unroll
                    for (int bj = 0; bj < 2; ++bj) { f32x4 v0 = acc[ai][bj][m][0], v1 = acc[ai][bj][m][1];
                        if (pn < 4) { v0 = gelu4(v0); v1 = gelu4(v1); } else if (pn >= 12) { v0 = sigm4(v0); v1 = sigm4(v1); }
                        *(u32x4*)(rowp + bj * HALF) = pack8(v0, v1); } }
        }
    }
};
struct PolP3 : PolBase {
    static constexpr int K = 1536; static constexpr bool HOOK = true; static constexpr int H1 = 8, H2 = 16;
    const bf16_t* A; const bf16_t* Bt; const bf16_t* PROJ; bf16_t* MERGED; int G, c;
    __device__ __forceinline__ bool next(int i, Unit& u) const { u.e = 0; u.mt = 0; return static_unit((long)i * G + c, T_TOK / 256, DM / 256, u.pm, u.pn); }
    __device__ __forceinline__ const char* a_base(const Unit& u) const { return (const char*)A + (size_t)u.pm * 256 * K * 2; }
    __device__ __forceinline__ const char* b_base(const Unit& u) const { return (const char*)Bt + (size_t)u.pn * 256 * K * 2; }
    __device__ __forceinline__ void khook(int t, f32x4 (&acc)[2][2][4][2], const Unit& u, int wr, int wc, int fr, int fq) const {
        const int gnum = (t == 8) ? 0 : 1024;
        int zero = 0; asm volatile("" : "+v"(zero));
        const int row0 = u.pm * 256 + wr * 64 + fr + zero, col0 = OFF_G + u.pn * 256 + wc * 32 + 8 * fq;
#pragma unroll
        for (int ai = 0; ai < 2; ++ai)
#pragma unroll
            for (int m = 0; m < 4; ++m) { const bf16_t* rowp = PROJ + (size_t)(row0 + ai * HALF + m * 16) * INW + col0;
#pragma unroll
                for (int bj = 0; bj < 2; ++bj) { const u32x4 wn = *(const u32x4*)(rowp + gnum + bj * HALF), wd = *(const u32x4*)(rowp + gnum + 1024 + bj * HALF);
                    f32x4 n0, n1, d0, d1; unpack8(wn, n0, n1); unpack8(wd, d0, d1);
#pragma unroll
                    for (int j = 0; j < 4; ++j) { acc[ai][bj][m][0][j] *= n0[j] * __builtin_amdgcn_rcpf(d0[j]); acc[ai][bj][m][1][j] *= n1[j] * __builtin_amdgcn_rcpf(d1[j]); } }
                if (m & 1) asm volatile("" ::: "memory"); }
    }
    __device__ __forceinline__ void epi(const f32x4 (&acc)[2][2][4][2], const Unit& u, int wr, int wc, int fr, int fq) const {
        const int row0 = u.pm * 256 + wr * 64 + fr, colt = u.pn * 256 + wc * 32 + 8 * fq;
#pragma unroll
        for (int ai = 0; ai < 2; ++ai)
#pragma unroll
            for (int m = 0; m < 4; ++m) { const size_t r = (size_t)(row0 + ai * HALF + m * 16);
#pragma unroll
                for (int bj = 0; bj < 2; ++bj) { const u32x4 wg = *(const u32x4*)(PROJ + r * INW + OFF_G + 2048 + colt + bj * HALF); f32x4 g0, g1; unpack8(wg, g0, g1);
                    *(u32x4*)(MERGED + r * DM + colt + bj * HALF) = pack8(acc[ai][bj][m][0] * g0, acc[ai][bj][m][1] * g1); }
                if (m & 1) asm volatile("" ::: "memory"); }
    }
};
struct PolP4 : PolBase {
    static constexpr int K = 1024;
    const bf16_t* A; const bf16_t* Bt; const float* x; float* out; bf16_t* X1B; int G, c;
    __device__ __forceinline__ bool next(int i, Unit& u) const { u.e = 0; u.mt = 0; return static_unit((long)i * G + c, T_TOK / 256, DM / 256, u.pm, u.pn); }
    __device__ __forceinline__ const char* a_base(const Unit& u) const { return (const char*)A + (size_t)u.pm * 256 * K * 2; }
    __device__ __forceinline__ const char* b_base(const Unit& u) const { return (const char*)Bt + (size_t)u.pn * 256 * K * 2; }
    __device__ __forceinline__ void epi(const f32x4 (&acc)[2][2][4][2], const Unit& u, int wr, int wc, int fr, int fq) const {
        const int row0 = u.pm * 256 + wr * 64 + fr, colt = u.pn * 256 + wc * 32 + 8 * fq;
#pragma unroll
        for (int ai = 0; ai < 2; ++ai)
#pragma unroll
            for (int m = 0; m < 4; ++m) { const size_t o = (size_t)(row0 + ai * HALF + m * 16) * DM + colt;
#pragma unroll
                for (int bj = 0; bj < 2; ++bj) { const f32x4 x0 = *(const f32x4*)(x + o + bj * HALF), x1 = *(const f32x4*)(x + o + bj * HALF + 4);
                    const f32x4 v0 = x0 + acc[ai][bj][m][0], v1 = x1 + acc[ai][bj][m][1];
                    *(f32x4*)(out + o + bj * HALF) = v0; *(f32x4*)(out + o + bj * HALF + 4) = v1; *(u32x4*)(X1B + o + bj * HALF) = pack8(v0, v1); }
                if (m & 1) asm volatile("" ::: "memory"); }
    }
};
struct GroupTab { const LAS int* tab; __device__ __forceinline__ int cnt(int e) const { return tab[TAB_CNT + e]; } __device__ __forceinline__ int tstart(int e) const { return tab[TAB_TST + e]; }
    __device__ __forceinline__ int tile_e(int vt) const { return tab[TAB_TE + vt]; } __device__ __forceinline__ int NT() const { return tab[TAB_TST + 32]; } };
struct PolP6 : PolBase {
    static constexpr int K = 1024; static constexpr bool GATHER = true;
    const bf16_t* X1B; const bf16_t* W1T; const int* LIST; const float* RSTDS; const float* b1; bf16_t* ACT; GroupTab tb; int G, c;
    __device__ __forceinline__ bool next(int i, Unit& u) const { if (!static_unit((long)i * G + c, tb.NT(), 8, u.pm, u.pn)) return false; u.e = tb.tile_e(u.pm); u.mt = u.pm - tb.tstart(u.e); return true; }
    __device__ __forceinline__ const char* a_base(const Unit&) const { return (const char*)X1B; }
    __device__ __forceinline__ const char* b_base(const Unit& u) const { return (const char*)W1T + ((size_t)u.e * 2048 + (size_t)u.pn * 256) * K * 2; }
    __device__ __forceinline__ void a_offsets(const Unit& u, const int (&Rr)[2], const int (&Cc)[2], unsigned (&g)[2][2]) const {
        const int valid = tb.cnt(u.e) - u.mt * 256; const int* lp = LIST + u.e * 32768 + u.mt * 256;
#pragma unroll
        for (int h = 0; h < 2; ++h)
#pragma unroll
            for (int i = 0; i < 2; ++i) { const int r = h * HALF + Rr[i]; const int tok = (r < valid) ? (lp[r] >> 2) : 0; g[h][i] = (unsigned)tok * (unsigned)(K * 2) + (unsigned)Cc[i] * 2u; }
    }
    __device__ __forceinline__ void epi(const f32x4 (&acc)[2][2][4][2], const Unit& u, int wr, int wc, int fr, int fq) const {
        const int valid = tb.cnt(u.e) - u.mt * 256, colg = u.pn * 128 + wc * 32 + 8 * fq;
        const float* bp = b1 + (size_t)u.e * 2048 + colg; const float* rp = RSTDS + u.e * 32768 + u.mt * 256;
        const f32x4 bg0 = *(const f32x4*)bp, bg1 = *(const f32x4*)(bp + 4), bl0 = *(const f32x4*)(bp + 1024), bl1 = *(const f32x4*)(bp + 1028);
#pragma unroll
        for (int ai = 0; ai < 2; ++ai)
#pragma unroll
            for (int m = 0; m < 4; ++m) { const int r = ai * HALF + wr * 64 + m * 16 + fr; const float rs = (r < valid) ? rp[r] : 0.f;
                f32x4 o[2];
#pragma unroll
                for (int n = 0; n < 2; ++n) { const f32x4 gv = acc[ai][0][m][n] * rs + (n ? bg1 : bg0), lv = acc[ai][1][m][n] * rs + (n ? bl1 : bl0);
#pragma unroll
                    for (int j = 0; j < 4; ++j) { const float gg = fminf(gv[j], 7.0f), ll = fminf(fmaxf(lv[j], -7.0f), 7.0f); o[n][j] = gg * sigm(1.702f * gg) * (ll + 1.0f); } }
                *(u32x4*)(ACT + (size_t)(u.pm * 256 + r) * DFF + colg) = pack8(o[0], o[1]); }
    }
};
struct PolP7 : PolBase {
    static constexpr int K = 1024;
    const bf16_t* ACT; const bf16_t* W2T; const int* LIST; const float* TOPWS; const float* b2; bf16_t* YS; GroupTab tb; int G, c;
    __device__ __forceinline__ bool next(int i, Unit& u) const { if (!static_unit((long)i * G + c, tb.NT(), 4, u.pm, u.pn)) return false; u.e = tb.tile_e(u.pm); u.mt = u.pm - tb.tstart(u.e); return true; }
    __device__ __forceinline__ const char* a_base(const Unit& u) const { return (const char*)ACT + (size_t)u.pm * 256 * K * 2; }
    __device__ __forceinline__ const char* b_base(const Unit& u) const { return (const char*)W2T + ((size_t)u.e * 1024 + (size_t)u.pn * 256) * K * 2; }
    __device__ __forceinline__ void epi(const f32x4 (&acc)[2][2][4][2], const Unit& u, int wr, int wc, int fr, int fq) const {
        const int valid = tb.cnt(u.e) - u.mt * 256, colt = u.pn * 256 + wc * 32 + 8 * fq;
        const float* bp = b2 + (size_t)u.e * 1024 + colt; const int* lp = LIST + u.e * 32768 + u.mt * 256; const float* wp = TOPWS + u.e * 32768 + u.mt * 256;
        f32x4 bv[2][2];
#pragma unroll
        for (int bj = 0; bj < 2; ++bj) { bv[bj][0] = *(const f32x4*)(bp + bj * HALF); bv[bj][1] = *(const f32x4*)(bp + bj * HALF + 4); }
#pragma unroll
        for (int ai = 0; ai < 2; ++ai)
#pragma unroll
            for (int m = 0; m < 4; ++m) { const int r = ai * HALF + wr * 64 + m * 16 + fr;
                if (r < valid) { const int slot = lp[r]; const float w = wp[r];
#pragma unroll
                    for (int bj = 0; bj < 2; ++bj) *(u32x4*)(YS + (size_t)slot * DM + colt + bj * HALF) = pack8((acc[ai][bj][m][0] + bv[bj][0]) * w, (acc[ai][bj][m][1] + bv[bj][1]) * w); } }
    }
};
}

__device__ __forceinline__ void grouped_setup(LAS int* tab, const unsigned* cnt) {
    const int tid = threadIdx.x;
    if (tid < 32) tab[TAB_CNT + tid] = (int)__hip_atomic_load(cnt + tid, __ATOMIC_RELAXED, __HIP_MEMORY_SCOPE_AGENT);
    __syncthreads();
    if (tid == 0) { int s = 0; for (int e = 0; e < 32; ++e) { tab[TAB_TST + e] = s; s += (tab[TAB_CNT + e] + 255) >> 8; } tab[TAB_TST + 32] = s; }
    __syncthreads();
    const int NT = tab[TAB_TST + 32];
    for (int vt = tid; vt < NT; vt += NWAVES * 64) { int e = 0; for (int k = 1; k < 32; ++k) if (tab[TAB_TST + k] <= vt) e = k; tab[TAB_TE + vt] = e; }
    __syncthreads();
}

struct MArgs { const float* in[24]; float* out; unsigned char* ws; int ph_lo, ph_hi; };
__global__ void __launch_bounds__(NWAVES * 64, 2) mk_fwd(MArgs a) {
    extern __shared__ __attribute__((aligned(16))) unsigned char lds_raw[];
    LAS unsigned char* lds = (LAS unsigned char*)lds_raw;
    const int tid = threadIdx.x;
    for (int u = tid; u < (LDS_BYTES - LDSCTL_OFF) / 4; u += NWAVES * 64) ((LAS unsigned*)(lds + LDSCTL_OFF))[u] = 0u;
    __syncthreads();
    unsigned char* ws = a.ws; unsigned* ctl = (unsigned*)(ws + WS_CTL);
    const int lo = a.ph_lo, hi = a.ph_hi; const int G = gridDim.x, c = blockIdx.x;
    XcdBarrier bar; bar.bar = ctl + CW_BAR; bar.x = 0; bar.st = nullptr;
    if (hi - lo > 1) bar = xcd_barrier_post(ctl + CW_BAR, (volatile LAS unsigned*)(lds + LDSCTL_OFF));
#define IN(k) (lo <= (k) && (k) < hi)
#define BOTH(k) (IN(k) && IN((k) + 1))
    bf16_t *WinT = (bf16_t*)(ws + WS_WIN), *WbrT = (bf16_t*)(ws + WS_WBR), *WoutT = (bf16_t*)(ws + WS_WOUT);
    bf16_t *W1T = (bf16_t*)(ws + WS_W1), *W2T = (bf16_t*)(ws + WS_W2);
    bf16_t *MERGED = (bf16_t*)(ws + WS_MERGED), *X1B = (bf16_t*)(ws + WS_X1B), *HB = (bf16_t*)(ws + WS_HB), *PROJ = (bf16_t*)(ws + WS_PROJ), *Y = (bf16_t*)(ws + WS_Y);
    bf16_t *ACT = (bf16_t*)(ws + WS_ACT), *YS = (bf16_t*)(ws + WS_YS);
    float* KMP = (float*)(ws + WS_KMP); int* LIST = (int*)(ws + WS_LIST); float* RSTDS = (float*)(ws + WS_RSTDS); float* TOPWS = (float*)(ws + WS_TOPWS);

#if !defined(ONLY) || ONLY == 1
    if (IN(1)) {
        pg::PolP1 P; P.A = HB; P.Bt = WinT; P.PROJ = PROJ; P.KMP = KMP; P.gq = a.in[7]; P.gk = a.in[8]; P.G = G; P.c = c;
        pg::gemm_run(lds, P);
        if (BOTH(1)) xcd_barrier(bar);
    }
#endif
#if !defined(ONLY) || ONLY == 3
    if (IN(3)) {
        pg::PolP3 P; P.A = Y; P.Bt = WbrT; P.PROJ = PROJ; P.MERGED = MERGED; P.G = G; P.c = c;
        pg::gemm_run(lds, P);
        if (BOTH(3)) xcd_barrier(bar);
    }
#endif
#if !defined(ONLY) || ONLY == 4
    if (IN(4)) {
        pg::PolP4 P; P.A = MERGED; P.Bt = WoutT; P.x = a.in[0]; P.out = a.out; P.X1B = X1B; P.G = G; P.c = c;
        pg::gemm_run(lds, P);
        if (BOTH(4)) xcd_barrier(bar);
    }
#endif
#if !defined(ONLY) || ONLY == 6
    if (IN(6)) {
        grouped_setup((LAS int*)(lds + TAB_OFF), ctl + CW_CNT);
        pg::PolP6 P; P.X1B = X1B; P.W1T = W1T; P.LIST = LIST; P.RSTDS = RSTDS; P.b1 = a.in[21]; P.ACT = ACT; P.tb.tab = (const LAS int*)(lds + TAB_OFF); P.G = G; P.c = c;
        pg::gemm_run(lds, P);
        if (BOTH(6)) xcd_barrier(bar);
    }
#endif
#if !defined(ONLY) || ONLY == 7
    if (IN(7)) {
        grouped_setup((LAS int*)(lds + TAB_OFF), ctl + CW_CNT);
        pg::PolP7 P; P.ACT = ACT; P.W2T = W2T; P.LIST = LIST; P.TOPWS = TOPWS; P.b2 = a.in[23]; P.YS = YS; P.tb.tab = (const LAS int*)(lds + TAB_OFF); P.G = G; P.c = c;
        pg::gemm_run(lds, P);
        if (BOTH(7)) xcd_barrier(bar);
    }
#endif
#undef IN
#undef BOTH
}

#ifndef USE_MK_P1
#define USE_MK_P1 1
#define USE_MK_P3 1
#define USE_MK_P4 1
#define USE_MK_P6 1
#define USE_MK_P7 1
#endif
static int g_grid = 0;
static void launch_mk(const MArgs& base, int lo, int hi, hipStream_t stream) {
    MArgs a = base; a.ph_lo = lo; a.ph_hi = hi;
    hipLaunchKernelGGL(mk_fwd, dim3(g_grid), dim3(NWAVES * 64), LDS_BYTES, stream, a);
}
extern "C" void kernel_launch(void* const* d_in, const int* in_sizes, int n_in, void* d_out, int out_size, void* d_ws, size_t ws_size, hipStream_t stream) {
    if (n_in != 24 || ws_size < WS_END) { fprintf(stderr, "kernel_launch: unexpected n_in %d or ws %zu\n", n_in, ws_size); return; }
    if (g_grid == 0) {
        int dev = 0, cus = 0, per_cu = 0;
        (void)hipGetDevice(&dev); (void)hipDeviceGetAttribute(&cus, hipDeviceAttributeMultiprocessorCount, dev);
        if (hipFuncSetAttribute((const void*)mk_fwd, hipFuncAttributeMaxDynamicSharedMemorySize, LDS_BYTES) != hipSuccess) fprintf(stderr, "kernel_launch: hipFuncSetAttribute failed\n");
        if (hipOccupancyMaxActiveBlocksPerMultiprocessor(&per_cu, (const void*)mk_fwd, NWAVES * 64, LDS_BYTES) != hipSuccess || per_cu < 1) fprintf(stderr, "kernel_launch: occupancy query says %d\n", per_cu);
        (void)hipGetLastError();
        g_grid = cus > 0 ? cus : 256;
    }
    const float* x = (const float*)d_in[0];        const float* mem = (const float*)d_in[1];     const float* g_mix = (const float*)d_in[2];
    const float* w_in = (const float*)d_in[3];     const float* g_sgu_v = (const float*)d_in[4]; const float* w_spatial = (const float*)d_in[5];
    const float* b_spatial = (const float*)d_in[6]; const float* g_q_moba = (const float*)d_in[7]; const float* g_k_moba = (const float*)d_in[8];
    const float* g_mem = (const float*)d_in[9];    const float* w_mem_kv = (const float*)d_in[10]; const float* g_q_mem = (const float*)d_in[11];
    const float* g_k_mem = (const float*)d_in[12]; const float* w_br_sgu = (const float*)d_in[13]; const float* w_br_moba = (const float*)d_in[14];
    const float* w_br_mem = (const float*)d_in[15]; const float* w_out = (const float*)d_in[16];  const float* g_ffn = (const float*)d_in[17];
    const float* w_router = (const float*)d_in[18]; const float* b_router = (const float*)d_in[19]; const float* w_gate_up = (const float*)d_in[20];
    const float* b_gate_up = (const float*)d_in[21]; const float* w_down = (const float*)d_in[22]; const float* b_down = (const float*)d_in[23];
    (void)b_gate_up; (void)b_down; (void)g_q_moba; (void)g_k_moba;
    float* out = (float*)d_out; unsigned char* ws = (unsigned char*)d_ws;
    unsigned* ctl = (unsigned*)(ws + WS_CTL);
    bf16_t *WinT = (bf16_t*)(ws + WS_WIN), *WbrT = (bf16_t*)(ws + WS_WBR), *WoutT = (bf16_t*)(ws + WS_WOUT), *WmemT = (bf16_t*)(ws + WS_WMEM);
    float* WrT = (float*)(ws + WS_WR); float* RSTD2 = (float*)(ws + WS_RSTD2); float* KMP = (float*)(ws + WS_KMP); float* TOPW = (float*)(ws + WS_TOPW);
    int* LIST = (int*)(ws + WS_LIST); float* RSTDS = (float*)(ws + WS_RSTDS); float* TOPWS = (float*)(ws + WS_TOPWS);
    bf16_t *MEMN = (bf16_t*)(ws + WS_MEMN), *MKV = (bf16_t*)(ws + WS_MKV), *W1T = (bf16_t*)(ws + WS_W1), *W2T = (bf16_t*)(ws + WS_W2);
    bf16_t *HB = (bf16_t*)(ws + WS_HB), *PROJ = (bf16_t*)(ws + WS_PROJ), *Y = (bf16_t*)(ws + WS_Y);
    bf16_t *YS = (bf16_t*)(ws + WS_YS);
    float* SCR = (float*)(ws + WS_SCR); (void)RSTD2; (void)TOPW; (void)W1T; (void)W2T; (void)WbrT; (void)WoutT;
    MArgs base{}; for (int i = 0; i < 24; ++i) base.in[i] = (const float*)d_in[i]; base.out = out; base.ws = ws;

    (void)hipMemsetAsync(ws + WS_CTL, 0, 1 * MiB, stream);
    n_rmsnorm_rows<<<T_TOK / 4, 256, 0, stream>>>(x, g_mix, HB, T_TOK);
    n_rmsnorm_rows<<<NBATCH * MEML / 4, 256, 0, stream>>>(mem, g_mem, MEMN, NBATCH * MEML);
    n_transpose<MapWin><<<dim3(INW / 32, DM / 32, 1), 256, 0, stream>>>(w_in, DM, INW, WinT, DM, 0, nullptr, 0, 0);
    n_transpose<MapId><<<dim3(DM / 32, 512 / 32, 1), 256, 0, stream>>>(w_br_sgu, 512, DM, WbrT, 1536, 0, nullptr, 0, 0);
    n_transpose<MapId><<<dim3(DM / 32, 512 / 32, 1), 256, 0, stream>>>(w_br_moba, 512, DM, WbrT, 1536, 512, nullptr, 0, 0);
    n_transpose<MapId><<<dim3(DM / 32, 512 / 32, 1), 256, 0, stream>>>(w_br_mem, 512, DM, WbrT, 1536, 1024, nullptr, 0, 0);
    n_transpose<MapId><<<dim3(DM / 32, DM / 32, 1), 256, 0, stream>>>(w_out, DM, DM, WoutT, DM, 0, nullptr, 0, 0);
    n_transpose<MapId><<<dim3(DM / 32, DM / 32, 1), 256, 0, stream>>>(w_mem_kv, DM, DM, WmemT, DM, 0, nullptr, 0, 0);
    n_transpose<MapW1><<<dim3(2048 / 32, DM / 32, NEXP), 256, 0, stream>>>(w_gate_up, DM, 2048, W1T, DM, 0, g_ffn, (size_t)DM * 2048, (size_t)2048 * DM);
    n_transpose<MapId><<<dim3(DM / 32, DFF / 32, NEXP), 256, 0, stream>>>(w_down, DFF, DM, W2T, DFF, 0, nullptr, (size_t)DFF * DM, (size_t)DM * DFF);
    n_router_w<<<128, 256, 0, stream>>>(w_router, g_ffn, WrT);
#if USE_MK_P1
    launch_mk(base, 1, 2, stream);
#else
    { EpiProj E{}; E.P = PROJ; n_gemm<EpiProj, false><<<dim3(INW / 64, T_TOK / 64, 1), 256, 0, stream>>>(HB, DM, WinT, DM, DM, E); }
    n_norm_heads64<<<T_TOK * 8 / 4, 256, 0, stream>>>(PROJ, OFF_QB, g_q_moba);
    n_norm_heads64<<<T_TOK * 8 / 4, 256, 0, stream>>>(PROJ, OFF_KB, g_k_moba);
    n_kmean<<<NBATCH * 16, 512, 0, stream>>>(PROJ, KMP);
#endif
    { EpiF32 E{}; E.C = SCR; E.ldc = 1024; E.pad = 0; n_gemm<EpiF32, false><<<dim3(1024 / 64, 2048 / 64, 1), 256, 0, stream>>>(MEMN, DM, WmemT, DM, DM, E); }
    n_memkv_norm<<<2048 * 4 / 4, 256, 0, stream>>>(SCR, g_k_mem, MKV);
    n_sgu_prep<<<T_TOK / 4, 256, 0, stream>>>(PROJ, g_sgu_v, SCR);
    n_sgu<<<T_TOK * 512 / 256, 256, 0, stream>>>(PROJ, SCR, w_spatial, b_spatial, Y);
    n_moba<<<NBATCH * 8 * SEQ, 64, 0, stream>>>(PROJ, KMP, Y);
    n_memattn<<<T_TOK * 4, 64, 0, stream>>>(PROJ, MKV, g_q_mem, Y);
#if USE_MK_P3
    launch_mk(base, 3, 4, stream);
#else
    n_merged<<<dim3(DM / 64, T_TOK / 64), 256, 0, stream>>>(Y, WbrT, PROJ, (bf16_t*)(ws + WS_MERGED));
#endif
#if USE_MK_P4
    launch_mk(base, 4, 5, stream);
#else
    { EpiX1 E{}; E.x = x; E.out = out; E.x1b = (bf16_t*)(ws + WS_X1B); n_gemm<EpiX1, false><<<dim3(DM / 64, T_TOK / 64, 1), 256, 0, stream>>>((bf16_t*)(ws + WS_MERGED), DM, WoutT, DM, DM, E); }
#endif
    n_router<<<T_TOK / 8, 256, 0, stream>>>(out, WrT, b_router, RSTD2, TOPW, LIST, RSTDS, TOPWS, ctl + CW_CNT);
#if USE_MK_P6
    launch_mk(base, 6, 7, stream);
#else
    { EpiExp1 E{}; E.cnt = ctl + CW_CNT; E.LIST = LIST; E.RSTD2 = RSTD2; E.b1 = b_gate_up; E.ACT = (bf16_t*)(ws + WS_ACT);
      n_gemm<EpiExp1, true><<<dim3(DFF / 64, T_TOK / 64, NEXP), 256, 0, stream>>>((bf16_t*)(ws + WS_X1B), DM, W1T, DM, DM, E); }
#endif
#if USE_MK_P7
    launch_mk(base, 7, 8, stream);
#else
    { EpiExp2 E{}; E.cnt = ctl + CW_CNT; E.LIST = LIST; E.TOPW = TOPW; E.b2 = b_down; E.YS = YS;
      n_gemm<EpiExp2, false><<<dim3(DM / 64, T_TOK / 64, NEXP), 256, 0, stream>>>((bf16_t*)(ws + WS_ACT), DFF, W2T, DFF, DFF, E); }
#endif
    n_combine<<<T_TOK * DM / 256, 256, 0, stream>>>(out, YS);
}
```

```cpp
#include <hip/hip_runtime.h>
#include <stdint.h>
#include <cstdio>

typedef unsigned short bf16_t;
typedef short bf16x8 __attribute__((ext_vector_type(8)));
typedef float f32x4 __attribute__((ext_vector_type(4)));
typedef unsigned u32x4 __attribute__((ext_vector_type(4)));

constexpr int NBATCH = 8, SEQ = 4096, DM = 1024, T_TOK = NBATCH * SEQ, INW = 6144, MEML = 256;
constexpr int OFF_U = 0, OFF_V = 512, OFF_QB = 1024, OFF_KB = 1536, OFF_VB = 2048, OFF_QM = 2560, OFF_G = 3072;
constexpr int NEXP = 32, TOPK = 4, DFF = 1024;
constexpr float EPS = 1e-6f;
constexpr int ACT_ROWS = T_TOK * TOPK + NEXP * 256;

constexpr size_t MiB = 1ull << 20;
constexpr size_t WS_CTL = 0;
constexpr size_t WS_WIN = 1 * MiB;
constexpr size_t WS_WBR = 13 * MiB;
constexpr size_t WS_WOUT = 16 * MiB;
constexpr size_t WS_WMEM = 18 * MiB;
constexpr size_t WS_WR = 20 * MiB;
constexpr size_t WS_RSTD2 = 21 * MiB;
constexpr size_t WS_WSB = 21 * MiB + 256 * 1024;
constexpr size_t WS_KMP = 22 * MiB;
constexpr size_t WS_TOPW = 23 * MiB;
constexpr size_t WS_LIST = 24 * MiB;
constexpr size_t WS_RSTDS = 28 * MiB;
constexpr size_t WS_TOPWS = 32 * MiB;
constexpr size_t WS_MEMN = 36 * MiB;
constexpr size_t WS_MKV = 40 * MiB;
constexpr size_t WS_W1 = 44 * MiB;
constexpr size_t WS_W2 = 172 * MiB;
constexpr size_t WS_MERGED = 236 * MiB;
constexpr size_t WS_X1B = 300 * MiB;
constexpr size_t WS_HB = 364 * MiB;
constexpr size_t WS_PROJ = 428 * MiB;
constexpr size_t WS_Y = 812 * MiB;
constexpr size_t WS_ACT = 364 * MiB;
constexpr size_t WS_YS = 636 * MiB;
constexpr size_t WS_SCR = 908 * MiB;
constexpr size_t WS_END = 1024 * MiB;
constexpr int CW_CNT = 64;

__device__ __forceinline__ float bf2f(bf16_t b) { return __uint_as_float(((unsigned)b) << 16); }
__device__ __forceinline__ bf16_t f2bf(float f) { unsigned u = __float_as_uint(f); u += 0x7fffu + ((u >> 16) & 1u); return (bf16_t)(u >> 16); }
__device__ __forceinline__ float wave_sum(float v) {
#pragma unroll
    for (int o = 1; o < 64; o <<= 1) v += __shfl_xor(v, o);
    return v;
}
__device__ __forceinline__ float wave_max(float v) {
#pragma unroll
    for (int o = 1; o < 64; o <<= 1) v = fmaxf(v, __shfl_xor(v, o));
    return v;
}
__device__ __forceinline__ float gelu_exact(float v) { return 0.5f * v * (1.0f + erff(v * 0.70710678118654752f)); }
__device__ __forceinline__ float sigmoidf_(float v) { return 1.0f / (1.0f + __expf(-v)); }

__global__ __launch_bounds__(256) void n_rmsnorm_rows(const float* x, const float* g, bf16_t* out, int rows) {
    const int row = blockIdx.x * 4 + (threadIdx.x >> 6), lane = threadIdx.x & 63;
    if (row >= rows) return;
    const f32x4* xr = (const f32x4*)(x + (size_t)row * DM);
    f32x4 v[4]; float s = 0.f;
#pragma unroll
    for (int j = 0; j < 4; ++j) { v[j] = xr[lane + 64 * j]; s += v[j].x * v[j].x + v[j].y * v[j].y + v[j].z * v[j].z + v[j].w * v[j].w; }
    const float rstd = rsqrtf(wave_sum(s) * (1.0f / DM) + EPS);
#pragma unroll
    for (int j = 0; j < 4; ++j) {
        const f32x4 gv = ((const f32x4*)g)[lane + 64 * j];
        bf16_t* o = out + (size_t)row * DM + (lane + 64 * j) * 4;
        o[0] = f2bf(v[j].x * rstd * gv.x); o[1] = f2bf(v[j].y * rstd * gv.y); o[2] = f2bf(v[j].z * rstd * gv.z); o[3] = f2bf(v[j].w * rstd * gv.w);
    }
}

struct MapId { __device__ int operator()(int n) const { return n; } };
struct MapWin { __device__ int operator()(int n) const { return (n >= 1024 && n < 2048) ? (n & ~255) + 128 * ((n >> 5) & 1) + 32 * ((n >> 6) & 3) + (n & 31) : n; } };
struct MapW1 { __device__ int operator()(int n) const { const int m = n & 1023; return (m >> 7) * 256 + (n >> 10) * 128 + (m & 127); } };
template <class Map> __global__ __launch_bounds__(256) void n_transpose(const float* W, int K, int N, bf16_t* WT, int ldo, int koff, const float* gk, size_t sstride, size_t dstride) {
    const Map map;
    __shared__ float t[32][33];
    const int tx = threadIdx.x & 31, ty = threadIdx.x >> 5;
    const int k0 = blockIdx.y * 32, n0 = blockIdx.x * 32;
    W += (size_t)blockIdx.z * sstride; WT += (size_t)blockIdx.z * dstride;
    for (int i = ty; i < 32; i += 8) t[i][tx] = W[(size_t)(k0 + i) * N + n0 + tx] * (gk ? gk[k0 + i] : 1.0f);
    __syncthreads();
    for (int i = ty; i < 32; i += 8) WT[(size_t)map(n0 + i) * ldo + koff + k0 + tx] = f2bf(t[tx][i]);
}
__global__ void n_router_w(const float* wr, const float* g, float* WrT) {
    const int i = blockIdx.x * blockDim.x + threadIdx.x; if (i >= 32 * 1024) return;
    const int e = i >> 10, k = i & 1023; WrT[i] = wr[k * 32 + e] * g[k];
}

template <class Epi, bool DUAL>
__global__ __launch_bounds__(256) void n_gemm(const bf16_t* A, int lda, const bf16_t* Bt, int ldb, int K, Epi E) {
    const int wid = threadIdx.x >> 6, lane = threadIdx.x & 63, fr = lane & 15, fq = lane >> 4;
    const int z = blockIdx.z;
    if (!E.active(z, blockIdx.y * 64)) return;
    const int row0 = blockIdx.y * 64 + (wid >> 1) * 32, col0 = blockIdx.x * 64 + (wid & 1) * 32;
    const bf16_t* Bz = Bt + E.boff(z);
    const bf16_t* ap[2]; const bf16_t* bp[2]; const bf16_t* bp2[2];
#pragma unroll
    for (int i = 0; i < 2; ++i) {
        ap[i] = A + (size_t)E.arow(z, row0 + 16 * i + fr) * lda + fq * 8;
        const int c = col0 + 16 * i + fr;
        if (DUAL) { const int br = (c >> 7) * 256 + (c & 127); bp[i] = Bz + (size_t)br * ldb + fq * 8; bp2[i] = bp[i] + (size_t)128 * ldb; }
        else { bp[i] = Bz + (size_t)c * ldb + fq * 8; bp2[i] = bp[i]; }
    }
    f32x4 acc[2][2], acc2[2][2];
#pragma unroll
    for (int i = 0; i < 2; ++i)
#pragma unroll
        for (int j = 0; j < 2; ++j) { acc[i][j] = (f32x4){0.f, 0.f, 0.f, 0.f}; acc2[i][j] = acc[i][j]; }
    for (int k = 0; k < K; k += 32) {
        bf16x8 af[2], bf[2], bf2[2];
#pragma unroll
        for (int i = 0; i < 2; ++i) { af[i] = *(const bf16x8*)(ap[i] + k); bf[i] = *(const bf16x8*)(bp[i] + k); if (DUAL) bf2[i] = *(const bf16x8*)(bp2[i] + k); }
#pragma unroll
        for (int i = 0; i < 2; ++i)
#pragma unroll
            for (int j = 0; j < 2; ++j) {
                acc[i][j] = __builtin_amdgcn_mfma_f32_16x16x32_bf16(af[i], bf[j], acc[i][j], 0, 0, 0);
                if (DUAL) acc2[i][j] = __builtin_amdgcn_mfma_f32_16x16x32_bf16(af[i], bf2[j], acc2[i][j], 0, 0, 0);
            }
    }
#pragma unroll
    for (int i = 0; i < 2; ++i)
#pragma unroll
        for (int j = 0; j < 2; ++j)
#pragma unroll
            for (int r = 0; r < 4; ++r) E(z, row0 + 16 * i + fq * 4 + r, col0 + 16 * j + fr, acc[i][j][r], acc2[i][j][r]);
}

struct EpiBase { __device__ bool active(int, int) const { return true; } __device__ size_t boff(int) const { return 0; } __device__ int arow(int, int r) const { return r; } };
struct EpiProj : EpiBase { bf16_t* P;
    __device__ void operator()(int, int r, int c, float v, float) const {
        if (c < 1024) v = gelu_exact(v); else if (c >= OFF_G) v = sigmoidf_(v);
        if (c >= 1024 && c < 2048) { const int cl = c & 255; c = (c & ~255) + 64 * ((cl >> 5) & 3) + 32 * (cl >> 7) + (cl & 31); }
        P[(size_t)r * INW + c] = f2bf(v); } };
struct EpiF32 : EpiBase { float* C; int ldc; int pad; __device__ void operator()(int, int r, int c, float v, float) const { C[(size_t)r * ldc + c] = v; } };
struct EpiX1 : EpiBase { const float* x; float* out; bf16_t* x1b;
    __device__ void operator()(int, int r, int c, float v, float) const { const size_t i = (size_t)r * DM + c; const float o = x[i] + v; out[i] = o; x1b[i] = f2bf(o); } };

__global__ __launch_bounds__(256) void n_merged(const bf16_t* Y, const bf16_t* WbrT, const bf16_t* PROJ, bf16_t* MERGED) {
    const int wid = threadIdx.x >> 6, lane = threadIdx.x & 63, fr = lane & 15, fq = lane >> 4;
    const int row0 = blockIdx.y * 64 + (wid >> 1) * 32, col0 = blockIdx.x * 64 + (wid & 1) * 32;
    f32x4 tot[2][2];
#pragma unroll
    for (int i = 0; i < 2; ++i)
#pragma unroll
        for (int j = 0; j < 2; ++j) tot[i][j] = (f32x4){0.f, 0.f, 0.f, 0.f};
    for (int br = 0; br < 3; ++br) {
        f32x4 acc[2][2];
#pragma unroll
        for (int i = 0; i < 2; ++i)
#pragma unroll
            for (int j = 0; j < 2; ++j) acc[i][j] = (f32x4){0.f, 0.f, 0.f, 0.f};
        for (int k = br * 512; k < br * 512 + 512; k += 32) {
            bf16x8 af[2], bf[2];
#pragma unroll
            for (int i = 0; i < 2; ++i) { af[i] = *(const bf16x8*)(Y + (size_t)(row0 + 16 * i + fr) * 1536 + fq * 8 + k); bf[i] = *(const bf16x8*)(WbrT + (size_t)(col0 + 16 * i + fr) * 1536 + fq * 8 + k); }
#pragma unroll
            for (int i = 0; i < 2; ++i)
#pragma unroll
                for (int j = 0; j < 2; ++j) acc[i][j] = __builtin_amdgcn_mfma_f32_16x16x32_bf16(af[i], bf[j], acc[i][j], 0, 0, 0);
        }
#pragma unroll
        for (int i = 0; i < 2; ++i)
#pragma unroll
            for (int j = 0; j < 2; ++j)
#pragma unroll
                for (int r = 0; r < 4; ++r) { const int row = row0 + 16 * i + fq * 4 + r, col = col0 + 16 * j + fr; tot[i][j][r] += bf2f(PROJ[(size_t)row * INW + OFF_G + br * 1024 + col]) * acc[i][j][r]; }
    }
#pragma unroll
    for (int i = 0; i < 2; ++i)
#pragma unroll
        for (int j = 0; j < 2; ++j)
#pragma unroll
            for (int r = 0; r < 4; ++r) MERGED[(size_t)(row0 + 16 * i + fq * 4 + r) * DM + col0 + 16 * j + fr] = f2bf(tot[i][j][r]);
}

__global__ __launch_bounds__(256) void n_norm_heads64(bf16_t* PROJ, int off, const float* g) {
    const int w = blockIdx.x * 4 + (threadIdx.x >> 6), lane = threadIdx.x & 63;
    const int t = w >> 3, h = w & 7;
    bf16_t* p = PROJ + (size_t)t * INW + off + h * 64 + lane;
    const float v = bf2f(*p); const float rstd = rsqrtf(wave_sum(v * v) * (1.0f / 64.0f) + EPS);
    *p = f2bf(v * rstd * g[lane]);
}
__global__ __launch_bounds__(512) void n_kmean(const bf16_t* PROJ, float* KMP) {
    const int bb = blockIdx.x, c = threadIdx.x;
    float s = 0.f; for (int r = 0; r < 256; ++r) s += bf2f(PROJ[((size_t)bb * 256 + r) * INW + OFF_KB + c]);
    KMP[((size_t)bb * 2 + 0) * 512 + c] = s; KMP[((size_t)bb * 2 + 1) * 512 + c] = 0.f;
}
__global__ __launch_bounds__(256) void n_memkv_norm(const float* raw, const float* g, bf16_t* MKV) {
    const int w = blockIdx.x * 4 + (threadIdx.x >> 6), lane = threadIdx.x & 63;
    const int r = w >> 2, h = w & 3;
    const float* p = raw + (size_t)r * 1024 + h * 128;
    const float a = p[lane], b = p[lane + 64];
    const float rstd = rsqrtf(wave_sum(a * a + b * b) * (1.0f / 128.0f) + EPS);
    bf16_t* o = MKV + (size_t)r * 1024 + h * 128;
    o[lane] = f2bf(a * rstd * g[lane]); o[lane + 64] = f2bf(b * rstd * g[lane + 64]);
    o[512 + lane] = f2bf(p[512 + lane]); o[512 + lane + 64] = f2bf(p[512 + lane + 64]);
}
__global__ __launch_bounds__(256) void n_sgu_prep(const bf16_t* PROJ, const float* g, float* VN) {
    const int t = blockIdx.x * 4 + (threadIdx.x >> 6), lane = threadIdx.x & 63;
    float v[8]; float s = 0.f;
#pragma unroll
    for (int j = 0; j < 8; ++j) { v[j] = bf2f(PROJ[(size_t)t * INW + OFF_V + lane + 64 * j]); s += v[j] * v[j]; }
    const float rstd = rsqrtf(wave_sum(s) * (1.0f / 512.0f) + EPS);
#pragma unroll
    for (int j = 0; j < 8; ++j) VN[(size_t)t * 512 + lane + 64 * j] = v[j] * rstd * g[lane + 64 * j];
}
__global__ __launch_bounds__(256) void n_sgu(const bf16_t* PROJ, const float* VN, const float* ws, const float* bs, bf16_t* Y) {
    const int i = blockIdx.x * 256 + threadIdx.x; const int t = i >> 9, c = i & 511, g = c >> 7;
    const int tl = t & 127, t0 = t - tl;
    float s = bs[g * 128 + tl];
    const float* w = ws + ((size_t)g * 128 + tl) * 128;
    for (int sidx = 0; sidx <= tl; ++sidx) s += w[sidx] * VN[(size_t)(t0 + sidx) * 512 + c];
    Y[(size_t)t * 1536 + c] = f2bf(bf2f(PROJ[(size_t)t * INW + OFF_U + c]) * s);
}
__global__ __launch_bounds__(64) void n_moba(const bf16_t* PROJ, const float* KMP, bf16_t* Y) {
    const int idx = blockIdx.x; const int t = idx & (SEQ - 1), h = (idx >> 12) & 7, b = idx >> 15;
    const int lane = threadIdx.x;
    __shared__ float qs[64]; __shared__ float ps[1024];
    const size_t rowq = (size_t)b * SEQ + t;
    qs[lane] = bf2f(PROJ[rowq * INW + OFF_QB + h * 64 + lane]);
    __syncthreads();
    const int jb = t >> 8;
    float gate = -1e30f;
    if (lane < 16 && lane < jb) {
        float s = 0.f; const float* k0 = KMP + ((size_t)(b * 16 + lane) * 2) * 512 + h * 64;
        for (int d = 0; d < 64; ++d) s += qs[d] * ((k0[d] + k0[512 + d]) * (1.0f / 256.0f));
        gate = s;
    }
    int blk[4];
#pragma unroll
    for (int i = 0; i < 3; ++i) {
        float m = gate; int mi = lane;
#pragma unroll
        for (int o = 1; o < 64; o <<= 1) { const float om = __shfl_xor(m, o); const int oi = __shfl_xor(mi, o); if (om > m || (om == m && oi < mi)) { m = om; mi = oi; } }
        blk[i] = (m > -5e29f) ? mi : -1;
        if (lane == mi) gate = -3e38f;
    }
    blk[3] = jb;
    const float slope = exp2f(-(float)(h + 1));
    float mx = -3e38f;
#pragma unroll
    for (int i = 0; i < 4; ++i) {
        for (int r = 0; r < 4; ++r) {
            const int j = lane + 64 * r; float s = -1e30f;
            if (blk[i] >= 0) {
                const int key = blk[i] * 256 + j;
                if (i < 3 || key <= t) {
                    const bf16_t* kp = PROJ + ((size_t)b * SEQ + key) * INW + OFF_KB + h * 64; float d = 0.f;
                    for (int e = 0; e < 64; ++e) d += qs[e] * bf2f(kp[e]);
                    s = d * 0.125f - slope * (float)(t - key);
                }
            }
            ps[i * 256 + j] = s; mx = fmaxf(mx, s);
        }
    }
    mx = wave_max(mx);
    float sum = 0.f;
    for (int i = lane; i < 1024; i += 64) { const float p = __expf(ps[i] - mx); ps[i] = p; sum += p; }
    sum = wave_sum(sum);
    __syncthreads();
    float o = 0.f;
#pragma unroll
    for (int i = 0; i < 4; ++i) {
        if (blk[i] < 0) continue;
        for (int j = 0; j < 256; ++j) { const float p = ps[i * 256 + j]; if (p != 0.f) o += p * bf2f(PROJ[((size_t)b * SEQ + blk[i] * 256 + j) * INW + OFF_VB + h * 64 + lane]); }
    }
    Y[rowq * 1536 + 512 + h * 64 + lane] = f2bf(o / sum);
}
__global__ __launch_bounds__(64) void n_memattn(const bf16_t* PROJ, const bf16_t* MKV, const float* gq, bf16_t* Y) {
    const int idx = blockIdx.x; const int h = idx & 3, tt = idx >> 2, b = tt >> 12;
    const int lane = threadIdx.x;
    __shared__ float qs[128]; __shared__ float ps[256];
    const float a = bf2f(PROJ[(size_t)tt * INW + OFF_QM + h * 128 + lane]), c = bf2f(PROJ[(size_t)tt * INW + OFF_QM + h * 128 + 64 + lane]);
    const float rstd = rsqrtf(wave_sum(a * a + c * c) * (1.0f / 128.0f) + EPS);
    qs[lane] = a * rstd * gq[lane]; qs[lane + 64] = c * rstd * gq[lane + 64];
    __syncthreads();
    float mx = -3e38f;
    for (int r = 0; r < 4; ++r) {
        const int m = lane + 64 * r; const bf16_t* kp = MKV + ((size_t)b * MEML + m) * 1024 + h * 128; float d = 0.f;
        for (int e = 0; e < 128; ++e) d += qs[e] * bf2f(kp[e]);
        d *= 0.08838834764831845f; ps[m] = d; mx = fmaxf(mx, d);
    }
    mx = wave_max(mx);
    float sum = 0.f;
    for (int i = lane; i < 256; i += 64) { const float p = __expf(ps[i] - mx); ps[i] = p; sum += p; }
    sum = wave_sum(sum);
    __syncthreads();
    float o0 = 0.f, o1 = 0.f;
    for (int m = 0; m < 256; ++m) { const float p = ps[m]; const bf16_t* vp = MKV + ((size_t)b * MEML + m) * 1024 + 512 + h * 128; o0 += p * bf2f(vp[lane]); o1 += p * bf2f(vp[lane + 64]); }
    Y[(size_t)tt * 1536 + 1024 + h * 128 + lane] = f2bf(o0 / sum); Y[(size_t)tt * 1536 + 1024 + h * 128 + 64 + lane] = f2bf(o1 / sum);
}
__global__ __launch_bounds__(256) void n_router(const float* X1, const float* WrT, const float* br, float* RSTD2, float* TOPW, int* LIST, float* RSTDS, float* TOPWS, unsigned* cnt) {
    const int tl = threadIdx.x >> 5, e = threadIdx.x & 31; const int t = blockIdx.x * 8 + tl;
    const float* xr = X1 + (size_t)t * DM; const float* w = WrT + (size_t)e * DM;
    float ss = 0.f, acc = 0.f;
    for (int k = 0; k < DM; ++k) { const float xv = xr[k]; ss += xv * xv; acc += xv * w[k]; }
    const float rstd = rsqrtf(ss * (1.0f / DM) + EPS);
    float logit = acc * rstd + br[e];
    if (e == 0) RSTD2[t] = rstd;
    float sel_l[4]; int sel_e[4]; float cur = logit;
#pragma unroll
    for (int i = 0; i < 4; ++i) {
        float m = cur; int mi = e;
#pragma unroll
        for (int o = 1; o < 32; o <<= 1) { const float om = __shfl_xor(m, o); const int oi = __shfl_xor(mi, o); if (om > m || (om == m && oi < mi)) { m = om; mi = oi; } }
        sel_l[i] = m; sel_e[i] = mi; if (e == mi) cur = -3e38f;
    }
    if (e < 4) {
        float den = 0.f;
#pragma unroll
        for (int i = 0; i < 4; ++i) den += __expf(sel_l[i] - sel_l[0]);
        float myl = sel_l[0]; int mye = sel_e[0];
#pragma unroll
        for (int i = 1; i < 4; ++i) if (e == i) { myl = sel_l[i]; mye = sel_e[i]; }
        const float wgt = __expf(myl - sel_l[0]) / den;
        const unsigned pos = atomicAdd(cnt + mye, 1u);
        LIST[mye * 32768 + pos] = t * 4 + e; TOPW[t * 4 + e] = wgt; RSTDS[mye * 32768 + pos] = rstd; TOPWS[mye * 32768 + pos] = wgt;
    }
}
__device__ __forceinline__ int expert_base(const unsigned* cnt, int e) { int b = 0; for (int i = 0; i < e; ++i) b += (int)((cnt[i] + 255u) & ~255u); return b; }
struct EpiExp1 { const unsigned* cnt; const int* LIST; const float* RSTD2; const float* b1; bf16_t* ACT;
    __device__ bool active(int z, int r0) const { return r0 < (int)cnt[z]; }
    __device__ size_t boff(int z) const { return (size_t)z * 2048 * 1024; }
    __device__ int arow(int z, int r) const { return r < (int)cnt[z] ? (LIST[z * 32768 + r] >> 2) : 0; }
    __device__ void operator()(int z, int r, int c, float vg, float vl) const {
        if (r >= (int)cnt[z]) return;
        const int tok = LIST[z * 32768 + r] >> 2; const float rs = RSTD2[tok];
        float g = rs * vg + b1[z * 2048 + c], l = rs * vl + b1[z * 2048 + 1024 + c];
        g = fminf(g, 7.0f); l = fminf(fmaxf(l, -7.0f), 7.0f);
        ACT[(size_t)(expert_base(cnt, z) + r) * DFF + c] = f2bf(g * sigmoidf_(1.702f * g) * (l + 1.0f)); } };
struct EpiExp2 { const unsigned* cnt; const int* LIST; const float* TOPW; const float* b2; bf16_t* YS;
    __device__ bool active(int z, int r0) const { return r0 < (int)cnt[z]; }
    __device__ size_t boff(int z) const { return (size_t)z * 1024 * 1024; }
    __device__ int arow(int z, int r) const { return expert_base(cnt, z) + r; }
    __device__ void operator()(int z, int r, int c, float v, float) const {
        if (r >= (int)cnt[z]) return;
        const int slot = LIST[z * 32768 + r];
        YS[(size_t)slot * DM + c] = f2bf((v + b2[z * 1024 + c]) * TOPW[slot]); } };
__global__ __launch_bounds__(256) void n_combine(float* out, const bf16_t* YS) {
    const size_t i = (size_t)blockIdx.x * 256 + threadIdx.x; const size_t t = i >> 10, c = i & 1023;
    float s = out[i];
#pragma unroll
    for (int k = 0; k < 4; ++k) s += bf2f(YS[(t * 4 + k) * DM + c]);
    out[i] = s;
}

#define LAS __attribute__((address_space(3)))
typedef float f32x2 __attribute__((ext_vector_type(2)));
constexpr int NWAVES = 8;
constexpr int RING_BYTES = 131072;
constexpr int LDSCTL_OFF = RING_BYTES;
constexpr int TAB_OFF = RING_BYTES + 64;
constexpr int TAB_CNT = 0, TAB_TST = 32, TAB_TE = 96, TAB_WORDS = 96 + 576;
constexpr int LDS_BYTES = 147456;
static_assert(TAB_OFF + TAB_WORDS * 4 <= LDS_BYTES, "LDS map");
constexpr int CW_BAR = 4096;

#define XB_TMO      128
#define XB_XCNT(j)  (256  + 64 * (j))
#define XB_XSUB(j)  (1280 + 64 * (j))
#define XB_XGEN(j)  (2304 + 64 * (j))
#define XB_TOP      3328
#define XB_TOPGEN   3392
#define XCD_BAR_WORDS 3456
#define XB_SPIN_CAP (1u << 18)
__device__ __forceinline__ unsigned xb_ld(unsigned* p)              { return __hip_atomic_load(p, __ATOMIC_RELAXED, __HIP_MEMORY_SCOPE_AGENT); }
__device__ __forceinline__ unsigned xb_add(unsigned* p, unsigned v) { return __hip_atomic_fetch_add(p, v, __ATOMIC_RELAXED, __HIP_MEMORY_SCOPE_AGENT); }
__device__ __forceinline__ unsigned xb_xcc_id() { return (unsigned)__builtin_amdgcn_s_getreg((3 << 11) | 20) & 0xFu; }
#define XB_SPIN(cond, bar) do { unsigned _sp = 0; while (cond) { __builtin_amdgcn_s_sleep(1); \
    if ((++_sp & 255u) == 0u) { if (xb_ld(&(bar)[XB_TMO])) break; if (_sp > XB_SPIN_CAP) { atomicAdd(&(bar)[XB_TMO], 1u); break; } } } } while (0)
struct XcdBarrier { unsigned* bar; unsigned x; volatile LAS unsigned* st; };
__device__ __forceinline__ XcdBarrier xcd_barrier_post(unsigned* bar, volatile LAS unsigned* st) {
    XcdBarrier b; b.bar = bar; b.x = xb_xcc_id(); b.st = st;
    if (threadIdx.x == 0) (void)xb_add(&bar[XB_XCNT(b.x)], 1u);
    return b;
}
__device__ __forceinline__ void xcd_barrier_complete(unsigned* bar, unsigned x, unsigned& nloc, unsigned& nx) {
    const unsigned G = gridDim.x * gridDim.y * gridDim.z;
    unsigned sum, cnt, mine, sp = 0u;
    for (;;) {
        sum = 0u; cnt = 0u; mine = 0u;
#pragma unroll
        for (unsigned j = 0; j < 16; ++j) { const unsigned c = xb_ld(&bar[XB_XCNT(j)]); sum += c; cnt += (c > 0u) ? 1u : 0u; mine = (j == x) ? c : mine; }
        if (sum == G) break;
        __builtin_amdgcn_s_sleep(1);
        if ((++sp & 255u) == 0u) { if (xb_ld(&bar[XB_TMO])) break; if (sp > XB_SPIN_CAP) { atomicAdd(&bar[XB_TMO], 1u); break; } }
    }
    nloc = mine > 0u ? mine : 1u; nx = cnt > 0u ? cnt : 1u;
}
__device__ __forceinline__ void xcd_barrier(const XcdBarrier& b) {
    asm volatile("s_waitcnt vmcnt(0)" ::: "memory");
    __syncthreads();
    if (threadIdx.x == 0) {
        unsigned* bar = b.bar;
        __builtin_amdgcn_s_waitcnt(0);
        unsigned nloc = b.st[0], nx = b.st[1];
        if (nloc == 0u) { xcd_barrier_complete(bar, b.x, nloc, nx); b.st[0] = nloc; b.st[1] = nx; }
        const unsigned old = xb_add(&bar[XB_XSUB(b.x)], 1u);
        const unsigned gen = old / nloc;
        if (old + 1u == (gen + 1u) * nloc) {
            __builtin_amdgcn_fence(__ATOMIC_RELEASE, "agent");
            asm volatile("s_waitcnt vmcnt(0)" ::: "memory");
            const unsigned og = xb_add(&bar[XB_TOP], 1u);
            const unsigned tg = og / nx;
            if (og + 1u == (tg + 1u) * nx) xb_add(&bar[XB_TOPGEN], 1u);
            else XB_SPIN(xb_ld(&bar[XB_TOPGEN]) == tg, bar);
            __builtin_amdgcn_fence(__ATOMIC_ACQUIRE, "agent");
            xb_add(&bar[XB_XGEN(b.x)], 1u);
            asm volatile("s_waitcnt vmcnt(0)" ::: "memory");
        } else {
            XB_SPIN(xb_ld(&bar[XB_XGEN(b.x)]) == gen, bar);
            __builtin_amdgcn_fence(__ATOMIC_ACQUIRE, "agent");
            asm volatile("s_waitcnt vmcnt(0)" ::: "memory");
        }
    }
    __syncthreads();
}

namespace pg {
constexpr int BM = 256, BK = 64, HALF = 128, HTB = HALF * BK * 2, STAGE_BYTES = 8 * HTB, NXCD = 8, WGM = 8;
__host__ __device__ __forceinline__ int lds_byte(int r, int c) { const int st = (r >> 4) * 2 + (c >> 5), rr = r & 15, cc = c & 31, ob = rr * 64 + cc * 2; return st * 1024 + (ob ^ (((ob >> 9) & 1) << 5)); }
__host__ __device__ __forceinline__ void stage_rc(int b, int& R, int& C) { const int st = b / 1024, sb = b % 1024, swz = sb ^ (((sb >> 9) & 1) << 5); R = (st >> 1) * 16 + swz / 64; C = (st & 1) * 32 + (swz % 64) / 2; }
__host__ __device__ __forceinline__ int perm32(int rho) { const int n = rho >> 4, i = rho & 15; return 8 * (i >> 2) + 4 * n + (i & 3); }
struct Unit { int pm, pn, e, mt; };
__device__ __forceinline__ bool static_unit(long L, int nM, int nN, int& pm, int& pn) {
    const int nwg = nM * nN; if (L >= nwg) return false;
    int wgid = (int)L; { const int q = nwg / NXCD, r = nwg % NXCD, xcd = wgid % NXCD, off = wgid / NXCD; wgid = (xcd < r ? xcd * (q + 1) : r * (q + 1) + (xcd - r) * q) + off; }
    const int nig = WGM * nN, gid = wgid / nig, fm = gid * WGM, gsz = (nM - fm) < WGM ? (nM - fm) : WGM;
    pm = fm + ((wgid % nig) % gsz); pn = (wgid % nig) / gsz; return true;
}
__device__ __forceinline__ unsigned cvt_pk_bf16(float lo, float hi) { unsigned r; asm volatile("v_cvt_pk_bf16_f32 %0, %1, %2" : "=v"(r) : "v"(lo), "v"(hi)); return r; }
__device__ __forceinline__ u32x4 pack8(const f32x4 v0, const f32x4 v1) { u32x4 w; w.x = cvt_pk_bf16(v0[0], v0[1]); w.y = cvt_pk_bf16(v0[2], v0[3]); w.z = cvt_pk_bf16(v1[0], v1[1]); w.w = cvt_pk_bf16(v1[2], v1[3]); return w; }
__device__ __forceinline__ void unpack8(const u32x4 w, f32x4& v0, f32x4& v1) {
    v0[0] = __uint_as_float(w.x << 16); v0[1] = __uint_as_float(w.x & 0xffff0000u); v0[2] = __uint_as_float(w.y << 16); v0[3] = __uint_as_float(w.y & 0xffff0000u);
    v1[0] = __uint_as_float(w.z << 16); v1[1] = __uint_as_float(w.z & 0xffff0000u); v1[2] = __uint_as_float(w.w << 16); v1[3] = __uint_as_float(w.w & 0xffff0000u); }
__device__ __forceinline__ f32x2 gelu_pk(f32x2 v) {
    const f32x2 av = __builtin_elementwise_abs(v), d = av * 0.2316418882f + 1.0f;
    f32x2 t; t.x = __builtin_amdgcn_rcpf(d.x); t.y = __builtin_amdgcn_rcpf(d.y);
    f32x2 q = t * 0.5307027145f + (-0.7265760135f); q = q * t + 0.7107068705f; q = q * t + (-0.142248368f); q = q * t + 0.127414796f; q = q * t;
    const f32x2 s = (v * v) * (-0.72134752044f);
    f32x2 e; e.x = __builtin_amdgcn_exp2f(s.x); e.y = __builtin_amdgcn_exp2f(s.y);
    const f32x2 m = v * (q * e), r = v - m;
    f32x2 o; o.x = v.x < 0.f ? m.x : r.x; o.y = v.y < 0.f ? m.y : r.y; return o;
}
__device__ __forceinline__ f32x4 gelu4(f32x4 v) { const f32x2 a = gelu_pk((f32x2){v[0], v[1]}), b = gelu_pk((f32x2){v[2], v[3]}); return (f32x4){a.x, a.y, b.x, b.y}; }
__device__ __forceinline__ float sigm(float v) { return __builtin_amdgcn_rcpf(1.0f + __builtin_amdgcn_exp2f(v * -1.4426950408889634f)); }
__device__ __forceinline__ f32x4 sigm4(f32x4 v) { return (f32x4){sigm(v[0]), sigm(v[1]), sigm(v[2]), sigm(v[3])}; }

template <class Pol>
__device__ __forceinline__ void gemm_run(LAS unsigned char* lds, const Pol& P) {
    constexpr int K = Pol::K, nt = K / BK;
    const int tid = threadIdx.x, wid = __builtin_amdgcn_readfirstlane(tid >> 6), lane = tid & 63, wr = wid >> 2, wc = wid & 3, fr = lane & 15, fq = lane >> 4;
    unsigned voffA[2], voffB[2]; int Rr[2], Cc[2];
#pragma unroll
    for (int i = 0; i < 2; ++i) { int R, C; stage_rc(tid * 16 + i * 8192, R, C); Rr[i] = R; Cc[i] = C; const int Rb = (R & ~31) + perm32(R & 31);
        voffA[i] = (unsigned)(R * K + C) * 2u; voffB[i] = (unsigned)(Rb * K + C) * 2u; }
    constexpr unsigned kstep = BK * 2, hstep = HALF * K * 2;
    const unsigned ldsw = (unsigned)wid * 1024u;
    const int aoff = lds_byte(wr * 64 + fr, fq * 8), boff = lds_byte(wc * 32 + fr, fq * 8);
#define PG_SA(b, h) (((b) * 2 + (h)) * HTB)
#define PG_SB(b, h) ((4 + (b) * 2 + (h)) * HTB)
#define PG_AOFF(nx, h, i) (Pol::GATHER ? ((nx) ? gN[h][i] : gC[h][i]) : (voffA[i] + (unsigned)(h) * hstep))
#define PG_STAGE_A(bufoff, gbase, nx, h) do { _Pragma("unroll") for (int _i = 0; _i < 2; ++_i) \
        __builtin_amdgcn_global_load_lds((const unsigned*)((const char*)(gbase) + PG_AOFF(nx, h, _i)), (LAS unsigned*)(lds + (bufoff) + ldsw + _i * 8192), 16, 0, 0); } while (0)
#define PG_STAGE_B(bufoff, gbase) do { _Pragma("unroll") for (int _i = 0; _i < 2; ++_i) \
        __builtin_amdgcn_global_load_lds((const unsigned*)((const char*)(gbase) + voffB[_i]), (LAS unsigned*)(lds + (bufoff) + ldsw + _i * 8192), 16, 0, 0); } while (0)
#define PG_LDA(dst, b, h) do { _Pragma("unroll") for (int m = 0; m < 4; ++m) _Pragma("unroll") for (int k = 0; k < 2; ++k) dst[m][k] = *(const LAS bf16x8*)(lds + PG_SA(b, h) + aoff + m * 2048 + k * 1024); } while (0)
#define PG_LDB(dst, b, h) do { _Pragma("unroll") for (int n = 0; n < 2; ++n) _Pragma("unroll") for (int k = 0; k < 2; ++k) dst[n][k] = *(const LAS bf16x8*)(lds + PG_SB(b, h) + boff + n * 2048 + k * 1024); } while (0)
#define PG_MMA(ai, bj, At, Bt) do { __builtin_amdgcn_s_setprio(1); _Pragma("unroll") for (int m = 0; m < 4; ++m) _Pragma("unroll") for (int n = 0; n < 2; ++n) _Pragma("unroll") for (int k = 0; k < 2; ++k) \
        acc[ai][bj][m][n] = __builtin_amdgcn_mfma_f32_16x16x32_bf16(Bt[n][k], At[m][k], acc[ai][bj][m][n], 0, 0, 0); __builtin_amdgcn_s_setprio(0); } while (0)
#define PG_WAIT_V(n) asm volatile("s_waitcnt vmcnt(" #n ")" ::: "memory")
#define PG_WAIT_L(n) asm volatile("s_waitcnt lgkmcnt(" #n ")" ::: "memory")
#define PG_BAR __builtin_amdgcn_s_barrier()
#define PG_SCHED __builtin_amdgcn_sched_barrier(0)
    Unit cur, nxt; int ui = 0;
    if (!P.next(0, cur)) return;
    f32x4 acc[2][2][4][2];
#pragma unroll
    for (int a = 0; a < 2; ++a)
#pragma unroll
        for (int b = 0; b < 2; ++b)
#pragma unroll
            for (int m = 0; m < 4; ++m)
#pragma unroll
                for (int n = 0; n < 2; ++n) acc[a][b][m][n] = (f32x4){0.f, 0.f, 0.f, 0.f};
    bf16x8 At[4][2], B0[2][2], B1[2][2];
    unsigned gC[2][2] = {{0u, 0u}, {0u, 0u}}, gN[2][2] = {{0u, 0u}, {0u, 0u}};
    const char* cA = P.a_base(cur); const char* cB = P.b_base(cur);
    if constexpr (Pol::GATHER) P.a_offsets(cur, Rr, Cc, gC);
    PG_STAGE_B(PG_SB(0, 0), cB); PG_STAGE_B(PG_SB(0, 1), cB + hstep); PG_STAGE_A(PG_SA(0, 0), cA, false, 0); PG_STAGE_A(PG_SA(0, 1), cA, false, 1);
    if (wr == 1) PG_BAR;
    PG_WAIT_V(2); PG_BAR;
    PG_STAGE_B(PG_SB(1, 0), cB + kstep); PG_STAGE_A(PG_SA(1, 0), cA + kstep, false, 0); PG_STAGE_B(PG_SB(1, 1), cB + hstep + kstep);
    PG_WAIT_V(6); PG_BAR;
    for (;;) {
        const bool has_next = P.next(ui + 1, nxt);
        const char* nA = has_next ? P.a_base(nxt) : cA; const char* nB = has_next ? P.b_base(nxt) : cB;
#pragma nounroll
        for (int t = 0; t < nt; t += 2) {
            const bool last = (t == nt - 2);
            if constexpr (Pol::GATHER) { if (last) { if (has_next) P.a_offsets(nxt, Rr, Cc, gN); else { gN[0][0] = gC[0][0]; gN[0][1] = gC[0][1]; gN[1][0] = gC[1][0]; gN[1][1] = gC[1][1]; } } }
            if constexpr (Pol::HOOK) { if (t == Pol::H1 || t == Pol::H2) P.khook(t, acc, cur, wr, wc, fr, fq); }
            const char* a1 = cA + (size_t)(t + 1) * kstep;
            const char* a2 = last ? nA : cA + (size_t)(t + 2) * kstep; const char* b2 = last ? nB : cB + (size_t)(t + 2) * kstep;
            const char* a3 = a2 + kstep; const char* b3 = b2 + kstep;
            PG_LDB(B0, 0, 0); PG_LDB(B1, 0, 1); PG_SCHED; PG_LDA(At, 0, 0); PG_STAGE_A(PG_SA(1, 1), a1, false, 1);
            PG_WAIT_V(8); PG_WAIT_L(0); PG_BAR; PG_MMA(0, 0, At, B0); PG_MMA(0, 1, At, B1); PG_BAR; PG_SCHED;
            PG_LDA(At, 0, 1); PG_STAGE_B(PG_SB(0, 0), b2); PG_STAGE_B(PG_SB(0, 1), b2 + hstep); PG_STAGE_A(PG_SA(0, 0), a2, last, 0);
            PG_WAIT_V(8); PG_WAIT_L(0); PG_BAR; PG_MMA(1, 0, At, B0); PG_MMA(1, 1, At, B1); PG_BAR; PG_SCHED;
            PG_LDB(B0, 1, 0); PG_LDB(B1, 1, 1); PG_SCHED; PG_LDA(At, 1, 0); PG_STAGE_A(PG_SA(0, 1), a2, last, 1);
            PG_WAIT_V(8); PG_WAIT_L(0); PG_BAR; PG_MMA(0, 0, At, B0); PG_MMA(0, 1, At, B1); PG_BAR; PG_SCHED;
            PG_LDA(At, 1, 1); PG_STAGE_B(PG_SB(1, 0), b3); PG_STAGE_B(PG_SB(1, 1), b3 + hstep); PG_STAGE_A(PG_SA(1, 0), a3, last, 0);
            PG_WAIT_V(8); PG_WAIT_L(0); PG_BAR; PG_MMA(1, 0, At, B0); PG_MMA(1, 1, At, B1); PG_BAR; PG_SCHED;
        }
        if (wr == 0) PG_BAR;
        P.epi(acc, cur, wr, wc, fr, fq);
        if (!has_next) break;
#pragma unroll
        for (int a = 0; a < 2; ++a)
#pragma unroll
            for (int b = 0; b < 2; ++b)
#pragma unroll
                for (int m = 0; m < 4; ++m)
#pragma unroll
                    for (int n = 0; n < 2; ++n) acc[a][b][m][n] = (f32x4){0.f, 0.f, 0.f, 0.f};
        cur = nxt; cA = nA; cB = nB; ++ui;
        if constexpr (Pol::GATHER) { gC[0][0] = gN[0][0]; gC[0][1] = gN[0][1]; gC[1][0] = gN[1][0]; gC[1][1] = gN[1][1]; }
        if (wr == 1) PG_BAR;
    }
    PG_WAIT_V(0);
    PG_BAR;
#undef PG_SA
#undef PG_SB
#undef PG_AOFF
#undef PG_STAGE_A
#undef PG_STAGE_B
#undef PG_LDA
#undef PG_LDB
#undef PG_MMA
#undef PG_WAIT_V
#undef PG_WAIT_L
#undef PG_BAR
#undef PG_SCHED
}

struct PolBase { static constexpr bool GATHER = false, HOOK = false; static constexpr int H1 = -1, H2 = -1;
    __device__ __forceinline__ void a_offsets(const Unit&, const int (&)[2], const int (&)[2], unsigned (&)[2][2]) const {}
    __device__ __forceinline__ void khook(int, f32x4 (&)[2][2][4][2], const Unit&, int, int, int, int) const {} };

struct PolP1 : PolBase {
    static constexpr int K = 1024;
    const bf16_t* A; const bf16_t* Bt; bf16_t* PROJ; float* KMP; const float* gq; const float* gk; int G, c;
    __device__ __forceinline__ bool next(int i, Unit& u) const { u.e = 0; u.mt = 0; return static_unit((long)i * G + c, T_TOK / 256, INW / 256, u.pm, u.pn); }
    __device__ __forceinline__ const char* a_base(const Unit& u) const { return (const char*)A + (size_t)u.pm * 256 * K * 2; }
    __device__ __forceinline__ const char* b_base(const Unit& u) const { return (const char*)Bt + (size_t)u.pn * 256 * K * 2; }
    __device__ __forceinline__ void epi(const f32x4 (&acc)[2][2][4][2], const Unit& u, int wr, int wc, int fr, int fq) const {
        const int row0 = u.pm * 256 + wr * 64 + fr, pn = u.pn;
        if (pn >= 4 && pn < 8) {
            const float* g = (pn < 6) ? gq : gk;
            f32x4 gv[2][2], cs[2][2];
#pragma unroll
            for (int bj = 0; bj < 2; ++bj)
#pragma unroll
                for (int n = 0; n < 2; ++n) { gv[bj][n] = *(const f32x4*)(g + 32 * bj + 8 * fq + 4 * n); cs[bj][n] = (f32x4){0.f, 0.f, 0.f, 0.f}; }
#pragma unroll
            for (int ai = 0; ai < 2; ++ai)
#pragma unroll
                for (int m = 0; m < 4; ++m) {
                    float ss = 0.f;
#pragma unroll
                    for (int bj = 0; bj < 2; ++bj)
#pragma unroll
                        for (int n = 0; n < 2; ++n) { const f32x4 x = acc[ai][bj][m][n]; ss += (x[0] * x[0] + x[1] * x[1]) + (x[2] * x[2] + x[3] * x[3]); }
                    ss += __shfl_xor(ss, 16); ss += __shfl_xor(ss, 32);
                    const float rstd = rsqrtf(ss * (1.0f / 64.0f) + EPS);
                    bf16_t* rowp = PROJ + (size_t)(row0 + ai * HALF + m * 16) * INW + 1024 + (pn - 4) * 256 + 64 * wc + 8 * fq;
#pragma unroll
                    for (int bj = 0; bj < 2; ++bj) { const f32x4 v0 = acc[ai][bj][m][0] * rstd * gv[bj][0], v1 = acc[ai][bj][m][1] * rstd * gv[bj][1];
                        cs[bj][0] += v0; cs[bj][1] += v1; *(u32x4*)(rowp + 32 * bj) = pack8(v0, v1); }
                }
            if (pn >= 6) {
#pragma unroll
                for (int bj = 0; bj < 2; ++bj)
#pragma unroll
                    for (int n = 0; n < 2; ++n)
#pragma unroll
                        for (int j = 0; j < 4; ++j) { float s = cs[bj][n][j]; s += __shfl_xor(s, 1); s += __shfl_xor(s, 2); s += __shfl_xor(s, 4); s += __shfl_xor(s, 8); cs[bj][n][j] = s; }
                if (fr == 0) {
                    float* kp = KMP + ((size_t)u.pm * 2 + wr) * 512 + (pn - 6) * 256 + 64 * wc + 8 * fq;
#pragma unroll
                    for (int bj = 0; bj < 2; ++bj) { *(f32x4*)(kp + 32 * bj) = cs[bj][0]; *(f32x4*)(kp + 32 * bj + 4) = cs[bj][1]; }
                }
            }
        } else {
            const int col0 = pn * 256 + wc * 32 + 8 * fq;
#pragma unroll
            for (int ai = 0; ai < 2; ++ai)
#pragma unroll
                for (int m = 0; m < 4; ++m) { bf16_t* rowp = PROJ + (size_t)(row0 + ai * HALF + m * 16) * INW + col0;
#pragma unroll
                    for (int bj = 0; bj < 2; ++bj) { f32x4 v0 = acc[ai][bj][m][0], v1 = acc[ai][bj][m][1];
                        if (pn < 4) { v0 = gelu4(v0); v1 = gelu4(v1); } else if (pn >= 12) { v0 = sigm4(v0); v1 = sigm4(v1); }
                        *(u32x4*)(rowp + bj * HALF) = pack8(v0, v1); } }
        }
    }
};
struct PolP3 : PolBase {
    static constexpr int K = 1536; static constexpr bool HOOK = true; static constexpr int H1 = 8, H2 = 16;
    const bf16_t* A; const bf16_t* Bt; const bf16_t* PROJ; bf16_t* MERGED; int G, c;
    __device__ __forceinline__ bool next(int i, Unit& u) const { u.e = 0; u.mt = 0; return static_unit((long)i * G + c, T_TOK / 256, DM / 256, u.pm, u.pn); }
    __device__ __forceinline__ const char* a_base(const Unit& u) const { return (const char*)A + (size_t)u.pm * 256 * K * 2; }
    __device__ __forceinline__ const char* b_base(const Unit& u) const { return (const char*)Bt + (size_t)u.pn * 256 * K * 2; }
    __device__ __forceinline__ void khook(int t, f32x4 (&acc)[2][2][4][2], const Unit& u, int wr, int wc, int fr, int fq) const {
        const int gnum = (t == 8) ? 0 : 1024;
        int zero = 0; asm volatile("" : "+v"(zero));
        const int row0 = u.pm * 256 + wr * 64 + fr + zero, col0 = OFF_G + u.pn * 256 + wc * 32 + 8 * fq;
#pragma unroll
        for (int ai = 0; ai < 2; ++ai)
#pragma unroll
            for (int m = 0; m < 4; ++m) { const bf16_t* rowp = PROJ + (size_t)(row0 + ai * HALF + m * 16) * INW + col0;
#pragma unroll
                for (int bj = 0; bj < 2; ++bj) { const u32x4 wn = *(const u32x4*)(rowp + gnum + bj * HALF), wd = *(const u32x4*)(rowp + gnum + 1024 + bj * HALF);
                    f32x4 n0, n1, d0, d1; unpack8(wn, n0, n1); unpack8(wd, d0, d1);
#pragma unroll
                    for (int j = 0; j < 4; ++j) { acc[ai][bj][m][0][j] *= n0[j] * __builtin_amdgcn_rcpf(d0[j]); acc[ai][bj][m][1][j] *= n1[j] * __builtin_amdgcn_rcpf(d1[j]); } }
                if (m & 1) asm volatile("" ::: "memory"); }
    }
    __device__ __forceinline__ void epi(const f32x4 (&acc)[2][2][4][2], const Unit& u, int wr, int wc, int fr, int fq) const {
        const int row0 = u.pm * 256 + wr * 64 + fr, colt = u.pn * 256 + wc * 32 + 8 * fq;
#pragma unroll
        for (int ai = 0; ai < 2; ++ai)
#pragma unroll
            for (int m = 0; m < 4; ++m) { const size_t r = (size_t)(row0 + ai * HALF + m * 16);
#pragma unroll
                for (int bj = 0; bj < 2; ++bj) { const u32x4 wg = *(const u32x4*)(PROJ + r * INW + OFF_G + 2048 + colt + bj * HALF); f32x4 g0, g1; unpack8(wg, g0, g1);
                    *(u32x4*)(MERGED + r * DM + colt + bj * HALF) = pack8(acc[ai][bj][m][0] * g0, acc[ai][bj][m][1] * g1); }
                if (m & 1) asm volatile("" ::: "memory"); }
    }
};
struct PolP4 : PolBase {
    static constexpr int K = 1024;
    const bf16_t* A; const bf16_t* Bt; const float* x; float* out; bf16_t* X1B; int G, c;
    __device__ __forceinline__ bool next(int i, Unit& u) const { u.e = 0; u.mt = 0; return static_unit((long)i * G + c, T_TOK / 256, DM / 256, u.pm, u.pn); }
    __device__ __forceinline__ const char* a_base(const Unit& u) const { return (const char*)A + (size_t)u.pm * 256 * K * 2; }
    __device__ __forceinline__ const char* b_base(const Unit& u) const { return (const char*)Bt + (size_t)u.pn * 256 * K * 2; }
    __device__ __forceinline__ void epi(const f32x4 (&acc)[2][2][4][2], const Unit& u, int wr, int wc, int fr, int fq) const {
        const int row0 = u.pm * 256 + wr * 64 + fr, colt = u.pn * 256 + wc * 32 + 8 * fq;
#pragma unroll
        for (int ai = 0; ai < 2; ++ai)
#pragma unroll
            for (int m = 0; m < 4; ++m) { const size_t o = (size_t)(row0 + ai * HALF + m * 16) * DM + colt;
#pragma unroll
                for (int bj = 0; bj < 2; ++bj) { const f32x4 x0 = *(const f32x4*)(x + o + bj * HALF), x1 = *(const f32x4*)(x + o + bj * HALF + 4);
                    const f32x4 v0 = x0 + acc[ai][bj][m][0], v1 = x1 + acc[ai][bj][m][1];
                    *(f32x4*)(out + o + bj * HALF) = v0; *(f32x4*)(out + o + bj * HALF + 4) = v1; *(u32x4*)(X1B + o + bj * HALF) = pack8(v0, v1); }
                if (m & 1) asm volatile("" ::: "memory"); }
    }
};
struct GroupTab { const LAS int* tab; __device__ __forceinline__ int cnt(int e) const { return tab[TAB_CNT + e]; } __device__ __forceinline__ int tstart(int e) const { return tab[TAB_TST + e]; }
    __device__ __forceinline__ int tile_e(int vt) const { return tab[TAB_TE + vt]; } __device__ __forceinline__ int NT() const { return tab[TAB_TST + 32]; } };
struct PolP6 : PolBase {
    static constexpr int K = 1024; static constexpr bool GATHER = true;
    const bf16_t* X1B; const bf16_t* W1T; const int* LIST; const float* RSTDS; const float* b1; bf16_t* ACT; GroupTab tb; int G, c;
    __device__ __forceinline__ bool next(int i, Unit& u) const { if (!static_unit((long)i * G + c, tb.NT(), 8, u.pm, u.pn)) return false; u.e = tb.tile_e(u.pm); u.mt = u.pm - tb.tstart(u.e); return true; }
    __device__ __forceinline__ const char* a_base(const Unit&) const { return (const char*)X1B; }
    __device__ __forceinline__ const char* b_base(const Unit& u) const { return (const char*)W1T + ((size_t)u.e * 2048 + (size_t)u.pn * 256) * K * 2; }
    __device__ __forceinline__ void a_offsets(const Unit& u, const int (&Rr)[2], const int (&Cc)[2], unsigned (&g)[2][2]) const {
        const int valid = tb.cnt(u.e) - u.mt * 256; const int* lp = LIST + u.e * 32768 + u.mt * 256;
#pragma unroll
        for (int h = 0; h < 2; ++h)
#pragma unroll
            for (int i = 0; i < 2; ++i) { const int r = h * HALF + Rr[i]; const int tok = (r < valid) ? (lp[r] >> 2) : 0; g[h][i] = (unsigned)tok * (unsigned)(K * 2) + (unsigned)Cc[i] * 2u; }
    }
    __device__ __forceinline__ void epi(const f32x4 (&acc)[2][2][4][2], const Unit& u, int wr, int wc, int fr, int fq) const {
        const int valid = tb.cnt(u.e) - u.mt * 256, colg = u.pn * 128 + wc * 32 + 8 * fq;
        const float* bp = b1 + (size_t)u.e * 2048 + colg; const float* rp = RSTDS + u.e * 32768 + u.mt * 256;
        const f32x4 bg0 = *(const f32x4*)bp, bg1 = *(const f32x4*)(bp + 4), bl0 = *(const f32x4*)(bp + 1024), bl1 = *(const f32x4*)(bp + 1028);
#pragma unroll
        for (int ai = 0; ai < 2; ++ai)
#pragma unroll
            for (int m = 0; m < 4; ++m) { const int r = ai * HALF + wr * 64 + m * 16 + fr; const float rs = (r < valid) ? rp[r] : 0.f;
                f32x4 o[2];
#pragma unroll
                for (int n = 0; n < 2; ++n) { const f32x4 gv = acc[ai][0][m][n] * rs + (n ? bg1 : bg0), lv = acc[ai][1][m][n] * rs + (n ? bl1 : bl0);
#pragma unroll
                    for (int j = 0; j < 4; ++j) { const float gg = fminf(gv[j], 7.0f), ll = fminf(fmaxf(lv[j], -7.0f), 7.0f); o[n][j] = gg * sigm(1.702f * gg) * (ll + 1.0f); } }
                *(u32x4*)(ACT + (size_t)(u.pm * 256 + r) * DFF + colg) = pack8(o[0], o[1]); }
    }
};
struct PolP7 : PolBase {
    static constexpr int K = 1024;
    const bf16_t* ACT; const bf16_t* W2T; const int* LIST; const float* TOPWS; const float* b2; bf16_t* YS; GroupTab tb; int G, c;
    __device__ __forceinline__ bool next(int i, Unit& u) const { if (!static_unit((long)i * G + c, tb.NT(), 4, u.pm, u.pn)) return false; u.e = tb.tile_e(u.pm); u.mt = u.pm - tb.tstart(u.e); return true; }
    __device__ __forceinline__ const char* a_base(const Unit& u) const { return (const char*)ACT + (size_t)u.pm * 256 * K * 2; }
    __device__ __forceinline__ const char* b_base(const Unit& u) const { return (const char*)W2T + ((size_t)u.e * 1024 + (size_t)u.pn * 256) * K * 2; }
    __device__ __forceinline__ void epi(const f32x4 (&acc)[2][2][4][2], const Unit& u, int wr, int wc, int fr, int fq) const {
        const int valid = tb.cnt(u.e) - u.mt * 256, colt = u.pn * 256 + wc * 32 + 8 * fq;
        const float* bp = b2 + (size_t)u.e * 1024 + colt; const int* lp = LIST + u.e * 32768 + u.mt * 256; const float* wp = TOPWS + u.e * 32768 + u.mt * 256;
        f32x4 bv[2][2];
#pragma unroll
        for (int bj = 0; bj < 2; ++bj) { bv[bj][0] = *(const f32x4*)(bp + bj * HALF); bv[bj][1] = *(const f32x4*)(bp + bj * HALF + 4); }
#pragma unroll
        for (int ai = 0; ai < 2; ++ai)
#pragma unroll
            for (int m = 0; m < 4; ++m) { const int r = ai * HALF + wr * 64 + m * 16 + fr;
                if (r < valid) { const int slot = lp[r]; const float w = wp[r];
#pragma unroll
                    for (int bj = 0; bj < 2; ++bj) *(u32x4*)(YS + (size_t)slot * DM + colt + bj * HALF) = pack8((acc[ai][bj][m][0] + bv[bj][0]) * w, (acc[ai][bj][m][1] + bv[bj][1]) * w); } }
    }
};
}

__device__ __forceinline__ void grouped_setup(LAS int* tab, const unsigned* cnt) {
    const int tid = threadIdx.x;
    if (tid < 32) tab[TAB_CNT + tid] = (int)__hip_atomic_load(cnt + tid, __ATOMIC_RELAXED, __HIP_MEMORY_SCOPE_AGENT);
    __syncthreads();
    if (tid == 0) { int s = 0; for (int e = 0; e < 32; ++e) { tab[TAB_TST + e] = s; s += (tab[TAB_CNT + e] + 255) >> 8; } tab[TAB_TST + 32] = s; }
    __syncthreads();
    const int NT = tab[TAB_TST + 32];
    for (int vt = tid; vt < NT; vt += NWAVES * 64) { int e = 0; for (int k = 1; k < 32; ++k) if (tab[TAB_TST + k] <= vt) e = k; tab[TAB_TE + vt] = e; }
    __syncthreads();
}

__device__ __forceinline__ void lds_fence() { asm volatile("s_waitcnt lgkmcnt(0)" ::: "memory"); }
template <int MAPK> __device__ __forceinline__ int p0_map(int n) {
    if (MAPK == 1) return (n >= 1024 && n < 2048) ? (n & ~255) + 128 * ((n >> 5) & 1) + 32 * ((n >> 6) & 3) + (n & 31) : n;
    if (MAPK == 2) { const int m = n & 1023; return (m >> 7) * 256 + (n >> 10) * 128 + (m & 127); }
    return n;
}
template <int MAPK> __device__ __forceinline__ void p0_transpose_item(const float* W, int N, bf16_t* WT, int ldo, int koff, const float* gk, LAS float* scr, int item, int lane) {
    const int nblk = N / 32, kb = item / nblk, nb = item % nblk, k0 = 64 * kb, n0 = 32 * nb;
#pragma unroll 8
    for (int i = 0; i < 32; ++i) { const int kk = 2 * i + (lane >> 5); float v = W[(size_t)(k0 + kk) * N + n0 + (lane & 31)]; if (gk) v *= gk[k0 + kk]; scr[kk * 33 + (lane & 31)] = v; }
    lds_fence();
    const int c8 = lane & 7;
#pragma unroll
    for (int j = 0; j < 4; ++j) { const int n = (lane >> 3) + 8 * j; const LAS float* s = scr + (8 * c8) * 33 + n;
        u32x4 o; o.x = pg::cvt_pk_bf16(s[0 * 33], s[1 * 33]); o.y = pg::cvt_pk_bf16(s[2 * 33], s[3 * 33]); o.z = pg::cvt_pk_bf16(s[4 * 33], s[5 * 33]); o.w = pg::cvt_pk_bf16(s[6 * 33], s[7 * 33]);
        *(u32x4*)(WT + (size_t)p0_map<MAPK>(n0 + n) * ldo + koff + k0 + 8 * c8) = o; }
    lds_fence();
}
__device__ __forceinline__ void p0_rmsnorm_row(const float* xrow, const float* g, bf16_t* orow, int lane) {
    const f32x4* xr = (const f32x4*)xrow;
    f32x4 v[4]; float s = 0.f;
#pragma unroll
    for (int j = 0; j < 4; ++j) { v[j] = xr[lane + 64 * j]; s += (v[j].x * v[j].x + v[j].y * v[j].y) + (v[j].z * v[j].z + v[j].w * v[j].w); }
    const float rstd = rsqrtf(wave_sum(s) * (1.0f / DM) + EPS);
#pragma unroll
    for (int j = 0; j < 4; ++j) { const f32x4 gv = ((const f32x4*)g)[lane + 64 * j];
        unsigned long long o = (unsigned long long)pg::cvt_pk_bf16(v[j].x * rstd * gv.x, v[j].y * rstd * gv.y) | ((unsigned long long)pg::cvt_pk_bf16(v[j].z * rstd * gv.z, v[j].w * rstd * gv.w) << 32);
        ((unsigned long long*)orow)[lane + 64 * j] = o; }
}
struct P0Args { const float *x, *mem, *g_mix, *g_mem, *w_in, *w_br0, *w_br1, *w_br2, *w_out, *w_mem_kv, *w_gate_up, *w_down, *g_ffn, *w_router, *w_spatial;
    bf16_t *HB, *MEMN, *WinT, *WbrT, *WoutT, *WmemT, *W1T, *W2T, *WSB; float* WrT; };
__device__ __forceinline__ void p0_prologue(const P0Args a, LAS unsigned char* lds, int G, int c) {
    const int tid = threadIdx.x, lane = tid & 63, wave = __builtin_amdgcn_readfirstlane(tid >> 6);
    LAS float* scr = (LAS float*)(lds + wave * 16384);
    const int gw = c * NWAVES + wave, NGW = G * NWAVES;
    constexpr int I_IN = 16 * 192, I_BR = 8 * 32, I_O = 16 * 32, I_1 = 16 * 64, I_2 = 16 * 32;
    constexpr int NITEMS = I_IN + 3 * I_BR + 2 * I_O + NEXP * (I_1 + I_2);
    for (int it = gw; it < NITEMS; it += NGW) {
        int r = it;
        if (r < I_IN) { p0_transpose_item<1>(a.w_in, INW, a.WinT, DM, 0, nullptr, scr, r, lane); continue; } r -= I_IN;
        if (r < 3 * I_BR) { const int br = r / I_BR; const float* wsrc = (br == 0) ? a.w_br0 : (br == 1) ? a.w_br1 : a.w_br2; p0_transpose_item<0>(wsrc, DM, a.WbrT, 1536, br * 512, nullptr, scr, r - br * I_BR, lane); continue; } r -= 3 * I_BR;
        if (r < I_O) { p0_transpose_item<0>(a.w_out, DM, a.WoutT, DM, 0, nullptr, scr, r, lane); continue; } r -= I_O;
        if (r < I_O) { p0_transpose_item<0>(a.w_mem_kv, DM, a.WmemT, DM, 0, nullptr, scr, r, lane); continue; } r -= I_O;
        if (r < NEXP * I_1) { const int e = r / I_1; p0_transpose_item<2>(a.w_gate_up + (size_t)e * DM * 2048, 2048, a.W1T + (size_t)e * 2048 * DM, DM, 0, a.g_ffn, scr, r - e * I_1, lane); continue; } r -= NEXP * I_1;
        { const int e = r / I_2; p0_transpose_item<0>(a.w_down + (size_t)e * DFF * DM, DM, a.W2T + (size_t)e * DM * DFF, DFF, 0, nullptr, scr, r - e * I_2, lane); }
    }
    for (int m = gw; m < T_TOK; m += NGW) p0_rmsnorm_row(a.x + (size_t)m * DM, a.g_mix, a.HB + (size_t)m * DM, lane);
    for (int m = gw; m < NBATCH * MEML; m += NGW) p0_rmsnorm_row(a.mem + (size_t)m * DM, a.g_mem, a.MEMN + (size_t)m * DM, lane);
    const int gt = c * NWAVES * 64 + tid, NGT = G * NWAVES * 64;
    for (int i = gt; i < 32 * 1024; i += NGT) { const int e = i >> 10, k = i & 1023; a.WrT[i] = a.w_router[k * 32 + e] * a.g_ffn[k]; }
    for (int i = gt; i < 4 * 128 * 128; i += NGT) { const int s = i & 127, t = (i >> 7) & 127; a.WSB[i] = (s <= t) ? f2bf(a.w_spatial[i]) : (bf16_t)0; }
}
__device__ __forceinline__ void p1_memkv(const bf16_t* MEMN, const bf16_t* WmemT, const float* gk, bf16_t* MKV, int G, int c) {
    const int tid = threadIdx.x, lane = tid & 63, wave = __builtin_amdgcn_readfirstlane(tid >> 6), fr = lane & 15, fq = lane >> 4;
    const int gw = c * NWAVES + wave, NGW = G * NWAVES;
    for (int unit = gw; unit < 1024; unit += NGW) {
        const int rt = unit >> 3, ct = unit & 7;
        f32x4 acc[8];
#pragma unroll
        for (int j = 0; j < 8; ++j) acc[j] = (f32x4){0.f, 0.f, 0.f, 0.f};
        const bf16_t* ap = MEMN + (size_t)(rt * 16 + fr) * DM + fq * 8; const bf16_t* bp = WmemT + (size_t)(ct * 128 + fr) * DM + fq * 8;
        for (int k = 0; k < DM; k += 32) {
            const bf16x8 af = *(const bf16x8*)(ap + k);
#pragma unroll
            for (int j = 0; j < 8; ++j) { const bf16x8 bf = *(const bf16x8*)(bp + (size_t)j * 16 * DM + k); acc[j] = __builtin_amdgcn_mfma_f32_16x16x32_bf16(af, bf, acc[j], 0, 0, 0); }
        }
        float rstd[4] = {1.f, 1.f, 1.f, 1.f};
        if (ct < 4) {
#pragma unroll
            for (int r = 0; r < 4; ++r) { float ss = 0.f;
#pragma unroll
                for (int j = 0; j < 8; ++j) ss += acc[j][r] * acc[j][r];
                ss += __shfl_xor(ss, 1); ss += __shfl_xor(ss, 2); ss += __shfl_xor(ss, 4); ss += __shfl_xor(ss, 8);
                rstd[r] = rsqrtf(ss * (1.0f / 128.0f) + EPS); }
        }
#pragma unroll
        for (int j = 0; j < 8; ++j) { const float gg = (ct < 4) ? gk[16 * j + fr] : 1.0f;
#pragma unroll
            for (int r = 0; r < 4; ++r) MKV[(size_t)(rt * 16 + fq * 4 + r) * 1024 + ct * 128 + 16 * j + fr] = f2bf(acc[j][r] * rstd[r] * gg); }
    }
}
__device__ __forceinline__ void p2_sgu_item(int item, const bf16_t* PROJ, const float* gsv, const float* ws, const float* bs, bf16_t* Y, LAS unsigned char* lds) {
    const int tid = threadIdx.x, lane = tid & 63, wave = __builtin_amdgcn_readfirstlane(tid >> 6);
    const int g = item & 3, t0 = (item >> 2) * 128;
    LAS float* rs = (LAS float*)lds; LAS float* vn = (LAS float*)(lds + 1024);
    for (int i = 0; i < 16; ++i) { const int tl = wave * 16 + i;
        const u32x4 w = *(const u32x4*)(PROJ + (size_t)(t0 + tl) * INW + OFF_V + lane * 8); f32x4 a, b; pg::unpack8(w, a, b);
        float ss = (a[0] * a[0] + a[1] * a[1]) + (a[2] * a[2] + a[3] * a[3]) + (b[0] * b[0] + b[1] * b[1]) + (b[2] * b[2] + b[3] * b[3]);
        ss = wave_sum(ss); if (lane == 0) rs[tl] = rsqrtf(ss * (1.0f / 512.0f) + EPS); }
    __syncthreads();
    { const int c8 = tid & 15; const f32x4 g0 = *(const f32x4*)(gsv + g * 128 + c8 * 8), g1 = *(const f32x4*)(gsv + g * 128 + c8 * 8 + 4);
#pragma unroll
        for (int j = 0; j < 4; ++j) { const int s = (tid >> 4) + 32 * j; const float r = rs[s];
            const u32x4 w = *(const u32x4*)(PROJ + (size_t)(t0 + s) * INW + OFF_V + g * 128 + c8 * 8); f32x4 a, b; pg::unpack8(w, a, b);
            *(LAS f32x4*)(vn + s * 128 + c8 * 8) = a * r * g0; *(LAS f32x4*)(vn + s * 128 + c8 * 8 + 4) = b * r * g1; } }
    __syncthreads();
    { const int d = tid & 127, tq = __builtin_amdgcn_readfirstlane(tid >> 7);
        for (int j = 0; j < 32; ++j) { const int tl = tq + 4 * j; const float* w = ws + ((size_t)g * 128 + tl) * 128; float acc = bs[g * 128 + tl];
            for (int s = 0; s <= tl; ++s) acc += w[s] * vn[s * 128 + d];
            const size_t row = (size_t)(t0 + tl);
            Y[row * 1536 + g * 128 + d] = f2bf(bf2f(PROJ[row * INW + OFF_U + g * 128 + d]) * acc); } }
    __syncthreads();
}
__device__ __forceinline__ void p2_moba_item(int idx, const bf16_t* PROJ, const float* KMP, bf16_t* Y, LAS float* qs, LAS float* ps, int lane) {
    const int t = idx & (SEQ - 1), h = (idx >> 12) & 7, b = idx >> 15;
    const size_t rowq = (size_t)b * SEQ + t;
    qs[lane] = bf2f(PROJ[rowq * INW + OFF_QB + h * 64 + lane]);
    lds_fence();
    const int jb = t >> 8;
    float gate = -1e30f;
    if (lane < 16 && lane < jb) {
        float s = 0.f; const float* k0 = KMP + ((size_t)(b * 16 + lane) * 2) * 512 + h * 64;
        for (int d = 0; d < 64; ++d) s += qs[d] * ((k0[d] + k0[512 + d]) * (1.0f / 256.0f));
        gate = s;
    }
    int blk[4];
#pragma unroll
    for (int i = 0; i < 3; ++i) {
        float m = gate; int mi = lane;
#pragma unroll
        for (int o = 1; o < 64; o <<= 1) { const float om = __shfl_xor(m, o); const int oi = __shfl_xor(mi, o); if (om > m || (om == m && oi < mi)) { m = om; mi = oi; } }
        blk[i] = (m > -5e29f) ? mi : -1;
        if (lane == mi) gate = -3e38f;
    }
    blk[3] = jb;
    const float slope = exp2f(-(float)(h + 1));
    float mx = -3e38f;
#pragma unroll
    for (int i = 0; i < 4; ++i) {
        for (int r = 0; r < 4; ++r) {
            const int j = lane + 64 * r; float s = -1e30f;
            if (blk[i] >= 0) {
                const int key = blk[i] * 256 + j;
                if (i < 3 || key <= t) {
                    const bf16_t* kp = PROJ + ((size_t)b * SEQ + key) * INW + OFF_KB + h * 64; float d = 0.f;
#pragma unroll
                    for (int e8 = 0; e8 < 8; ++e8) { const u32x4 w = *(const u32x4*)(kp + e8 * 8); f32x4 x0, x1; pg::unpack8(w, x0, x1);
                        d += qs[e8 * 8 + 0] * x0[0] + qs[e8 * 8 + 1] * x0[1] + qs[e8 * 8 + 2] * x0[2] + qs[e8 * 8 + 3] * x0[3] + qs[e8 * 8 + 4] * x1[0] + qs[e8 * 8 + 5] * x1[1] + qs[e8 * 8 + 6] * x1[2] + qs[e8 * 8 + 7] * x1[3]; }
                    s = d * 0.125f - slope * (float)(t - key);
                }
            }
            ps[i * 256 + j] = s; mx = fmaxf(mx, s);
        }
    }
    mx = wave_max(mx);
    lds_fence();
    float sum = 0.f;
    for (int i = lane; i < 1024; i += 64) { const float p = __expf(ps[i] - mx); ps[i] = p; sum += p; }
    sum = wave_sum(sum);
    lds_fence();
    float o = 0.f;
#pragma unroll
    for (int i = 0; i < 4; ++i) {
        if (blk[i] < 0) continue;
        const int jend = (i == 3) ? (t - jb * 256 + 1) : 256;
        const bf16_t* vp = PROJ + ((size_t)b * SEQ + blk[i] * 256) * INW + OFF_VB + h * 64 + lane;
        for (int j = 0; j < jend; ++j) o += ps[i * 256 + j] * bf2f(vp[(size_t)j * INW]);
    }
    Y[rowq * 1536 + 512 + h * 64 + lane] = f2bf(o / sum);
    lds_fence();
}
__device__ __forceinline__ void p2_mem_item(int idx, const bf16_t* PROJ, const bf16_t* MKV, const float* gq, bf16_t* Y, LAS float* qs, LAS float* ps, int lane) {
    const int h = idx & 3, tt = idx >> 2, b = tt >> 12;
    const float a = bf2f(PROJ[(size_t)tt * INW + OFF_QM + h * 128 + lane]), c = bf2f(PROJ[(size_t)tt * INW + OFF_QM + h * 128 + 64 + lane]);
    const float rstd = rsqrtf(wave_sum(a * a + c * c) * (1.0f / 128.0f) + EPS);
    qs[lane] = a * rstd * gq[lane]; qs[lane + 64] = c * rstd * gq[lane + 64];
    lds_fence();
    float mx = -3e38f;
    for (int r = 0; r < 4; ++r) {
        const int m = lane + 64 * r; const bf16_t* kp = MKV + ((size_t)b * MEML + m) * 1024 + h * 128; float d = 0.f;
#pragma unroll
        for (int e8 = 0; e8 < 16; ++e8) { const u32x4 w = *(const u32x4*)(kp + e8 * 8); f32x4 x0, x1; pg::unpack8(w, x0, x1);
            d += qs[e8 * 8 + 0] * x0[0] + qs[e8 * 8 + 1] * x0[1] + qs[e8 * 8 + 2] * x0[2] + qs[e8 * 8 + 3] * x0[3] + qs[e8 * 8 + 4] * x1[0] + qs[e8 * 8 + 5] * x1[1] + qs[e8 * 8 + 6] * x1[2] + qs[e8 * 8 + 7] * x1[3]; }
        d *= 0.08838834764831845f; ps[m] = d; mx = fmaxf(mx, d);
    }
    mx = wave_max(mx);
    lds_fence();
    float sum = 0.f;
    for (int i = lane; i < 256; i += 64) { const float p = __expf(ps[i] - mx); ps[i] = p; sum += p; }
    sum = wave_sum(sum);
    lds_fence();
    float o0 = 0.f, o1 = 0.f;
    const bf16_t* vp = MKV + ((size_t)b * MEML) * 1024 + 512 + h * 128 + lane;
    for (int m = 0; m < 256; ++m) { const float p = ps[m]; o0 += p * bf2f(vp[(size_t)m * 1024]); o1 += p * bf2f(vp[(size_t)m * 1024 + 64]); }
    Y[(size_t)tt * 1536 + 1024 + h * 128 + lane] = f2bf(o0 / sum); Y[(size_t)tt * 1536 + 1024 + h * 128 + 64 + lane] = f2bf(o1 / sum);
    lds_fence();
}
__device__ __forceinline__ void p5_router(const float* X1, const float* WrT, const float* br, int* LIST, float* RSTDS, float* TOPWS, unsigned* cnt, int G, int c) {
    const int tl = threadIdx.x >> 5, e = threadIdx.x & 31;
    for (int t = c * 16 + tl; t < T_TOK; t += G * 16) {
        const f32x4* xr = (const f32x4*)(X1 + (size_t)t * DM); const f32x4* w = (const f32x4*)(WrT + (size_t)e * DM);
        float ss = 0.f, acc = 0.f;
        for (int k = 0; k < DM / 4; ++k) { const f32x4 xv = xr[k], wv = w[k]; ss += (xv[0] * xv[0] + xv[1] * xv[1]) + (xv[2] * xv[2] + xv[3] * xv[3]); acc += (xv[0] * wv[0] + xv[1] * wv[1]) + (xv[2] * wv[2] + xv[3] * wv[3]); }
        const float rstd = rsqrtf(ss * (1.0f / DM) + EPS);
        const float logit = acc * rstd + br[e];
        float sel_l[4]; int sel_e[4]; float cur = logit;
#pragma unroll
        for (int i = 0; i < 4; ++i) {
            float m = cur; int mi = e;
#pragma unroll
            for (int o = 1; o < 32; o <<= 1) { const float om = __shfl_xor(m, o); const int oi = __shfl_xor(mi, o); if (om > m || (om == m && oi < mi)) { m = om; mi = oi; } }
            sel_l[i] = m; sel_e[i] = mi; if (e == mi) cur = -3e38f;
        }
        if (e < 4) {
            float den = 0.f;
#pragma unroll
            for (int i = 0; i < 4; ++i) den += __expf(sel_l[i] - sel_l[0]);
            float myl = sel_l[0]; int mye = sel_e[0];
#pragma unroll
            for (int i = 1; i < 4; ++i) if (e == i) { myl = sel_l[i]; mye = sel_e[i]; }
            const float wgt = __expf(myl - sel_l[0]) / den;
            const unsigned pos = atomicAdd(cnt + mye, 1u);
            LIST[mye * 32768 + pos] = t * 4 + e; RSTDS[mye * 32768 + pos] = rstd; TOPWS[mye * 32768 + pos] = wgt;
        }
    }
}
__device__ __forceinline__ void p8_combine(float* out, const bf16_t* YS, int G, int c) {
    const size_t gt = (size_t)c * NWAVES * 64 + threadIdx.x, NGT = (size_t)G * NWAVES * 64;
    for (size_t i = gt; i < (size_t)T_TOK * DM / 8; i += NGT) {
        const size_t t = i >> 7, c8 = (i & 127) * 8;
        f32x4 o0 = *(const f32x4*)(out + t * DM + c8), o1 = *(const f32x4*)(out + t * DM + c8 + 4);
#pragma unroll
        for (int k = 0; k < 4; ++k) { const u32x4 w = *(const u32x4*)(YS + (t * 4 + k) * DM + c8); f32x4 a, b; pg::unpack8(w, a, b); o0 += a; o1 += b; }
        *(f32x4*)(out + t * DM + c8) = o0; *(f32x4*)(out + t * DM + c8 + 4) = o1;
    }
}

struct MArgs { const float* in[24]; float* out; unsigned char* ws; int ph_lo, ph_hi; };
__global__ void __launch_bounds__(NWAVES * 64, 2) mk_fwd(MArgs a) {
    extern __shared__ __attribute__((aligned(16))) unsigned char lds_raw[];
    LAS unsigned char* lds = (LAS unsigned char*)lds_raw;
    const int tid = threadIdx.x;
    for (int u = tid; u < (LDS_BYTES - LDSCTL_OFF) / 4; u += NWAVES * 64) ((LAS unsigned*)(lds + LDSCTL_OFF))[u] = 0u;
    __syncthreads();
    unsigned char* ws = a.ws; unsigned* ctl = (unsigned*)(ws + WS_CTL);
    const int lo = a.ph_lo, hi = a.ph_hi; const int G = gridDim.x, c = blockIdx.x;
    XcdBarrier bar; bar.bar = ctl + CW_BAR; bar.x = 0; bar.st = nullptr;
    if (hi - lo > 1) bar = xcd_barrier_post(ctl + CW_BAR, (volatile LAS unsigned*)(lds + LDSCTL_OFF));
typedef const MArgs __attribute__((address_space(4))) * kargp_t;
    const kargp_t kargs = (kargp_t)__builtin_amdgcn_kernarg_segment_ptr();
#define KA_BEGIN() kargp_t q = kargs; asm volatile("" : "+s"(q))
#define IN(k) (lo <= (k) && (k) < hi)
#define BOTH(k) (IN(k) && IN((k) + 1))
    bf16_t *WinT = (bf16_t*)(ws + WS_WIN), *WbrT = (bf16_t*)(ws + WS_WBR), *WoutT = (bf16_t*)(ws + WS_WOUT);
    bf16_t *W1T = (bf16_t*)(ws + WS_W1), *W2T = (bf16_t*)(ws + WS_W2);
    bf16_t *MERGED = (bf16_t*)(ws + WS_MERGED), *X1B = (bf16_t*)(ws + WS_X1B), *HB = (bf16_t*)(ws + WS_HB), *PROJ = (bf16_t*)(ws + WS_PROJ), *Y = (bf16_t*)(ws + WS_Y);
    bf16_t *ACT = (bf16_t*)(ws + WS_ACT), *YS = (bf16_t*)(ws + WS_YS);
    float* KMP = (float*)(ws + WS_KMP); int* LIST = (int*)(ws + WS_LIST); float* RSTDS = (float*)(ws + WS_RSTDS); float* TOPWS = (float*)(ws + WS_TOPWS);

    bf16_t *WmemT = (bf16_t*)(ws + WS_WMEM), *MEMN = (bf16_t*)(ws + WS_MEMN), *MKV = (bf16_t*)(ws + WS_MKV), *WSB = (bf16_t*)(ws + WS_WSB); float* WrT = (float*)(ws + WS_WR);
#if !defined(ONLY) || ONLY == 0
    if (IN(0)) {
        KA_BEGIN();
        P0Args p; p.x = q->in[0]; p.mem = q->in[1]; p.g_mix = q->in[2]; p.g_mem = q->in[9]; p.w_in = q->in[3]; p.w_br0 = q->in[13]; p.w_br1 = q->in[14]; p.w_br2 = q->in[15]; p.w_out = q->in[16];
        p.w_mem_kv = q->in[10]; p.w_gate_up = q->in[20]; p.w_down = q->in[22]; p.g_ffn = q->in[17]; p.w_router = q->in[18]; p.w_spatial = q->in[5];
        p.HB = HB; p.MEMN = MEMN; p.WinT = WinT; p.WbrT = WbrT; p.WoutT = WoutT; p.WmemT = WmemT; p.W1T = W1T; p.W2T = W2T; p.WSB = WSB; p.WrT = WrT;
        p0_prologue(p, lds, G, c);
        if (BOTH(0)) xcd_barrier(bar);
    }
#endif
#if !defined(ONLY) || ONLY == 1
    if (IN(1)) {
        KA_BEGIN();
        pg::PolP1 P; P.A = HB; P.Bt = WinT; P.PROJ = PROJ; P.KMP = KMP; P.gq = q->in[7]; P.gk = q->in[8]; P.G = G; P.c = c;
        pg::gemm_run(lds, P);
        p1_memkv(MEMN, WmemT, q->in[12], MKV, G, c);
        if (BOTH(1)) xcd_barrier(bar);
    }
#endif
#if !defined(ONLY) || ONLY == 2
    if (IN(2)) {
        KA_BEGIN();
        const int wave = __builtin_amdgcn_readfirstlane(tid >> 6), lane = tid & 63;
        for (int it = c; it < 1024; it += G) p2_sgu_item(it, PROJ, q->in[4], q->in[5], q->in[6], Y, lds);
        LAS float* qs = (LAS float*)(lds + wave * 16384); LAS float* ps = qs + 128;
        const int gw = c * NWAVES + wave, NGW = G * NWAVES;
        for (int it = gw; it < T_TOK * 4; it += NGW) p2_mem_item(it, PROJ, MKV, q->in[11], Y, qs, ps, lane);
        for (int it = gw; it < NBATCH * 8 * SEQ; it += NGW) p2_moba_item(it, PROJ, KMP, Y, qs, ps, lane);
        if (BOTH(2)) xcd_barrier(bar);
    }
#endif
#if !defined(ONLY) || ONLY == 3
    if (IN(3)) {
        KA_BEGIN();
        pg::PolP3 P; P.A = Y; P.Bt = WbrT; P.PROJ = PROJ; P.MERGED = MERGED; P.G = G; P.c = c;
        pg::gemm_run(lds, P);
        if (BOTH(3)) xcd_barrier(bar);
    }
#endif
#if !defined(ONLY) || ONLY == 4
    if (IN(4)) {
        KA_BEGIN();
        pg::PolP4 P; P.A = MERGED; P.Bt = WoutT; P.x = q->in[0]; P.out = q->out; P.X1B = X1B; P.G = G; P.c = c;
        pg::gemm_run(lds, P);
        if (BOTH(4)) xcd_barrier(bar);
    }
#endif
#if !defined(ONLY) || ONLY == 5
    if (IN(5)) {
        KA_BEGIN();
        p5_router(q->out, WrT, q->in[19], LIST, RSTDS, TOPWS, ctl + CW_CNT, G, c);
        if (BOTH(5)) xcd_barrier(bar);
    }
#endif
#if !defined(ONLY) || ONLY == 6
    if (IN(6)) {
        KA_BEGIN();
        grouped_setup((LAS int*)(lds + TAB_OFF), ctl + CW_CNT);
        pg::PolP6 P; P.X1B = X1B; P.W1T = W1T; P.LIST = LIST; P.RSTDS = RSTDS; P.b1 = q->in[21]; P.ACT = ACT; P.tb.tab = (const LAS int*)(lds + TAB_OFF); P.G = G; P.c = c;
        pg::gemm_run(lds, P);
        if (BOTH(6)) xcd_barrier(bar);
    }
#endif
#if !defined(ONLY) || ONLY == 7
    if (IN(7)) {
        KA_BEGIN();
        grouped_setup((LAS int*)(lds + TAB_OFF), ctl + CW_CNT);
        pg::PolP7 P; P.ACT = ACT; P.W2T = W2T; P.LIST = LIST; P.TOPWS = TOPWS; P.b2 = q->in[23]; P.YS = YS; P.tb.tab = (const LAS int*)(lds + TAB_OFF); P.G = G; P.c = c;
        pg::gemm_run(lds, P);
        if (BOTH(7)) xcd_barrier(bar);
    }
#endif
#if !defined(ONLY) || ONLY == 8
    if (IN(8)) { KA_BEGIN(); p8_combine(q->out, YS, G, c); }
#endif
#undef IN
#undef BOTH
}

#ifndef SINGLE_LAUNCH
#define SINGLE_LAUNCH 1
#endif
#ifndef USE_MK_P1
#define USE_MK_P1 1
#define USE_MK_P3 1
#define USE_MK_P4 1
#define USE_MK_P6 1
#define USE_MK_P7 1
#endif
static int g_grid = 0;
static void launch_mk(const MArgs& base, int lo, int hi, hipStream_t stream) {
    MArgs a = base; a.ph_lo = lo; a.ph_hi = hi;
    hipLaunchKernelGGL(mk_fwd, dim3(g_grid), dim3(NWAVES * 64), LDS_BYTES, stream, a);
}
extern "C" void kernel_launch(void* const* d_in, const int* in_sizes, int n_in, void* d_out, int out_size, void* d_ws, size_t ws_size, hipStream_t stream) {
    if (n_in != 24 || ws_size < WS_END) { fprintf(stderr, "kernel_launch: unexpected n_in %d or ws %zu\n", n_in, ws_size); return; }
    if (g_grid == 0) {
        int dev = 0, cus = 0, per_cu = 0;
        (void)hipGetDevice(&dev); (void)hipDeviceGetAttribute(&cus, hipDeviceAttributeMultiprocessorCount, dev);
        if (hipFuncSetAttribute((const void*)mk_fwd, hipFuncAttributeMaxDynamicSharedMemorySize, LDS_BYTES) != hipSuccess) fprintf(stderr, "kernel_launch: hipFuncSetAttribute failed\n");
        if (hipOccupancyMaxActiveBlocksPerMultiprocessor(&per_cu, (const void*)mk_fwd, NWAVES * 64, LDS_BYTES) != hipSuccess || per_cu < 1) fprintf(stderr, "kernel_launch: occupancy query says %d\n", per_cu);
        (void)hipGetLastError();
        g_grid = cus > 0 ? cus : 256;
    }
    const float* x = (const float*)d_in[0];        const float* mem = (const float*)d_in[1];     const float* g_mix = (const float*)d_in[2];
    const float* w_in = (const float*)d_in[3];     const float* g_sgu_v = (const float*)d_in[4]; const float* w_spatial = (const float*)d_in[5];
    const float* b_spatial = (const float*)d_in[6]; const float* g_q_moba = (const float*)d_in[7]; const float* g_k_moba = (const float*)d_in[8];
    const float* g_mem = (const float*)d_in[9];    const float* w_mem_kv = (const float*)d_in[10]; const float* g_q_mem = (const float*)d_in[11];
    const float* g_k_mem = (const float*)d_in[12]; const float* w_br_sgu = (const float*)d_in[13]; const float* w_br_moba = (const float*)d_in[14];
    const float* w_br_mem = (const float*)d_in[15]; const float* w_out = (const float*)d_in[16];  const float* g_ffn = (const float*)d_in[17];
    const float* w_router = (const float*)d_in[18]; const float* b_router = (const float*)d_in[19]; const float* w_gate_up = (const float*)d_in[20];
    const float* b_gate_up = (const float*)d_in[21]; const float* w_down = (const float*)d_in[22]; const float* b_down = (const float*)d_in[23];
    (void)b_gate_up; (void)b_down; (void)g_q_moba; (void)g_k_moba;
    float* out = (float*)d_out; unsigned char* ws = (unsigned char*)d_ws;
    unsigned* ctl = (unsigned*)(ws + WS_CTL);
    bf16_t *WinT = (bf16_t*)(ws + WS_WIN), *WbrT = (bf16_t*)(ws + WS_WBR), *WoutT = (bf16_t*)(ws + WS_WOUT), *WmemT = (bf16_t*)(ws + WS_WMEM);
    float* WrT = (float*)(ws + WS_WR); float* RSTD2 = (float*)(ws + WS_RSTD2); float* KMP = (float*)(ws + WS_KMP); float* TOPW = (float*)(ws + WS_TOPW);
    int* LIST = (int*)(ws + WS_LIST); float* RSTDS = (float*)(ws + WS_RSTDS); float* TOPWS = (float*)(ws + WS_TOPWS);
    bf16_t *MEMN = (bf16_t*)(ws + WS_MEMN), *MKV = (bf16_t*)(ws + WS_MKV), *W1T = (bf16_t*)(ws + WS_W1), *W2T = (bf16_t*)(ws + WS_W2);
    bf16_t *HB = (bf16_t*)(ws + WS_HB), *PROJ = (bf16_t*)(ws + WS_PROJ), *Y = (bf16_t*)(ws + WS_Y);
    bf16_t *YS = (bf16_t*)(ws + WS_YS);
    float* SCR = (float*)(ws + WS_SCR); (void)RSTD2; (void)TOPW; (void)W1T; (void)W2T; (void)WbrT; (void)WoutT;
    MArgs base{}; for (int i = 0; i < 24; ++i) base.in[i] = (const float*)d_in[i]; base.out = out; base.ws = ws;

    (void)hipMemsetAsync(ws + WS_CTL, 0, 1 * MiB, stream);
#if SINGLE_LAUNCH
    launch_mk(base, 0, 9, stream);
    return;
#endif
    n_rmsnorm_rows<<<T_TOK / 4, 256, 0, stream>>>(x, g_mix, HB, T_TOK);
    n_rmsnorm_rows<<<NBATCH * MEML / 4, 256, 0, stream>>>(mem, g_mem, MEMN, NBATCH * MEML);
    n_transpose<MapWin><<<dim3(INW / 32, DM / 32, 1), 256, 0, stream>>>(w_in, DM, INW, WinT, DM, 0, nullptr, 0, 0);
    n_transpose<MapId><<<dim3(DM / 32, 512 / 32, 1), 256, 0, stream>>>(w_br_sgu, 512, DM, WbrT, 1536, 0, nullptr, 0, 0);
    n_transpose<MapId><<<dim3(DM / 32, 512 / 32, 1), 256, 0, stream>>>(w_br_moba, 512, DM, WbrT, 1536, 512, nullptr, 0, 0);
    n_transpose<MapId><<<dim3(DM / 32, 512 / 32, 1), 256, 0, stream>>>(w_br_mem, 512, DM, WbrT, 1536, 1024, nullptr, 0, 0);
    n_transpose<MapId><<<dim3(DM / 32, DM / 32, 1), 256, 0, stream>>>(w_out, DM, DM, WoutT, DM, 0, nullptr, 0, 0);
    n_transpose<MapId><<<dim3(DM / 32, DM / 32, 1), 256, 0, stream>>>(w_mem_kv, DM, DM, WmemT, DM, 0, nullptr, 0, 0);
    n_transpose<MapW1><<<dim3(2048 / 32, DM / 32, NEXP), 256, 0, stream>>>(w_gate_up, DM, 2048, W1T, DM, 0, g_ffn, (size_t)DM * 2048, (size_t)2048 * DM);
    n_transpose<MapId><<<dim3(DM / 32, DFF / 32, NEXP), 256, 0, stream>>>(w_down, DFF, DM, W2T, DFF, 0, nullptr, (size_t)DFF * DM, (size_t)DM * DFF);
    n_router_w<<<128, 256, 0, stream>>>(w_router, g_ffn, WrT);
#if USE_MK_P1
    launch_mk(base, 1, 2, stream);
#else
    { EpiProj E{}; E.P = PROJ; n_gemm<EpiProj, false><<<dim3(INW / 64, T_TOK / 64, 1), 256, 0, stream>>>(HB, DM, WinT, DM, DM, E); }
    n_norm_heads64<<<T_TOK * 8 / 4, 256, 0, stream>>>(PROJ, OFF_QB, g_q_moba);
    n_norm_heads64<<<T_TOK * 8 / 4, 256, 0, stream>>>(PROJ, OFF_KB, g_k_moba);
    n_kmean<<<NBATCH * 16, 512, 0, stream>>>(PROJ, KMP);
#endif
    { EpiF32 E{}; E.C = SCR; E.ldc = 1024; E.pad = 0; n_gemm<EpiF32, false><<<dim3(1024 / 64, 2048 / 64, 1), 256, 0, stream>>>(MEMN, DM, WmemT, DM, DM, E); }
    n_memkv_norm<<<2048 * 4 / 4, 256, 0, stream>>>(SCR, g_k_mem, MKV);
    n_sgu_prep<<<T_TOK / 4, 256, 0, stream>>>(PROJ, g_sgu_v, SCR);
    n_sgu<<<T_TOK * 512 / 256, 256, 0, stream>>>(PROJ, SCR, w_spatial, b_spatial, Y);
    n_moba<<<NBATCH * 8 * SEQ, 64, 0, stream>>>(PROJ, KMP, Y);
    n_memattn<<<T_TOK * 4, 64, 0, stream>>>(PROJ, MKV, g_q_mem, Y);
#if USE_MK_P3
    launch_mk(base, 3, 4, stream);
#else
    n_merged<<<dim3(DM / 64, T_TOK / 64), 256, 0, stream>>>(Y, WbrT, PROJ, (bf16_t*)(ws + WS_MERGED));
#endif
#if USE_MK_P4
    launch_mk(base, 4, 5, stream);
#else
    { EpiX1 E{}; E.x = x; E.out = out; E.x1b = (bf16_t*)(ws + WS_X1B); n_gemm<EpiX1, false><<<dim3(DM / 64, T_TOK / 64, 1), 256, 0, stream>>>((bf16_t*)(ws + WS_MERGED), DM, WoutT, DM, DM, E); }
#endif
    n_router<<<T_TOK / 8, 256, 0, stream>>>(out, WrT, b_router, RSTD2, TOPW, LIST, RSTDS, TOPWS, ctl + CW_CNT);
#if USE_MK_P6
    launch_mk(base, 6, 7, stream);
#else
    { EpiExp1 E{}; E.cnt = ctl + CW_CNT; E.LIST = LIST; E.RSTD2 = RSTD2; E.b1 = b_gate_up; E.ACT = (bf16_t*)(ws + WS_ACT);
      n_gemm<EpiExp1, true><<<dim3(DFF / 64, T_TOK / 64, NEXP), 256, 0, stream>>>((bf16_t*)(ws + WS_X1B), DM, W1T, DM, DM, E); }
#endif
#if USE_MK_P7
    launch_mk(base, 7, 8, stream);
#else
    { EpiExp2 E{}; E.cnt = ctl + CW_CNT; E.LIST = LIST; E.TOPW = TOPW; E.b2 = b_down; E.YS = YS;
      n_gemm<EpiExp2, false><<<dim3(DM / 64, T_TOK / 64, NEXP), 256, 0, stream>>>((bf16_t*)(ws + WS_ACT), DFF, W2T, DFF, DFF, E); }
#endif
    n_combine<<<T_TOK * DM / 256, 256, 0, stream>>>(out, YS);
}
```

```cpp
#include <hip/hip_runtime.h>
#include <stdint.h>
#include <cstdio>
#ifndef USE_MFMA_ATTN
#define USE_MFMA_ATTN 1
#endif

typedef unsigned short bf16_t;
typedef short bf16x8 __attribute__((ext_vector_type(8)));
typedef float f32x4 __attribute__((ext_vector_type(4)));
typedef unsigned u32x4 __attribute__((ext_vector_type(4)));

constexpr int NBATCH = 8, SEQ = 4096, DM = 1024, T_TOK = NBATCH * SEQ, INW = 6144, MEML = 256;
constexpr int OFF_U = 0, OFF_V = 512, OFF_QB = 1024, OFF_KB = 1536, OFF_VB = 2048, OFF_QM = 2560, OFF_G = 3072;
constexpr int NEXP = 32, TOPK = 4, DFF = 1024;
constexpr float EPS = 1e-6f;
constexpr int ACT_ROWS = T_TOK * TOPK + NEXP * 256;

constexpr size_t MiB = 1ull << 20;
constexpr size_t WS_CTL = 0;
constexpr size_t WS_WIN = 1 * MiB;
constexpr size_t WS_WBR = 13 * MiB;
constexpr size_t WS_WOUT = 16 * MiB;
constexpr size_t WS_WMEM = 18 * MiB;
constexpr size_t WS_WR = 20 * MiB;
constexpr size_t WS_RSTD2 = 21 * MiB;
constexpr size_t WS_WSB = 21 * MiB + 256 * 1024;
constexpr size_t WS_KMP = 22 * MiB;
constexpr size_t WS_TOPW = 23 * MiB;
constexpr size_t WS_LIST = 24 * MiB;
constexpr size_t WS_RSTDS = 28 * MiB;
constexpr size_t WS_TOPWS = 32 * MiB;
constexpr size_t WS_MEMN = 36 * MiB;
constexpr size_t WS_MKV = 40 * MiB;
constexpr size_t WS_W1 = 44 * MiB;
constexpr size_t WS_W2 = 172 * MiB;
constexpr size_t WS_MERGED = 236 * MiB;
constexpr size_t WS_X1B = 300 * MiB;
constexpr size_t WS_HB = 364 * MiB;
constexpr size_t WS_PROJ = 428 * MiB;
constexpr size_t WS_Y = 812 * MiB;
constexpr size_t WS_ACT = 364 * MiB;
constexpr size_t WS_YS = 636 * MiB;
constexpr size_t WS_SCR = 908 * MiB;
constexpr size_t WS_END = 1024 * MiB;
constexpr int CW_CNT = 64;

__device__ __forceinline__ float bf2f(bf16_t b) { return __uint_as_float(((unsigned)b) << 16); }
__device__ __forceinline__ bf16_t f2bf(float f) { unsigned u = __float_as_uint(f); u += 0x7fffu + ((u >> 16) & 1u); return (bf16_t)(u >> 16); }
__device__ __forceinline__ float wave_sum(float v) {
#pragma unroll
    for (int o = 1; o < 64; o <<= 1) v += __shfl_xor(v, o);
    return v;
}
__device__ __forceinline__ float wave_max(float v) {
#pragma unroll
    for (int o = 1; o < 64; o <<= 1) v = fmaxf(v, __shfl_xor(v, o));
    return v;
}
__device__ __forceinline__ float gelu_exact(float v) { return 0.5f * v * (1.0f + erff(v * 0.70710678118654752f)); }
__device__ __forceinline__ float sigmoidf_(float v) { return 1.0f / (1.0f + __expf(-v)); }

__global__ __launch_bounds__(256) void n_rmsnorm_rows(const float* x, const float* g, bf16_t* out, int rows) {
    const int row = blockIdx.x * 4 + (threadIdx.x >> 6), lane = threadIdx.x & 63;
    if (row >= rows) return;
    const f32x4* xr = (const f32x4*)(x + (size_t)row * DM);
    f32x4 v[4]; float s = 0.f;
#pragma unroll
    for (int j = 0; j < 4; ++j) { v[j] = xr[lane + 64 * j]; s += v[j].x * v[j].x + v[j].y * v[j].y + v[j].z * v[j].z + v[j].w * v[j].w; }
    const float rstd = rsqrtf(wave_sum(s) * (1.0f / DM) + EPS);
#pragma unroll
    for (int j = 0; j < 4; ++j) {
        const f32x4 gv = ((const f32x4*)g)[lane + 64 * j];
        bf16_t* o = out + (size_t)row * DM + (lane + 64 * j) * 4;
        o[0] = f2bf(v[j].x * rstd * gv.x); o[1] = f2bf(v[j].y * rstd * gv.y); o[2] = f2bf(v[j].z * rstd * gv.z); o[3] = f2bf(v[j].w * rstd * gv.w);
    }
}

struct MapId { __device__ int operator()(int n) const { return n; } };
struct MapWin { __device__ int operator()(int n) const { return (n >= 1024 && n < 2048) ? (n & ~255) + 128 * ((n >> 5) & 1) + 32 * ((n >> 6) & 3) + (n & 31) : n; } };
struct MapW1 { __device__ int operator()(int n) const { const int m = n & 1023; return (m >> 7) * 256 + (n >> 10) * 128 + (m & 127); } };
template <class Map> __global__ __launch_bounds__(256) void n_transpose(const float* W, int K, int N, bf16_t* WT, int ldo, int koff, const float* gk, size_t sstride, size_t dstride) {
    const Map map;
    __shared__ float t[32][33];
    const int tx = threadIdx.x & 31, ty = threadIdx.x >> 5;
    const int k0 = blockIdx.y * 32, n0 = blockIdx.x * 32;
    W += (size_t)blockIdx.z * sstride; WT += (size_t)blockIdx.z * dstride;
    for (int i = ty; i < 32; i += 8) t[i][tx] = W[(size_t)(k0 + i) * N + n0 + tx] * (gk ? gk[k0 + i] : 1.0f);
    __syncthreads();
    for (int i = ty; i < 32; i += 8) WT[(size_t)map(n0 + i) * ldo + koff + k0 + tx] = f2bf(t[tx][i]);
}
__global__ void n_router_w(const float* wr, const float* g, float* WrT) {
    const int i = blockIdx.x * blockDim.x + threadIdx.x; if (i >= 32 * 1024) return;
    const int e = i >> 10, k = i & 1023; WrT[i] = wr[k * 32 + e] * g[k];
}

template <class Epi, bool DUAL>
__global__ __launch_bounds__(256) void n_gemm(const bf16_t* A, int lda, const bf16_t* Bt, int ldb, int K, Epi E) {
    const int wid = threadIdx.x >> 6, lane = threadIdx.x & 63, fr = lane & 15, fq = lane >> 4;
    const int z = blockIdx.z;
    if (!E.active(z, blockIdx.y * 64)) return;
    const int row0 = blockIdx.y * 64 + (wid >> 1) * 32, col0 = blockIdx.x * 64 + (wid & 1) * 32;
    const bf16_t* Bz = Bt + E.boff(z);
    const bf16_t* ap[2]; const bf16_t* bp[2]; const bf16_t* bp2[2];
#pragma unroll
    for (int i = 0; i < 2; ++i) {
        ap[i] = A + (size_t)E.arow(z, row0 + 16 * i + fr) * lda + fq * 8;
        const int c = col0 + 16 * i + fr;
        if (DUAL) { const int br = (c >> 7) * 256 + (c & 127); bp[i] = Bz + (size_t)br * ldb + fq * 8; bp2[i] = bp[i] + (size_t)128 * ldb; }
        else { bp[i] = Bz + (size_t)c * ldb + fq * 8; bp2[i] = bp[i]; }
    }
    f32x4 acc[2][2], acc2[2][2];
#pragma unroll
    for (int i = 0; i < 2; ++i)
#pragma unroll
        for (int j = 0; j < 2; ++j) { acc[i][j] = (f32x4){0.f, 0.f, 0.f, 0.f}; acc2[i][j] = acc[i][j]; }
    for (int k = 0; k < K; k += 32) {
        bf16x8 af[2], bf[2], bf2[2];
#pragma unroll
        for (int i = 0; i < 2; ++i) { af[i] = *(const bf16x8*)(ap[i] + k); bf[i] = *(const bf16x8*)(bp[i] + k); if (DUAL) bf2[i] = *(const bf16x8*)(bp2[i] + k); }
#pragma unroll
        for (int i = 0; i < 2; ++i)
#pragma unroll
            for (int j = 0; j < 2; ++j) {
                acc[i][j] = __builtin_amdgcn_mfma_f32_16x16x32_bf16(af[i], bf[j], acc[i][j], 0, 0, 0);
                if (DUAL) acc2[i][j] = __builtin_amdgcn_mfma_f32_16x16x32_bf16(af[i], bf2[j], acc2[i][j], 0, 0, 0);
            }
    }
#pragma unroll
    for (int i = 0; i < 2; ++i)
#pragma unroll
        for (int j = 0; j < 2; ++j)
#pragma unroll
            for (int r = 0; r < 4; ++r) E(z, row0 + 16 * i + fq * 4 + r, col0 + 16 * j + fr, acc[i][j][r], acc2[i][j][r]);
}

struct EpiBase { __device__ bool active(int, int) const { return true; } __device__ size_t boff(int) const { return 0; } __device__ int arow(int, int r) const { return r; } };
struct EpiProj : EpiBase { bf16_t* P;
    __device__ void operator()(int, int r, int c, float v, float) const {
        if (c < 1024) v = gelu_exact(v); else if (c >= OFF_G) v = sigmoidf_(v);
        if (c >= 1024 && c < 2048) { const int cl = c & 255; c = (c & ~255) + 64 * ((cl >> 5) & 3) + 32 * (cl >> 7) + (cl & 31); }
        P[(size_t)r * INW + c] = f2bf(v); } };
struct EpiF32 : EpiBase { float* C; int ldc; int pad; __device__ void operator()(int, int r, int c, float v, float) const { C[(size_t)r * ldc + c] = v; } };
struct EpiX1 : EpiBase { const float* x; float* out; bf16_t* x1b;
    __device__ void operator()(int, int r, int c, float v, float) const { const size_t i = (size_t)r * DM + c; const float o = x[i] + v; out[i] = o; x1b[i] = f2bf(o); } };

__global__ __launch_bounds__(256) void n_merged(const bf16_t* Y, const bf16_t* WbrT, const bf16_t* PROJ, bf16_t* MERGED) {
    const int wid = threadIdx.x >> 6, lane = threadIdx.x & 63, fr = lane & 15, fq = lane >> 4;
    const int row0 = blockIdx.y * 64 + (wid >> 1) * 32, col0 = blockIdx.x * 64 + (wid & 1) * 32;
    f32x4 tot[2][2];
#pragma unroll
    for (int i = 0; i < 2; ++i)
#pragma unroll
        for (int j = 0; j < 2; ++j) tot[i][j] = (f32x4){0.f, 0.f, 0.f, 0.f};
    for (int br = 0; br < 3; ++br) {
        f32x4 acc[2][2];
#pragma unroll
        for (int i = 0; i < 2; ++i)
#pragma unroll
            for (int j = 0; j < 2; ++j) acc[i][j] = (f32x4){0.f, 0.f, 0.f, 0.f};
        for (int k = br * 512; k < br * 512 + 512; k += 32) {
            bf16x8 af[2], bf[2];
#pragma unroll
            for (int i = 0; i < 2; ++i) { af[i] = *(const bf16x8*)(Y + (size_t)(row0 + 16 * i + fr) * 1536 + fq * 8 + k); bf[i] = *(const bf16x8*)(WbrT + (size_t)(col0 + 16 * i + fr) * 1536 + fq * 8 + k); }
#pragma unroll
            for (int i = 0; i < 2; ++i)
#pragma unroll
                for (int j = 0; j < 2; ++j) acc[i][j] = __builtin_amdgcn_mfma_f32_16x16x32_bf16(af[i], bf[j], acc[i][j], 0, 0, 0);
        }
#pragma unroll
        for (int i = 0; i < 2; ++i)
#pragma unroll
            for (int j = 0; j < 2; ++j)
#pragma unroll
                for (int r = 0; r < 4; ++r) { const int row = row0 + 16 * i + fq * 4 + r, col = col0 + 16 * j + fr; tot[i][j][r] += bf2f(PROJ[(size_t)row * INW + OFF_G + br * 1024 + col]) * acc[i][j][r]; }
    }
#pragma unroll
    for (int i = 0; i < 2; ++i)
#pragma unroll
        for (int j = 0; j < 2; ++j)
#pragma unroll
            for (int r = 0; r < 4; ++r) MERGED[(size_t)(row0 + 16 * i + fq * 4 + r) * DM + col0 + 16 * j + fr] = f2bf(tot[i][j][r]);
}

__global__ __launch_bounds__(256) void n_norm_heads64(bf16_t* PROJ, int off, const float* g) {
    const int w = blockIdx.x * 4 + (threadIdx.x >> 6), lane = threadIdx.x & 63;
    const int t = w >> 3, h = w & 7;
    bf16_t* p = PROJ + (size_t)t * INW + off + h * 64 + lane;
    const float v = bf2f(*p); const float rstd = rsqrtf(wave_sum(v * v) * (1.0f / 64.0f) + EPS);
    *p = f2bf(v * rstd * g[lane]);
}
__global__ __launch_bounds__(512) void n_kmean(const bf16_t* PROJ, float* KMP) {
    const int bb = blockIdx.x, c = threadIdx.x;
    float s = 0.f; for (int r = 0; r < 256; ++r) s += bf2f(PROJ[((size_t)bb * 256 + r) * INW + OFF_KB + c]);
    KMP[((size_t)bb * 2 + 0) * 512 + c] = s; KMP[((size_t)bb * 2 + 1) * 512 + c] = 0.f;
}
__global__ __launch_bounds__(256) void n_memkv_norm(const float* raw, const float* g, bf16_t* MKV) {
    const int w = blockIdx.x * 4 + (threadIdx.x >> 6), lane = threadIdx.x & 63;
    const int r = w >> 2, h = w & 3;
    const float* p = raw + (size_t)r * 1024 + h * 128;
    const float a = p[lane], b = p[lane + 64];
    const float rstd = rsqrtf(wave_sum(a * a + b * b) * (1.0f / 128.0f) + EPS);
    bf16_t* o = MKV + (size_t)r * 1024 + h * 128;
    o[lane] = f2bf(a * rstd * g[lane]); o[lane + 64] = f2bf(b * rstd * g[lane + 64]);
    o[512 + lane] = f2bf(p[512 + lane]); o[512 + lane + 64] = f2bf(p[512 + lane + 64]);
}
__global__ __launch_bounds__(256) void n_sgu_prep(const bf16_t* PROJ, const float* g, float* VN) {
    const int t = blockIdx.x * 4 + (threadIdx.x >> 6), lane = threadIdx.x & 63;
    float v[8]; float s = 0.f;
#pragma unroll
    for (int j = 0; j < 8; ++j) { v[j] = bf2f(PROJ[(size_t)t * INW + OFF_V + lane + 64 * j]); s += v[j] * v[j]; }
    const float rstd = rsqrtf(wave_sum(s) * (1.0f / 512.0f) + EPS);
#pragma unroll
    for (int j = 0; j < 8; ++j) VN[(size_t)t * 512 + lane + 64 * j] = v[j] * rstd * g[lane + 64 * j];
}
__global__ __launch_bounds__(256) void n_sgu(const bf16_t* PROJ, const float* VN, const float* ws, const float* bs, bf16_t* Y) {
    const int i = blockIdx.x * 256 + threadIdx.x; const int t = i >> 9, c = i & 511, g = c >> 7;
    const int tl = t & 127, t0 = t - tl;
    float s = bs[g * 128 + tl];
    const float* w = ws + ((size_t)g * 128 + tl) * 128;
    for (int sidx = 0; sidx <= tl; ++sidx) s += w[sidx] * VN[(size_t)(t0 + sidx) * 512 + c];
    Y[(size_t)t * 1536 + c] = f2bf(bf2f(PROJ[(size_t)t * INW + OFF_U + c]) * s);
}
__global__ __launch_bounds__(64) void n_moba(const bf16_t* PROJ, const float* KMP, bf16_t* Y) {
    const int idx = blockIdx.x; const int t = idx & (SEQ - 1), h = (idx >> 12) & 7, b = idx >> 15;
    const int lane = threadIdx.x;
    __shared__ float qs[64]; __shared__ float ps[1024];
    const size_t rowq = (size_t)b * SEQ + t;
    qs[lane] = bf2f(PROJ[rowq * INW + OFF_QB + h * 64 + lane]);
    __syncthreads();
    const int jb = t >> 8;
    float gate = -1e30f;
    if (lane < 16 && lane < jb) {
        float s = 0.f; const float* k0 = KMP + ((size_t)(b * 16 + lane) * 2) * 512 + h * 64;
        for (int d = 0; d < 64; ++d) s += qs[d] * ((k0[d] + k0[512 + d]) * (1.0f / 256.0f));
        gate = s;
    }
    int blk[4];
#pragma unroll
    for (int i = 0; i < 3; ++i) {
        float m = gate; int mi = lane;
#pragma unroll
        for (int o = 1; o < 64; o <<= 1) { const float om = __shfl_xor(m, o); const int oi = __shfl_xor(mi, o); if (om > m || (om == m && oi < mi)) { m = om; mi = oi; } }
        blk[i] = (m > -5e29f) ? mi : -1;
        if (lane == mi) gate = -3e38f;
    }
    blk[3] = jb;
    const float slope = exp2f(-(float)(h + 1));
    float mx = -3e38f;
#pragma unroll
    for (int i = 0; i < 4; ++i) {
        for (int r = 0; r < 4; ++r) {
            const int j = lane + 64 * r; float s = -1e30f;
            if (blk[i] >= 0) {
                const int key = blk[i] * 256 + j;
                if (i < 3 || key <= t) {
                    const bf16_t* kp = PROJ + ((size_t)b * SEQ + key) * INW + OFF_KB + h * 64; float d = 0.f;
                    for (int e = 0; e < 64; ++e) d += qs[e] * bf2f(kp[e]);
                    s = d * 0.125f - slope * (float)(t - key);
                }
            }
            ps[i * 256 + j] = s; mx = fmaxf(mx, s);
        }
    }
    mx = wave_max(mx);
    float sum = 0.f;
    for (int i = lane; i < 1024; i += 64) { const float p = __expf(ps[i] - mx); ps[i] = p; sum += p; }
    sum = wave_sum(sum);
    __syncthreads();
    float o = 0.f;
#pragma unroll
    for (int i = 0; i < 4; ++i) {
        if (blk[i] < 0) continue;
        for (int j = 0; j < 256; ++j) { const float p = ps[i * 256 + j]; if (p != 0.f) o += p * bf2f(PROJ[((size_t)b * SEQ + blk[i] * 256 + j) * INW + OFF_VB + h * 64 + lane]); }
    }
    Y[rowq * 1536 + 512 + h * 64 + lane] = f2bf(o / sum);
}
__global__ __launch_bounds__(64) void n_memattn(const bf16_t* PROJ, const bf16_t* MKV, const float* gq, bf16_t* Y) {
    const int idx = blockIdx.x; const int h = idx & 3, tt = idx >> 2, b = tt >> 12;
    const int lane = threadIdx.x;
    __shared__ float qs[128]; __shared__ float ps[256];
    const float a = bf2f(PROJ[(size_t)tt * INW + OFF_QM + h * 128 + lane]), c = bf2f(PROJ[(size_t)tt * INW + OFF_QM + h * 128 + 64 + lane]);
    const float rstd = rsqrtf(wave_sum(a * a + c * c) * (1.0f / 128.0f) + EPS);
    qs[lane] = a * rstd * gq[lane]; qs[lane + 64] = c * rstd * gq[lane + 64];
    __syncthreads();
    float mx = -3e38f;
    for (int r = 0; r < 4; ++r) {
        const int m = lane + 64 * r; const bf16_t* kp = MKV + ((size_t)b * MEML + m) * 1024 + h * 128; float d = 0.f;
        for (int e = 0; e < 128; ++e) d += qs[e] * bf2f(kp[e]);
        d *= 0.08838834764831845f; ps[m] = d; mx = fmaxf(mx, d);
    }
    mx = wave_max(mx);
    float sum = 0.f;
    for (int i = lane; i < 256; i += 64) { const float p = __expf(ps[i] - mx); ps[i] = p; sum += p; }
    sum = wave_sum(sum);
    __syncthreads();
    float o0 = 0.f, o1 = 0.f;
    for (int m = 0; m < 256; ++m) { const float p = ps[m]; const bf16_t* vp = MKV + ((size_t)b * MEML + m) * 1024 + 512 + h * 128; o0 += p * bf2f(vp[lane]); o1 += p * bf2f(vp[lane + 64]); }
    Y[(size_t)tt * 1536 + 1024 + h * 128 + lane] = f2bf(o0 / sum); Y[(size_t)tt * 1536 + 1024 + h * 128 + 64 + lane] = f2bf(o1 / sum);
}
__global__ __launch_bounds__(256) void n_router(const float* X1, const float* WrT, const float* br, float* RSTD2, float* TOPW, int* LIST, float* RSTDS, float* TOPWS, unsigned* cnt) {
    const int tl = threadIdx.x >> 5, e = threadIdx.x & 31; const int t = blockIdx.x * 8 + tl;
    const float* xr = X1 + (size_t)t * DM; const float* w = WrT + (size_t)e * DM;
    float ss = 0.f, acc = 0.f;
    for (int k = 0; k < DM; ++k) { const float xv = xr[k]; ss += xv * xv; acc += xv * w[k]; }
    const float rstd = rsqrtf(ss * (1.0f / DM) + EPS);
    float logit = acc * rstd + br[e];
    if (e == 0) RSTD2[t] = rstd;
    float sel_l[4]; int sel_e[4]; float cur = logit;
#pragma unroll
    for (int i = 0; i < 4; ++i) {
        float m = cur; int mi = e;
#pragma unroll
        for (int o = 1; o < 32; o <<= 1) { const float om = __shfl_xor(m, o); const int oi = __shfl_xor(mi, o); if (om > m || (om == m && oi < mi)) { m = om; mi = oi; } }
        sel_l[i] = m; sel_e[i] = mi; if (e == mi) cur = -3e38f;
    }
    if (e < 4) {
        float den = 0.f;
#pragma unroll
        for (int i = 0; i < 4; ++i) den += __expf(sel_l[i] - sel_l[0]);
        float myl = sel_l[0]; int mye = sel_e[0];
#pragma unroll
        for (int i = 1; i < 4; ++i) if (e == i) { myl = sel_l[i]; mye = sel_e[i]; }
        const float wgt = __expf(myl - sel_l[0]) / den;
        const unsigned pos = atomicAdd(cnt + mye, 1u);
        LIST[mye * 32768 + pos] = t * 4 + e; TOPW[t * 4 + e] = wgt; RSTDS[mye * 32768 + pos] = rstd; TOPWS[mye * 32768 + pos] = wgt;
    }
}
__device__ __forceinline__ int expert_base(const unsigned* cnt, int e) { int b = 0; for (int i = 0; i < e; ++i) b += (int)((cnt[i] + 255u) & ~255u); return b; }
struct EpiExp1 { const unsigned* cnt; const int* LIST; const float* RSTD2; const float* b1; bf16_t* ACT;
    __device__ bool active(int z, int r0) const { return r0 < (int)cnt[z]; }
    __device__ size_t boff(int z) const { return (size_t)z * 2048 * 1024; }
    __device__ int arow(int z, int r) const { return r < (int)cnt[z] ? (LIST[z * 32768 + r] >> 2) : 0; }
    __device__ void operator()(int z, int r, int c, float vg, float vl) const {
        if (r >= (int)cnt[z]) return;
        const int tok = LIST[z * 32768 + r] >> 2; const float rs = RSTD2[tok];
        float g = rs * vg + b1[z * 2048 + c], l = rs * vl + b1[z * 2048 + 1024 + c];
        g = fminf(g, 7.0f); l = fminf(fmaxf(l, -7.0f), 7.0f);
        ACT[(size_t)(expert_base(cnt, z) + r) * DFF + c] = f2bf(g * sigmoidf_(1.702f * g) * (l + 1.0f)); } };
struct EpiExp2 { const unsigned* cnt; const int* LIST; const float* TOPW; const float* b2; bf16_t* YS;
    __device__ bool active(int z, int r0) const { return r0 < (int)cnt[z]; }
    __device__ size_t boff(int z) const { return (size_t)z * 1024 * 1024; }
    __device__ int arow(int z, int r) const { return expert_base(cnt, z) + r; }
    __device__ void operator()(int z, int r, int c, float v, float) const {
        if (r >= (int)cnt[z]) return;
        const int slot = LIST[z * 32768 + r];
        YS[(size_t)slot * DM + c] = f2bf((v + b2[z * 1024 + c]) * TOPW[slot]); } };
__global__ __launch_bounds__(256) void n_combine(float* out, const bf16_t* YS) {
    const size_t i = (size_t)blockIdx.x * 256 + threadIdx.x; const size_t t = i >> 10, c = i & 1023;
    float s = out[i];
#pragma unroll
    for (int k = 0; k < 4; ++k) s += bf2f(YS[(t * 4 + k) * DM + c]);
    out[i] = s;
}

#define LAS __attribute__((address_space(3)))
typedef float f32x2 __attribute__((ext_vector_type(2)));
constexpr int NWAVES = 8;
constexpr int RING_BYTES = 131072;
constexpr int LDSCTL_OFF = RING_BYTES;
constexpr int TAB_OFF = RING_BYTES + 64;
constexpr int TAB_CNT = 0, TAB_TST = 32, TAB_TE = 96, TAB_WORDS = 96 + 576;
constexpr int LDS_BYTES = 147456;
static_assert(TAB_OFF + TAB_WORDS * 4 <= LDS_BYTES, "LDS map");
constexpr int CW_BAR = 4096;

#define XB_TMO      128
#define XB_XCNT(j)  (256  + 64 * (j))
#define XB_XSUB(j)  (1280 + 64 * (j))
#define XB_XGEN(j)  (2304 + 64 * (j))
#define XB_TOP      3328
#define XB_TOPGEN   3392
#define XCD_BAR_WORDS 3456
#define XB_SPIN_CAP (1u << 18)
__device__ __forceinline__ unsigned xb_ld(unsigned* p)              { return __hip_atomic_load(p, __ATOMIC_RELAXED, __HIP_MEMORY_SCOPE_AGENT); }
__device__ __forceinline__ unsigned xb_add(unsigned* p, unsigned v) { return __hip_atomic_fetch_add(p, v, __ATOMIC_RELAXED, __HIP_MEMORY_SCOPE_AGENT); }
__device__ __forceinline__ unsigned xb_xcc_id() { return (unsigned)__builtin_amdgcn_s_getreg((3 << 11) | 20) & 0xFu; }
#define XB_SPIN(cond, bar) do { unsigned _sp = 0; while (cond) { __builtin_amdgcn_s_sleep(1); \
    if ((++_sp & 255u) == 0u) { if (xb_ld(&(bar)[XB_TMO])) break; if (_sp > XB_SPIN_CAP) { atomicAdd(&(bar)[XB_TMO], 1u); break; } } } } while (0)
struct XcdBarrier { unsigned* bar; unsigned x; volatile LAS unsigned* st; };
__device__ __forceinline__ XcdBarrier xcd_barrier_post(unsigned* bar, volatile LAS unsigned* st) {
    XcdBarrier b; b.bar = bar; b.x = xb_xcc_id(); b.st = st;
    if (threadIdx.x == 0) (void)xb_add(&bar[XB_XCNT(b.x)], 1u);
    return b;
}
__device__ __forceinline__ void xcd_barrier_complete(unsigned* bar, unsigned x, unsigned& nloc, unsigned& nx) {
    const unsigned G = gridDim.x * gridDim.y * gridDim.z;
    unsigned sum, cnt, mine, sp = 0u;
    for (;;) {
        sum = 0u; cnt = 0u; mine = 0u;
#pragma unroll
        for (unsigned j = 0; j < 16; ++j) { const unsigned c = xb_ld(&bar[XB_XCNT(j)]); sum += c; cnt += (c > 0u) ? 1u : 0u; mine = (j == x) ? c : mine; }
        if (sum == G) break;
        __builtin_amdgcn_s_sleep(1);
        if ((++sp & 255u) == 0u) { if (xb_ld(&bar[XB_TMO])) break; if (sp > XB_SPIN_CAP) { atomicAdd(&bar[XB_TMO], 1u); break; } }
    }
    nloc = mine > 0u ? mine : 1u; nx = cnt > 0u ? cnt : 1u;
}
__device__ __forceinline__ void xcd_barrier(const XcdBarrier& b) {
    asm volatile("s_waitcnt vmcnt(0)" ::: "memory");
    __syncthreads();
    if (threadIdx.x == 0) {
        unsigned* bar = b.bar;
        __builtin_amdgcn_s_waitcnt(0);
        unsigned nloc = b.st[0], nx = b.st[1];
        if (nloc == 0u) { xcd_barrier_complete(bar, b.x, nloc, nx); b.st[0] = nloc; b.st[1] = nx; }
        const unsigned old = xb_add(&bar[XB_XSUB(b.x)], 1u);
        const unsigned gen = old / nloc;
        if (old + 1u == (gen + 1u) * nloc) {
            __builtin_amdgcn_fence(__ATOMIC_RELEASE, "agent");
            asm volatile("s_waitcnt vmcnt(0)" ::: "memory");
            const unsigned og = xb_add(&bar[XB_TOP], 1u);
            const unsigned tg = og / nx;
            if (og + 1u == (tg + 1u) * nx) xb_add(&bar[XB_TOPGEN], 1u);
            else XB_SPIN(xb_ld(&bar[XB_TOPGEN]) == tg, bar);
            __builtin_amdgcn_fence(__ATOMIC_ACQUIRE, "agent");
            xb_add(&bar[XB_XGEN(b.x)], 1u);
            asm volatile("s_waitcnt vmcnt(0)" ::: "memory");
        } else {
            XB_SPIN(xb_ld(&bar[XB_XGEN(b.x)]) == gen, bar);
            __builtin_amdgcn_fence(__ATOMIC_ACQUIRE, "agent");
            asm volatile("s_waitcnt vmcnt(0)" ::: "memory");
        }
    }
    __syncthreads();
}

namespace pg {
constexpr int BM = 256, BK = 64, HALF = 128, HTB = HALF * BK * 2, STAGE_BYTES = 8 * HTB, NXCD = 8, WGM = 8;
__host__ __device__ __forceinline__ int lds_byte(int r, int c) { const int st = (r >> 4) * 2 + (c >> 5), rr = r & 15, cc = c & 31, ob = rr * 64 + cc * 2; return st * 1024 + (ob ^ (((ob >> 9) & 1) << 5)); }
__host__ __device__ __forceinline__ void stage_rc(int b, int& R, int& C) { const int st = b / 1024, sb = b % 1024, swz = sb ^ (((sb >> 9) & 1) << 5); R = (st >> 1) * 16 + swz / 64; C = (st & 1) * 32 + (swz % 64) / 2; }
__host__ __device__ __forceinline__ int perm32(int rho) { const int n = rho >> 4, i = rho & 15; return 8 * (i >> 2) + 4 * n + (i & 3); }
struct Unit { int pm, pn, e, mt; };
__device__ __forceinline__ bool static_unit(long L, int nM, int nN, int& pm, int& pn) {
    const int nwg = nM * nN; if (L >= nwg) return false;
    int wgid = (int)L; { const int q = nwg / NXCD, r = nwg % NXCD, xcd = wgid % NXCD, off = wgid / NXCD; wgid = (xcd < r ? xcd * (q + 1) : r * (q + 1) + (xcd - r) * q) + off; }
    const int nig = WGM * nN, gid = wgid / nig, fm = gid * WGM, gsz = (nM - fm) < WGM ? (nM - fm) : WGM;
    pm = fm + ((wgid % nig) % gsz); pn = (wgid % nig) / gsz; return true;
}
__device__ __forceinline__ unsigned cvt_pk_bf16(float lo, float hi) { unsigned r; asm volatile("v_cvt_pk_bf16_f32 %0, %1, %2" : "=v"(r) : "v"(lo), "v"(hi)); return r; }
__device__ __forceinline__ u32x4 pack8(const f32x4 v0, const f32x4 v1) { u32x4 w; w.x = cvt_pk_bf16(v0[0], v0[1]); w.y = cvt_pk_bf16(v0[2], v0[3]); w.z = cvt_pk_bf16(v1[0], v1[1]); w.w = cvt_pk_bf16(v1[2], v1[3]); return w; }
__device__ __forceinline__ void unpack8(const u32x4 w, f32x4& v0, f32x4& v1) {
    v0[0] = __uint_as_float(w.x << 16); v0[1] = __uint_as_float(w.x & 0xffff0000u); v0[2] = __uint_as_float(w.y << 16); v0[3] = __uint_as_float(w.y & 0xffff0000u);
    v1[0] = __uint_as_float(w.z << 16); v1[1] = __uint_as_float(w.z & 0xffff0000u); v1[2] = __uint_as_float(w.w << 16); v1[3] = __uint_as_float(w.w & 0xffff0000u); }
__device__ __forceinline__ f32x2 gelu_pk(f32x2 v) {
    const f32x2 av = __builtin_elementwise_abs(v), d = av * 0.2316418882f + 1.0f;
    f32x2 t; t.x = __builtin_amdgcn_rcpf(d.x); t.y = __builtin_amdgcn_rcpf(d.y);
    f32x2 q = t * 0.5307027145f + (-0.7265760135f); q = q * t + 0.7107068705f; q = q * t + (-0.142248368f); q = q * t + 0.127414796f; q = q * t;
    const f32x2 s = (v * v) * (-0.72134752044f);
    f32x2 e; e.x = __builtin_amdgcn_exp2f(s.x); e.y = __builtin_amdgcn_exp2f(s.y);
    const f32x2 m = v * (q * e), r = v - m;
    f32x2 o; o.x = v.x < 0.f ? m.x : r.x; o.y = v.y < 0.f ? m.y : r.y; return o;
}
__device__ __forceinline__ f32x4 gelu4(f32x4 v) { const f32x2 a = gelu_pk((f32x2){v[0], v[1]}), b = gelu_pk((f32x2){v[2], v[3]}); return (f32x4){a.x, a.y, b.x, b.y}; }
__device__ __forceinline__ float sigm(float v) { return __builtin_amdgcn_rcpf(1.0f + __builtin_amdgcn_exp2f(v * -1.4426950408889634f)); }
__device__ __forceinline__ f32x4 sigm4(f32x4 v) { return (f32x4){sigm(v[0]), sigm(v[1]), sigm(v[2]), sigm(v[3])}; }

template <class Pol>
__device__ __forceinline__ void gemm_run(LAS unsigned char* lds, const Pol& P) {
    constexpr int K = Pol::K, nt = K / BK;
    const int tid = threadIdx.x, wid = __builtin_amdgcn_readfirstlane(tid >> 6), lane = tid & 63, wr = wid >> 2, wc = wid & 3, fr = lane & 15, fq = lane >> 4;
    unsigned voffA[2], voffB[2]; int Rr[2], Cc[2];
#pragma unroll
    for (int i = 0; i < 2; ++i) { int R, C; stage_rc(tid * 16 + i * 8192, R, C); Rr[i] = R; Cc[i] = C; const int Rb = (R & ~31) + perm32(R & 31);
        voffA[i] = (unsigned)(R * K + C) * 2u; voffB[i] = (unsigned)(Rb * K + C) * 2u; }
    constexpr unsigned kstep = BK * 2, hstep = HALF * K * 2;
    const unsigned ldsw = (unsigned)wid * 1024u;
    const int aoff = lds_byte(wr * 64 + fr, fq * 8), boff = lds_byte(wc * 32 + fr, fq * 8);
#define PG_SA(b, h) (((b) * 2 + (h)) * HTB)
#define PG_SB(b, h) ((4 + (b) * 2 + (h)) * HTB)
#define PG_AOFF(nx, h, i) (Pol::GATHER ? ((nx) ? gN[h][i] : gC[h][i]) : (voffA[i] + (unsigned)(h) * hstep))
#define PG_STAGE_A(bufoff, gbase, nx, h) do { _Pragma("unroll") for (int _i = 0; _i < 2; ++_i) \
        __builtin_amdgcn_global_load_lds((const unsigned*)((const char*)(gbase) + PG_AOFF(nx, h, _i)), (LAS unsigned*)(lds + (bufoff) + ldsw + _i * 8192), 16, 0, 0); } while (0)
#define PG_STAGE_B(bufoff, gbase) do { _Pragma("unroll") for (int _i = 0; _i < 2; ++_i) \
        __builtin_amdgcn_global_load_lds((const unsigned*)((const char*)(gbase) + voffB[_i]), (LAS unsigned*)(lds + (bufoff) + ldsw + _i * 8192), 16, 0, 0); } while (0)
#define PG_LDA(dst, b, h) do { _Pragma("unroll") for (int m = 0; m < 4; ++m) _Pragma("unroll") for (int k = 0; k < 2; ++k) dst[m][k] = *(const LAS bf16x8*)(lds + PG_SA(b, h) + aoff + m * 2048 + k * 1024); } while (0)
#define PG_LDB(dst, b, h) do { _Pragma("unroll") for (int n = 0; n < 2; ++n) _Pragma("unroll") for (int k = 0; k < 2; ++k) dst[n][k] = *(const LAS bf16x8*)(lds + PG_SB(b, h) + boff + n * 2048 + k * 1024); } while (0)
#define PG_MMA(ai, bj, At, Bt) do { __builtin_amdgcn_s_setprio(1); _Pragma("unroll") for (int m = 0; m < 4; ++m) _Pragma("unroll") for (int n = 0; n < 2; ++n) _Pragma("unroll") for (int k = 0; k < 2; ++k) \
        acc[ai][bj][m][n] = __builtin_amdgcn_mfma_f32_16x16x32_bf16(Bt[n][k], At[m][k], acc[ai][bj][m][n], 0, 0, 0); __builtin_amdgcn_s_setprio(0); } while (0)
#define PG_WAIT_V(n) asm volatile("s_waitcnt vmcnt(" #n ")" ::: "memory")
#define PG_WAIT_L(n) asm volatile("s_waitcnt lgkmcnt(" #n ")" ::: "memory")
#define PG_BAR __builtin_amdgcn_s_barrier()
#define PG_SCHED __builtin_amdgcn_sched_barrier(0)
    Unit cur, nxt; int ui = 0;
    if (!P.next(0, cur)) return;
    f32x4 acc[2][2][4][2];
#pragma unroll
    for (int a = 0; a < 2; ++a)
#pragma unroll
        for (int b = 0; b < 2; ++b)
#pragma unroll
            for (int m = 0; m < 4; ++m)
#pragma unroll
                for (int n = 0; n < 2; ++n) acc[a][b][m][n] = (f32x4){0.f, 0.f, 0.f, 0.f};
    bf16x8 At[4][2], B0[2][2], B1[2][2];
    unsigned gC[2][2] = {{0u, 0u}, {0u, 0u}}, gN[2][2] = {{0u, 0u}, {0u, 0u}};
    const char* cA = P.a_base(cur); const char* cB = P.b_base(cur);
    if constexpr (Pol::GATHER) P.a_offsets(cur, Rr, Cc, gC);
    PG_STAGE_B(PG_SB(0, 0), cB); PG_STAGE_B(PG_SB(0, 1), cB + hstep); PG_STAGE_A(PG_SA(0, 0), cA, false, 0); PG_STAGE_A(PG_SA(0, 1), cA, false, 1);
    if (wr == 1) PG_BAR;
    PG_WAIT_V(2); PG_BAR;
    PG_STAGE_B(PG_SB(1, 0), cB + kstep); PG_STAGE_A(PG_SA(1, 0), cA + kstep, false, 0); PG_STAGE_B(PG_SB(1, 1), cB + hstep + kstep);
    PG_WAIT_V(6); PG_BAR;
    for (;;) {
        const bool has_next = P.next(ui + 1, nxt);
        const char* nA = has_next ? P.a_base(nxt) : cA; const char* nB = has_next ? P.b_base(nxt) : cB;
#pragma nounroll
        for (int t = 0; t < nt; t += 2) {
            const bool last = (t == nt - 2);
            if constexpr (Pol::GATHER) { if (last) { if (has_next) P.a_offsets(nxt, Rr, Cc, gN); else { gN[0][0] = gC[0][0]; gN[0][1] = gC[0][1]; gN[1][0] = gC[1][0]; gN[1][1] = gC[1][1]; } } }
            if constexpr (Pol::HOOK) { if (t == Pol::H1 || t == Pol::H2) P.khook(t, acc, cur, wr, wc, fr, fq); }
            const char* a1 = cA + (size_t)(t + 1) * kstep;
            const char* a2 = last ? nA : cA + (size_t)(t + 2) * kstep; const char* b2 = last ? nB : cB + (size_t)(t + 2) * kstep;
            const char* a3 = a2 + kstep; const char* b3 = b2 + kstep;
            PG_LDB(B0, 0, 0); PG_LDB(B1, 0, 1); PG_SCHED; PG_LDA(At, 0, 0); PG_STAGE_A(PG_SA(1, 1), a1, false, 1);
            PG_WAIT_V(8); PG_WAIT_L(0); PG_BAR; PG_MMA(0, 0, At, B0); PG_MMA(0, 1, At, B1); PG_BAR; PG_SCHED;
            PG_LDA(At, 0, 1); PG_STAGE_B(PG_SB(0, 0), b2); PG_STAGE_B(PG_SB(0, 1), b2 + hstep); PG_STAGE_A(PG_SA(0, 0), a2, last, 0);
            PG_WAIT_V(8); PG_WAIT_L(0); PG_BAR; PG_MMA(1, 0, At, B0); PG_MMA(1, 1, At, B1); PG_BAR; PG_SCHED;
            PG_LDB(B0, 1, 0); PG_LDB(B1, 1, 1); PG_SCHED; PG_LDA(At, 1, 0); PG_STAGE_A(PG_SA(0, 1), a2, last, 1);
            PG_WAIT_V(8); PG_WAIT_L(0); PG_BAR; PG_MMA(0, 0, At, B0); PG_MMA(0, 1, At, B1); PG_BAR; PG_SCHED;
            PG_LDA(At, 1, 1); PG_STAGE_B(PG_SB(1, 0), b3); PG_STAGE_B(PG_SB(1, 1), b3 + hstep); PG_STAGE_A(PG_SA(1, 0), a3, last, 0);
            PG_WAIT_V(8); PG_WAIT_L(0); PG_BAR; PG_MMA(1, 0, At, B0); PG_MMA(1, 1, At, B1); PG_BAR; PG_SCHED;
        }
        if (wr == 0) PG_BAR;
        P.epi(acc, cur, wr, wc, fr, fq);
        if (!has_next) break;
#pragma unroll
        for (int a = 0; a < 2; ++a)
#pragma unroll
            for (int b = 0; b < 2; ++b)
#pragma unroll
                for (int m = 0; m < 4; ++m)
#pragma unroll
                    for (int n = 0; n < 2; ++n) acc[a][b][m][n] = (f32x4){0.f, 0.f, 0.f, 0.f};
        cur = nxt; cA = nA; cB = nB; ++ui;
        if constexpr (Pol::GATHER) { gC[0][0] = gN[0][0]; gC[0][1] = gN[0][1]; gC[1][0] = gN[1][0]; gC[1][1] = gN[1][1]; }
        if (wr == 1) PG_BAR;
    }
    PG_WAIT_V(0);
    PG_BAR;
#undef PG_SA
#undef PG_SB
#undef PG_AOFF
#undef PG_STAGE_A
#undef PG_STAGE_B
#undef PG_LDA
#undef PG_LDB
#undef PG_MMA
#undef PG_WAIT_V
#undef PG_WAIT_L
#undef PG_BAR
#undef PG_SCHED
}

struct PolBase { static constexpr bool GATHER = false, HOOK = false; static constexpr int H1 = -1, H2 = -1;
    __device__ __forceinline__ void a_offsets(const Unit&, const int (&)[2], const int (&)[2], unsigned (&)[2][2]) const {}
    __device__ __forceinline__ void khook(int, f32x4 (&)[2][2][4][2], const Unit&, int, int, int, int) const {} };

struct PolP1 : PolBase {
    static constexpr int K = 1024;
    const bf16_t* A; const bf16_t* Bt; bf16_t* PROJ; float* KMP; const float* gq; const float* gk; int G, c;
    __device__ __forceinline__ bool next(int i, Unit& u) const { u.e = 0; u.mt = 0; return static_unit((long)i * G + c, T_TOK / 256, INW / 256, u.pm, u.pn); }
    __device__ __forceinline__ const char* a_base(const Unit& u) const { return (const char*)A + (size_t)u.pm * 256 * K * 2; }
    __device__ __forceinline__ const char* b_base(const Unit& u) const { return (const char*)Bt + (size_t)u.pn * 256 * K * 2; }
    __device__ __forceinline__ void epi(const f32x4 (&acc)[2][2][4][2], const Unit& u, int wr, int wc, int fr, int fq) const {
        const int row0 = u.pm * 256 + wr * 64 + fr, pn = u.pn;
        if (pn >= 4 && pn < 8) {
            const float* g = (pn < 6) ? gq : gk;
            f32x4 gv[2][2], cs[2][2];
#pragma unroll
            for (int bj = 0; bj < 2; ++bj)
#pragma unroll
                for (int n = 0; n < 2; ++n) { gv[bj][n] = *(const f32x4*)(g + 32 * bj + 8 * fq + 4 * n); cs[bj][n] = (f32x4){0.f, 0.f, 0.f, 0.f}; }
#pragma unroll
            for (int ai = 0; ai < 2; ++ai)
#pragma unroll
                for (int m = 0; m < 4; ++m) {
                    float ss = 0.f;
#pragma unroll
                    for (int bj = 0; bj < 2; ++bj)
#pragma unroll
                        for (int n = 0; n < 2; ++n) { const f32x4 x = acc[ai][bj][m][n]; ss += (x[0] * x[0] + x[1] * x[1]) + (x[2] * x[2] + x[3] * x[3]); }
                    ss += __shfl_xor(ss, 16); ss += __shfl_xor(ss, 32);
                    const float rstd = rsqrtf(ss * (1.0f / 64.0f) + EPS);
                    bf16_t* rowp = PROJ + (size_t)(row0 + ai * HALF + m * 16) * INW + 1024 + (pn - 4) * 256 + 64 * wc + 8 * fq;
#pragma unroll
                    for (int bj = 0; bj < 2; ++bj) { const f32x4 v0 = acc[ai][bj][m][0] * rstd * gv[bj][0], v1 = acc[ai][bj][m][1] * rstd * gv[bj][1];
                        cs[bj][0] += v0; cs[bj][1] += v1; *(u32x4*)(rowp + 32 * bj) = pack8(v0, v1); }
                }
            if (pn >= 6) {
#pragma unroll
                for (int bj = 0; bj < 2; ++bj)
#pragma unroll
                    for (int n = 0; n < 2; ++n)
#pragma unroll
                        for (int j = 0; j < 4; ++j) { float s = cs[bj][n][j]; s += __shfl_xor(s, 1); s += __shfl_xor(s, 2); s += __shfl_xor(s, 4); s += __shfl_xor(s, 8); cs[bj][n][j] = s; }
                if (fr == 0) {
                    float* kp = KMP + ((size_t)u.pm * 2 + wr) * 512 + (pn - 6) * 256 + 64 * wc + 8 * fq;
#pragma unroll
                    for (int bj = 0; bj < 2; ++bj) { *(f32x4*)(kp + 32 * bj) = cs[bj][0]; *(f32x4*)(kp + 32 * bj + 4) = cs[bj][1]; }
                }
            }
        } else {
            const int col0 = pn * 256 + wc * 32 + 8 * fq;
#pragma unroll
            for (int ai = 0; ai < 2; ++ai)
#pragma unroll
                for (int m = 0; m < 4; ++m) { bf16_t* rowp = PROJ + (size_t)(row0 + ai * HALF + m * 16) * INW + col0;
#pragma unroll
                    for (int bj = 0; bj < 2; ++bj) { f32x4 v0 = acc[ai][bj][m][0], v1 = acc[ai][bj][m][1];
                        if (pn < 4) { v0 = gelu4(v0); v1 = gelu4(v1); } else if (pn >= 12) { v0 = sigm4(v0); v1 = sigm4(v1); }
                        *(u32x4*)(rowp + bj * HALF) = pack8(v0, v1); } }
        }
    }
};
struct PolP3 : PolBase {
    static constexpr int K = 1536; static constexpr bool HOOK = true; static constexpr int H1 = 8, H2 = 16;
    const bf16_t* A; const bf16_t* Bt; const bf16_t* PROJ; bf16_t* MERGED; int G, c;
    __device__ __forceinline__ bool next(int i, Unit& u) const { u.e = 0; u.mt = 0; return static_unit((long)i * G + c, T_TOK / 256, DM / 256, u.pm, u.pn); }
    __device__ __forceinline__ const char* a_base(const Unit& u) const { return (const char*)A + (size_t)u.pm * 256 * K * 2; }
    __device__ __forceinline__ const char* b_base(const Unit& u) const { return (const char*)Bt + (size_t)u.pn * 256 * K * 2; }
    __device__ __forceinline__ void khook(int t, f32x4 (&acc)[2][2][4][2], const Unit& u, int wr, int wc, int fr, int fq) const {
        const int gnum = (t == 8) ? 0 : 1024;
        int zero = 0; asm volatile("" : "+v"(zero));
        const int row0 = u.pm * 256 + wr * 64 + fr + zero, col0 = OFF_G + u.pn * 256 + wc * 32 + 8 * fq;
#pragma unroll
        for (int ai = 0; ai < 2; ++ai)
#pragma unroll
            for (int m = 0; m < 4; ++m) { const bf16_t* rowp = PROJ + (size_t)(row0 + ai * HALF + m * 16) * INW + col0;
#pragma unroll
                for (int bj = 0; bj < 2; ++bj) { const u32x4 wn = *(const u32x4*)(rowp + gnum + bj * HALF), wd = *(const u32x4*)(rowp + gnum + 1024 + bj * HALF);
                    f32x4 n0, n1, d0, d1; unpack8(wn, n0, n1); unpack8(wd, d0, d1);
#pragma unroll
                    for (int j = 0; j < 4; ++j) { acc[ai][bj][m][0][j] *= n0[j] * __builtin_amdgcn_rcpf(d0[j]); acc[ai][bj][m][1][j] *= n1[j] * __builtin_amdgcn_rcpf(d1[j]); } }
                if (m & 1) asm volatile("" ::: "memory"); }
    }
    __device__ __forceinline__ void epi(const f32x4 (&acc)[2][2][4][2], const Unit& u, int wr, int wc, int fr, int fq) const {
        const int row0 = u.pm * 256 + wr * 64 + fr, colt = u.pn * 256 + wc * 32 + 8 * fq;
#pragma unroll
        for (int ai = 0; ai < 2; ++ai)
#pragma unroll
            for (int m = 0; m < 4; ++m) { const size_t r = (size_t)(row0 + ai * HALF + m * 16);
#pragma unroll
                for (int bj = 0; bj < 2; ++bj) { const u32x4 wg = *(const u32x4*)(PROJ + r * INW + OFF_G + 2048 + colt + bj * HALF); f32x4 g0, g1; unpack8(wg, g0, g1);
                    *(u32x4*)(MERGED + r * DM + colt + bj * HALF) = pack8(acc[ai][bj][m][0] * g0, acc[ai][bj][m][1] * g1); }
                if (m & 1) asm volatile("" ::: "memory"); }
    }
};
struct PolP4 : PolBase {
    static constexpr int K = 1024;
    const bf16_t* A; const bf16_t* Bt; const float* x; float* out; bf16_t* X1B; int G, c;
    __device__ __forceinline__ bool next(int i, Unit& u) const { u.e = 0; u.mt = 0; return static_unit((long)i * G + c, T_TOK / 256, DM / 256, u.pm, u.pn); }
    __device__ __forceinline__ const char* a_base(const Unit& u) const { return (const char*)A + (size_t)u.pm * 256 * K * 2; }
    __device__ __forceinline__ const char* b_base(const Unit& u) const { return (const char*)Bt + (size_t)u.pn * 256 * K * 2; }
    __device__ __forceinline__ void epi(const f32x4 (&acc)[2][2][4][2], const Unit& u, int wr, int wc, int fr, int fq) const {
        const int row0 = u.pm * 256 + wr * 64 + fr, colt = u.pn * 256 + wc * 32 + 8 * fq;
#pragma unroll
        for (int ai = 0; ai < 2; ++ai)
#pragma unroll
            for (int m = 0; m < 4; ++m) { const size_t o = (size_t)(row0 + ai * HALF + m * 16) * DM + colt;
#pragma unroll
                for (int bj = 0; bj < 2; ++bj) { const f32x4 x0 = *(const f32x4*)(x + o + bj * HALF), x1 = *(const f32x4*)(x + o + bj * HALF + 4);
                    const f32x4 v0 = x0 + acc[ai][bj][m][0], v1 = x1 + acc[ai][bj][m][1];
                    *(f32x4*)(out + o + bj * HALF) = v0; *(f32x4*)(out + o + bj * HALF + 4) = v1; *(u32x4*)(X1B + o + bj * HALF) = pack8(v0, v1); }
                if (m & 1) asm volatile("" ::: "memory"); }
    }
};
struct GroupTab { const LAS int* tab; __device__ __forceinline__ int cnt(int e) const { return tab[TAB_CNT + e]; } __device__ __forceinline__ int tstart(int e) const { return tab[TAB_TST + e]; }
    __device__ __forceinline__ int tile_e(int vt) const { return tab[TAB_TE + vt]; } __device__ __forceinline__ int NT() const { return tab[TAB_TST + 32]; } };
struct PolP6 : PolBase {
    static constexpr int K = 1024; static constexpr bool GATHER = true;
    const bf16_t* X1B; const bf16_t* W1T; const int* LIST; const float* RSTDS; const float* b1; bf16_t* ACT; GroupTab tb; int G, c;
    __device__ __forceinline__ bool next(int i, Unit& u) const { if (!static_unit((long)i * G + c, tb.NT(), 8, u.pm, u.pn)) return false; u.e = tb.tile_e(u.pm); u.mt = u.pm - tb.tstart(u.e); return true; }
    __device__ __forceinline__ const char* a_base(const Unit&) const { return (const char*)X1B; }
    __device__ __forceinline__ const char* b_base(const Unit& u) const { return (const char*)W1T + ((size_t)u.e * 2048 + (size_t)u.pn * 256) * K * 2; }
    __device__ __forceinline__ void a_offsets(const Unit& u, const int (&Rr)[2], const int (&Cc)[2], unsigned (&g)[2][2]) const {
        const int valid = tb.cnt(u.e) - u.mt * 256; const int* lp = LIST + u.e * 32768 + u.mt * 256;
#pragma unroll
        for (int h = 0; h < 2; ++h)
#pragma unroll
            for (int i = 0; i < 2; ++i) { const int r = h * HALF + Rr[i]; const int tok = (r < valid) ? (lp[r] >> 2) : 0; g[h][i] = (unsigned)tok * (unsigned)(K * 2) + (unsigned)Cc[i] * 2u; }
    }
    __device__ __forceinline__ void epi(const f32x4 (&acc)[2][2][4][2], const Unit& u, int wr, int wc, int fr, int fq) const {
        const int valid = tb.cnt(u.e) - u.mt * 256, colg = u.pn * 128 + wc * 32 + 8 * fq;
        const float* bp = b1 + (size_t)u.e * 2048 + colg; const float* rp = RSTDS + u.e * 32768 + u.mt * 256;
        const f32x4 bg0 = *(const f32x4*)bp, bg1 = *(const f32x4*)(bp + 4), bl0 = *(const f32x4*)(bp + 1024), bl1 = *(const f32x4*)(bp + 1028);
#pragma unroll
        for (int ai = 0; ai < 2; ++ai)
#pragma unroll
            for (int m = 0; m < 4; ++m) { const int r = ai * HALF + wr * 64 + m * 16 + fr; const float rs = (r < valid) ? rp[r] : 0.f;
                f32x4 o[2];
#pragma unroll
                for (int n = 0; n < 2; ++n) { const f32x4 gv = acc[ai][0][m][n] * rs + (n ? bg1 : bg0), lv = acc[ai][1][m][n] * rs + (n ? bl1 : bl0);
#pragma unroll
                    for (int j = 0; j < 4; ++j) { const float gg = fminf(gv[j], 7.0f), ll = fminf(fmaxf(lv[j], -7.0f), 7.0f); o[n][j] = gg * sigm(1.702f * gg) * (ll + 1.0f); } }
                *(u32x4*)(ACT + (size_t)(u.pm * 256 + r) * DFF + colg) = pack8(o[0], o[1]); }
    }
};
struct PolP7 : PolBase {
    static constexpr int K = 1024;
    const bf16_t* ACT; const bf16_t* W2T; const int* LIST; const float* TOPWS; const float* b2; bf16_t* YS; GroupTab tb; int G, c;
    __device__ __forceinline__ bool next(int i, Unit& u) const { if (!static_unit((long)i * G + c, tb.NT(), 4, u.pm, u.pn)) return false; u.e = tb.tile_e(u.pm); u.mt = u.pm - tb.tstart(u.e); return true; }
    __device__ __forceinline__ const char* a_base(const Unit& u) const { return (const char*)ACT + (size_t)u.pm * 256 * K * 2; }
    __device__ __forceinline__ const char* b_base(const Unit& u) const { return (const char*)W2T + ((size_t)u.e * 1024 + (size_t)u.pn * 256) * K * 2; }
    __device__ __forceinline__ void epi(const f32x4 (&acc)[2][2][4][2], const Unit& u, int wr, int wc, int fr, int fq) const {
        const int valid = tb.cnt(u.e) - u.mt * 256, colt = u.pn * 256 + wc * 32 + 8 * fq;
        const float* bp = b2 + (size_t)u.e * 1024 + colt; const int* lp = LIST + u.e * 32768 + u.mt * 256; const float* wp = TOPWS + u.e * 32768 + u.mt * 256;
        f32x4 bv[2][2];
#pragma unroll
        for (int bj = 0; bj < 2; ++bj) { bv[bj][0] = *(const f32x4*)(bp + bj * HALF); bv[bj][1] = *(const f32x4*)(bp + bj * HALF + 4); }
#pragma unroll
        for (int ai = 0; ai < 2; ++ai)
#pragma unroll
            for (int m = 0; m < 4; ++m) { const int r = ai * HALF + wr * 64 + m * 16 + fr;
                if (r < valid) { const int slot = lp[r]; const float w = wp[r];
#pragma unroll
                    for (int bj = 0; bj < 2; ++bj) *(u32x4*)(YS + (size_t)slot * DM + colt + bj * HALF) = pack8((acc[ai][bj][m][0] + bv[bj][0]) * w, (acc[ai][bj][m][1] + bv[bj][1]) * w); } }
    }
};
}

__device__ __forceinline__ void grouped_setup(LAS int* tab, const unsigned* cnt) {
    const int tid = threadIdx.x;
    if (tid < 32) tab[TAB_CNT + tid] = (int)__hip_atomic_load(cnt + tid, __ATOMIC_RELAXED, __HIP_MEMORY_SCOPE_AGENT);
    __syncthreads();
    if (tid == 0) { int s = 0; for (int e = 0; e < 32; ++e) { tab[TAB_TST + e] = s; s += (tab[TAB_CNT + e] + 255) >> 8; } tab[TAB_TST + 32] = s; }
    __syncthreads();
    const int NT = tab[TAB_TST + 32];
    for (int vt = tid; vt < NT; vt += NWAVES * 64) { int e = 0; for (int k = 1; k < 32; ++k) if (tab[TAB_TST + k] <= vt) e = k; tab[TAB_TE + vt] = e; }
    __syncthreads();
}

__device__ __forceinline__ void lds_fence() { asm volatile("s_waitcnt lgkmcnt(0)" ::: "memory"); }
template <int MAPK> __device__ __forceinline__ int p0_map(int n) {
    if (MAPK == 1) return (n >= 1024 && n < 2048) ? (n & ~255) + 128 * ((n >> 5) & 1) + 32 * ((n >> 6) & 3) + (n & 31) : n;
    if (MAPK == 2) { const int m = n & 1023; return (m >> 7) * 256 + (n >> 10) * 128 + (m & 127); }
    return n;
}
template <int MAPK> __device__ __forceinline__ void p0_transpose_item(const float* W, int N, bf16_t* WT, int ldo, int koff, const float* gk, LAS float* scr, int item, int lane) {
    const int nblk = N / 32, kb = item / nblk, nb = item % nblk, k0 = 64 * kb, n0 = 32 * nb;
#pragma unroll 8
    for (int i = 0; i < 32; ++i) { const int kk = 2 * i + (lane >> 5); float v = W[(size_t)(k0 + kk) * N + n0 + (lane & 31)]; if (gk) v *= gk[k0 + kk]; scr[kk * 33 + (lane & 31)] = v; }
    lds_fence();
    const int c8 = lane & 7;
#pragma unroll
    for (int j = 0; j < 4; ++j) { const int n = (lane >> 3) + 8 * j; const LAS float* s = scr + (8 * c8) * 33 + n;
        u32x4 o; o.x = pg::cvt_pk_bf16(s[0 * 33], s[1 * 33]); o.y = pg::cvt_pk_bf16(s[2 * 33], s[3 * 33]); o.z = pg::cvt_pk_bf16(s[4 * 33], s[5 * 33]); o.w = pg::cvt_pk_bf16(s[6 * 33], s[7 * 33]);
        *(u32x4*)(WT + (size_t)p0_map<MAPK>(n0 + n) * ldo + koff + k0 + 8 * c8) = o; }
    lds_fence();
}
__device__ __forceinline__ void p0_rmsnorm_row(const float* xrow, const float* g, bf16_t* orow, int lane) {
    const f32x4* xr = (const f32x4*)xrow;
    f32x4 v[4]; float s = 0.f;
#pragma unroll
    for (int j = 0; j < 4; ++j) { v[j] = xr[lane + 64 * j]; s += (v[j].x * v[j].x + v[j].y * v[j].y) + (v[j].z * v[j].z + v[j].w * v[j].w); }
    const float rstd = rsqrtf(wave_sum(s) * (1.0f / DM) + EPS);
#pragma unroll
    for (int j = 0; j < 4; ++j) { const f32x4 gv = ((const f32x4*)g)[lane + 64 * j];
        unsigned long long o = (unsigned long long)pg::cvt_pk_bf16(v[j].x * rstd * gv.x, v[j].y * rstd * gv.y) | ((unsigned long long)pg::cvt_pk_bf16(v[j].z * rstd * gv.z, v[j].w * rstd * gv.w) << 32);
        ((unsigned long long*)orow)[lane + 64 * j] = o; }
}
struct P0Args { const float *x, *mem, *g_mix, *g_mem, *w_in, *w_br0, *w_br1, *w_br2, *w_out, *w_mem_kv, *w_gate_up, *w_down, *g_ffn, *w_router, *w_spatial;
    bf16_t *HB, *MEMN, *WinT, *WbrT, *WoutT, *WmemT, *W1T, *W2T, *WSB; float* WrT; };
__device__ __forceinline__ void p0_prologue(const P0Args a, LAS unsigned char* lds, int G, int c) {
    const int tid = threadIdx.x, lane = tid & 63, wave = __builtin_amdgcn_readfirstlane(tid >> 6);
    LAS float* scr = (LAS float*)(lds + wave * 16384);
    const int gw = c * NWAVES + wave, NGW = G * NWAVES;
    constexpr int I_IN = 16 * 192, I_BR = 8 * 32, I_O = 16 * 32, I_1 = 16 * 64, I_2 = 16 * 32;
    constexpr int NITEMS = I_IN + 3 * I_BR + 2 * I_O + NEXP * (I_1 + I_2);
    for (int it = gw; it < NITEMS; it += NGW) {
        int r = it;
        if (r < I_IN) { p0_transpose_item<1>(a.w_in, INW, a.WinT, DM, 0, nullptr, scr, r, lane); continue; } r -= I_IN;
        if (r < 3 * I_BR) { const int br = r / I_BR; const float* wsrc = (br == 0) ? a.w_br0 : (br == 1) ? a.w_br1 : a.w_br2; p0_transpose_item<0>(wsrc, DM, a.WbrT, 1536, br * 512, nullptr, scr, r - br * I_BR, lane); continue; } r -= 3 * I_BR;
        if (r < I_O) { p0_transpose_item<0>(a.w_out, DM, a.WoutT, DM, 0, nullptr, scr, r, lane); continue; } r -= I_O;
        if (r < I_O) { p0_transpose_item<0>(a.w_mem_kv, DM, a.WmemT, DM, 0, nullptr, scr, r, lane); continue; } r -= I_O;
        if (r < NEXP * I_1) { const int e = r / I_1; p0_transpose_item<2>(a.w_gate_up + (size_t)e * DM * 2048, 2048, a.W1T + (size_t)e * 2048 * DM, DM, 0, a.g_ffn, scr, r - e * I_1, lane); continue; } r -= NEXP * I_1;
        { const int e = r / I_2; p0_transpose_item<0>(a.w_down + (size_t)e * DFF * DM, DM, a.W2T + (size_t)e * DM * DFF, DFF, 0, nullptr, scr, r - e * I_2, lane); }
    }
    for (int m = gw; m < T_TOK; m += NGW) p0_rmsnorm_row(a.x + (size_t)m * DM, a.g_mix, a.HB + (size_t)m * DM, lane);
    for (int m = gw; m < NBATCH * MEML; m += NGW) p0_rmsnorm_row(a.mem + (size_t)m * DM, a.g_mem, a.MEMN + (size_t)m * DM, lane);
    const int gt = c * NWAVES * 64 + tid, NGT = G * NWAVES * 64;
    for (int i = gt; i < 32 * 1024; i += NGT) { const int e = i >> 10, k = i & 1023; a.WrT[i] = a.w_router[k * 32 + e] * a.g_ffn[k]; }
    for (int i = gt; i < 4 * 128 * 128; i += NGT) { const int s = i & 127, t = (i >> 7) & 127; a.WSB[i] = (s <= t) ? f2bf(a.w_spatial[i]) : (bf16_t)0; }
}
__device__ __forceinline__ void p1_memkv(const bf16_t* MEMN, const bf16_t* WmemT, const float* gk, bf16_t* MKV, int G, int c) {
    const int tid = threadIdx.x, lane = tid & 63, wave = __builtin_amdgcn_readfirstlane(tid >> 6), fr = lane & 15, fq = lane >> 4;
    const int gw = c * NWAVES + wave, NGW = G * NWAVES;
    for (int unit = gw; unit < 1024; unit += NGW) {
        const int rt = unit >> 3, ct = unit & 7;
        f32x4 acc[8];
#pragma unroll
        for (int j = 0; j < 8; ++j) acc[j] = (f32x4){0.f, 0.f, 0.f, 0.f};
        const bf16_t* ap = MEMN + (size_t)(rt * 16 + fr) * DM + fq * 8; const bf16_t* bp = WmemT + (size_t)(ct * 128 + fr) * DM + fq * 8;
        for (int k = 0; k < DM; k += 32) {
            const bf16x8 af = *(const bf16x8*)(ap + k);
#pragma unroll
            for (int j = 0; j < 8; ++j) { const bf16x8 bf = *(const bf16x8*)(bp + (size_t)j * 16 * DM + k); acc[j] = __builtin_amdgcn_mfma_f32_16x16x32_bf16(af, bf, acc[j], 0, 0, 0); }
        }
        float rstd[4] = {1.f, 1.f, 1.f, 1.f};
        if (ct < 4) {
#pragma unroll
            for (int r = 0; r < 4; ++r) { float ss = 0.f;
#pragma unroll
                for (int j = 0; j < 8; ++j) ss += acc[j][r] * acc[j][r];
                ss += __shfl_xor(ss, 1); ss += __shfl_xor(ss, 2); ss += __shfl_xor(ss, 4); ss += __shfl_xor(ss, 8);
                rstd[r] = rsqrtf(ss * (1.0f / 128.0f) + EPS); }
        }
#pragma unroll
        for (int j = 0; j < 8; ++j) { const float gg = (ct < 4) ? gk[16 * j + fr] : 1.0f;
#pragma unroll
            for (int r = 0; r < 4; ++r) MKV[(size_t)(rt * 16 + fq * 4 + r) * 1024 + ct * 128 + 16 * j + fr] = f2bf(acc[j][r] * rstd[r] * gg); }
    }
}
__device__ __forceinline__ void p2_sgu_item(int item, const bf16_t* PROJ, const float* gsv, const float* ws, const float* bs, bf16_t* Y, LAS unsigned char* lds) {
    const int tid = threadIdx.x, lane = tid & 63, wave = __builtin_amdgcn_readfirstlane(tid >> 6);
    const int g = item & 3, t0 = (item >> 2) * 128;
    LAS float* rs = (LAS float*)lds; LAS float* vn = (LAS float*)(lds + 1024);
    for (int i = 0; i < 16; ++i) { const int tl = wave * 16 + i;
        const u32x4 w = *(const u32x4*)(PROJ + (size_t)(t0 + tl) * INW + OFF_V + lane * 8); f32x4 a, b; pg::unpack8(w, a, b);
        float ss = (a[0] * a[0] + a[1] * a[1]) + (a[2] * a[2] + a[3] * a[3]) + (b[0] * b[0] + b[1] * b[1]) + (b[2] * b[2] + b[3] * b[3]);
        ss = wave_sum(ss); if (lane == 0) rs[tl] = rsqrtf(ss * (1.0f / 512.0f) + EPS); }
    __syncthreads();
    { const int c8 = tid & 15; const f32x4 g0 = *(const f32x4*)(gsv + g * 128 + c8 * 8), g1 = *(const f32x4*)(gsv + g * 128 + c8 * 8 + 4);
#pragma unroll
        for (int j = 0; j < 4; ++j) { const int s = (tid >> 4) + 32 * j; const float r = rs[s];
            const u32x4 w = *(const u32x4*)(PROJ + (size_t)(t0 + s) * INW + OFF_V + g * 128 + c8 * 8); f32x4 a, b; pg::unpack8(w, a, b);
            *(LAS f32x4*)(vn + s * 128 + c8 * 8) = a * r * g0; *(LAS f32x4*)(vn + s * 128 + c8 * 8 + 4) = b * r * g1; } }
    __syncthreads();
    { const int d = tid & 127, tq = __builtin_amdgcn_readfirstlane(tid >> 7);
        for (int j = 0; j < 32; ++j) { const int tl = tq + 4 * j; const float* w = ws + ((size_t)g * 128 + tl) * 128; float acc = bs[g * 128 + tl];
            for (int s = 0; s <= tl; ++s) acc += w[s] * vn[s * 128 + d];
            const size_t row = (size_t)(t0 + tl);
            Y[row * 1536 + g * 128 + d] = f2bf(bf2f(PROJ[row * INW + OFF_U + g * 128 + d]) * acc); } }
    __syncthreads();
}
__device__ __forceinline__ void p2_moba_item(int idx, const bf16_t* PROJ, const float* KMP, bf16_t* Y, LAS float* qs, LAS float* ps, int lane) {
    const int t = idx & (SEQ - 1), h = (idx >> 12) & 7, b = idx >> 15;
    const size_t rowq = (size_t)b * SEQ + t;
    qs[lane] = bf2f(PROJ[rowq * INW + OFF_QB + h * 64 + lane]);
    lds_fence();
    const int jb = t >> 8;
    float gate = -1e30f;
    if (lane < 16 && lane < jb) {
        float s = 0.f; const float* k0 = KMP + ((size_t)(b * 16 + lane) * 2) * 512 + h * 64;
        for (int d = 0; d < 64; ++d) s += qs[d] * ((k0[d] + k0[512 + d]) * (1.0f / 256.0f));
        gate = s;
    }
    int blk[4];
#pragma unroll
    for (int i = 0; i < 3; ++i) {
        float m = gate; int mi = lane;
#pragma unroll
        for (int o = 1; o < 64; o <<= 1) { const float om = __shfl_xor(m, o); const int oi = __shfl_xor(mi, o); if (om > m || (om == m && oi < mi)) { m = om; mi = oi; } }
        blk[i] = (m > -5e29f) ? mi : -1;
        if (lane == mi) gate = -3e38f;
    }
    blk[3] = jb;
    const float slope = exp2f(-(float)(h + 1));
    float mx = -3e38f;
#pragma unroll
    for (int i = 0; i < 4; ++i) {
        for (int r = 0; r < 4; ++r) {
            const int j = lane + 64 * r; float s = -1e30f;
            if (blk[i] >= 0) {
                const int key = blk[i] * 256 + j;
                if (i < 3 || key <= t) {
                    const bf16_t* kp = PROJ + ((size_t)b * SEQ + key) * INW + OFF_KB + h * 64; float d = 0.f;
#pragma unroll
                    for (int e8 = 0; e8 < 8; ++e8) { const u32x4 w = *(const u32x4*)(kp + e8 * 8); f32x4 x0, x1; pg::unpack8(w, x0, x1);
                        d += qs[e8 * 8 + 0] * x0[0] + qs[e8 * 8 + 1] * x0[1] + qs[e8 * 8 + 2] * x0[2] + qs[e8 * 8 + 3] * x0[3] + qs[e8 * 8 + 4] * x1[0] + qs[e8 * 8 + 5] * x1[1] + qs[e8 * 8 + 6] * x1[2] + qs[e8 * 8 + 7] * x1[3]; }
                    s = d * 0.125f - slope * (float)(t - key);
                }
            }
            ps[i * 256 + j] = s; mx = fmaxf(mx, s);
        }
    }
    mx = wave_max(mx);
    lds_fence();
    float sum = 0.f;
    for (int i = lane; i < 1024; i += 64) { const float p = __expf(ps[i] - mx); ps[i] = p; sum += p; }
    sum = wave_sum(sum);
    lds_fence();
    float o = 0.f;
#pragma unroll
    for (int i = 0; i < 4; ++i) {
        if (blk[i] < 0) continue;
        const int jend = (i == 3) ? (t - jb * 256 + 1) : 256;
        const bf16_t* vp = PROJ + ((size_t)b * SEQ + blk[i] * 256) * INW + OFF_VB + h * 64 + lane;
        for (int j = 0; j < jend; ++j) o += ps[i * 256 + j] * bf2f(vp[(size_t)j * INW]);
    }
    Y[rowq * 1536 + 512 + h * 64 + lane] = f2bf(o / sum);
    lds_fence();
}
__device__ __forceinline__ void p2_mem_item(int idx, const bf16_t* PROJ, const bf16_t* MKV, const float* gq, bf16_t* Y, LAS float* qs, LAS float* ps, int lane) {
    const int h = idx & 3, tt = idx >> 2, b = tt >> 12;
    const float a = bf2f(PROJ[(size_t)tt * INW + OFF_QM + h * 128 + lane]), c = bf2f(PROJ[(size_t)tt * INW + OFF_QM + h * 128 + 64 + lane]);
    const float rstd = rsqrtf(wave_sum(a * a + c * c) * (1.0f / 128.0f) + EPS);
    qs[lane] = a * rstd * gq[lane]; qs[lane + 64] = c * rstd * gq[lane + 64];
    lds_fence();
    float mx = -3e38f;
    for (int r = 0; r < 4; ++r) {
        const int m = lane + 64 * r; const bf16_t* kp = MKV + ((size_t)b * MEML + m) * 1024 + h * 128; float d = 0.f;
#pragma unroll
        for (int e8 = 0; e8 < 16; ++e8) { const u32x4 w = *(const u32x4*)(kp + e8 * 8); f32x4 x0, x1; pg::unpack8(w, x0, x1);
            d += qs[e8 * 8 + 0] * x0[0] + qs[e8 * 8 + 1] * x0[1] + qs[e8 * 8 + 2] * x0[2] + qs[e8 * 8 + 3] * x0[3] + qs[e8 * 8 + 4] * x1[0] + qs[e8 * 8 + 5] * x1[1] + qs[e8 * 8 + 6] * x1[2] + qs[e8 * 8 + 7] * x1[3]; }
        d *= 0.08838834764831845f; ps[m] = d; mx = fmaxf(mx, d);
    }
    mx = wave_max(mx);
    lds_fence();
    float sum = 0.f;
    for (int i = lane; i < 256; i += 64) { const float p = __expf(ps[i] - mx); ps[i] = p; sum += p; }
    sum = wave_sum(sum);
    lds_fence();
    float o0 = 0.f, o1 = 0.f;
    const bf16_t* vp = MKV + ((size_t)b * MEML) * 1024 + 512 + h * 128 + lane;
    for (int m = 0; m < 256; ++m) { const float p = ps[m]; o0 += p * bf2f(vp[(size_t)m * 1024]); o1 += p * bf2f(vp[(size_t)m * 1024 + 64]); }
    Y[(size_t)tt * 1536 + 1024 + h * 128 + lane] = f2bf(o0 / sum); Y[(size_t)tt * 1536 + 1024 + h * 128 + 64 + lane] = f2bf(o1 / sum);
    lds_fence();
}
__device__ __forceinline__ void p5_router(const float* X1, const float* WrT, const float* br, int* LIST, float* RSTDS, float* TOPWS, unsigned* cnt, int G, int c) {
    const int tl = threadIdx.x >> 5, e = threadIdx.x & 31;
    for (int t = c * 16 + tl; t < T_TOK; t += G * 16) {
        const f32x4* xr = (const f32x4*)(X1 + (size_t)t * DM); const f32x4* w = (const f32x4*)(WrT + (size_t)e * DM);
        float ss = 0.f, acc = 0.f;
        for (int k = 0; k < DM / 4; ++k) { const f32x4 xv = xr[k], wv = w[k]; ss += (xv[0] * xv[0] + xv[1] * xv[1]) + (xv[2] * xv[2] + xv[3] * xv[3]); acc += (xv[0] * wv[0] + xv[1] * wv[1]) + (xv[2] * wv[2] + xv[3] * wv[3]); }
        const float rstd = rsqrtf(ss * (1.0f / DM) + EPS);
        const float logit = acc * rstd + br[e];
        float sel_l[4]; int sel_e[4]; float cur = logit;
#pragma unroll
        for (int i = 0; i < 4; ++i) {
            float m = cur; int mi = e;
#pragma unroll
            for (int o = 1; o < 32; o <<= 1) { const float om = __shfl_xor(m, o); const int oi = __shfl_xor(mi, o); if (om > m || (om == m && oi < mi)) { m = om; mi = oi; } }
            sel_l[i] = m; sel_e[i] = mi; if (e == mi) cur = -3e38f;
        }
        if (e < 4) {
            float den = 0.f;
#pragma unroll
            for (int i = 0; i < 4; ++i) den += __expf(sel_l[i] - sel_l[0]);
            float myl = sel_l[0]; int mye = sel_e[0];
#pragma unroll
            for (int i = 1; i < 4; ++i) if (e == i) { myl = sel_l[i]; mye = sel_e[i]; }
            const float wgt = __expf(myl - sel_l[0]) / den;
            const unsigned pos = atomicAdd(cnt + mye, 1u);
            LIST[mye * 32768 + pos] = t * 4 + e; RSTDS[mye * 32768 + pos] = rstd; TOPWS[mye * 32768 + pos] = wgt;
        }
    }
}
__device__ __forceinline__ void p8_combine(float* out, const bf16_t* YS, int G, int c) {
    const size_t gt = (size_t)c * NWAVES * 64 + threadIdx.x, NGT = (size_t)G * NWAVES * 64;
    for (size_t i = gt; i < (size_t)T_TOK * DM / 8; i += NGT) {
        const size_t t = i >> 7, c8 = (i & 127) * 8;
        f32x4 o0 = *(const f32x4*)(out + t * DM + c8), o1 = *(const f32x4*)(out + t * DM + c8 + 4);
#pragma unroll
        for (int k = 0; k < 4; ++k) { const u32x4 w = *(const u32x4*)(YS + (t * 4 + k) * DM + c8); f32x4 a, b; pg::unpack8(w, a, b); o0 += a; o1 += b; }
        *(f32x4*)(out + t * DM + c8) = o0; *(f32x4*)(out + t * DM + c8 + 4) = o1;
    }
}

namespace at {
typedef __attribute__((address_space(3))) const char* lds_cptr;
typedef short s16x4 __attribute__((ext_vector_type(4)));
typedef float f32x16 __attribute__((ext_vector_type(16)));
__device__ __forceinline__ int crow(int r, int hi) { return (r & 3) + 8 * (r >> 2) + 4 * hi; }
__device__ __forceinline__ s16x4 vtr(lds_cptr p) { return __builtin_bit_cast(s16x4, __builtin_amdgcn_ds_read_tr16_b64_v4i16((__attribute__((address_space(3))) s16x4*)p)); }
template <int ND0> __device__ __forceinline__ void qk_step(f32x16& p0, f32x16& p1, lds_cptr kb, int kch2, const bf16x8 (&qr)[ND0]) {
#pragma unroll
    for (int r = 0; r < 16; ++r) { p0[r] = 0.f; p1[r] = 0.f; }
#pragma unroll
    for (int d0 = 0; d0 < ND0; ++d0) {
        const bf16x8 b0 = *(const __attribute__((address_space(3))) bf16x8*)(kb + d0 * kch2);
        const bf16x8 b1 = *(const __attribute__((address_space(3))) bf16x8*)(kb + d0 * kch2 + 512);
        p0 = __builtin_amdgcn_mfma_f32_32x32x16_bf16(b0, qr[d0], p0, 0, 0, 0);
        p1 = __builtin_amdgcn_mfma_f32_32x32x16_bf16(b1, qr[d0], p1, 0, 0, 0);
    }
}
template <int NDB> __device__ __forceinline__ void softmax_step(f32x16& s0, f32x16& s1, float& m, float& l, f32x16 (&o)[NDB], LAS float* wsf, int r32, int hi, u32x4 (&pw)[4]) {
    float tm = fmaxf(s0[0], s1[0]);
#pragma unroll
    for (int r = 1; r < 16; ++r) tm = fmaxf(tm, fmaxf(s0[r], s1[r]));
    tm = fmaxf(tm, __shfl_xor(tm, 32));
    const float mn = fmaxf(m, tm);
    if (__any(mn > m)) {
        const float alpha = __builtin_amdgcn_exp2f(m - mn);
        l *= alpha; m = mn;
        if (hi == 0) wsf[r32] = alpha;
        asm volatile("s_waitcnt lgkmcnt(0)" ::: "memory");
#pragma unroll
        for (int r = 0; r < 16; ++r) { const float f = wsf[crow(r, hi)];
#pragma unroll
            for (int db = 0; db < NDB; ++db) o[db][r] *= f; }
    }
    float sum = 0.f;
#pragma unroll
    for (int r = 0; r < 16; ++r) { s0[r] = __builtin_amdgcn_exp2f(s0[r] - m); s1[r] = __builtin_amdgcn_exp2f(s1[r] - m); sum += s0[r] + s1[r]; }
    l += sum;
    pw[0] = (u32x4){pg::cvt_pk_bf16(s0[0], s0[1]), pg::cvt_pk_bf16(s0[2], s0[3]), pg::cvt_pk_bf16(s0[4], s0[5]), pg::cvt_pk_bf16(s0[6], s0[7])};
    pw[1] = (u32x4){pg::cvt_pk_bf16(s0[8], s0[9]), pg::cvt_pk_bf16(s0[10], s0[11]), pg::cvt_pk_bf16(s0[12], s0[13]), pg::cvt_pk_bf16(s0[14], s0[15])};
    pw[2] = (u32x4){pg::cvt_pk_bf16(s1[0], s1[1]), pg::cvt_pk_bf16(s1[2], s1[3]), pg::cvt_pk_bf16(s1[4], s1[5]), pg::cvt_pk_bf16(s1[6], s1[7])};
    pw[3] = (u32x4){pg::cvt_pk_bf16(s1[8], s1[9]), pg::cvt_pk_bf16(s1[10], s1[11]), pg::cvt_pk_bf16(s1[12], s1[13]), pg::cvt_pk_bf16(s1[14], s1[15])};
}
template <int NDB> __device__ __forceinline__ void pv_step(f32x16 (&o)[NDB], const u32x4 (&pw)[4], lds_cptr vb, int vdb_stride) {
#pragma unroll
    for (int db = 0; db < NDB; ++db)
#pragma unroll
        for (int ks = 0; ks < 4; ++ks) {
            const s16x4 lo = vtr(vb + db * vdb_stride + ks * 1024), hh = vtr(vb + db * vdb_stride + ks * 1024 + 512);
            const bf16x8 vf = (bf16x8){lo[0], lo[1], lo[2], lo[3], hh[0], hh[1], hh[2], hh[3]};
            o[db] = __builtin_amdgcn_mfma_f32_32x32x16_bf16(__builtin_bit_cast(bf16x8, pw[ks]), vf, o[db], 0, 0, 0);
        }
}
template <int NDB> __device__ __forceinline__ void store_o(const f32x16 (&o)[NDB], float l, LAS float* wsf, int r32, int hi, bf16_t* yrow0  , int ldy) {
    l += __shfl_xor(l, 32);
    if (hi == 0) wsf[r32] = __builtin_amdgcn_rcpf(l);
    asm volatile("s_waitcnt lgkmcnt(0)" ::: "memory");
#pragma unroll
    for (int r = 0; r < 16; ++r) { const int q = crow(r, hi); const float inv = wsf[q];
#pragma unroll
        for (int db = 0; db < NDB; ++db) yrow0[(size_t)q * ldy + db * 32 + r32] = f2bf(o[db][r] * inv); }
    asm volatile("s_waitcnt lgkmcnt(0)" ::: "memory");
}

__device__ __forceinline__ void moba_unit(int b, int h, int jb, const bf16_t* PROJ, const float* KMP, bf16_t* Y, LAS unsigned char* lds) {
    const int tid = threadIdx.x, lane = tid & 63, r32 = lane & 31, hi = lane >> 5, w = __builtin_amdgcn_readfirstlane(tid >> 6);
    LAS float* kmean = (LAS float*)(lds + 32768);
    LAS float* wsf = (LAS float*)(lds + 36864) + w * 64;
    const size_t rowbase = (size_t)b * SEQ; const int q0 = jb * 256; const int t = q0 + 32 * w + r32;
    for (int i = tid; i < jb * 64; i += NWAVES * 64) { const int n = i >> 6, d = i & 63; const float* p = KMP + ((size_t)(b * 16 + n) * 2) * 512 + h * 64 + d; kmean[i] = (p[0] + p[512]) * (1.0f / 256.0f); }
    const bf16_t* qp = PROJ + (rowbase + t) * INW + OFF_QB + h * 64 + hi * 8;
    bf16x8 qr[4];
#pragma unroll
    for (int d0 = 0; d0 < 4; ++d0) qr[d0] = *(const bf16x8*)(qp + d0 * 16);
    const bf16_t* kg = PROJ + (rowbase + lane) * INW + OFF_KB + h * 64 + w * 8;
    const bf16_t* vg = PROJ + (rowbase + 16 * (w & 3) + (lane >> 2)) * INW + OFF_VB + h * 64 + (w >> 2) * 32 + (lane & 3) * 8;
    const int kdst = w * 1024 + lane * 16, vdst = 8192 + w * 1024 + lane * 16;
    u32x4 kreg = *(const u32x4*)kg, vreg = *(const u32x4*)vg;
    __syncthreads();
    unsigned selmask = 0u;
    {
        float qf[32];
#pragma unroll
        for (int d0 = 0; d0 < 4; ++d0) { f32x4 a, c; pg::unpack8(__builtin_bit_cast(u32x4, qr[d0]), a, c);
#pragma unroll
            for (int j = 0; j < 4; ++j) { qf[d0 * 8 + j] = a[j]; qf[d0 * 8 + 4 + j] = c[j]; } }
        float v0 = -INFINITY, v1 = -INFINITY, v2 = -INFINITY; int i0 = -1, i1 = -1, i2 = -1;
        for (int n = 0; n < jb; ++n) {
            const LAS float* km = kmean + n * 64 + hi * 8; float g = 0.f;
#pragma unroll
            for (int d0 = 0; d0 < 4; ++d0) { const f32x4 ka = *(const LAS f32x4*)(km + d0 * 16), kc = *(const LAS f32x4*)(km + d0 * 16 + 4);
#pragma unroll
                for (int j = 0; j < 4; ++j) g += qf[d0 * 8 + j] * ka[j] + qf[d0 * 8 + 4 + j] * kc[j]; }
            g += __shfl_xor(g, 32);
            if (g > v0) { v2 = v1; i2 = i1; v1 = v0; i1 = i0; v0 = g; i0 = n; } else if (g > v1) { v2 = v1; i2 = i1; v1 = g; i1 = n; } else if (g > v2) { v2 = g; i2 = n; }
        }
        if (i0 >= 0) selmask |= 1u << i0; if (i1 >= 0) selmask |= 1u << i1; if (i2 >= 0) selmask |= 1u << i2;
    }
    *(LAS u32x4*)(lds + kdst) = kreg; *(LAS u32x4*)(lds + vdst) = vreg;
    __syncthreads();
    const float slope2 = exp2f(-(float)(h + 1)) * 1.4426950408889634f; const float cs = 0.125f * 1.4426950408889634f;
    float m = -1e30f, l = 0.f; f32x16 o[2];
#pragma unroll
    for (int r = 0; r < 16; ++r) { o[0][r] = 0.f; o[1][r] = 0.f; }
    const int qrel = 32 * w + r32;
    const int NT = 4 * (jb + 1);
    const lds_cptr lb = (lds_cptr)lds;
    const int koff = hi * 1024 + r32 * 16, voff = 8192 + ((lane >> 4) & 1) * 32 + (lane & 3) * 8 + (4 * hi + ((lane & 15) >> 2)) * 64;
    for (int T = 0; T < NT; ++T) {
        const int slot = (T & 1) * 16384;
        if (T + 1 < NT) { kreg = *(const u32x4*)(kg + (size_t)(T + 1) * 64 * INW); vreg = *(const u32x4*)(vg + (size_t)(T + 1) * 64 * INW); }
        const int n = T >> 2, kt = T & 3;
        const bool own = (n == jb);
        const bool sel = own || ((selmask >> n) & 1u);
        const bool need = own ? (64 * kt <= 32 * w + 31) : (__any(sel) != 0);
        if (need) {
            f32x16 s0, s1;
            qk_step<4>(s0, s1, lb + slot + koff, 2048, qr);
            const float lbias = slope2 * (float)(T * 64 + 4 * hi - t);
#pragma unroll
            for (int r = 0; r < 16; ++r) { const float kb = slope2 * (float)((r & 3) + 8 * (r >> 2));
                s0[r] = s0[r] * cs + (lbias + kb); s1[r] = s1[r] * cs + (lbias + kb + 32.0f * slope2); }
            if (own) {
                const int kr = kt * 64 + 4 * hi;
#pragma unroll
                for (int r = 0; r < 16; ++r) { const int kk = kr + (r & 3) + 8 * (r >> 2); if (kk > qrel) s0[r] = -INFINITY; if (kk + 32 > qrel) s1[r] = -INFINITY; }
            } else if (!sel) {
#pragma unroll
                for (int r = 0; r < 16; ++r) { s0[r] = -INFINITY; s1[r] = -INFINITY; }
            }
            u32x4 pw[4];
            softmax_step<2>(s0, s1, m, l, o, wsf, r32, hi, pw);
            pv_step<2>(o, pw, lb + slot + voff, 4096);
        }
        if (T + 1 < NT) { *(LAS u32x4*)(lds + (slot ^ 16384) + kdst) = kreg; *(LAS u32x4*)(lds + (slot ^ 16384) + vdst) = vreg; }
        __syncthreads();
    }
    store_o<2>(o, l, wsf, r32, hi, Y + (rowbase + q0 + 32 * w) * 1536 + 512 + h * 64, 1536);
}

__device__ __forceinline__ void mem_units(int b, int h, int qt0, int nqt, const bf16_t* PROJ, const bf16_t* MKV, const float* gq, bf16_t* Y, LAS unsigned char* lds) {
    const int tid = threadIdx.x, lane = tid & 63, r32 = lane & 31, hi = lane >> 5, w = __builtin_amdgcn_readfirstlane(tid >> 6);
    LAS float* wsf = (LAS float*)(lds + RING_BYTES + 4096) + w * 64;
    __syncthreads();
#pragma unroll
    for (int i = 0; i < 8; ++i) { const int p = tid + 512 * i, key = p & 255, ch = p >> 8;
        const u32x4 wv = *(const u32x4*)(MKV + ((size_t)b * MEML + key) * 1024 + h * 128 + ch * 8); f32x4 a, c; pg::unpack8(wv, a, c);
        const f32x4 g0 = *(const f32x4*)(gq + ch * 8), g1 = *(const f32x4*)(gq + ch * 8 + 4);
        *(LAS u32x4*)(lds + ch * 4096 + key * 16) = pg::pack8(a * g0, c * g1); }
#pragma unroll
    for (int i = 0; i < 8; ++i) { const int p = tid + 512 * i, key = p >> 4, c16 = p & 15;
        const u32x4 wv = *(const u32x4*)(MKV + ((size_t)b * MEML + key) * 1024 + 512 + h * 128 + c16 * 8);
        *(LAS u32x4*)(lds + 65536 + (c16 >> 2) * 16384 + (key >> 4) * 1024 + (key & 15) * 64 + (c16 & 3) * 16) = wv; }
    __syncthreads();
    const lds_cptr lb = (lds_cptr)lds;
    const int koff = hi * 4096 + r32 * 16, voff = 65536 + ((lane >> 4) & 1) * 32 + (lane & 3) * 8 + (4 * hi + ((lane & 15) >> 2)) * 64;
    for (int qi = 0; qi < nqt; ++qi) {
        const size_t row0 = (size_t)b * SEQ + (size_t)(qt0 + qi) * 256 + 32 * w;
        const bf16_t* qp = PROJ + (row0 + r32) * INW + OFF_QM + h * 128 + hi * 8;
        bf16x8 qr[8]; float ss = 0.f;
#pragma unroll
        for (int d0 = 0; d0 < 8; ++d0) { qr[d0] = *(const bf16x8*)(qp + d0 * 16); f32x4 a, c; pg::unpack8(__builtin_bit_cast(u32x4, qr[d0]), a, c);
            ss += (a[0] * a[0] + a[1] * a[1]) + (a[2] * a[2] + a[3] * a[3]) + (c[0] * c[0] + c[1] * c[1]) + (c[2] * c[2] + c[3] * c[3]); }
        ss += __shfl_xor(ss, 32);
        const float cs = rsqrtf(ss * (1.0f / 128.0f) + EPS) * (0.08838834764831845f * 1.4426950408889634f);
        float m = -1e30f, l = 0.f; f32x16 o[4];
#pragma unroll
        for (int r = 0; r < 16; ++r) { o[0][r] = 0.f; o[1][r] = 0.f; o[2][r] = 0.f; o[3][r] = 0.f; }
        for (int kt = 0; kt < 4; ++kt) {
            f32x16 s0, s1;
            qk_step<8>(s0, s1, lb + koff + kt * 1024, 8192, qr);
#pragma unroll
            for (int r = 0; r < 16; ++r) { s0[r] *= cs; s1[r] *= cs; }
            u32x4 pw[4];
            softmax_step<4>(s0, s1, m, l, o, wsf, r32, hi, pw);
            pv_step<4>(o, pw, lb + voff + kt * 4096, 16384);
        }
        store_o<4>(o, l, wsf, r32, hi, Y + row0 * 1536 + 1024 + h * 128, 1536);
    }
    __syncthreads();
}
}

struct MArgs { const float* in[24]; float* out; unsigned char* ws; int ph_lo, ph_hi; };
__global__ void __launch_bounds__(NWAVES * 64, 2) mk_fwd(MArgs a) {
    extern __shared__ __attribute__((aligned(16))) unsigned char lds_raw[];
    LAS unsigned char* lds = (LAS unsigned char*)lds_raw;
    const int tid = threadIdx.x;
    for (int u = tid; u < (LDS_BYTES - LDSCTL_OFF) / 4; u += NWAVES * 64) ((LAS unsigned*)(lds + LDSCTL_OFF))[u] = 0u;
    __syncthreads();
    unsigned char* ws = a.ws; unsigned* ctl = (unsigned*)(ws + WS_CTL);
    const int lo = a.ph_lo, hi = a.ph_hi; const int G = gridDim.x, c = blockIdx.x;
    XcdBarrier bar; bar.bar = ctl + CW_BAR; bar.x = 0; bar.st = nullptr;
    if (hi - lo > 1) bar = xcd_barrier_post(ctl + CW_BAR, (volatile LAS unsigned*)(lds + LDSCTL_OFF));
typedef const MArgs __attribute__((address_space(4))) * kargp_t;
    const kargp_t kargs = (kargp_t)__builtin_amdgcn_kernarg_segment_ptr();
#define KA_BEGIN() kargp_t q = kargs; asm volatile("" : "+s"(q))
#define IN(k) (lo <= (k) && (k) < hi)
#define BOTH(k) (IN(k) && IN((k) + 1))
    bf16_t *WinT = (bf16_t*)(ws + WS_WIN), *WbrT = (bf16_t*)(ws + WS_WBR), *WoutT = (bf16_t*)(ws + WS_WOUT);
    bf16_t *W1T = (bf16_t*)(ws + WS_W1), *W2T = (bf16_t*)(ws + WS_W2);
    bf16_t *MERGED = (bf16_t*)(ws + WS_MERGED), *X1B = (bf16_t*)(ws + WS_X1B), *HB = (bf16_t*)(ws + WS_HB), *PROJ = (bf16_t*)(ws + WS_PROJ), *Y = (bf16_t*)(ws + WS_Y);
    bf16_t *ACT = (bf16_t*)(ws + WS_ACT), *YS = (bf16_t*)(ws + WS_YS);
    float* KMP = (float*)(ws + WS_KMP); int* LIST = (int*)(ws + WS_LIST); float* RSTDS = (float*)(ws + WS_RSTDS); float* TOPWS = (float*)(ws + WS_TOPWS);

    bf16_t *WmemT = (bf16_t*)(ws + WS_WMEM), *MEMN = (bf16_t*)(ws + WS_MEMN), *MKV = (bf16_t*)(ws + WS_MKV), *WSB = (bf16_t*)(ws + WS_WSB); float* WrT = (float*)(ws + WS_WR);
#if !defined(ONLY) || ONLY == 0
    if (IN(0)) {
        KA_BEGIN();
        P0Args p; p.x = q->in[0]; p.mem = q->in[1]; p.g_mix = q->in[2]; p.g_mem = q->in[9]; p.w_in = q->in[3]; p.w_br0 = q->in[13]; p.w_br1 = q->in[14]; p.w_br2 = q->in[15]; p.w_out = q->in[16];
        p.w_mem_kv = q->in[10]; p.w_gate_up = q->in[20]; p.w_down = q->in[22]; p.g_ffn = q->in[17]; p.w_router = q->in[18]; p.w_spatial = q->in[5];
        p.HB = HB; p.MEMN = MEMN; p.WinT = WinT; p.WbrT = WbrT; p.WoutT = WoutT; p.WmemT = WmemT; p.W1T = W1T; p.W2T = W2T; p.WSB = WSB; p.WrT = WrT;
        p0_prologue(p, lds, G, c);
        if (BOTH(0)) xcd_barrier(bar);
    }
#endif
#if !defined(ONLY) || ONLY == 1
    if (IN(1)) {
        KA_BEGIN();
        pg::PolP1 P; P.A = HB; P.Bt = WinT; P.PROJ = PROJ; P.KMP = KMP; P.gq = q->in[7]; P.gk = q->in[8]; P.G = G; P.c = c;
        pg::gemm_run(lds, P);
        p1_memkv(MEMN, WmemT, q->in[12], MKV, G, c);
        if (BOTH(1)) xcd_barrier(bar);
    }
#endif
#if !defined(ONLY) || ONLY == 2
    if (IN(2)) {
        KA_BEGIN();
        const int wave = __builtin_amdgcn_readfirstlane(tid >> 6), lane = tid & 63;
        const int vcu = (G % 8 == 0) ? (c % 8) * (G / 8) + c / 8 : c;
#if USE_MFMA_ATTN
        for (int u = vcu; u < 256; u += G) at::mem_units(u >> 5, (u >> 3) & 3, (u & 7) * 2, 2, PROJ, MKV, q->in[11], Y, lds);
        for (int u = vcu; u < 256; u += G) { const int bh = u >> 2, s4 = u & 3;
            for (int i = 0; i < 4; ++i) { const int jb = (i == 0) ? 15 - s4 : (i == 1) ? 8 + s4 : (i == 2) ? 7 - s4 : s4; at::moba_unit(bh >> 3, bh & 7, jb, PROJ, KMP, Y, lds); } }
        __syncthreads();
        for (int it = vcu; it < 1024; it += G) p2_sgu_item(it, PROJ, q->in[4], q->in[5], q->in[6], Y, lds);
#else
        for (int it = c; it < 1024; it += G) p2_sgu_item(it, PROJ, q->in[4], q->in[5], q->in[6], Y, lds);
        LAS float* qs = (LAS float*)(lds + wave * 16384); LAS float* ps = qs + 128;
        const int gw = c * NWAVES + wave, NGW = G * NWAVES;
        for (int it = gw; it < T_TOK * 4; it += NGW) p2_mem_item(it, PROJ, MKV, q->in[11], Y, qs, ps, lane);
        for (int it = gw; it < NBATCH * 8 * SEQ; it += NGW) p2_moba_item(it, PROJ, KMP, Y, qs, ps, lane);
#endif
        if (BOTH(2)) xcd_barrier(bar);
    }
#endif
#if !defined(ONLY) || ONLY == 3
    if (IN(3)) {
        KA_BEGIN();
        pg::PolP3 P; P.A = Y; P.Bt = WbrT; P.PROJ = PROJ; P.MERGED = MERGED; P.G = G; P.c = c;
        pg::gemm_run(lds, P);
        if (BOTH(3)) xcd_barrier(bar);
    }
#endif
#if !defined(ONLY) || ONLY == 4
    if (IN(4)) {
        KA_BEGIN();
        pg::PolP4 P; P.A = MERGED; P.Bt = WoutT; P.x = q->in[0]; P.out = q->out; P.X1B = X1B; P.G = G; P.c = c;
        pg::gemm_run(lds, P);
        if (BOTH(4)) xcd_barrier(bar);
    }
#endif
#if !defined(ONLY) || ONLY == 5
    if (IN(5)) {
        KA_BEGIN();
        p5_router(q->out, WrT, q->in[19], LIST, RSTDS, TOPWS, ctl + CW_CNT, G, c);
        if (BOTH(5)) xcd_barrier(bar);
    }
#endif
#if !defined(ONLY) || ONLY == 6
    if (IN(6)) {
        KA_BEGIN();
        grouped_setup((LAS int*)(lds + TAB_OFF), ctl + CW_CNT);
        pg::PolP6 P; P.X1B = X1B; P.W1T = W1T; P.LIST = LIST; P.RSTDS = RSTDS; P.b1 = q->in[21]; P.ACT = ACT; P.tb.tab = (const LAS int*)(lds + TAB_OFF); P.G = G; P.c = c;
        pg::gemm_run(lds, P);
        if (BOTH(6)) xcd_barrier(bar);
    }
#endif
#if !defined(ONLY) || ONLY == 7
    if (IN(7)) {
        KA_BEGIN();
        grouped_setup((LAS int*)(lds + TAB_OFF), ctl + CW_CNT);
        pg::PolP7 P; P.ACT = ACT; P.W2T = W2T; P.LIST = LIST; P.TOPWS = TOPWS; P.b2 = q->in[23]; P.YS = YS; P.tb.tab = (const LAS int*)(lds + TAB_OFF); P.G = G; P.c = c;
        pg::gemm_run(lds, P);
        if (BOTH(7)) xcd_barrier(bar);
    }
#endif
#if !defined(ONLY) || ONLY == 8
    if (IN(8)) { KA_BEGIN(); p8_combine(q->out, YS, G, c); }
#endif
#undef IN
#undef BOTH
}

#ifndef SINGLE_LAUNCH
#define SINGLE_LAUNCH 1
#endif
#ifndef USE_MK_P1
#define USE_MK_P1 1
#define USE_MK_P3 1
#define USE_MK_P4 1
#define USE_MK_P6 1
#define USE_MK_P7 1
#endif
static int g_grid = 0;
static void launch_mk(const MArgs& base, int lo, int hi, hipStream_t stream) {
    MArgs a = base; a.ph_lo = lo; a.ph_hi = hi;
    hipLaunchKernelGGL(mk_fwd, dim3(g_grid), dim3(NWAVES * 64), LDS_BYTES, stream, a);
}
extern "C" void kernel_launch(void* const* d_in, const int* in_sizes, int n_in, void* d_out, int out_size, void* d_ws, size_t ws_size, hipStream_t stream) {
    if (n_in != 24 || ws_size < WS_END) { fprintf(stderr, "kernel_launch: unexpected n_in %d or ws %zu\n", n_in, ws_size); return; }
    if (g_grid == 0) {
        int dev = 0, cus = 0, per_cu = 0;
        (void)hipGetDevice(&dev); (void)hipDeviceGetAttribute(&cus, hipDeviceAttributeMultiprocessorCount, dev);
        if (hipFuncSetAttribute((const void*)mk_fwd, hipFuncAttributeMaxDynamicSharedMemorySize, LDS_BYTES) != hipSuccess) fprintf(stderr, "kernel_launch: hipFuncSetAttribute failed\n");
        if (hipOccupancyMaxActiveBlocksPerMultiprocessor(&per_cu, (const void*)mk_fwd, NWAVES * 64, LDS_BYTES) != hipSuccess || per_cu < 1) fprintf(stderr, "kernel_launch: occupancy query says %d\n", per_cu);
        (void)hipGetLastError();
        g_grid = cus > 0 ? cus : 256;
    }
    const float* x = (const float*)d_in[0];        const float* mem = (const float*)d_in[1];     const float* g_mix = (const float*)d_in[2];
    const float* w_in = (const float*)d_in[3];     const float* g_sgu_v = (const float*)d_in[4]; const float* w_spatial = (const float*)d_in[5];
    const float* b_spatial = (const float*)d_in[6]; const float* g_q_moba = (const float*)d_in[7]; const float* g_k_moba = (const float*)d_in[8];
    const float* g_mem = (const float*)d_in[9];    const float* w_mem_kv = (const float*)d_in[10]; const float* g_q_mem = (const float*)d_in[11];
    const float* g_k_mem = (const float*)d_in[12]; const float* w_br_sgu = (const float*)d_in[13]; const float* w_br_moba = (const float*)d_in[14];
    const float* w_br_mem = (const float*)d_in[15]; const float* w_out = (const float*)d_in[16];  const float* g_ffn = (const float*)d_in[17];
    const float* w_router = (const float*)d_in[18]; const float* b_router = (const float*)d_in[19]; const float* w_gate_up = (const float*)d_in[20];
    const float* b_gate_up = (const float*)d_in[21]; const float* w_down = (const float*)d_in[22]; const float* b_down = (const float*)d_in[23];
    (void)b_gate_up; (void)b_down; (void)g_q_moba; (void)g_k_moba;
    float* out = (float*)d_out; unsigned char* ws = (unsigned char*)d_ws;
    unsigned* ctl = (unsigned*)(ws + WS_CTL);
    bf16_t *WinT = (bf16_t*)(ws + WS_WIN), *WbrT = (bf16_t*)(ws + WS_WBR), *WoutT = (bf16_t*)(ws + WS_WOUT), *WmemT = (bf16_t*)(ws + WS_WMEM);
    float* WrT = (float*)(ws + WS_WR); float* RSTD2 = (float*)(ws + WS_RSTD2); float* KMP = (float*)(ws + WS_KMP); float* TOPW = (float*)(ws + WS_TOPW);
    int* LIST = (int*)(ws + WS_LIST); float* RSTDS = (float*)(ws + WS_RSTDS); float* TOPWS = (float*)(ws + WS_TOPWS);
    bf16_t *MEMN = (bf16_t*)(ws + WS_MEMN), *MKV = (bf16_t*)(ws + WS_MKV), *W1T = (bf16_t*)(ws + WS_W1), *W2T = (bf16_t*)(ws + WS_W2);
    bf16_t *HB = (bf16_t*)(ws + WS_HB), *PROJ = (bf16_t*)(ws + WS_PROJ), *Y = (bf16_t*)(ws + WS_Y);
    bf16_t *YS = (bf16_t*)(ws + WS_YS);
    float* SCR = (float*)(ws + WS_SCR); (void)RSTD2; (void)TOPW; (void)W1T; (void)W2T; (void)WbrT; (void)WoutT;
    MArgs base{}; for (int i = 0; i < 24; ++i) base.in[i] = (const float*)d_in[i]; base.out = out; base.ws = ws;

    (void)hipMemsetAsync(ws + WS_CTL, 0, 1 * MiB, stream);
#if SINGLE_LAUNCH
    launch_mk(base, 0, 9, stream);
    return;
#endif
    n_rmsnorm_rows<<<T_TOK / 4, 256, 0, stream>>>(x, g_mix, HB, T_TOK);
    n_rmsnorm_rows<<<NBATCH * MEML / 4, 256, 0, stream>>>(mem, g_mem, MEMN, NBATCH * MEML);
    n_transpose<MapWin><<<dim3(INW / 32, DM / 32, 1), 256, 0, stream>>>(w_in, DM, INW, WinT, DM, 0, nullptr, 0, 0);
    n_transpose<MapId><<<dim3(DM / 32, 512 / 32, 1), 256, 0, stream>>>(w_br_sgu, 512, DM, WbrT, 1536, 0, nullptr, 0, 0);
    n_transpose<MapId><<<dim3(DM / 32, 512 / 32, 1), 256, 0, stream>>>(w_br_moba, 512, DM, WbrT, 1536, 512, nullptr, 0, 0);
    n_transpose<MapId><<<dim3(DM / 32, 512 / 32, 1), 256, 0, stream>>>(w_br_mem, 512, DM, WbrT, 1536, 1024, nullptr, 0, 0);
    n_transpose<MapId><<<dim3(DM / 32, DM / 32, 1), 256, 0, stream>>>(w_out, DM, DM, WoutT, DM, 0, nullptr, 0, 0);
    n_transpose<MapId><<<dim3(DM / 32, DM / 32, 1), 256, 0, stream>>>(w_mem_kv, DM, DM, WmemT, DM, 0, nullptr, 0, 0);
    n_transpose<MapW1><<<dim3(2048 / 32, DM / 32, NEXP), 256, 0, stream>>>(w_gate_up, DM, 2048, W1T, DM, 0, g_ffn, (size_t)DM * 2048, (size_t)2048 * DM);
    n_transpose<MapId><<<dim3(DM / 32, DFF / 32, NEXP), 256, 0, stream>>>(w_down, DFF, DM, W2T, DFF, 0, nullptr, (size_t)DFF * DM, (size_t)DM * DFF);
    n_router_w<<<128, 256, 0, stream>>>(w_router, g_ffn, WrT);
#if USE_MK_P1
    launch_mk(base, 1, 2, stream);
#else
    { EpiProj E{}; E.P = PROJ; n_gemm<EpiProj, false><<<dim3(INW / 64, T_TOK / 64, 1), 256, 0, stream>>>(HB, DM, WinT, DM, DM, E); }
    n_norm_heads64<<<T_TOK * 8 / 4, 256, 0, stream>>>(PROJ, OFF_QB, g_q_moba);
    n_norm_heads64<<<T_TOK * 8 / 4, 256, 0, stream>>>(PROJ, OFF_KB, g_k_moba);
    n_kmean<<<NBATCH * 16, 512, 0, stream>>>(PROJ, KMP);
#endif
    { EpiF32 E{}; E.C = SCR; E.ldc = 1024; E.pad = 0; n_gemm<EpiF32, false><<<dim3(1024 / 64, 2048 / 64, 1), 256, 0, stream>>>(MEMN, DM, WmemT, DM, DM, E); }
    n_memkv_norm<<<2048 * 4 / 4, 256, 0, stream>>>(SCR, g_k_mem, MKV);
    n_sgu_prep<<<T_TOK / 4, 256, 0, stream>>>(PROJ, g_sgu_v, SCR);
    n_sgu<<<T_TOK * 512 / 256, 256, 0, stream>>>(PROJ, SCR, w_spatial, b_spatial, Y);
    n_moba<<<NBATCH * 8 * SEQ, 64, 0, stream>>>(PROJ, KMP, Y);
    n_memattn<<<T_TOK * 4, 64, 0, stream>>>(PROJ, MKV, g_q_mem, Y);
#if USE_MK_P3
    launch_mk(base, 3, 4, stream);
#else
    n_merged<<<dim3(DM / 64, T_TOK / 64), 256, 0, stream>>>(Y, WbrT, PROJ, (bf16_t*)(ws + WS_MERGED));
#endif
#if USE_MK_P4
    launch_mk(base, 4, 5, stream);
#else
    { EpiX1 E{}; E.x = x; E.out = out; E.x1b = (bf16_t*)(ws + WS_X1B); n_gemm<EpiX1, false><<<dim3(DM / 64, T_TOK / 64, 1), 256, 0, stream>>>((bf16_t*)(ws + WS_MERGED), DM, WoutT, DM, DM, E); }
#endif
    n_router<<<T_TOK / 8, 256, 0, stream>>>(out, WrT, b_router, RSTD2, TOPW, LIST, RSTDS, TOPWS, ctl + CW_CNT);
#if USE_MK_P6
    launch_mk(base, 6, 7, stream);
#else
    { EpiExp1 E{}; E.cnt = ctl + CW_CNT; E.LIST = LIST; E.RSTD2 = RSTD2; E.b1 = b_gate_up; E.ACT = (bf16_t*)(ws + WS_ACT);
      n_gemm<EpiExp1, true><<<dim3(DFF / 64, T_TOK / 64, NEXP), 256, 0, stream>>>((bf16_t*)(ws + WS_X1B), DM, W1T, DM, DM, E); }
#endif
#if USE_MK_P7
    launch_mk(base, 7, 8, stream);
#else
    { EpiExp2 E{}; E.cnt = ctl + CW_CNT; E.LIST = LIST; E.TOPW = TOPW; E.b2 = b_down; E.YS = YS;
      n_gemm<EpiExp2, false><<<dim3(DM / 64, T_TOK / 64, NEXP), 256, 0, stream>>>((bf16_t*)(ws + WS_ACT), DFF, W2T, DFF, DFF, E); }
#endif
    n_combine<<<T_TOK * DM / 256, 256, 0, stream>>>(out, YS);
}
```

```cpp
#include <hip/hip_runtime.h>
#include <stdint.h>
#include <cstdio>
#ifndef DUP_P2
#define DUP_P2 0
#endif
#ifndef DUP_PHASE
#define DUP_PHASE -1
#endif

typedef unsigned short bf16_t;
typedef short bf16x8 __attribute__((ext_vector_type(8)));
typedef float f32x4 __attribute__((ext_vector_type(4)));
typedef unsigned u32x4 __attribute__((ext_vector_type(4)));
typedef int i32x8 __attribute__((ext_vector_type(8)));
typedef int i32x4 __attribute__((ext_vector_type(4)));

constexpr int NBATCH = 8, SEQ = 4096, DM = 1024, T_TOK = NBATCH * SEQ, INW = 6144, MEML = 256;
constexpr int OFF_U = 0, OFF_V = 512, OFF_QB = 1024, OFF_KB = 1536, OFF_VB = 2048, OFF_QM = 2560, OFF_G = 3072;
constexpr int NEXP = 32, TOPK = 4, DFF = 1024;
constexpr float EPS = 1e-6f;
constexpr int ACT_ROWS = T_TOK * TOPK + NEXP * 256;

constexpr size_t MiB = 1ull << 20;
constexpr size_t WS_CTL = 0;
constexpr size_t WS_WIN = 1 * MiB;
constexpr size_t WS_WBR = 13 * MiB;
constexpr size_t WS_WOUT = 16 * MiB;
constexpr size_t WS_WMEM = 18 * MiB;
constexpr size_t WS_WR = 20 * MiB;
constexpr size_t WS_RSTD2 = 21 * MiB;
constexpr size_t WS_WSB = 21 * MiB + 256 * 1024;
constexpr size_t WS_KMP = 22 * MiB;
constexpr size_t WS_TOPW = 23 * MiB;
constexpr size_t WS_LIST = 24 * MiB;
constexpr size_t WS_RSTDS = 28 * MiB;
constexpr size_t WS_TOPWS = 32 * MiB;
constexpr size_t WS_MEMN = 36 * MiB;
constexpr size_t WS_MKV = 40 * MiB;
constexpr size_t WS_W1 = 44 * MiB;
constexpr size_t WS_W2 = 172 * MiB;
constexpr size_t WS_MERGED = 236 * MiB;
constexpr size_t WS_X1B = 300 * MiB;
constexpr size_t WS_HB = 364 * MiB;
constexpr size_t WS_PROJ = 428 * MiB;
constexpr size_t WS_Y = 812 * MiB;
constexpr size_t WS_ACT = 364 * MiB;
constexpr size_t WS_YS = 636 * MiB;
constexpr size_t WS_X1H = 500 * MiB;
constexpr size_t WS_HBQ = 908 * MiB;
constexpr size_t WS_WINQ = 944 * MiB;
constexpr size_t WS_SCR = 960 * MiB;
constexpr size_t WS_END = 1024 * MiB;
constexpr int CW_CNT = 64;
constexpr int CW_DIAG = 128;

__device__ __forceinline__ float bf2f(bf16_t b) { return __uint_as_float(((unsigned)b) << 16); }
__device__ __forceinline__ bf16_t f2bf(float f) { unsigned u = __float_as_uint(f); u += 0x7fffu + ((u >> 16) & 1u); return (bf16_t)(u >> 16); }
__device__ __forceinline__ float wave_sum(float v) {
#pragma unroll
    for (int o = 1; o < 64; o <<= 1) v += __shfl_xor(v, o);
    return v;
}
__device__ __forceinline__ float wave_max(float v) {
#pragma unroll
    for (int o = 1; o < 64; o <<= 1) v = fmaxf(v, __shfl_xor(v, o));
    return v;
}
__device__ __forceinline__ float gelu_exact(float v) { return 0.5f * v * (1.0f + erff(v * 0.70710678118654752f)); }
__device__ __forceinline__ float sigmoidf_(float v) { return 1.0f / (1.0f + __expf(-v)); }

#define LAS __attribute__((address_space(3)))
typedef float f32x2 __attribute__((ext_vector_type(2)));
constexpr int NWAVES = 8;
constexpr int RING_BYTES = 131072;
constexpr int LDSCTL_OFF = RING_BYTES;
constexpr int TAB_OFF = RING_BYTES + 64;
constexpr int TAB_CNT = 0, TAB_TST = 32, TAB_TE = 96, TAB_WORDS = 96 + 576;
constexpr int RTAB_OFF = RING_BYTES + 8192;
constexpr int RT_STRIDE = 4096;
constexpr int LDS_BYTES = 147456;
static_assert(TAB_OFF + TAB_WORDS * 4 <= LDS_BYTES && RTAB_OFF + 2 * RT_STRIDE <= LDS_BYTES, "LDS map");
constexpr int CW_BAR = 4096;

#define XB_TMO      128
#define XB_XCNT(j)  (256  + 64 * (j))
#define XB_XSUB(j)  (1280 + 64 * (j))
#define XB_XGEN(j)  (2304 + 64 * (j))
#define XB_TOP      3328
#define XB_TOPGEN   3392
#define XCD_BAR_WORDS 3456
#define XB_SPIN_CAP (1u << 18)
__device__ __forceinline__ unsigned xb_ld(unsigned* p)              { return __hip_atomic_load(p, __ATOMIC_RELAXED, __HIP_MEMORY_SCOPE_AGENT); }
__device__ __forceinline__ unsigned xb_add(unsigned* p, unsigned v) { return __hip_atomic_fetch_add(p, v, __ATOMIC_RELAXED, __HIP_MEMORY_SCOPE_AGENT); }
__device__ __forceinline__ unsigned xb_xcc_id() { return (unsigned)__builtin_amdgcn_s_getreg((3 << 11) | 20) & 0xFu; }
#define XB_SPIN(cond, bar) do { unsigned _sp = 0; while (cond) { __builtin_amdgcn_s_sleep(1); \
    if ((++_sp & 255u) == 0u) { if (xb_ld(&(bar)[XB_TMO])) break; if (_sp > XB_SPIN_CAP) { atomicAdd(&(bar)[XB_TMO], 1u); break; } } } } while (0)
struct XcdBarrier { unsigned* bar; unsigned x; volatile LAS unsigned* st; };
__device__ __forceinline__ XcdBarrier xcd_barrier_post(unsigned* bar, volatile LAS unsigned* st) {
    XcdBarrier b; b.bar = bar; b.x = xb_xcc_id(); b.st = st;
    if (threadIdx.x == 0) (void)xb_add(&bar[XB_XCNT(b.x)], 1u);
    return b;
}
__device__ __forceinline__ void xcd_barrier_complete(unsigned* bar, unsigned x, unsigned& nloc, unsigned& nx) {
    const unsigned G = gridDim.x * gridDim.y * gridDim.z;
    unsigned sum, cnt, mine, sp = 0u;
    for (;;) {
        sum = 0u; cnt = 0u; mine = 0u;
#pragma unroll
        for (unsigned j = 0; j < 16; ++j) { const unsigned c = xb_ld(&bar[XB_XCNT(j)]); sum += c; cnt += (c > 0u) ? 1u : 0u; mine = (j == x) ? c : mine; }
        if (sum == G) break;
        __builtin_amdgcn_s_sleep(1);
        if ((++sp & 255u) == 0u) { if (xb_ld(&bar[XB_TMO])) break; if (sp > XB_SPIN_CAP) { atomicAdd(&bar[XB_TMO], 1u); break; } }
    }
    nloc = mine > 0u ? mine : 1u; nx = cnt > 0u ? cnt : 1u;
}
__device__ __forceinline__ void xcd_barrier(const XcdBarrier& b) {
    asm volatile("s_waitcnt vmcnt(0)" ::: "memory");
    __syncthreads();
    if (threadIdx.x == 0) {
        unsigned* bar = b.bar;
        __builtin_amdgcn_s_waitcnt(0);
        unsigned nloc = b.st[0], nx = b.st[1];
        if (nloc == 0u) { xcd_barrier_complete(bar, b.x, nloc, nx); b.st[0] = nloc; b.st[1] = nx; }
        const unsigned old = xb_add(&bar[XB_XSUB(b.x)], 1u);
        const unsigned gen = old / nloc;
        if (old + 1u == (gen + 1u) * nloc) {
            __builtin_amdgcn_fence(__ATOMIC_RELEASE, "agent");
            asm volatile("s_waitcnt vmcnt(0)" ::: "memory");
            const unsigned og = xb_add(&bar[XB_TOP], 1u);
            const unsigned tg = og / nx;
            if (og + 1u == (tg + 1u) * nx) xb_add(&bar[XB_TOPGEN], 1u);
            else XB_SPIN(xb_ld(&bar[XB_TOPGEN]) == tg, bar);
            __builtin_amdgcn_fence(__ATOMIC_ACQUIRE, "agent");
            xb_add(&bar[XB_XGEN(b.x)], 1u);
            asm volatile("s_waitcnt vmcnt(0)" ::: "memory");
        } else {
            XB_SPIN(xb_ld(&bar[XB_XGEN(b.x)]) == gen, bar);
            __builtin_amdgcn_fence(__ATOMIC_ACQUIRE, "agent");
            asm volatile("s_waitcnt vmcnt(0)" ::: "memory");
        }
    }
    __syncthreads();
}

#ifndef PG_ALIGN
#define PG_ALIGN true
#endif
namespace pg {
constexpr int BM = 256, BK = 64, HALF = 128, HTB = HALF * BK * 2, STAGE_BYTES = 8 * HTB, NXCD = 8, WGM = 8;
__host__ __device__ __forceinline__ int lds_byte(int r, int c) { const int st = (r >> 4) * 2 + (c >> 5), rr = r & 15, cc = c & 31, ob = rr * 64 + cc * 2; return st * 1024 + (ob ^ (((ob >> 9) & 1) << 5)); }
__host__ __device__ __forceinline__ void stage_rc(int b, int& R, int& C) { const int st = b / 1024, sb = b % 1024, swz = sb ^ (((sb >> 9) & 1) << 5); R = (st >> 1) * 16 + swz / 64; C = (st & 1) * 32 + (swz % 64) / 2; }
__host__ __device__ __forceinline__ int perm32(int rho) { const int n = rho >> 4, i = rho & 15; return 8 * (i >> 2) + 4 * n + (i & 3); }
struct Unit { int pm, pn, e, mt; };
__device__ __forceinline__ bool static_unit(long L, int nM, int nN, int& pm, int& pn) {
    const int nwg = nM * nN; if (L >= nwg) return false;
    int wgid = (int)L; { const int q = nwg / NXCD, r = nwg % NXCD, xcd = wgid % NXCD, off = wgid / NXCD; wgid = (xcd < r ? xcd * (q + 1) : r * (q + 1) + (xcd - r) * q) + off; }
    const int nig = WGM * nN, gid = wgid / nig, fm = gid * WGM, gsz = (nM - fm) < WGM ? (nM - fm) : WGM;
    pm = fm + ((wgid % nig) % gsz); pn = (wgid % nig) / gsz; return true;
}
typedef __bf16 bf16x2_hw __attribute__((ext_vector_type(2)));
__device__ __forceinline__ unsigned cvt_pk_bf16(float lo, float hi) { const bf16x2_hw b = __builtin_convertvector((f32x2){lo, hi}, bf16x2_hw); return __builtin_bit_cast(unsigned, b); }
__device__ __forceinline__ u32x4 pack8(const f32x4 v0, const f32x4 v1) { u32x4 w; w.x = cvt_pk_bf16(v0[0], v0[1]); w.y = cvt_pk_bf16(v0[2], v0[3]); w.z = cvt_pk_bf16(v1[0], v1[1]); w.w = cvt_pk_bf16(v1[2], v1[3]); return w; }
constexpr float YQ_SCALE = 32.0f, YQ_INV = 1.0f / 32.0f;
constexpr float WQ_SCALE = 64.0f, WQ_INV = 1.0f / 64.0f;
__device__ __forceinline__ uint2 pack8_fp8(const f32x4 v0, const f32x4 v1) { int a = 0, b = 0;
    a = __builtin_amdgcn_cvt_pk_fp8_f32(v0[0], v0[1], a, false); a = __builtin_amdgcn_cvt_pk_fp8_f32(v0[2], v0[3], a, true);
    b = __builtin_amdgcn_cvt_pk_fp8_f32(v1[0], v1[1], b, false); b = __builtin_amdgcn_cvt_pk_fp8_f32(v1[2], v1[3], b, true); return make_uint2((unsigned)a, (unsigned)b); }
#ifndef EPI_NT
#define EPI_NT 0
#endif
__device__ __forceinline__ void st16(void* p, const u32x4 v) { if (EPI_NT) __builtin_nontemporal_store(v, (u32x4*)p); else *(u32x4*)p = v; }
__device__ __forceinline__ void st16f(void* p, const f32x4 v) { if (EPI_NT) __builtin_nontemporal_store(v, (f32x4*)p); else *(f32x4*)p = v; }
__device__ __forceinline__ void st8(void* p, const uint2 v) { typedef unsigned u32x2 __attribute__((ext_vector_type(2))); const u32x2 w = {v.x, v.y}; if (EPI_NT) __builtin_nontemporal_store(w, (u32x2*)p); else *(u32x2*)p = w; }
__device__ __forceinline__ void unpack8(const u32x4 w, f32x4& v0, f32x4& v1) {
    v0[0] = __uint_as_float(w.x << 16); v0[1] = __uint_as_float(w.x & 0xffff0000u); v0[2] = __uint_as_float(w.y << 16); v0[3] = __uint_as_float(w.y & 0xffff0000u);
    v1[0] = __uint_as_float(w.z << 16); v1[1] = __uint_as_float(w.z & 0xffff0000u); v1[2] = __uint_as_float(w.w << 16); v1[3] = __uint_as_float(w.w & 0xffff0000u); }
__device__ __forceinline__ f32x2 gelu_pk(f32x2 v) {
    const f32x2 av = __builtin_elementwise_abs(v), d = av * 0.2316418882f + 1.0f;
    f32x2 t; t.x = __builtin_amdgcn_rcpf(d.x); t.y = __builtin_amdgcn_rcpf(d.y);
    f32x2 q = t * 0.5307027145f + (-0.7265760135f); q = q * t + 0.7107068705f; q = q * t + (-0.142248368f); q = q * t + 0.127414796f; q = q * t;
    const f32x2 s = (v * v) * (-0.72134752044f);
    f32x2 e; e.x = __builtin_amdgcn_exp2f(s.x); e.y = __builtin_amdgcn_exp2f(s.y);
    const f32x2 m = v * (q * e), r = v - m;
    f32x2 o; o.x = v.x < 0.f ? m.x : r.x; o.y = v.y < 0.f ? m.y : r.y; return o;
}
__device__ __forceinline__ f32x4 gelu4(f32x4 v) { const f32x2 a = gelu_pk((f32x2){v[0], v[1]}), b = gelu_pk((f32x2){v[2], v[3]}); return (f32x4){a.x, a.y, b.x, b.y}; }
__device__ __forceinline__ float sigm(float v) { return __builtin_amdgcn_rcpf(1.0f + __builtin_amdgcn_exp2f(v * -1.4426950408889634f)); }
__device__ __forceinline__ f32x4 sigm4(f32x4 v) { return (f32x4){sigm(v[0]), sigm(v[1]), sigm(v[2]), sigm(v[3])}; }

template <class Pol>
__device__ __forceinline__ void gemm_run(LAS unsigned char* lds, const Pol& P) {
    constexpr int KB = Pol::FP8 ? Pol::K : Pol::K * 2, nt = KB / (BK * 2);
    const int tid = threadIdx.x, wid = __builtin_amdgcn_readfirstlane(tid >> 6), lane = tid & 63, wr = wid >> 2, wc = wid & 3, fr = lane & 15, fq = lane >> 4;
    unsigned voffA[2], voffB[2]; int Rr[2], Cc[2];
#pragma unroll
    for (int i = 0; i < 2; ++i) { int R, C; stage_rc(tid * 16 + i * 8192, R, C); Rr[i] = R; Cc[i] = C; const int Rb = (R & ~31) + perm32(R & 31);
        voffA[i] = (unsigned)(R * KB + C * 2); voffB[i] = (unsigned)(Rb * KB + C * 2); }
    constexpr unsigned kstep = BK * 2, hstep = HALF * KB;
    const unsigned ldsw = (unsigned)wid * 1024u;
    const int aoff = lds_byte(wr * 64 + fr, fq * (Pol::FP8 ? 16 : 8)), boff = lds_byte(wc * 32 + fr, fq * (Pol::FP8 ? 16 : 8));
#define PG_SA(b, h) (((b) * 2 + (h)) * HTB)
#define PG_SB(b, h) ((4 + (b) * 2 + (h)) * HTB)
#define PG_AOFF(nx, h, i) (Pol::GATHER ? gC[h][i] : (voffA[i] + (unsigned)(h) * hstep))
#define PG_STAGE_A(bufoff, gbase, nx, h) do { _Pragma("unroll") for (int _i = 0; _i < 2; ++_i) \
        __builtin_amdgcn_global_load_lds((const unsigned*)((const char*)(gbase) + PG_AOFF(nx, h, _i)), (LAS unsigned*)(lds + (bufoff) + ldsw + _i * 8192), 16, 0, 0); } while (0)
#define PG_STAGE_B(bufoff, gbase) do { _Pragma("unroll") for (int _i = 0; _i < 2; ++_i) \
        __builtin_amdgcn_global_load_lds((const unsigned*)((const char*)(gbase) + voffB[_i]), (LAS unsigned*)(lds + (bufoff) + ldsw + _i * 8192), 16, 0, 0); } while (0)
#define PG_LD32(p) ({ const i32x4 _lo = *(const LAS i32x4*)(p), _hi = *(const LAS i32x4*)((p) + 16); (i32x8){_lo[0], _lo[1], _lo[2], _lo[3], _hi[0], _hi[1], _hi[2], _hi[3]}; })
#define PG_LDA(dst, b, h) do { if constexpr (Pol::FP8) { _Pragma("unroll") for (int m = 0; m < 4; ++m) dst##_8[m] = PG_LD32(lds + PG_SA(b, h) + aoff + m * 2048); } \
        else { _Pragma("unroll") for (int m = 0; m < 4; ++m) _Pragma("unroll") for (int k = 0; k < 2; ++k) dst[m][k] = *(const LAS bf16x8*)(lds + PG_SA(b, h) + aoff + m * 2048 + k * 1024); } } while (0)
#define PG_LDB(dst, b, h) do { if constexpr (Pol::FP8) { _Pragma("unroll") for (int n = 0; n < 2; ++n) dst##_8[n] = PG_LD32(lds + PG_SB(b, h) + boff + n * 2048); } \
        else { _Pragma("unroll") for (int n = 0; n < 2; ++n) _Pragma("unroll") for (int k = 0; k < 2; ++k) dst[n][k] = *(const LAS bf16x8*)(lds + PG_SB(b, h) + boff + n * 2048 + k * 1024); } } while (0)
#define PG_MMA(ai, bj, At, Bt) do { __builtin_amdgcn_s_setprio(1); \
        if constexpr (Pol::FP8) { _Pragma("unroll") for (int m = 0; m < 4; ++m) _Pragma("unroll") for (int n = 0; n < 2; ++n) \
            acc[ai][bj][m][n] = __builtin_amdgcn_mfma_scale_f32_16x16x128_f8f6f4(Bt##_8[n], At##_8[m], acc[ai][bj][m][n], 0, 0, 0, 0x7F7F7F7F, 0, 0x7F7F7F7F); } \
        else { _Pragma("unroll") for (int m = 0; m < 4; ++m) _Pragma("unroll") for (int n = 0; n < 2; ++n) _Pragma("unroll") for (int k = 0; k < 2; ++k) \
            acc[ai][bj][m][n] = __builtin_amdgcn_mfma_f32_16x16x32_bf16(Bt[n][k], At[m][k], acc[ai][bj][m][n], 0, 0, 0); } \
        __builtin_amdgcn_s_setprio(0); } while (0)
#define PG_WAIT_V(n) asm volatile("s_waitcnt vmcnt(" #n ")" ::: "memory")
#define PG_WAIT_L(n) asm volatile("s_waitcnt lgkmcnt(" #n ")" ::: "memory")
#define PG_BAR __builtin_amdgcn_s_barrier()
#define PG_SCHED __builtin_amdgcn_sched_barrier(0)
    Unit cur, nxt; int ui = 0;
    if (!P.next(0, cur)) return;
    f32x4 acc[2][2][4][2];
#pragma unroll
    for (int a = 0; a < 2; ++a)
#pragma unroll
        for (int b = 0; b < 2; ++b)
#pragma unroll
            for (int m = 0; m < 4; ++m)
#pragma unroll
                for (int n = 0; n < 2; ++n) acc[a][b][m][n] = (f32x4){0.f, 0.f, 0.f, 0.f};
    bf16x8 At[4][2], B0[2][2], B1[2][2];
    i32x8 At_8[4], B0_8[2], B1_8[2];
    unsigned gC[2][2] = {{0u, 0u}, {0u, 0u}};
    const char* cA = P.a_base(cur); const char* cB = P.b_base(cur);
    if constexpr (Pol::ROWTAB) { P.tab_issue(cur, 0); asm volatile("s_waitcnt vmcnt(0)" ::: "memory"); __builtin_amdgcn_s_barrier(); asm volatile("" ::: "memory"); }
    if constexpr (Pol::GATHER) P.a_offsets(cur, Rr, Cc, gC, 0);
    PG_STAGE_B(PG_SB(0, 0), cB); PG_STAGE_B(PG_SB(0, 1), cB + hstep); PG_STAGE_A(PG_SA(0, 0), cA, false, 0); PG_STAGE_A(PG_SA(0, 1), cA, false, 1);
    if (wr == 1) PG_BAR;
    PG_WAIT_V(2); PG_BAR;
    PG_STAGE_B(PG_SB(1, 0), cB + kstep); PG_STAGE_A(PG_SA(1, 0), cA + kstep, false, 0); PG_STAGE_B(PG_SB(1, 1), cB + hstep + kstep);
    PG_WAIT_V(6); PG_BAR;
    for (;;) {
        const bool has_next = P.next(ui + 1, nxt);
        const char* nA = has_next ? P.a_base(nxt) : cA; const char* nB = has_next ? P.b_base(nxt) : cB;
#pragma nounroll
        for (int t = 0; t < nt; t += 2) {
            const bool last = (t == nt - 2);
            if constexpr (Pol::ROWTAB) { if (t == 2 && has_next) P.tab_issue(nxt, (ui + 1) & 1); }
            if constexpr (Pol::HOOK) { if (t == Pol::H1 || t == Pol::H2) P.khook(t, acc, cur, wr, wc, fr, fq); }
            const char* a1 = cA + (size_t)(t + 1) * kstep;
            const char* a2 = last ? nA : cA + (size_t)(t + 2) * kstep; const char* b2 = last ? nB : cB + (size_t)(t + 2) * kstep;
            const char* a3 = a2 + kstep; const char* b3 = b2 + kstep;
            PG_LDB(B0, 0, 0); PG_LDB(B1, 0, 1); PG_SCHED; PG_LDA(At, 0, 0); PG_STAGE_A(PG_SA(1, 1), a1, false, 1);
            if constexpr (Pol::GATHER) { if (last && has_next) P.a_offsets(nxt, Rr, Cc, gC, (ui + 1) & 1); }
            PG_WAIT_V(8); PG_WAIT_L(0); PG_BAR; PG_MMA(0, 0, At, B0); PG_MMA(0, 1, At, B1); PG_BAR; PG_SCHED;
            PG_LDA(At, 0, 1); PG_STAGE_B(PG_SB(0, 0), b2); PG_STAGE_B(PG_SB(0, 1), b2 + hstep); PG_STAGE_A(PG_SA(0, 0), a2, last, 0);
            PG_WAIT_V(8); PG_WAIT_L(0); PG_BAR; PG_MMA(1, 0, At, B0); PG_MMA(1, 1, At, B1); PG_BAR; PG_SCHED;
            PG_LDB(B0, 1, 0); PG_LDB(B1, 1, 1); PG_SCHED; PG_LDA(At, 1, 0); PG_STAGE_A(PG_SA(0, 1), a2, last, 1);
            PG_WAIT_V(8); PG_WAIT_L(0); PG_BAR; PG_MMA(0, 0, At, B0); PG_MMA(0, 1, At, B1); PG_BAR; PG_SCHED;
            PG_LDA(At, 1, 1); PG_STAGE_B(PG_SB(1, 0), b3); PG_STAGE_B(PG_SB(1, 1), b3 + hstep); PG_STAGE_A(PG_SA(1, 0), a3, last, 0);
            PG_WAIT_V(8); PG_WAIT_L(0); PG_BAR; PG_MMA(1, 0, At, B0); PG_MMA(1, 1, At, B1); PG_BAR; PG_SCHED;
        }
        if constexpr (PG_ALIGN) { if (wr == 0) PG_BAR; }
        P.epi(acc, cur, wr, wc, fr, fq, ui & 1);
#ifdef DUP_EPI
        if (Pol::K == DUP_EPI_K) { asm volatile("" ::: "memory"); P.epi(acc, cur, wr, wc, fr, fq, ui & 1); }
#endif
        if (!has_next) break;
#pragma unroll
        for (int a = 0; a < 2; ++a)
#pragma unroll
            for (int b = 0; b < 2; ++b)
#pragma unroll
                for (int m = 0; m < 4; ++m)
#pragma unroll
                    for (int n = 0; n < 2; ++n) acc[a][b][m][n] = (f32x4){0.f, 0.f, 0.f, 0.f};
        cur = nxt; cA = nA; cB = nB; ++ui;
        if constexpr (PG_ALIGN) { if (wr == 1) PG_BAR; }
    }
    PG_WAIT_V(0);
    if constexpr (!PG_ALIGN) { if (wr == 0) PG_BAR; }
    PG_BAR;
#undef PG_SA
#undef PG_SB
#undef PG_AOFF
#undef PG_STAGE_A
#undef PG_STAGE_B
#undef PG_LDA
#undef PG_LD32
#undef PG_LDB
#undef PG_MMA
#undef PG_WAIT_V
#undef PG_WAIT_L
#undef PG_BAR
#undef PG_SCHED
}

__device__ __forceinline__ void glds4_asm(const void* gsrc, unsigned lds_dst) { unsigned keep;
    asm volatile("s_mov_b32 %0, m0\n\ts_mov_b32 m0, %2\n\ts_nop 0\n\tglobal_load_lds_dword %1, off\n\ts_mov_b32 m0, %0" : "=&s"(keep) : "v"(gsrc), "s"(lds_dst) : "memory"); }
__device__ __forceinline__ void glds16_asm(const void* gsrc, unsigned lds_dst) { unsigned keep;
    asm volatile("s_mov_b32 %0, m0\n\ts_mov_b32 m0, %2\n\ts_nop 0\n\tglobal_load_lds_dwordx4 %1, off\n\ts_mov_b32 m0, %0" : "=&s"(keep) : "v"(gsrc), "s"(lds_dst) : "memory"); }
struct PolBase { static constexpr bool GATHER = false, HOOK = false, FP8 = false, ROWTAB = false;
    __device__ __forceinline__ void tab_issue(const Unit&, int) const {} static constexpr int H1 = -1, H2 = -1;
    __device__ __forceinline__ void a_offsets(const Unit&, const int (&)[2], const int (&)[2], unsigned (&)[2][2], int) const {}
    __device__ __forceinline__ void khook(int, f32x4 (&)[2][2][4][2], const Unit&, int, int, int, int) const {} };

constexpr int GQ_OFF = OFF_G * 2;
__device__ __forceinline__ void gq_unpack(const uint2 w, f32x4& g0, f32x4& g1) {
    g0 = (f32x4){(float)(w.x & 0xffu), (float)((w.x >> 8) & 0xffu), (float)((w.x >> 16) & 0xffu), (float)(w.x >> 24)} * (1.0f / 256.0f) + (0.5f / 256.0f);
    g1 = (f32x4){(float)(w.y & 0xffu), (float)((w.y >> 8) & 0xffu), (float)((w.y >> 16) & 0xffu), (float)(w.y >> 24)} * (1.0f / 256.0f) + (0.5f / 256.0f); }
#ifndef P1_FP8_TILES
#define P1_FP8_TILES 0xFFFF0Cu
#endif
static_assert((P1_FP8_TILES & 0xF0u) == 0u, "the q_b / k_b tiles (head rmsnorm, block selection) stay bf16");
static_assert((P1_FP8_TILES & 0xFFF000u) == 0xFFF000u, "the gate tiles are written (as 8-bit codes) by the fp8 policy only");
static_assert((P1_FP8_TILES | 0xFFu) == 0xFFFFFFu, "bf16 weight rows are only prepared for column tiles 0..7");
constexpr int p1_popc(unsigned m) { int n = 0; for (int t = 0; t < 24; ++t) n += (m >> t) & 1u; return n; }
constexpr int P1_NF8 = p1_popc(P1_FP8_TILES), P1_NBF = 24 - P1_NF8;
__device__ __forceinline__ int p1_tile(unsigned mask, int j) { int t = 0;
    for (; t < 24; ++t) if ((mask >> t) & 1u) { if (j == 0) break; --j; }
    return t; }
struct PolP1 : PolBase {
    static constexpr int K = 1024;
    const bf16_t* A; const bf16_t* Bt; bf16_t* PROJ; float* KMP; const float* gq; const float* gk; int G, c;
    __device__ __forceinline__ bool next(int i, Unit& u) const { u.e = 0; u.mt = 0; if (!static_unit((long)i * G + c, T_TOK / 256, P1_NBF, u.pm, u.pn)) return false; u.pn = p1_tile(P1_FP8_TILES ^ 0xFFFFFFu, u.pn); return true; }
    __device__ __forceinline__ const char* a_base(const Unit& u) const { return (const char*)A + (size_t)u.pm * 256 * K * 2; }
    __device__ __forceinline__ const char* b_base(const Unit& u) const { return (const char*)Bt + (size_t)u.pn * 256 * K * 2; }
    __device__ __forceinline__ void epi(const f32x4 (&acc)[2][2][4][2], const Unit& u, int wr, int wc, int fr, int fq, int) const {
        const int row0 = u.pm * 256 + wr * 64 + fr, pn = u.pn;
        if (pn >= 4 && pn < 8) {
            const float* g = (pn < 6) ? gq : gk;
            f32x4 gv[2][2], cs[2][2];
#pragma unroll
            for (int bj = 0; bj < 2; ++bj)
#pragma unroll
                for (int n = 0; n < 2; ++n) { gv[bj][n] = *(const f32x4*)(g + 32 * bj + 8 * fq + 4 * n); cs[bj][n] = (f32x4){0.f, 0.f, 0.f, 0.f}; }
#pragma unroll
            for (int ai = 0; ai < 2; ++ai)
#pragma unroll
                for (int m = 0; m < 4; ++m) {
                    float ss = 0.f;
#pragma unroll
                    for (int bj = 0; bj < 2; ++bj)
#pragma unroll
                        for (int n = 0; n < 2; ++n) { const f32x4 x = acc[ai][bj][m][n]; ss += (x[0] * x[0] + x[1] * x[1]) + (x[2] * x[2] + x[3] * x[3]); }
                    ss += __shfl_xor(ss, 16); ss += __shfl_xor(ss, 32);
                    const float rstd = rsqrtf(ss * (1.0f / 64.0f) + EPS) * ((pn < 6) ? 0.18033688011112042f : 1.0f);
                    bf16_t* rowp = PROJ + (size_t)(row0 + ai * HALF + m * 16) * INW + 1024 + (pn - 4) * 256 + 64 * wc + 8 * fq;
#pragma unroll
                    for (int bj = 0; bj < 2; ++bj) { const f32x4 v0 = acc[ai][bj][m][0] * rstd * gv[bj][0], v1 = acc[ai][bj][m][1] * rstd * gv[bj][1];
                        cs[bj][0] += v0; cs[bj][1] += v1; st16(rowp + 32 * bj, pack8(v0, v1)); }
                }
            if (pn >= 6) {
#pragma unroll
                for (int bj = 0; bj < 2; ++bj)
#pragma unroll
                    for (int n = 0; n < 2; ++n)
#pragma unroll
                        for (int j = 0; j < 4; ++j) { float s = cs[bj][n][j]; s += __shfl_xor(s, 1); s += __shfl_xor(s, 2); s += __shfl_xor(s, 4); s += __shfl_xor(s, 8); cs[bj][n][j] = s; }
                if (fr == 0) {
                    float* kp = KMP + ((size_t)u.pm * 2 + wr) * 512 + (pn - 6) * 256 + 64 * wc + 8 * fq;
#pragma unroll
                    for (int bj = 0; bj < 2; ++bj) { *(f32x4*)(kp + 32 * bj) = cs[bj][0]; *(f32x4*)(kp + 32 * bj + 4) = cs[bj][1]; }
                }
            }
        } else {
            const int col0 = pn * 256 + wc * 32 + 8 * fq;
#pragma unroll
            for (int ai = 0; ai < 2; ++ai)
#pragma unroll
                for (int m = 0; m < 4; ++m) { bf16_t* rowp = PROJ + (size_t)(row0 + ai * HALF + m * 16) * INW + col0;
#pragma unroll
                    for (int bj = 0; bj < 2; ++bj) { f32x4 v0 = acc[ai][bj][m][0], v1 = acc[ai][bj][m][1];
                        if (pn < 4) { v0 = gelu4(v0); v1 = gelu4(v1); } else if (pn >= 12) { v0 = sigm4(v0); v1 = sigm4(v1); }
                        st16(rowp + bj * HALF, pack8(v0, v1)); } }
        }
    }
};

struct PolP1G : PolBase {
    static constexpr int K = 1024; static constexpr bool FP8 = true, GATHER = true;
    const unsigned char* A; const unsigned char* Bt; bf16_t* PROJ; int G, c;
    __device__ __forceinline__ bool next(int i, Unit& u) const { u.e = 0; u.mt = 0; constexpr int NU = T_TOK / 256 * P1_NF8; long L = (long)i * G + c;
        if (G == 256 && NU % 256 == 0 && NU / 256 >= 2) { constexpr int R = NU / 256; if (i < R - 1) L = (long)i * 256 + c; else if (c >= 128 && i < R + 1) L = (long)(R - 1) * 256 + (i - (R - 1)) * 128 + (c - 128); else return false; }
        if (!static_unit(L, T_TOK / 256, P1_NF8, u.pm, u.pn)) return false; u.pn = p1_tile(P1_FP8_TILES, u.pn); return true; }
    __device__ __forceinline__ const char* a_base(const Unit&) const { return (const char*)A; }
    __device__ __forceinline__ const char* b_base(const Unit& u) const { return (const char*)Bt + (size_t)u.pn * 256 * K; }
    __device__ __forceinline__ void a_offsets(const Unit& u, const int (&Rr)[2], const int (&Cc)[2], unsigned (&g)[2][2], int) const {
#pragma unroll
        for (int h = 0; h < 2; ++h)
#pragma unroll
            for (int i = 0; i < 2; ++i) g[h][i] = (unsigned)(u.pm * 256 + h * HALF + Rr[i]) * (unsigned)K + (unsigned)Cc[i] * 2u;
    }
    __device__ __forceinline__ void epi(const f32x4 (&acc)[2][2][4][2], const Unit& u, int wr, int wc, int fr, int fq, int) const {
        const int row0 = u.pm * 256 + wr * 64 + fr, pn = u.pn, col0 = pn * 256 + wc * 32 + 8 * fq;
        if (pn >= 12) {
#pragma unroll
            for (int ai = 0; ai < 2; ++ai)
#pragma unroll
                for (int m = 0; m < 4; ++m) { unsigned char* rowq = (unsigned char*)PROJ + (size_t)(row0 + ai * HALF + m * 16) * (INW * 2) + GQ_OFF + (col0 - OFF_G);
#pragma unroll
                    for (int bj = 0; bj < 2; ++bj) { unsigned w[2] = {0u, 0u};
#pragma unroll
                        for (int n = 0; n < 2; ++n) {
                            f32x4 v = acc[ai][bj][m][n] * (-1.4426950408889634f * WQ_INV) + (-8.0f);
#pragma unroll
                            for (int j = 0; j < 4; ++j) v[j] = __builtin_amdgcn_exp2f(v[j]);
                            v = v + 0.00390625f;
#pragma unroll
                            for (int j = 0; j < 4; ++j) w[n] = __builtin_amdgcn_cvt_pk_u8_f32(__builtin_floorf(__builtin_amdgcn_rcpf(v[j])), j, w[n]); }
                        st8(rowq + bj * HALF, make_uint2(w[0], w[1])); } }
        } else {
#pragma unroll
            for (int ai = 0; ai < 2; ++ai)
#pragma unroll
                for (int m = 0; m < 4; ++m) { bf16_t* rowp = PROJ + (size_t)(row0 + ai * HALF + m * 16) * INW + col0;
#pragma unroll
                    for (int bj = 0; bj < 2; ++bj) { f32x4 v0 = acc[ai][bj][m][0] * WQ_INV, v1 = acc[ai][bj][m][1] * WQ_INV;
                        if (pn < 4) { v0 = gelu4(v0); v1 = gelu4(v1); }
                        st16(rowp + bj * HALF, pack8(v0, v1)); } }
        }
    }
};
struct PolP3 : PolBase {
    static constexpr int K = 1536; static constexpr bool HOOK = true; static constexpr int H1 = 8, H2 = 16;
    const bf16_t* A; const bf16_t* Bt; const bf16_t* PROJ; bf16_t* MERGED; int G, c;
    __device__ __forceinline__ bool next(int i, Unit& u) const { u.e = 0; u.mt = 0; return static_unit((long)i * G + c, T_TOK / 256, DM / 256, u.pm, u.pn); }
    __device__ __forceinline__ const char* a_base(const Unit& u) const { return (const char*)A + (size_t)u.pm * 256 * K * 2; }
    __device__ __forceinline__ const char* b_base(const Unit& u) const { return (const char*)Bt + (size_t)u.pn * 256 * K * 2; }
    __device__ __forceinline__ void khook(int t, f32x4 (&acc)[2][2][4][2], const Unit& u, int wr, int wc, int fr, int fq) const {
        const int gnum = (t == 8) ? 0 : 1024;
        int zero = 0; asm volatile("" : "+v"(zero));
        const int row0 = u.pm * 256 + wr * 64 + fr + zero, col0 = GQ_OFF + u.pn * 256 + wc * 32 + 8 * fq;
#pragma unroll
        for (int ai = 0; ai < 2; ++ai) {
            uint2 wn[4][2], wd[4][2];
#pragma unroll
            for (int m = 0; m < 4; ++m) { const unsigned char* rowp = (const unsigned char*)PROJ + (size_t)(row0 + ai * HALF + m * 16) * (INW * 2) + col0;
#pragma unroll
                for (int bj = 0; bj < 2; ++bj) { wn[m][bj] = *(const uint2*)(rowp + gnum + bj * HALF); wd[m][bj] = *(const uint2*)(rowp + gnum + 1024 + bj * HALF); } }
#pragma unroll
            for (int m = 0; m < 4; ++m)
#pragma unroll
                for (int bj = 0; bj < 2; ++bj) { f32x4 n0, n1, d0, d1; gq_unpack(wn[m][bj], n0, n1); gq_unpack(wd[m][bj], d0, d1);
#pragma unroll
                    for (int j = 0; j < 4; ++j) { acc[ai][bj][m][0][j] *= n0[j] * __builtin_amdgcn_rcpf(d0[j]); acc[ai][bj][m][1][j] *= n1[j] * __builtin_amdgcn_rcpf(d1[j]); } }
            asm volatile("" ::: "memory");
        }
    }
    __device__ __forceinline__ void epi(const f32x4 (&acc)[2][2][4][2], const Unit& u, int wr, int wc, int fr, int fq, int) const {
        const int row0 = u.pm * 256 + wr * 64 + fr, colt = u.pn * 256 + wc * 32 + 8 * fq;
#pragma unroll
        for (int ai = 0; ai < 2; ++ai)
#pragma unroll
            for (int m = 0; m < 4; ++m) { const size_t r = (size_t)(row0 + ai * HALF + m * 16);
#pragma unroll
                for (int bj = 0; bj < 2; ++bj) { const uint2 wg = *(const uint2*)((const unsigned char*)PROJ + r * (INW * 2) + GQ_OFF + 2048 + colt + bj * HALF); f32x4 g0, g1; gq_unpack(wg, g0, g1);
                    st16(MERGED + r * DM + colt + bj * HALF, pack8(acc[ai][bj][m][0] * g0, acc[ai][bj][m][1] * g1)); }
                if (m == 3) asm volatile("" ::: "memory"); }
    }
};
struct PolP4 : PolBase {
    static constexpr int K = 1024;
    const bf16_t* A; const bf16_t* Bt; const float* x; bf16_t* X1H; unsigned char* X1Q; const float* gffn; int G, c;
    __device__ __forceinline__ bool next(int i, Unit& u) const { u.e = 0; u.mt = 0; return static_unit((long)i * G + c, T_TOK / 256, DM / 256, u.pm, u.pn); }
    __device__ __forceinline__ const char* a_base(const Unit& u) const { return (const char*)A + (size_t)u.pm * 256 * K * 2; }
    __device__ __forceinline__ const char* b_base(const Unit& u) const { return (const char*)Bt + (size_t)u.pn * 256 * K * 2; }
    __device__ __forceinline__ void epi(const f32x4 (&acc)[2][2][4][2], const Unit& u, int wr, int wc, int fr, int fq, int) const {
        const int row0 = u.pm * 256 + wr * 64 + fr, colt = u.pn * 256 + wc * 32 + 8 * fq;
#pragma unroll
        for (int ai = 0; ai < 2; ++ai)
#pragma unroll
            for (int m = 0; m < 4; ++m) { const size_t o = (size_t)(row0 + ai * HALF + m * 16) * DM + colt;
#pragma unroll
                for (int bj = 0; bj < 2; ++bj) { const f32x4 x0 = *(const f32x4*)(x + o + bj * HALF), x1 = *(const f32x4*)(x + o + bj * HALF + 4);
                    const f32x4 v0 = x0 + acc[ai][bj][m][0], v1 = x1 + acc[ai][bj][m][1];
                    st16(X1H + o + bj * HALF, pack8(v0, v1));
                    const f32x4 g0 = *(const f32x4*)(gffn + colt + bj * HALF), g1 = *(const f32x4*)(gffn + colt + bj * HALF + 4);
                    st8(X1Q + o + bj * HALF, pack8_fp8(v0 * g0, v1 * g1)); }
                if (m & 1) asm volatile("" ::: "memory"); }
    }
};
struct GroupTab { const LAS int* tab; __device__ __forceinline__ int cnt(int e) const { return tab[TAB_CNT + e]; } __device__ __forceinline__ int tstart(int e) const { return tab[TAB_TST + e]; }
    __device__ __forceinline__ int tile_e(int vt) const { return tab[TAB_TE + vt]; } __device__ __forceinline__ int NT() const { return tab[TAB_TST + 32]; } };
struct PolP6 : PolBase {
    static constexpr int K = 1024; static constexpr bool GATHER = true, FP8 = true, ROWTAB = true;
    const unsigned char* X1Q; const unsigned char* W1Q; const int* LIST; const float* RSTDS; const float* b1; unsigned char* ACTQ; GroupTab tb; int G, c; LAS unsigned char* rtab;
    __device__ __forceinline__ void tab_issue(const Unit& u, int buf) const {
        const int tid = threadIdx.x;
        if (tid < 256) { const int valid = tb.cnt(u.e) - u.mt * 256, rc = tid < valid ? tid : 0; const size_t o = (size_t)u.e * 32768 + u.mt * 256 + rc;
            const unsigned dst = (unsigned)__builtin_amdgcn_readfirstlane((int)((unsigned)(size_t)rtab + buf * RT_STRIDE + (tid & ~63) * 4));
            glds4_asm(LIST + o, dst); glds4_asm(RSTDS + o, dst + 1024u);
            glds4_asm(b1 + (size_t)u.e * 2048 + u.pn * 128 + (tid < 128 ? tid : 1024 + (tid - 128)), dst + 2048u); }
    }
    __device__ __forceinline__ bool next(int i, Unit& u) const { if (!static_unit((long)i * G + c, tb.NT(), 8, u.pm, u.pn)) return false; u.e = tb.tile_e(u.pm); u.mt = u.pm - tb.tstart(u.e); return true; }
    __device__ __forceinline__ const char* a_base(const Unit&) const { return (const char*)X1Q; }
    __device__ __forceinline__ const char* b_base(const Unit& u) const { return (const char*)W1Q + ((size_t)u.e * 2048 + (size_t)u.pn * 256) * K; }
    __device__ __forceinline__ void a_offsets(const Unit&, const int (&Rr)[2], const int (&Cc)[2], unsigned (&g)[2][2], int buf) const {
        const LAS int* lp = (const LAS int*)(rtab + buf * RT_STRIDE);
#pragma unroll
        for (int h = 0; h < 2; ++h)
#pragma unroll
            for (int i = 0; i < 2; ++i) { const int tok = lp[h * HALF + Rr[i]] >> 2; g[h][i] = (unsigned)tok * (unsigned)K + (unsigned)Cc[i] * 2u; }
    }
    __device__ __forceinline__ void epi(const f32x4 (&acc)[2][2][4][2], const Unit& u, int wr, int wc, int fr, int fq, int buf) const {
        int zero = 0; asm volatile("" : "+v"(zero)); fr += zero;
        const int valid = tb.cnt(u.e) - u.mt * 256, colg = u.pn * 128 + wc * 32 + 8 * fq;
        const LAS float* rp = (const LAS float*)(rtab + buf * RT_STRIDE + 1024); const LAS float* bp = (const LAS float*)(rtab + buf * RT_STRIDE + 2048) + wc * 32 + 8 * fq;
        const f32x4 bg0 = *(const LAS f32x4*)bp, bg1 = *(const LAS f32x4*)(bp + 4), bl0 = *(const LAS f32x4*)(bp + 128), bl1 = *(const LAS f32x4*)(bp + 132);
        float rsv[8];
#pragma unroll
        for (int i = 0; i < 8; ++i) rsv[i] = rp[(i >> 2) * HALF + wr * 64 + (i & 3) * 16 + fr];
#pragma unroll
        for (int i = 0; i < 8; ++i) { const int ai = i >> 2, m = i & 3, r = ai * HALF + wr * 64 + m * 16 + fr; const float rs = (r < valid) ? rsv[i] * WQ_INV : 0.f;
            f32x4 o[2];
#pragma unroll
            for (int n = 0; n < 2; ++n) { const f32x4 gv = acc[ai][0][m][n] * rs + (n ? bg1 : bg0), lv = acc[ai][1][m][n] * rs + (n ? bl1 : bl0);
                f32x4 gg, ll, d;
#pragma unroll
                for (int j = 0; j < 4; ++j) { gg[j] = fminf(gv[j], 7.0f); ll[j] = __builtin_amdgcn_fmed3f(lv[j], -7.0f, 7.0f); }
                const f32x4 e = gg * (-1.702f * 1.4426950408889634f);
#pragma unroll
                for (int j = 0; j < 4; ++j) d[j] = __builtin_amdgcn_exp2f(e[j]);
                d = d + 1.0f;
#pragma unroll
                for (int j = 0; j < 4; ++j) d[j] = __builtin_amdgcn_rcpf(d[j]);
                const f32x4 t = gg * d;
                o[n] = t * ll + t; }
            st8(ACTQ + (size_t)(u.pm * 256 + r) * DFF + colg, pack8_fp8(o[0], o[1])); }
    }
};
struct PolP7 : PolBase {
    static constexpr int K = 1024; static constexpr bool FP8 = true, GATHER = true;
    const unsigned char* ACTQ; const unsigned char* W2Q; const int* LIST; const float* TOPWS; const float* b2; bf16_t* YS; GroupTab tb; int G, c; LAS unsigned char* rtab;
    static constexpr bool ROWTAB = true;
    __device__ __forceinline__ void tab_issue(const Unit& u, int buf) const {
        const int tid = threadIdx.x;
        if (tid < 256) { const int valid = tb.cnt(u.e) - u.mt * 256, rc = tid < valid ? tid : 0; const size_t o = (size_t)u.e * 32768 + u.mt * 256 + rc;
            const unsigned dst = (unsigned)__builtin_amdgcn_readfirstlane((int)((unsigned)(size_t)rtab + buf * RT_STRIDE + (tid & ~63) * 4));
            glds4_asm(LIST + o, dst); glds4_asm(TOPWS + o, dst + 1024u);
            glds4_asm(b2 + (size_t)u.e * 1024 + u.pn * 256 + tid, dst + 2048u); }
    }
    __device__ __forceinline__ bool next(int i, Unit& u) const { if (!static_unit((long)i * G + c, tb.NT(), 4, u.pm, u.pn)) return false; u.e = tb.tile_e(u.pm); u.mt = u.pm - tb.tstart(u.e); return true; }
    __device__ __forceinline__ const char* a_base(const Unit&) const { return (const char*)ACTQ; }
    __device__ __forceinline__ void a_offsets(const Unit& u, const int (&Rr)[2], const int (&Cc)[2], unsigned (&g)[2][2], int) const {
#pragma unroll
        for (int h = 0; h < 2; ++h)
#pragma unroll
            for (int i = 0; i < 2; ++i) g[h][i] = (unsigned)(u.pm * 256 + h * HALF + Rr[i]) * (unsigned)K + (unsigned)Cc[i] * 2u;
    }
    __device__ __forceinline__ const char* b_base(const Unit& u) const { return (const char*)W2Q + ((size_t)u.e * 1024 + (size_t)u.pn * 256) * K; }
    __device__ __forceinline__ void epi(const f32x4 (&acc)[2][2][4][2], const Unit& u, int wr, int wc, int fr, int fq, int buf) const {
        int zero = 0; asm volatile("" : "+v"(zero)); fr += zero;
        const int valid = tb.cnt(u.e) - u.mt * 256, colt = u.pn * 256 + wc * 32 + 8 * fq;
        const LAS float* bp = (const LAS float*)(rtab + buf * RT_STRIDE + 2048) + wc * 32 + 8 * fq; const LAS int* lp = (const LAS int*)(rtab + buf * RT_STRIDE); const LAS float* wp = (const LAS float*)(rtab + buf * RT_STRIDE + 1024);
        int slot[8]; float wv[8];
#pragma unroll
        for (int i = 0; i < 8; ++i) { const int r = (i >> 2) * HALF + wr * 64 + (i & 3) * 16 + fr; const bool ok = r < valid; const int rc = ok ? r : 0; const int sl = lp[rc]; wv[i] = wp[rc]; slot[i] = ok ? sl : -1; }
        f32x4 bv[2][2];
#pragma unroll
        for (int bj = 0; bj < 2; ++bj) { bv[bj][0] = *(const LAS f32x4*)(bp + bj * HALF); bv[bj][1] = *(const LAS f32x4*)(bp + bj * HALF + 4); }
#pragma unroll
        for (int i = 0; i < 8; ++i) { const int ai = i >> 2, m = i & 3;
            if (slot[i] >= 0) { const float w = wv[i] * YQ_SCALE, wq = w * WQ_INV;
#pragma unroll
                for (int bj = 0; bj < 2; ++bj) st8((unsigned char*)YS + (size_t)slot[i] * DM + colt + bj * HALF, pack8_fp8(acc[ai][bj][m][0] * wq + bv[bj][0] * w, acc[ai][bj][m][1] * wq + bv[bj][1] * w)); } }
    }
};
}

__device__ __forceinline__ void grouped_setup(LAS int* tab, const unsigned* cnt) {
    const int tid = threadIdx.x;
    if (tid < 32) tab[TAB_CNT + tid] = (int)__hip_atomic_load(cnt + tid, __ATOMIC_RELAXED, __HIP_MEMORY_SCOPE_AGENT);
    __syncthreads();
    if (tid == 0) { int s = 0; for (int e = 0; e < 32; ++e) { tab[TAB_TST + e] = s; s += (tab[TAB_CNT + e] + 255) >> 8; } tab[TAB_TST + 32] = s; }
    __syncthreads();
    const int NT = tab[TAB_TST + 32];
    for (int vt = tid; vt < NT; vt += NWAVES * 64) { int e = 0; for (int k = 1; k < 32; ++k) if (tab[TAB_TST + k] <= vt) e = k; tab[TAB_TE + vt] = e; }
    __syncthreads();
}

__device__ __forceinline__ void lds_fence() { asm volatile("s_waitcnt lgkmcnt(0)" ::: "memory"); }
template <int MAPK> __device__ __forceinline__ int p0_map(int n) {
    if (MAPK == 1) return (n >= 1024 && n < 2048) ? (n & ~255) + 128 * ((n >> 5) & 1) + 32 * ((n >> 6) & 3) + (n & 31) : n;
    if (MAPK == 2) { const int m = n & 1023; return (m >> 7) * 256 + (n >> 10) * 128 + (m & 127); }
    return n;
}
template <int MAPK, bool Q8 = false> __device__ __forceinline__ void p0_transpose_item(const float* W, int N, bf16_t* WT, int ldo, int koff, const float* gk, LAS float* scr, int item, int lane, int nblk_ = 0) {
    const int nblk = nblk_ ? nblk_ : N / 32, kb = item / nblk, nb = item % nblk, k0 = 64 * kb, n0 = 32 * nb;
    float tv[32];
#pragma unroll
    for (int i = 0; i < 32; ++i) tv[i] = __builtin_nontemporal_load(W + (size_t)(k0 + 2 * i + (lane >> 5)) * N + n0 + (lane & 31));
    if (gk) {
#pragma unroll
        for (int i = 0; i < 32; ++i) tv[i] *= gk[k0 + 2 * i + (lane >> 5)];
    }
#pragma unroll
    for (int i = 0; i < 32; ++i) scr[(2 * i + (lane >> 5)) * 33 + (lane & 31)] = tv[i];
    lds_fence();
    const int c8 = lane & 7;
#pragma unroll
    for (int j = 0; j < 4; ++j) { const int n = (lane >> 3) + 8 * j; const LAS float* s = scr + (8 * c8) * 33 + n;
        if constexpr (Q8) {
            const f32x4 a = (f32x4){s[0 * 33], s[1 * 33], s[2 * 33], s[3 * 33]} * pg::WQ_SCALE, b = (f32x4){s[4 * 33], s[5 * 33], s[6 * 33], s[7 * 33]} * pg::WQ_SCALE;
            *(uint2*)((unsigned char*)WT + (size_t)p0_map<MAPK>(n0 + n) * ldo + koff + k0 + 8 * c8) = pg::pack8_fp8(a, b);
        } else {
        u32x4 o; o.x = pg::cvt_pk_bf16(s[0 * 33], s[1 * 33]); o.y = pg::cvt_pk_bf16(s[2 * 33], s[3 * 33]); o.z = pg::cvt_pk_bf16(s[4 * 33], s[5 * 33]); o.w = pg::cvt_pk_bf16(s[6 * 33], s[7 * 33]);
        *(u32x4*)(WT + (size_t)p0_map<MAPK>(n0 + n) * ldo + koff + k0 + 8 * c8) = o; } }
    lds_fence();
}
__device__ __forceinline__ void p0_rmsnorm_row(const float* xrow, const float* g, bf16_t* orow, int lane) {
    const f32x4* xr = (const f32x4*)xrow;
    f32x4 v[4]; float s = 0.f;
#pragma unroll
    for (int j = 0; j < 4; ++j) { v[j] = xr[lane + 64 * j]; s += (v[j].x * v[j].x + v[j].y * v[j].y) + (v[j].z * v[j].z + v[j].w * v[j].w); }
    const float rstd = rsqrtf(wave_sum(s) * (1.0f / DM) + EPS);
#pragma unroll
    for (int j = 0; j < 4; ++j) { const f32x4 gv = ((const f32x4*)g)[lane + 64 * j];
        unsigned long long o = (unsigned long long)pg::cvt_pk_bf16(v[j].x * rstd * gv.x, v[j].y * rstd * gv.y) | ((unsigned long long)pg::cvt_pk_bf16(v[j].z * rstd * gv.z, v[j].w * rstd * gv.w) << 32);
        ((unsigned long long*)orow)[lane + 64 * j] = o; }
}
struct P0Args { const float *x, *mem, *g_mix, *g_mem, *w_in, *w_br0, *w_br1, *w_br2, *w_out, *w_mem_kv, *w_gate_up, *w_down, *g_ffn, *w_router, *w_spatial;
    bf16_t *HB, *MEMN, *WinT, *WbrT, *WoutT, *WmemT, *W1T, *W2T, *WSB; float* WrT; unsigned char *HBQ, *WINQ; };
__device__ __forceinline__ void p0_prologue(const P0Args a, LAS unsigned char* lds, int G, int c) {
    const int tid = threadIdx.x, lane = tid & 63, wave = __builtin_amdgcn_readfirstlane(tid >> 6);
    LAS float* scr = (LAS float*)(lds + wave * 16384);
    const int gw = c * NWAVES + wave, NGW = G * NWAVES;
    constexpr int I_IN = 16 * 64, I_G = 16 * 192, I_BR = 8 * 32, I_O = 16 * 32, I_1 = 16 * 64, I_2 = 16 * 32;
    constexpr int NITEMS = I_IN + I_G + 3 * I_BR + 2 * I_O;
    for (int it = gw; it < NITEMS; it += NGW) {
        int r = it;
        if (r < I_IN) { p0_transpose_item<1>(a.w_in, INW, a.WinT, DM, 0, nullptr, scr, r, lane, 64); continue; } r -= I_IN;
        if (r < I_G) { p0_transpose_item<0, true>(a.w_in, INW, (bf16_t*)a.WINQ, DM, 0, nullptr, scr, r, lane); continue; } r -= I_G;
        if (r < 3 * I_BR) { const int br = r / I_BR; const float* wsrc = (br == 0) ? a.w_br0 : (br == 1) ? a.w_br1 : a.w_br2; p0_transpose_item<0>(wsrc, DM, a.WbrT, 1536, br * 512, nullptr, scr, r - br * I_BR, lane); continue; } r -= 3 * I_BR;
        if (r < I_O) { p0_transpose_item<0>(a.w_out, DM, a.WoutT, DM, 0, nullptr, scr, r, lane); continue; } r -= I_O;
        p0_transpose_item<0>(a.w_mem_kv, DM, a.WmemT, DM, 0, nullptr, scr, r, lane);
    }
    for (int m = gw; m < T_TOK; m += 2 * NGW) {
        const int m2 = (m + NGW < T_TOK) ? m + NGW : m;
        const f32x4* xa = (const f32x4*)(a.x + (size_t)m * DM); const f32x4* xb = (const f32x4*)(a.x + (size_t)m2 * DM);
        f32x4 va[4], vb[4]; float sa = 0.f, sb = 0.f;
#pragma unroll
        for (int j = 0; j < 4; ++j) { va[j] = __builtin_nontemporal_load(xa + lane + 64 * j); vb[j] = __builtin_nontemporal_load(xb + lane + 64 * j); }
#pragma unroll
        for (int j = 0; j < 4; ++j) { sa += (va[j].x * va[j].x + va[j].y * va[j].y) + (va[j].z * va[j].z + va[j].w * va[j].w); sb += (vb[j].x * vb[j].x + vb[j].y * vb[j].y) + (vb[j].z * vb[j].z + vb[j].w * vb[j].w); }
        const float ra = rsqrtf(wave_sum(sa) * (1.0f / DM) + EPS), rb = rsqrtf(wave_sum(sb) * (1.0f / DM) + EPS);
#pragma unroll
        for (int j = 0; j < 4; ++j) { const f32x4 gv = ((const f32x4*)a.g_mix)[lane + 64 * j];
            ((unsigned long long*)(a.HB + (size_t)m * DM))[lane + 64 * j] = (unsigned long long)pg::cvt_pk_bf16(va[j].x * ra * gv.x, va[j].y * ra * gv.y) | ((unsigned long long)pg::cvt_pk_bf16(va[j].z * ra * gv.z, va[j].w * ra * gv.w) << 32);
            ((unsigned long long*)(a.HB + (size_t)m2 * DM))[lane + 64 * j] = (unsigned long long)pg::cvt_pk_bf16(vb[j].x * rb * gv.x, vb[j].y * rb * gv.y) | ((unsigned long long)pg::cvt_pk_bf16(vb[j].z * rb * gv.z, vb[j].w * rb * gv.w) << 32);
            { int qa = 0, qb = 0; qa = __builtin_amdgcn_cvt_pk_fp8_f32(va[j].x * ra * gv.x, va[j].y * ra * gv.y, qa, false); qa = __builtin_amdgcn_cvt_pk_fp8_f32(va[j].z * ra * gv.z, va[j].w * ra * gv.w, qa, true);
              qb = __builtin_amdgcn_cvt_pk_fp8_f32(vb[j].x * rb * gv.x, vb[j].y * rb * gv.y, qb, false); qb = __builtin_amdgcn_cvt_pk_fp8_f32(vb[j].z * rb * gv.z, vb[j].w * rb * gv.w, qb, true);
              ((int*)(a.HBQ + (size_t)m * DM))[lane + 64 * j] = qa; ((int*)(a.HBQ + (size_t)m2 * DM))[lane + 64 * j] = qb; } }
    }
    for (int m = gw; m < NBATCH * MEML; m += NGW) p0_rmsnorm_row(a.mem + (size_t)m * DM, a.g_mem, a.MEMN + (size_t)m * DM, lane);
    const int gt = c * NWAVES * 64 + tid, NGT = G * NWAVES * 64;
    for (int i = gt; i < 32 * 1024; i += NGT) { const int e = i >> 10, k = i & 1023; a.WrT[i] = a.w_router[k * 32 + e] * a.g_ffn[k]; }
    for (int i = gt; i < 4 * 128 * 128; i += NGT) { const int s = i & 127, t = (i >> 7) & 127; a.WSB[i] = (s <= t) ? f2bf(a.w_spatial[i]) : (bf16_t)0; }
}
__device__ __forceinline__ void p1_memkv(const bf16_t* MEMN, const bf16_t* WmemT, const float* gk, bf16_t* MKV, int G, int c, LAS unsigned char* lds) {
    int tid_ = threadIdx.x; asm volatile("" : "+v"(tid_));
    const int tid = tid_, lane = tid & 63, wave = __builtin_amdgcn_readfirstlane(tid >> 6), fr = lane & 15, fq = lane >> 4;
    constexpr int LDB = 72;
    for (int unit = c; unit < 128; unit += G) {
        const int rt = unit >> 3, ct = unit & 7;
        f32x4 acc[8];
#pragma unroll
        for (int j = 0; j < 8; ++j) acc[j] = (f32x4){0.f, 0.f, 0.f, 0.f};
        const bf16_t* ap = MEMN + (size_t)(rt * 128 + wave * 16 + fr) * DM + fq * 8;
        const bf16_t* bsrc = WmemT + (size_t)(ct * 128 + (tid >> 3)) * DM + (tid & 7) * 8;
        const int bdst = ((tid >> 3) * LDB + (tid & 7) * 8) * 2;
        u32x4 r0 = *(const u32x4*)bsrc, r1 = *(const u32x4*)(bsrc + (size_t)64 * DM);
        __syncthreads();
        *(LAS u32x4*)(lds + bdst) = r0; *(LAS u32x4*)(lds + bdst + 64 * LDB * 2) = r1;
        __syncthreads();
#pragma nounroll
        for (int kc = 0; kc < 16; ++kc) {
            const int buf = (kc & 1) * (128 * LDB * 2);
            if (kc + 1 < 16) { r0 = *(const u32x4*)(bsrc + (kc + 1) * 64); r1 = *(const u32x4*)(bsrc + (size_t)64 * DM + (kc + 1) * 64); }
#pragma unroll
            for (int ks = 0; ks < 2; ++ks) { const bf16x8 af = *(const bf16x8*)(ap + kc * 64 + ks * 32);
#pragma unroll
                for (int j = 0; j < 8; ++j) { const bf16x8 bf = *(const LAS bf16x8*)(lds + buf + ((16 * j + fr) * LDB + ks * 32 + fq * 8) * 2); acc[j] = __builtin_amdgcn_mfma_f32_16x16x32_bf16(af, bf, acc[j], 0, 0, 0); } }
            if (kc + 1 < 16) { *(LAS u32x4*)(lds + (buf ^ (128 * LDB * 2)) + bdst) = r0; *(LAS u32x4*)(lds + (buf ^ (128 * LDB * 2)) + bdst + 64 * LDB * 2) = r1; }
            __syncthreads();
        }
        float rstd[4] = {1.f, 1.f, 1.f, 1.f};
        if (ct < 4) {
#pragma unroll
            for (int r = 0; r < 4; ++r) { float ss = 0.f;
#pragma unroll
                for (int j = 0; j < 8; ++j) ss += acc[j][r] * acc[j][r];
                ss += __shfl_xor(ss, 1); ss += __shfl_xor(ss, 2); ss += __shfl_xor(ss, 4); ss += __shfl_xor(ss, 8);
                rstd[r] = rsqrtf(ss * (1.0f / 128.0f) + EPS); }
        }
#pragma unroll
        for (int j = 0; j < 8; ++j) { const float gg = (ct < 4) ? gk[16 * j + fr] : 1.0f;
#pragma unroll
            for (int r = 0; r < 4; ++r) MKV[(size_t)(rt * 128 + wave * 16 + fq * 4 + r) * 1024 + ct * 128 + 16 * j + fr] = f2bf(acc[j][r] * rstd[r] * gg); }
    }
}
__device__ __forceinline__ void p5_router(const bf16_t* X1, const float* WrT, const float* br, int* LIST, float* RSTDS, float* TOPWS, unsigned* cnt, int G, int c, LAS unsigned char* lds) {
    const int tid = threadIdx.x, lane = tid & 63, wave = __builtin_amdgcn_readfirstlane(tid >> 6), r = lane & 15, qd = lane >> 4;
    LAS unsigned* lcnt = (LAS unsigned*)lds;
    for (int gbase = c * NWAVES; gbase < T_TOK / 16; gbase += G * NWAVES) {
        const int t0 = (gbase + wave) * 16;
        if (tid < 32) lcnt[tid] = 0u;
        __syncthreads();
        const bf16_t* xp = X1 + (size_t)(t0 + r) * DM + 8 * qd; const float* w0 = WrT + (size_t)r * DM + 8 * qd; const float* w1 = w0 + 16 * DM;
        f32x4 acc0 = (f32x4){0.f, 0.f, 0.f, 0.f}, acc1 = acc0; float ss = 0.f;
#pragma unroll 2
        for (int it = 0; it < DM / 32; ++it) {
            f32x4 a0, a1; pg::unpack8(*(const u32x4*)(xp + 32 * it), a0, a1);
            const f32x4 b00 = *(const f32x4*)(w0 + 32 * it), b01 = *(const f32x4*)(w0 + 32 * it + 4), b10 = *(const f32x4*)(w1 + 32 * it), b11 = *(const f32x4*)(w1 + 32 * it + 4);
            ss += (a0[0] * a0[0] + a0[1] * a0[1]) + (a0[2] * a0[2] + a0[3] * a0[3]) + (a1[0] * a1[0] + a1[1] * a1[1]) + (a1[2] * a1[2] + a1[3] * a1[3]);
#pragma unroll
            for (int i = 0; i < 4; ++i) { acc0 = __builtin_amdgcn_mfma_f32_16x16x4f32(a0[i], b00[i], acc0, 0, 0, 0); acc1 = __builtin_amdgcn_mfma_f32_16x16x4f32(a0[i], b10[i], acc1, 0, 0, 0); }
#pragma unroll
            for (int i = 0; i < 4; ++i) { acc0 = __builtin_amdgcn_mfma_f32_16x16x4f32(a1[i], b01[i], acc0, 0, 0, 0); acc1 = __builtin_amdgcn_mfma_f32_16x16x4f32(a1[i], b11[i], acc1, 0, 0, 0); }
        }
        ss += __shfl_xor(ss, 16); ss += __shfl_xor(ss, 32);
        const float rstd_r = rsqrtf(ss * (1.0f / DM) + EPS);
        const float bias0 = br[r], bias1 = br[16 + r];
        float rs[4], l0[4], l1[4];
#pragma unroll
        for (int g = 0; g < 4; ++g) { rs[g] = __shfl(rstd_r, 4 * qd + g); l0[g] = acc0[g] * rs[g] + bias0; l1[g] = acc1[g] * rs[g] + bias1; }
        float sv[4][4]; int se[4][4];
#pragma unroll
        for (int rank = 0; rank < 4; ++rank)
#pragma unroll
            for (int g = 0; g < 4; ++g) {
                float v = l0[g]; int ix = r; if (l1[g] > v) { v = l1[g]; ix = r + 16; }
#pragma unroll
                for (int o = 1; o < 16; o <<= 1) { const float ov = __shfl_xor(v, o); const int oi = __shfl_xor(ix, o); if (ov > v || (ov == v && oi < ix)) { v = ov; ix = oi; } }
                sv[rank][g] = v; se[rank][g] = ix;
                if (ix == r) l0[g] = -INFINITY; if (ix == r + 16) l1[g] = -INFINITY;
            }
        float wgt[4]; int mye[4]; unsigned lp[4];
        if (r < 4) {
#pragma unroll
            for (int g = 0; g < 4; ++g) {
                const float den = 1.0f + __expf(sv[1][g] - sv[0][g]) + __expf(sv[2][g] - sv[0][g]) + __expf(sv[3][g] - sv[0][g]);
                const float myv = (r == 0) ? sv[0][g] : (r == 1) ? sv[1][g] : (r == 2) ? sv[2][g] : sv[3][g];
                mye[g] = (r == 0) ? se[0][g] : (r == 1) ? se[1][g] : (r == 2) ? se[2][g] : se[3][g];
                wgt[g] = __expf(myv - sv[0][g]) / den;
                lp[g] = __hip_atomic_fetch_add(lcnt + mye[g], 1u, __ATOMIC_RELAXED, __HIP_MEMORY_SCOPE_WORKGROUP);
            }
        }
        __syncthreads();
        if (tid < 32) lcnt[32 + tid] = atomicAdd(cnt + tid, lcnt[tid]);
        __syncthreads();
        if (r < 4) {
#pragma unroll
            for (int g = 0; g < 4; ++g) { const unsigned pos = lcnt[32 + mye[g]] + lp[g]; const int t = t0 + 4 * qd + g;
                LIST[mye[g] * 32768 + pos] = t * 4 + r; RSTDS[mye[g] * 32768 + pos] = rs[g]; TOPWS[mye[g] * 32768 + pos] = wgt[g]; }
        }
        __syncthreads();
    }
}
__device__ __forceinline__ void p8_combine(float* out, const bf16_t* X1H, const bf16_t* YS, int G, int c, float dscale) {
    typedef float f32x2v __attribute__((ext_vector_type(2)));
    const unsigned char* YQ = (const unsigned char*)YS;
    const size_t gt = (size_t)c * NWAVES * 64 + threadIdx.x, NGT = (size_t)G * NWAVES * 64;
    for (size_t i = gt; i < (size_t)T_TOK * DM / 8; i += NGT) {
        const size_t t = i >> 7, c8 = (i & 127) * 8;
        f32x4 o0, o1; pg::unpack8(*(const u32x4*)(X1H + t * DM + c8), o0, o1);
        if (dscale < 0.f) { o0 = *(const f32x4*)(out + t * DM + c8); o1 = *(const f32x4*)(out + t * DM + c8 + 4); }
        f32x4 s0 = (f32x4){0.f, 0.f, 0.f, 0.f}, s1 = s0;
#pragma unroll
        for (int k = 0; k < 4; ++k) { typedef unsigned u32x2v __attribute__((ext_vector_type(2))); const u32x2v w = __builtin_nontemporal_load((const u32x2v*)(YQ + (t * 4 + k) * DM + c8));
            const f32x2v a0 = __builtin_amdgcn_cvt_pk_f32_fp8((int)w.x, false), a1 = __builtin_amdgcn_cvt_pk_f32_fp8((int)w.x, true), b0 = __builtin_amdgcn_cvt_pk_f32_fp8((int)w.y, false), b1 = __builtin_amdgcn_cvt_pk_f32_fp8((int)w.y, true);
            s0 += (f32x4){a0[0], a0[1], a1[0], a1[1]}; s1 += (f32x4){b0[0], b0[1], b1[0], b1[1]}; }
        s0 = s0 * pg::YQ_INV; s1 = s1 * pg::YQ_INV;
        if (dscale < 0.f) { o0 = (o0 - s0) + s0; o1 = (o1 - s1) + s1; } else { o0 = (o0 + s0) * dscale; o1 = (o1 + s1) * dscale; }
        *(f32x4*)(out + t * DM + c8) = o0; *(f32x4*)(out + t * DM + c8 + 4) = o1;
    }
}


struct ConvJob { const float* w1; const float* w2; const float* gf; unsigned char* W1Q; unsigned char* W2Q; LAS float* scr; int item, end, stride; };
constexpr int CV_W1 = NEXP * 32 * 64, CV_W2 = NEXP * 32 * 32, CV_TOTAL = CV_W1 + CV_W2;
__device__ __forceinline__ void conv_issue(const ConvJob& J, float (&tv)[16], int lane) {
    const int h = J.item; const float* src; int N;
    if (h < CV_W1) { const int e = h >> 11, rem = h & 2047, kb = rem >> 6, nb = rem & 63; N = 2048; src = J.w1 + (size_t)e * DM * 2048 + (size_t)(32 * kb) * 2048 + 32 * nb; }
    else { const int h2 = h - CV_W1, e = h2 >> 10, rem = h2 & 1023, kb = rem >> 5, nb = rem & 31; N = 1024; src = J.w2 + (size_t)e * DFF * DM + (size_t)(32 * kb) * 1024 + 32 * nb; }
    src += (size_t)(16 * (lane >> 5)) * N + (lane & 31);
#pragma unroll
    for (int i = 0; i < 16; ++i) tv[i] = __builtin_nontemporal_load(src + (size_t)i * N);
}
__device__ __forceinline__ void conv_finish(ConvJob& J, const float (&tv)[16], int lane) {
    const int h = J.item; const bool is1 = h < CV_W1;
    int e, kb, nb; if (is1) { e = h >> 11; const int rem = h & 2047; kb = rem >> 6; nb = rem & 63; } else { const int h2 = h - CV_W1; e = h2 >> 10; const int rem = h2 & 1023; kb = rem >> 5; nb = rem & 31; }
    const int n = lane & 31, kh = lane >> 5;
    const f32x4 a = (f32x4){tv[0], tv[1], tv[2], tv[3]} * pg::WQ_SCALE, b = (f32x4){tv[4], tv[5], tv[6], tv[7]} * pg::WQ_SCALE;
    const f32x4 c = (f32x4){tv[8], tv[9], tv[10], tv[11]} * pg::WQ_SCALE, d = (f32x4){tv[12], tv[13], tv[14], tv[15]} * pg::WQ_SCALE;
    const uint2 lo = pg::pack8_fp8(a, b), hi2 = pg::pack8_fp8(c, d);
    const int ncol = 32 * nb + n;
    unsigned char* dst = is1 ? J.W1Q + ((size_t)e * 2048 + p0_map<2>(ncol)) * DM + 32 * kb + 16 * kh : J.W2Q + ((size_t)e * 1024 + ncol) * DFF + 32 * kb + 16 * kh;
    *(u32x4*)dst = (u32x4){lo.x, lo.y, hi2.x, hi2.y};
    asm volatile("s_waitcnt lgkmcnt(0)" ::: "memory");
    J.item += J.stride;
}
namespace at {
typedef __attribute__((address_space(3))) const char* lds_cptr;
typedef short s16x4 __attribute__((ext_vector_type(4)));
typedef float f32x16 __attribute__((ext_vector_type(16)));
__device__ __forceinline__ int crow(int r, int hi) { return (r & 3) + 8 * (r >> 2) + 4 * hi; }
__device__ __forceinline__ s16x4 vtr(lds_cptr p) { return __builtin_bit_cast(s16x4, __builtin_amdgcn_ds_read_tr16_b64_v4i16((__attribute__((address_space(3))) s16x4*)p)); }
template <int ND0> __device__ __forceinline__ void qk_step(f32x16& p0, f32x16& p1, lds_cptr kb, int kch2, const bf16x8 (&qr)[ND0]) {
#pragma unroll
    for (int d0 = 0; d0 < ND0; ++d0) {
        const bf16x8 b0 = *(const __attribute__((address_space(3))) bf16x8*)(kb + d0 * kch2);
        const bf16x8 b1 = *(const __attribute__((address_space(3))) bf16x8*)(kb + d0 * kch2 + 512);
        p0 = __builtin_amdgcn_mfma_f32_32x32x16_bf16(b0, qr[d0], p0, 0, 0, 0);
        p1 = __builtin_amdgcn_mfma_f32_32x32x16_bf16(b1, qr[d0], p1, 0, 0, 0);
        if ((d0 & 1) == 1) __builtin_amdgcn_sched_barrier(0);
    }
}
template <int NDB> __device__ __forceinline__ void softmax_step(f32x16& s0, f32x16& s1, float& m, float& l, f32x16 (&o)[NDB], LAS float* wsf, int r32, int hi, u32x4 (&pw)[4]) {
    float tm = fmaxf(s0[0], s1[0]);
#pragma unroll
    for (int r = 1; r < 16; ++r) tm = fmaxf(tm, fmaxf(s0[r], s1[r]));
    tm = fmaxf(tm, __shfl_xor(tm, 32));
    const float mn = fmaxf(m, tm);
    if (__any(mn > m)) {
        const float alpha = __builtin_amdgcn_exp2f(m - mn);
        l *= alpha; m = mn;
        if (hi == 0) wsf[r32] = alpha;
        asm volatile("s_waitcnt lgkmcnt(0)" ::: "memory");
#pragma unroll
        for (int r = 0; r < 16; ++r) { const float f = wsf[crow(r, hi)];
#pragma unroll
            for (int db = 0; db < NDB; ++db) o[db][r] *= f; }
    }
    float sum = 0.f;
#pragma unroll
    for (int r = 0; r < 16; ++r) { s0[r] = __builtin_amdgcn_exp2f(s0[r] - m); s1[r] = __builtin_amdgcn_exp2f(s1[r] - m); sum += s0[r] + s1[r]; }
    l += sum;
    pw[0] = (u32x4){pg::cvt_pk_bf16(s0[0], s0[1]), pg::cvt_pk_bf16(s0[2], s0[3]), pg::cvt_pk_bf16(s0[4], s0[5]), pg::cvt_pk_bf16(s0[6], s0[7])};
    pw[1] = (u32x4){pg::cvt_pk_bf16(s0[8], s0[9]), pg::cvt_pk_bf16(s0[10], s0[11]), pg::cvt_pk_bf16(s0[12], s0[13]), pg::cvt_pk_bf16(s0[14], s0[15])};
    pw[2] = (u32x4){pg::cvt_pk_bf16(s1[0], s1[1]), pg::cvt_pk_bf16(s1[2], s1[3]), pg::cvt_pk_bf16(s1[4], s1[5]), pg::cvt_pk_bf16(s1[6], s1[7])};
    pw[3] = (u32x4){pg::cvt_pk_bf16(s1[8], s1[9]), pg::cvt_pk_bf16(s1[10], s1[11]), pg::cvt_pk_bf16(s1[12], s1[13]), pg::cvt_pk_bf16(s1[14], s1[15])};
}
template <int NDB> __device__ __forceinline__ void softmax_rel_a(f32x16& s0, f32x16& s1, float& m, float& l, f32x16 (&o)[NDB], LAS float* wsf, int r32, int hi) {
    constexpr float THR = 4.0f;
#define AT_MX3(a, b, c) __builtin_fmaxf(__builtin_fmaxf((a), (b)), (c))
    float ta = AT_MX3(s0[0], s0[1], s1[0]), tb = AT_MX3(s0[2], s0[3], s1[1]); ta = AT_MX3(ta, s1[2], s1[3]);
#pragma unroll
    for (int r = 4; r < 16; r += 4) { ta = AT_MX3(ta, s0[r], s0[r + 1]); tb = AT_MX3(tb, s0[r + 2], s0[r + 3]); ta = AT_MX3(ta, s1[r], s1[r + 1]); tb = AT_MX3(tb, s1[r + 2], s1[r + 3]); }
    float rm = __builtin_fmaxf(ta, tb);
    { const auto rr = __builtin_amdgcn_permlane32_swap(__float_as_uint(rm), __float_as_uint(rm), false, false); rm = __builtin_fmaxf(__uint_as_float(rr[0]), __uint_as_float(rr[1])); }
#undef AT_MX3
    if (__any(rm > THR)) {
        const float dl = rm > THR ? rm : 0.f;
        m += dl;
#pragma unroll
        for (int r = 0; r < 16; ++r) { s0[r] -= dl; s1[r] -= dl; }
        const float f = __builtin_amdgcn_exp2f(-dl);
        l *= f;
        if (hi == 0) wsf[r32] = f;
        asm volatile("s_waitcnt lgkmcnt(0)" ::: "memory");
#pragma unroll
        for (int r = 0; r < 16; ++r) { const float g = wsf[crow(r, hi)];
#pragma unroll
            for (int db = 0; db < NDB; ++db) o[db][r] *= g; }
    }
}
template <int NDB> __device__ __forceinline__ void softmax_rel(f32x16& s0, f32x16& s1, float& m, float& l, f32x16 (&o)[NDB], LAS float* wsf, int r32, int hi, u32x4 (&pw)[4]) {
    constexpr float THR = 4.0f;
#define AT_MX3(a, b, c) __builtin_fmaxf(__builtin_fmaxf((a), (b)), (c))
    float ta = AT_MX3(s0[0], s0[1], s1[0]), tb = AT_MX3(s0[2], s0[3], s1[1]); ta = AT_MX3(ta, s1[2], s1[3]);
#pragma unroll
    for (int r = 4; r < 16; r += 4) { ta = AT_MX3(ta, s0[r], s0[r + 1]); tb = AT_MX3(tb, s0[r + 2], s0[r + 3]); ta = AT_MX3(ta, s1[r], s1[r + 1]); tb = AT_MX3(tb, s1[r + 2], s1[r + 3]); }
    float rm = __builtin_fmaxf(ta, tb);
    { const auto rr = __builtin_amdgcn_permlane32_swap(__float_as_uint(rm), __float_as_uint(rm), false, false); rm = __builtin_fmaxf(__uint_as_float(rr[0]), __uint_as_float(rr[1])); }
#undef AT_MX3
    if (__any(rm > THR)) {
        const float dl = rm > THR ? rm : 0.f;
        m += dl;
#pragma unroll
        for (int r = 0; r < 16; ++r) { s0[r] -= dl; s1[r] -= dl; }
        const float f = __builtin_amdgcn_exp2f(-dl);
        l *= f;
        if (hi == 0) wsf[r32] = f;
        asm volatile("s_waitcnt lgkmcnt(0)" ::: "memory");
#pragma unroll
        for (int r = 0; r < 16; ++r) { const float g = wsf[crow(r, hi)];
#pragma unroll
            for (int db = 0; db < NDB; ++db) o[db][r] *= g; }
    }
    float sa = 0.f, sb = 0.f;
#pragma unroll
    for (int r = 0; r < 16; ++r) { s0[r] = __builtin_amdgcn_exp2f(s0[r]); s1[r] = __builtin_amdgcn_exp2f(s1[r]); sa += s0[r]; sb += s1[r]; }
    l += sa + sb;
    pw[0] = (u32x4){pg::cvt_pk_bf16(s0[0], s0[1]), pg::cvt_pk_bf16(s0[2], s0[3]), pg::cvt_pk_bf16(s0[4], s0[5]), pg::cvt_pk_bf16(s0[6], s0[7])};
    pw[1] = (u32x4){pg::cvt_pk_bf16(s0[8], s0[9]), pg::cvt_pk_bf16(s0[10], s0[11]), pg::cvt_pk_bf16(s0[12], s0[13]), pg::cvt_pk_bf16(s0[14], s0[15])};
    pw[2] = (u32x4){pg::cvt_pk_bf16(s1[0], s1[1]), pg::cvt_pk_bf16(s1[2], s1[3]), pg::cvt_pk_bf16(s1[4], s1[5]), pg::cvt_pk_bf16(s1[6], s1[7])};
    pw[3] = (u32x4){pg::cvt_pk_bf16(s1[8], s1[9]), pg::cvt_pk_bf16(s1[10], s1[11]), pg::cvt_pk_bf16(s1[12], s1[13]), pg::cvt_pk_bf16(s1[14], s1[15])};
}
template <int NDB> __device__ __forceinline__ void pv_step(f32x16 (&o)[NDB], const u32x4 (&pw)[4], lds_cptr vb, int vdb_stride) {
#pragma unroll
    for (int db = 0; db < NDB; ++db)
#pragma unroll
        for (int ks = 0; ks < 4; ++ks) {
            const s16x4 lo = vtr(vb + db * vdb_stride + ks * 1024), hh = vtr(vb + db * vdb_stride + ks * 1024 + 512);
            const bf16x8 vf = (bf16x8){lo[0], lo[1], lo[2], lo[3], hh[0], hh[1], hh[2], hh[3]};
            o[db] = __builtin_amdgcn_mfma_f32_32x32x16_bf16(__builtin_bit_cast(bf16x8, pw[ks]), vf, o[db], 0, 0, 0);
            if (ks == 3) __builtin_amdgcn_sched_barrier(0);
        }
}
__device__ __forceinline__ void exp_pv(f32x16& s0, f32x16& s1, float& l, f32x16 (&o)[2], lds_cptr vb) {
    s16x4 vl[2][4], vh[2][4];
#pragma unroll
    for (int db = 0; db < 2; ++db)
#pragma unroll
        for (int ks = 0; ks < 4; ++ks) { vl[db][ks] = vtr(vb + db * 4096 + ks * 1024); vh[db][ks] = vtr(vb + db * 4096 + ks * 1024 + 512); }
    float sa = 0.f, sb = 0.f;
    __builtin_amdgcn_sched_barrier(0);
#pragma unroll
    for (int ks = 0; ks < 4; ++ks) {
        float e[8];
#pragma unroll
        for (int j = 0; j < 8; ++j) e[j] = __builtin_amdgcn_exp2f(ks < 2 ? s0[(ks & 1) * 8 + j] : s1[(ks & 1) * 8 + j]);
        sa += (e[0] + e[1]) + (e[2] + e[3]); sb += (e[4] + e[5]) + (e[6] + e[7]);
        u32x4 pw = (u32x4){pg::cvt_pk_bf16(e[0], e[1]), pg::cvt_pk_bf16(e[2], e[3]), pg::cvt_pk_bf16(e[4], e[5]), pg::cvt_pk_bf16(e[6], e[7])};
        asm volatile("" : "+v"(pw));
#pragma unroll
        for (int db = 0; db < 2; ++db) { const bf16x8 vf = (bf16x8){vl[db][ks][0], vl[db][ks][1], vl[db][ks][2], vl[db][ks][3], vh[db][ks][0], vh[db][ks][1], vh[db][ks][2], vh[db][ks][3]};
            o[db] = __builtin_amdgcn_mfma_f32_32x32x16_bf16(__builtin_bit_cast(bf16x8, pw), vf, o[db], 0, 0, 0); }
        __builtin_amdgcn_sched_barrier(0);
    }
    l += sa + sb;
}
template <int NDB> __device__ __forceinline__ void store_o(const f32x16 (&o)[NDB], float l, LAS float* wsf, int r32, int hi, bf16_t* yrow0  , int ldy) {
    l += __shfl_xor(l, 32);
    if (hi == 0) wsf[r32] = __builtin_amdgcn_rcpf(l);
    asm volatile("s_waitcnt lgkmcnt(0)" ::: "memory");
#pragma unroll
    for (int r = 0; r < 16; ++r) { const int q = crow(r, hi); const float inv = wsf[q];
#pragma unroll
        for (int db = 0; db < NDB; ++db) yrow0[(size_t)q * ldy + db * 32 + r32] = f2bf(o[db][r] * inv); }
    asm volatile("s_waitcnt lgkmcnt(0)" ::: "memory");
}

__device__ __forceinline__ void moba_unit(int b, int h, int jb, const bf16_t* PROJ, const float* KMP, bf16_t* Y, LAS unsigned char* lds, ConvJob& J, float (&tv)[16]) {
    int tid_ = threadIdx.x; asm volatile("" : "+v"(tid_));
    const int tid = tid_, lane = tid & 63, r32 = lane & 31, hi = lane >> 5, w = __builtin_amdgcn_readfirstlane(tid >> 6);
    LAS float* kmean = (LAS float*)(lds + 32768);
    LAS float* wsf = (LAS float*)(lds + 36864) + w * 64;
    const size_t rowbase = (size_t)b * SEQ; const int q0 = jb * 256; const int t = q0 + 32 * w + r32;
    for (int i = tid; i < jb * 64; i += NWAVES * 64) { const int n = i >> 6, d = i & 63; const float* p = KMP + ((size_t)(b * 16 + n) * 2) * 512 + h * 64 + d; kmean[i] = (p[0] + p[512]) * (1.0f / 256.0f); }
    const bf16_t* qp = PROJ + (rowbase + t) * INW + OFF_QB + h * 64 + hi * 8;
    bf16x8 qr[4];
#pragma unroll
    for (int d0 = 0; d0 < 4; ++d0) qr[d0] = *(const bf16x8*)(qp + d0 * 16);
    const bf16_t* kg = PROJ + (rowbase + 8 * w + (lane >> 3)) * INW + OFF_KB + h * 64 + (((lane & 7) ^ ((4 * w + (lane >> 4)) & 7)) << 3);
    const bf16_t* vg = PROJ + (rowbase + 16 * (w & 3) + (lane >> 2)) * INW + OFF_VB + h * 64 + (w >> 2) * 32 + (lane & 3) * 8;
    const unsigned kdst = (unsigned)__builtin_amdgcn_readfirstlane((int)((unsigned)(size_t)lds + w * 1024)), vdst = kdst + 8192u;
    __syncthreads();
    pg::glds16_asm(kg, kdst); pg::glds16_asm(vg, vdst);
    unsigned selmask = 0u;
    {
        float qf[32];
#pragma unroll
        for (int d0 = 0; d0 < 4; ++d0) { f32x4 a, c; pg::unpack8(__builtin_bit_cast(u32x4, qr[d0]), a, c);
#pragma unroll
            for (int j = 0; j < 4; ++j) { qf[d0 * 8 + j] = a[j]; qf[d0 * 8 + 4 + j] = c[j]; } }
        float v0 = -INFINITY, v1 = -INFINITY, v2 = -INFINITY; int i0 = -1, i1 = -1, i2 = -1;
        for (int n = 0; n < jb; ++n) {
            const LAS float* km = kmean + n * 64 + hi * 8; float g = 0.f;
#pragma unroll
            for (int d0 = 0; d0 < 4; ++d0) { const f32x4 ka = *(const LAS f32x4*)(km + d0 * 16), kc = *(const LAS f32x4*)(km + d0 * 16 + 4);
#pragma unroll
                for (int j = 0; j < 4; ++j) g += qf[d0 * 8 + j] * ka[j] + qf[d0 * 8 + 4 + j] * kc[j]; }
            g += __shfl_xor(g, 32);
            if (g > v0) { v2 = v1; i2 = i1; v1 = v0; i1 = i0; v0 = g; i0 = n; } else if (g > v1) { v2 = v1; i2 = i1; v1 = g; i1 = n; } else if (g > v2) { v2 = g; i2 = n; }
        }
        if (i0 >= 0) selmask |= 1u << i0; if (i1 >= 0) selmask |= 1u << i1; if (i2 >= 0) selmask |= 1u << i2;
    }
    asm volatile("s_waitcnt vmcnt(0)" ::: "memory");
    __syncthreads();
    const float slope2 = exp2f(-(float)(h + 1)) * 1.4426950408889634f;
    float m = 0.f, l = 0.f; f32x16 o[2];
#pragma unroll
    for (int r = 0; r < 16; ++r) { o[0][r] = 0.f; o[1][r] = 0.f; }
    const int qrel = 32 * w + r32;
    const int NT = 4 * (jb + 1);
    const lds_cptr lb = (lds_cptr)lds;
    const int voff = 8192 + ((lane >> 4) & 1) * 32 + (lane & 3) * 8 + (4 * hi + ((lane & 15) >> 2)) * 64;
#pragma nounroll
    for (int T = 0; T < NT; ++T) {
        const int slot = (T & 1) * 16384;
        if (T + 1 < NT) { pg::glds16_asm(kg + (size_t)(T + 1) * 64 * INW, kdst + (unsigned)(slot ^ 16384)); pg::glds16_asm(vg + (size_t)(T + 1) * 64 * INW, vdst + (unsigned)(slot ^ 16384)); }
        const bool cv_issue = (J.item < J.end) && ((T & 1) == 0);
        if (cv_issue) conv_issue(J, tv, lane);
        const int n = T >> 2, kt = T & 3;
        const bool own = (n == jb);
        const bool sel = own || ((selmask >> n) & 1u);
        const bool need = own ? (64 * kt <= 32 * w + 31) : (__any(sel) != 0);
        if (need) {
            const float lbias = sel ? (slope2 * (float)(T * 64 + 4 * hi - t) - m) : -INFINITY;
            f32x16 s0, s1;
#pragma unroll
            for (int r = 0; r < 16; ++r) { s0[r] = slope2 * (float)((r & 3) + 8 * (r >> 2)) + lbias; s1[r] = slope2 * (float)((r & 3) + 8 * (r >> 2) + 32) + lbias; }
            if (own && 64 * kt + 63 > 32 * w) {
                const int kr = kt * 64 + 4 * hi;
#pragma unroll
                for (int r = 0; r < 16; ++r) { const int kk = kr + (r & 3) + 8 * (r >> 2); if (kk > qrel) s0[r] = -INFINITY; if (kk + 32 > qrel) s1[r] = -INFINITY; }
            }
            bf16x8 kf[8];
#pragma unroll
            for (int d0 = 0; d0 < 4; ++d0) { const lds_cptr kp = lb + slot + r32 * 128 + (((2 * d0 + hi) ^ ((r32 >> 1) & 7)) << 4);
                kf[2 * d0] = *(const __attribute__((address_space(3))) bf16x8*)kp; kf[2 * d0 + 1] = *(const __attribute__((address_space(3))) bf16x8*)(kp + 32 * 128); }
            __builtin_amdgcn_sched_barrier(0);
#pragma unroll
            for (int d0 = 0; d0 < 4; ++d0) { s0 = __builtin_amdgcn_mfma_f32_32x32x16_bf16(kf[2 * d0], qr[d0], s0, 0, 0, 0); s1 = __builtin_amdgcn_mfma_f32_32x32x16_bf16(kf[2 * d0 + 1], qr[d0], s1, 0, 0, 0); }
            __builtin_amdgcn_sched_barrier(0);
            softmax_rel_a<2>(s0, s1, m, l, o, wsf, r32, hi);
            exp_pv(s0, s1, l, o, lb + slot + voff);
        }
        const bool cv_fin = (J.item < J.end) && ((T & 1) == 1);
        if (cv_fin) conv_finish(J, tv, lane);
        if (cv_issue) asm volatile("s_waitcnt vmcnt(16) lgkmcnt(0)" ::: "memory");
        else if (cv_fin) asm volatile("s_waitcnt vmcnt(1) lgkmcnt(0)" ::: "memory");
        else asm volatile("s_waitcnt vmcnt(0) lgkmcnt(0)" ::: "memory");
        __builtin_amdgcn_s_barrier(); asm volatile("" ::: "memory");
    }
    store_o<2>(o, l, wsf, r32, hi, Y + (rowbase + q0 + 32 * w) * 1536 + 512 + h * 64, 1536);
}

__device__ __forceinline__ void mem_units(int b, int h, int qt0, int nqt, const bf16_t* PROJ, const bf16_t* MKV, const float* gq, bf16_t* Y, LAS unsigned char* lds) {
    int tid_ = threadIdx.x; asm volatile("" : "+v"(tid_));
    const int tid = tid_, lane = tid & 63, r32 = lane & 31, hi = lane >> 5, w = __builtin_amdgcn_readfirstlane(tid >> 6);
    LAS float* wsf = (LAS float*)(lds + RING_BYTES + 4096) + w * 64;
    __syncthreads();
#pragma unroll 2
    for (int i = 0; i < 8; ++i) { const int p = tid + 512 * i, key = p >> 4, ch = p & 15;
        const u32x4 wv = *(const u32x4*)(MKV + ((size_t)b * MEML + key) * 1024 + h * 128 + ch * 8); f32x4 a, c; pg::unpack8(wv, a, c);
        const f32x4 g0 = *(const f32x4*)(gq + ch * 8), g1 = *(const f32x4*)(gq + ch * 8 + 4);
        *(LAS u32x4*)(lds + key * 256 + ((ch ^ (key & 15)) << 4)) = pg::pack8(a * g0, c * g1); }
#pragma unroll 4
    for (int i = 0; i < 8; ++i) { const int p = tid + 512 * i, key = p >> 4, c16 = p & 15;
        const u32x4 wv = *(const u32x4*)(MKV + ((size_t)b * MEML + key) * 1024 + 512 + h * 128 + c16 * 8);
        *(LAS u32x4*)(lds + 65536 + (c16 >> 2) * 16384 + (key >> 4) * 1024 + (key & 15) * 64 + (c16 & 3) * 16) = wv; }
    __syncthreads();
    const lds_cptr lb = (lds_cptr)lds;
    const int voff = 65536 + ((lane >> 4) & 1) * 32 + (lane & 3) * 8 + (4 * hi + ((lane & 15) >> 2)) * 64;
#pragma nounroll
    for (int qi = 0; qi < nqt; ++qi) {
        const size_t row0 = (size_t)b * SEQ + (size_t)(qt0 + qi) * 256 + 32 * w;
        const bf16_t* qp = PROJ + (row0 + r32) * INW + OFF_QM + h * 128 + hi * 8;
        bf16x8 qr[8]; float ss = 0.f;
#pragma unroll
        for (int d0 = 0; d0 < 8; ++d0) { qr[d0] = *(const bf16x8*)(qp + d0 * 16); f32x4 a, c; pg::unpack8(__builtin_bit_cast(u32x4, qr[d0]), a, c);
            ss += (a[0] * a[0] + a[1] * a[1]) + (a[2] * a[2] + a[3] * a[3]) + (c[0] * c[0] + c[1] * c[1]) + (c[2] * c[2] + c[3] * c[3]); }
        ss += __shfl_xor(ss, 32);
        const float cs = rsqrtf(ss * (1.0f / 128.0f) + EPS) * (0.08838834764831845f * 1.4426950408889634f);
        float m = -1e30f, l = 0.f; f32x16 o[4];
#pragma unroll
        for (int r = 0; r < 16; ++r) { o[0][r] = 0.f; o[1][r] = 0.f; o[2][r] = 0.f; o[3][r] = 0.f; }
#pragma nounroll
        for (int kt = 0; kt < 4; ++kt) {
            f32x16 s0, s1;
#pragma unroll
            for (int r = 0; r < 16; ++r) { s0[r] = 0.f; s1[r] = 0.f; }
#pragma unroll
            for (int d0 = 0; d0 < 8; ++d0) {
                const lds_cptr kp = lb + (kt * 64 + r32) * 256 + (((2 * d0 + hi) ^ (r32 & 15)) << 4);
                const bf16x8 b0 = *(const __attribute__((address_space(3))) bf16x8*)kp, b1 = *(const __attribute__((address_space(3))) bf16x8*)(kp + 32 * 256);
                s0 = __builtin_amdgcn_mfma_f32_32x32x16_bf16(b0, qr[d0], s0, 0, 0, 0); s1 = __builtin_amdgcn_mfma_f32_32x32x16_bf16(b1, qr[d0], s1, 0, 0, 0);
                if ((d0 & 1) == 1) __builtin_amdgcn_sched_barrier(0); }
#pragma unroll
            for (int r = 0; r < 16; ++r) { s0[r] *= cs; s1[r] *= cs; }
            u32x4 pw[4];
            softmax_step<4>(s0, s1, m, l, o, wsf, r32, hi, pw);
            pv_step<4>(o, pw, lb + voff + kt * 4096, 16384);
        }
        store_o<4>(o, l, wsf, r32, hi, Y + row0 * 1536 + 1024 + h * 128, 1536);
    }
    __syncthreads();
}
}


__device__ __forceinline__ void sgu_chunk(int chunk, const bf16_t* PROJ, const float* gsv, const bf16_t* WSB, const float* bs, bf16_t* Y, LAS unsigned char* lds) {
    int tid_ = threadIdx.x; asm volatile("" : "+v"(tid_));
    const int tid = tid_, lane = tid & 63, r32 = lane & 31, hi = lane >> 5, w = __builtin_amdgcn_readfirstlane(tid >> 6);
    const int t0 = chunk * 128;
    LAS float* rs = (LAS float*)(lds + 32768);
    for (int i = 0; i < 16; ++i) { const int tl = w * 16 + i;
        const u32x4 wv = *(const u32x4*)(PROJ + (size_t)(t0 + tl) * INW + OFF_V + lane * 8); f32x4 a, b; pg::unpack8(wv, a, b);
        float ss = (a[0] * a[0] + a[1] * a[1]) + (a[2] * a[2] + a[3] * a[3]) + (b[0] * b[0] + b[1] * b[1]) + (b[2] * b[2] + b[3] * b[3]);
        ss = wave_sum(ss); if (lane == 0) rs[tl] = rsqrtf(ss * (1.0f / 512.0f) + EPS); }
    __syncthreads();
    const int tt = w & 3, dh = w >> 2;
    const at::lds_cptr vb = (at::lds_cptr)lds + ((lane >> 4) & 1) * 32 + (lane & 3) * 8 + (4 * hi + ((lane & 15) >> 2)) * 64 + dh * 16384;
#pragma nounroll
    for (int g = 0; g < 4; ++g) {
        { const int c8 = tid & 15; const f32x4 g0 = *(const f32x4*)(gsv + g * 128 + c8 * 8), g1 = *(const f32x4*)(gsv + g * 128 + c8 * 8 + 4);
#pragma unroll
            for (int j = 0; j < 4; ++j) { const int s = (tid >> 4) + 32 * j; const float r = rs[s];
                const u32x4 wv = *(const u32x4*)(PROJ + (size_t)(t0 + s) * INW + OFF_V + g * 128 + c8 * 8); f32x4 a, b; pg::unpack8(wv, a, b);
                *(LAS u32x4*)(lds + (c8 >> 2) * 8192 + (s >> 4) * 1024 + (s & 15) * 64 + (c8 & 3) * 16) = pg::pack8(a * r * g0, b * r * g1); } }
        __syncthreads();
        at::f32x16 o[2];
#pragma unroll
        for (int r = 0; r < 16; ++r) { o[0][r] = 0.f; o[1][r] = 0.f; }
        const bf16_t* wrow = WSB + ((size_t)g * 128 + 32 * tt + r32) * 128 + 4 * hi;
        const int nks = 2 * tt + 2;
        for (int ks = 0; ks < nks; ++ks) {
            const uint2 alo = *(const uint2*)(wrow + 16 * ks), ahi = *(const uint2*)(wrow + 16 * ks + 8);
            const bf16x8 af = __builtin_bit_cast(bf16x8, (u32x4){alo.x, alo.y, ahi.x, ahi.y});
#pragma unroll
            for (int dbl = 0; dbl < 2; ++dbl) { const at::s16x4 lo = at::vtr(vb + dbl * 8192 + ks * 1024), hh = at::vtr(vb + dbl * 8192 + ks * 1024 + 512);
                const bf16x8 vf = (bf16x8){lo[0], lo[1], lo[2], lo[3], hh[0], hh[1], hh[2], hh[3]};
                o[dbl] = __builtin_amdgcn_mfma_f32_32x32x16_bf16(af, vf, o[dbl], 0, 0, 0); }
        }
        LAS float* stg = (LAS float*)(lds + 40960);
#pragma unroll
        for (int r = 0; r < 16; ++r) { const int t = 32 * tt + at::crow(r, hi); const float bias = bs[g * 128 + t];
#pragma unroll
            for (int dbl = 0; dbl < 2; ++dbl) stg[t * 128 + (2 * dh + dbl) * 32 + r32] = o[dbl][r] + bias; }
        __syncthreads();
#pragma unroll
        for (int j = 0; j < 4; ++j) { const int p = tid + 512 * j, t = p >> 4, c8 = (p & 15) * 8; const size_t row = (size_t)(t0 + t);
            const f32x4 m0 = *(const LAS f32x4*)(stg + t * 128 + c8), m1 = *(const LAS f32x4*)(stg + t * 128 + c8 + 4);
            f32x4 u0, u1; pg::unpack8(*(const u32x4*)(PROJ + row * INW + OFF_U + g * 128 + c8), u0, u1);
            *(u32x4*)(Y + row * 1536 + g * 128 + c8) = pg::pack8(u0 * m0, u1 * m1); }
        __syncthreads();
    }
}

struct MArgs { const float* in[24]; float* out; unsigned char* ws; int ph_lo, ph_hi; };
__global__ void __launch_bounds__(NWAVES * 64, 2) mk_fwd(MArgs a) {
    extern __shared__ __attribute__((aligned(16))) unsigned char lds_raw[];
    LAS unsigned char* lds = (LAS unsigned char*)lds_raw;
    const int tid = threadIdx.x;
    for (int u = tid; u < (LDS_BYTES - LDSCTL_OFF) / 4; u += NWAVES * 64) ((LAS unsigned*)(lds + LDSCTL_OFF))[u] = 0u;
    __syncthreads();
    unsigned char* ws = a.ws; unsigned* ctl = (unsigned*)(ws + WS_CTL);
    const int lo = a.ph_lo, hi = a.ph_hi; const int G = gridDim.x, c = blockIdx.x;
    XcdBarrier bar; bar.bar = ctl + CW_BAR; bar.x = 0; bar.st = nullptr;
    if (hi - lo > 1) bar = xcd_barrier_post(ctl + CW_BAR, (volatile LAS unsigned*)(lds + LDSCTL_OFF));
typedef const MArgs __attribute__((address_space(4))) * kargp_t;
    const kargp_t kargs = (kargp_t)__builtin_amdgcn_kernarg_segment_ptr();
#define KA_BEGIN() kargp_t q = kargs; asm volatile("" : "+s"(q))
#ifdef DIAG_PHASE
    if (c == 0 && tid == 0) *(LAS unsigned long long*)(lds + LDSCTL_OFF + 16) = wall_clock64();
#define DIAG_STAMP(k) do { if ((k) == DIAG_PHASE && c == 0 && tid == 0) ctl[CW_DIAG] = (unsigned)(wall_clock64() - *(LAS unsigned long long*)(lds + LDSCTL_OFF + 16)); } while (0)
#else
#define DIAG_STAMP(k) do { } while (0)
#endif
#define IN(k) (lo <= (k) && (k) < hi)
#define BOTH(k) (IN(k) && IN((k) + 1))
    bf16_t *WinT = (bf16_t*)(ws + WS_WIN), *WbrT = (bf16_t*)(ws + WS_WBR), *WoutT = (bf16_t*)(ws + WS_WOUT);
    bf16_t *W1T = (bf16_t*)(ws + WS_W1), *W2T = (bf16_t*)(ws + WS_W2);
    bf16_t *MERGED = (bf16_t*)(ws + WS_MERGED), *X1B = (bf16_t*)(ws + WS_X1B), *HB = (bf16_t*)(ws + WS_HB), *PROJ = (bf16_t*)(ws + WS_PROJ), *Y = (bf16_t*)(ws + WS_Y);
    bf16_t *ACT = (bf16_t*)(ws + WS_ACT), *YS = (bf16_t*)(ws + WS_YS);
    float* KMP = (float*)(ws + WS_KMP); int* LIST = (int*)(ws + WS_LIST); float* RSTDS = (float*)(ws + WS_RSTDS); float* TOPWS = (float*)(ws + WS_TOPWS);

    bf16_t *WmemT = (bf16_t*)(ws + WS_WMEM), *MEMN = (bf16_t*)(ws + WS_MEMN), *MKV = (bf16_t*)(ws + WS_MKV), *WSB = (bf16_t*)(ws + WS_WSB); float* WrT = (float*)(ws + WS_WR);
#if !defined(ONLY) || ONLY == 0
    if (IN(0)) {
        KA_BEGIN();
        {
        P0Args p; p.x = q->in[0]; p.mem = q->in[1]; p.g_mix = q->in[2]; p.g_mem = q->in[9]; p.w_in = q->in[3]; p.w_br0 = q->in[13]; p.w_br1 = q->in[14]; p.w_br2 = q->in[15]; p.w_out = q->in[16];
        p.w_mem_kv = q->in[10]; p.w_gate_up = q->in[20]; p.w_down = q->in[22]; p.g_ffn = q->in[17]; p.w_router = q->in[18]; p.w_spatial = q->in[5];
        p.HBQ = ws + WS_HBQ; p.WINQ = ws + WS_WINQ; p.HB = HB; p.MEMN = MEMN; p.WinT = WinT; p.WbrT = WbrT; p.WoutT = WoutT; p.WmemT = WmemT; p.W1T = W1T; p.W2T = W2T; p.WSB = WSB; p.WrT = WrT;
        p0_prologue(p, lds, G, c);
        }
#if DUP_PHASE == 0
        {
        P0Args p; p.x = q->in[0]; p.mem = q->in[1]; p.g_mix = q->in[2]; p.g_mem = q->in[9]; p.w_in = q->in[3]; p.w_br0 = q->in[13]; p.w_br1 = q->in[14]; p.w_br2 = q->in[15]; p.w_out = q->in[16];
        p.w_mem_kv = q->in[10]; p.w_gate_up = q->in[20]; p.w_down = q->in[22]; p.g_ffn = q->in[17]; p.w_router = q->in[18]; p.w_spatial = q->in[5];
        p.HBQ = ws + WS_HBQ; p.WINQ = ws + WS_WINQ; p.HB = HB; p.MEMN = MEMN; p.WinT = WinT; p.WbrT = WbrT; p.WoutT = WoutT; p.WmemT = WmemT; p.W1T = W1T; p.W2T = W2T; p.WSB = WSB; p.WrT = WrT;
        p0_prologue(p, lds, G, c);
        }
#endif
        if (BOTH(0)) xcd_barrier(bar);
        DIAG_STAMP(0);
    }
#endif
#if !defined(ONLY) || ONLY == 1
    if (IN(1)) {
        KA_BEGIN();
        {
        pg::PolP1 P; P.A = HB; P.Bt = WinT; P.PROJ = PROJ; P.KMP = KMP; P.gq = q->in[7]; P.gk = q->in[8]; P.G = G; P.c = c;
        pg::gemm_run(lds, P);
        { pg::PolP1G Pg; Pg.A = ws + WS_HBQ; Pg.Bt = ws + WS_WINQ; Pg.PROJ = PROJ; Pg.G = G; Pg.c = c; pg::gemm_run(lds, Pg); }
        p1_memkv(MEMN, WmemT, q->in[12], MKV, G, c, lds);
        }
#if DUP_PHASE == 1
        {
        pg::PolP1 P; P.A = HB; P.Bt = WinT; P.PROJ = PROJ; P.KMP = KMP; P.gq = q->in[7]; P.gk = q->in[8]; P.G = G; P.c = c;
        pg::gemm_run(lds, P);
        p1_memkv(MEMN, WmemT, q->in[12], MKV, G, c, lds);
        }
#endif
        if (BOTH(1)) xcd_barrier(bar);
        DIAG_STAMP(1);
    }
#endif
#if !defined(ONLY) || ONLY == 2
    if (IN(2)) {
        KA_BEGIN();
        {
        const int wave = __builtin_amdgcn_readfirstlane(tid >> 6), lane = tid & 63;
        const int vcu = (G % 8 == 0) ? (c % 8) * (G / 8) + c / 8 : c;
        for (int u = vcu; u < 256; u += G) at::mem_units(u >> 5, (u >> 3) & 3, (u & 7) * 2, 2, PROJ, MKV, q->in[11], Y, lds);
#if DUP_P2 == 1
        for (int u = vcu; u < 256; u += G) at::mem_units(u >> 5, (u >> 3) & 3, (u & 7) * 2, 2, PROJ, MKV, q->in[11], Y, lds);
#endif
        ConvJob J; J.w1 = q->in[20]; J.w2 = q->in[22]; J.gf = q->in[17]; J.W1Q = (unsigned char*)W1T; J.W2Q = (unsigned char*)W2T; J.scr = (LAS float*)(lds + 40960 + wave * 4352);
        J.item = c * NWAVES + wave; J.end = CV_TOTAL; J.stride = G * NWAVES; float tv[16];
        for (int u = vcu; u < 256; u += G) { const int bh = u >> 2, s4 = u & 3;
            for (int i = 0; i < 4; ++i) { const int jb = (i == 0) ? 15 - s4 : (i == 1) ? 8 + s4 : (i == 2) ? 7 - s4 : s4; at::moba_unit(bh >> 3, bh & 7, jb, PROJ, KMP, Y, lds, J, tv); } }
#if DUP_P2 == 2
        for (int u = vcu; u < 256; u += G) { const int bh = u >> 2, s4 = u & 3;
            for (int i = 0; i < 4; ++i) { const int jb = (i == 0) ? 15 - s4 : (i == 1) ? 8 + s4 : (i == 2) ? 7 - s4 : s4; at::moba_unit(bh >> 3, bh & 7, jb, PROJ, KMP, Y, lds, J, tv); } }
#endif
        while (J.item < J.end) { conv_issue(J, tv, lane); conv_finish(J, tv, lane); }
        __syncthreads();
        for (int ch = vcu; ch < 256; ch += G) sgu_chunk(ch, PROJ, q->in[4], WSB, q->in[6], Y, lds);
#if DUP_P2 == 3
        for (int ch = vcu; ch < 256; ch += G) sgu_chunk(ch, PROJ, q->in[4], WSB, q->in[6], Y, lds);
#endif
        }
#if DUP_PHASE == 2
        {
        const int wave = __builtin_amdgcn_readfirstlane(tid >> 6), lane = tid & 63;
        const int vcu = (G % 8 == 0) ? (c % 8) * (G / 8) + c / 8 : c;
        for (int u = vcu; u < 256; u += G) at::mem_units(u >> 5, (u >> 3) & 3, (u & 7) * 2, 2, PROJ, MKV, q->in[11], Y, lds);
        for (int u = vcu; u < 256; u += G) { const int bh = u >> 2, s4 = u & 3;
            for (int i = 0; i < 4; ++i) { const int jb = (i == 0) ? 15 - s4 : (i == 1) ? 8 + s4 : (i == 2) ? 7 - s4 : s4; at::moba_unit(bh >> 3, bh & 7, jb, PROJ, KMP, Y, lds, J, tv); } }
        __syncthreads();
        for (int ch = vcu; ch < 256; ch += G) sgu_chunk(ch, PROJ, q->in[4], WSB, q->in[6], Y, lds);
        }
#endif
        if (BOTH(2)) xcd_barrier(bar);
        DIAG_STAMP(2);
    }
#endif
#if !defined(ONLY) || ONLY == 3
    if (IN(3)) {
        KA_BEGIN();
        {
        pg::PolP3 P; P.A = Y; P.Bt = WbrT; P.PROJ = PROJ; P.MERGED = MERGED; P.G = G; P.c = c;
        pg::gemm_run(lds, P);
        }
#if DUP_PHASE == 3
        {
        pg::PolP3 P; P.A = Y; P.Bt = WbrT; P.PROJ = PROJ; P.MERGED = MERGED; P.G = G; P.c = c;
        pg::gemm_run(lds, P);
        }
#endif
        if (BOTH(3)) xcd_barrier(bar);
        DIAG_STAMP(3);
    }
#endif
#if !defined(ONLY) || ONLY == 4
    if (IN(4)) {
        KA_BEGIN();
        {
        pg::PolP4 P; P.A = MERGED; P.Bt = WoutT; P.x = q->in[0]; P.X1H = (bf16_t*)(ws + WS_X1H); P.X1Q = (unsigned char*)X1B; P.gffn = q->in[17]; P.G = G; P.c = c;
        pg::gemm_run(lds, P);
        }
#if DUP_PHASE == 4
        {
        pg::PolP4 P; P.A = MERGED; P.Bt = WoutT; P.x = q->in[0]; P.X1H = (bf16_t*)(ws + WS_X1H); P.X1Q = (unsigned char*)X1B; P.gffn = q->in[17]; P.G = G; P.c = c;
        pg::gemm_run(lds, P);
        }
#endif
        if (BOTH(4)) xcd_barrier(bar);
#ifdef DUP_BAR
        for (int i_ = 0; i_ < DUP_BAR; ++i_) xcd_barrier(bar);
#endif
        DIAG_STAMP(4);
    }
#endif
#if !defined(ONLY) || ONLY == 5
    if (IN(5)) {
        KA_BEGIN();
        {
        p5_router((const bf16_t*)(ws + WS_X1H), WrT, q->in[19], LIST, RSTDS, TOPWS, ctl + CW_CNT, G, c, lds);
        }
#if DUP_PHASE == 5
        {
        p5_router((const bf16_t*)(ws + WS_X1H), WrT, q->in[19], (int*)(ws + WS_SCR), (float*)(ws + WS_SCR + 4 * MiB), (float*)(ws + WS_SCR + 8 * MiB), ctl + 512, G, c, lds);
        }
#endif
        if (BOTH(5)) xcd_barrier(bar);
        DIAG_STAMP(5);
    }
#endif
#if !defined(ONLY) || ONLY == 6
    if (IN(6)) {
        KA_BEGIN();
        {
        grouped_setup((LAS int*)(lds + TAB_OFF), ctl + CW_CNT);
        pg::PolP6 P; P.X1Q = (const unsigned char*)X1B; P.W1Q = (const unsigned char*)W1T; P.LIST = LIST; P.RSTDS = RSTDS; P.b1 = q->in[21]; P.ACTQ = (unsigned char*)ACT; P.tb.tab = (const LAS int*)(lds + TAB_OFF); P.G = G; P.c = c; P.rtab = lds + RTAB_OFF;
        pg::gemm_run(lds, P);
        }
#if DUP_PHASE == 6
        {
        grouped_setup((LAS int*)(lds + TAB_OFF), ctl + CW_CNT);
        pg::PolP6 P; P.X1Q = (const unsigned char*)X1B; P.W1Q = (const unsigned char*)W1T; P.LIST = LIST; P.RSTDS = RSTDS; P.b1 = q->in[21]; P.ACTQ = (unsigned char*)ACT; P.tb.tab = (const LAS int*)(lds + TAB_OFF); P.G = G; P.c = c; P.rtab = lds + RTAB_OFF;
        pg::gemm_run(lds, P);
        }
#endif
        if (BOTH(6)) xcd_barrier(bar);
        DIAG_STAMP(6);
    }
#endif
#if !defined(ONLY) || ONLY == 7
    if (IN(7)) {
        KA_BEGIN();
        {
        grouped_setup((LAS int*)(lds + TAB_OFF), ctl + CW_CNT);
        pg::PolP7 P; P.ACTQ = (const unsigned char*)ACT; P.W2Q = (const unsigned char*)W2T; P.LIST = LIST; P.TOPWS = TOPWS; P.b2 = q->in[23]; P.YS = YS; P.tb.tab = (const LAS int*)(lds + TAB_OFF); P.G = G; P.c = c; P.rtab = lds + RTAB_OFF;
        pg::gemm_run(lds, P);
        }
#if DUP_PHASE == 7
        {
        grouped_setup((LAS int*)(lds + TAB_OFF), ctl + CW_CNT);
        pg::PolP7 P; P.ACTQ = (const unsigned char*)ACT; P.W2Q = (const unsigned char*)W2T; P.LIST = LIST; P.TOPWS = TOPWS; P.b2 = q->in[23]; P.YS = YS; P.tb.tab = (const LAS int*)(lds + TAB_OFF); P.G = G; P.c = c; P.rtab = lds + RTAB_OFF;
        pg::gemm_run(lds, P);
        }
#endif
        if (BOTH(7)) xcd_barrier(bar);
        DIAG_STAMP(7);
    }
#endif
#if !defined(ONLY) || ONLY == 8
    if (IN(8)) { KA_BEGIN();
#ifdef DIAG_PHASE
        p8_combine(q->out, (const bf16_t*)(ws + WS_X1H), YS, G, c, 1.0f + sqrtf((float)ctl[CW_DIAG] * 1e-5f));
#else
        p8_combine(q->out, (const bf16_t*)(ws + WS_X1H), YS, G, c, 1.0f);
#if DUP_PHASE == 8
        p8_combine(q->out, (const bf16_t*)(ws + WS_X1H), YS, G, c, -1.0f);
#endif
#endif
    }
#endif
#undef IN
#undef BOTH
}

static int g_grid = 0;
static void launch_mk(const MArgs& base, int lo, int hi, hipStream_t stream) {
    MArgs a = base; a.ph_lo = lo; a.ph_hi = hi;
    hipLaunchKernelGGL(mk_fwd, dim3(g_grid), dim3(NWAVES * 64), LDS_BYTES, stream, a);
}
extern "C" void kernel_launch(void* const* d_in, const int* in_sizes, int n_in, void* d_out, int out_size, void* d_ws, size_t ws_size, hipStream_t stream) {
    if (n_in != 24 || ws_size < WS_END) { fprintf(stderr, "kernel_launch: unexpected n_in %d or ws %zu\n", n_in, ws_size); return; }
    if (g_grid == 0) {
        int dev = 0, cus = 0, per_cu = 0;
        (void)hipGetDevice(&dev); (void)hipDeviceGetAttribute(&cus, hipDeviceAttributeMultiprocessorCount, dev);
        if (hipFuncSetAttribute((const void*)mk_fwd, hipFuncAttributeMaxDynamicSharedMemorySize, LDS_BYTES) != hipSuccess) fprintf(stderr, "kernel_launch: hipFuncSetAttribute failed\n");
        if (hipOccupancyMaxActiveBlocksPerMultiprocessor(&per_cu, (const void*)mk_fwd, NWAVES * 64, LDS_BYTES) != hipSuccess || per_cu < 1) fprintf(stderr, "kernel_launch: occupancy query says %d\n", per_cu);
        (void)hipGetLastError();
        g_grid = cus > 0 ? cus : 256;
    }
    unsigned char* ws = (unsigned char*)d_ws; float* out = (float*)d_out;
    MArgs base{}; for (int i = 0; i < 24; ++i) base.in[i] = (const float*)d_in[i]; base.out = out; base.ws = ws;

    (void)hipMemsetAsync(ws + WS_CTL, 0, 1 * MiB, stream);
    launch_mk(base, 0, 9, stream);
}
```

```cpp
#include <hip/hip_runtime.h>
#include <stdint.h>
#include <cstdio>
#ifndef DUP_P2
#define DUP_P2 0
#endif
#ifndef DUP_PHASE
#define DUP_PHASE -1
#endif

typedef unsigned short bf16_t;
typedef short bf16x8 __attribute__((ext_vector_type(8)));
typedef float f32x4 __attribute__((ext_vector_type(4)));
typedef unsigned u32x4 __attribute__((ext_vector_type(4)));
typedef int i32x8 __attribute__((ext_vector_type(8)));
typedef int i32x4 __attribute__((ext_vector_type(4)));

constexpr int NBATCH = 8, SEQ = 4096, DM = 1024, T_TOK = NBATCH * SEQ, INW = 6144, MEML = 256;
constexpr int OFF_U = 0, OFF_V = 512, OFF_QB = 1024, OFF_KB = 1536, OFF_VB = 2048, OFF_QM = 2560, OFF_G = 3072;
constexpr int NEXP = 32, TOPK = 4, DFF = 1024;
constexpr float EPS = 1e-6f;
constexpr int ACT_ROWS = T_TOK * TOPK + NEXP * 256;

constexpr size_t MiB = 1ull << 20;
constexpr size_t WS_CTL = 0;
constexpr size_t WS_WIN = 1 * MiB;
constexpr size_t WS_WBR = 13 * MiB;
constexpr size_t WS_WOUT = 16 * MiB;
constexpr size_t WS_WMEM = 18 * MiB;
constexpr size_t WS_WR = 20 * MiB;
constexpr size_t WS_RSTD2 = 21 * MiB;
constexpr size_t WS_WSB = 21 * MiB + 256 * 1024;
constexpr size_t WS_KMP = 22 * MiB;
constexpr size_t WS_TOPW = 23 * MiB;
constexpr size_t WS_LIST = 24 * MiB;
constexpr size_t WS_RSTDS = 28 * MiB;
constexpr size_t WS_TOPWS = 32 * MiB;
constexpr size_t WS_MEMN = 36 * MiB;
constexpr size_t WS_MKV = 40 * MiB;
constexpr size_t WS_W1 = 44 * MiB;
constexpr size_t WS_W2 = 172 * MiB;
constexpr size_t WS_MERGED = 236 * MiB;
constexpr size_t WS_X1B = 300 * MiB;
constexpr size_t WS_HB = 364 * MiB;
constexpr size_t WS_PROJ = 428 * MiB;
constexpr size_t WS_Y = 812 * MiB;
constexpr size_t WS_ACT = 364 * MiB;
constexpr size_t WS_YS = 636 * MiB;
constexpr size_t WS_X1H = 500 * MiB;
constexpr size_t WS_HBQ = 908 * MiB;
constexpr size_t WS_WINQ = 944 * MiB;
constexpr size_t WS_SCR = 960 * MiB;
constexpr size_t WS_END = 1024 * MiB;
constexpr int CW_CNT = 64;
constexpr int CW_DIAG = 128;

__device__ __forceinline__ float bf2f(bf16_t b) { return __uint_as_float(((unsigned)b) << 16); }
__device__ __forceinline__ bf16_t f2bf(float f) { unsigned u = __float_as_uint(f); u += 0x7fffu + ((u >> 16) & 1u); return (bf16_t)(u >> 16); }
__device__ __forceinline__ float wave_sum(float v) {
#pragma unroll
    for (int o = 1; o < 64; o <<= 1) v += __shfl_xor(v, o);
    return v;
}
__device__ __forceinline__ float wave_max(float v) {
#pragma unroll
    for (int o = 1; o < 64; o <<= 1) v = fmaxf(v, __shfl_xor(v, o));
    return v;
}
__device__ __forceinline__ float gelu_exact(float v) { return 0.5f * v * (1.0f + erff(v * 0.70710678118654752f)); }
__device__ __forceinline__ float sigmoidf_(float v) { return 1.0f / (1.0f + __expf(-v)); }

#define LAS __attribute__((address_space(3)))
typedef float f32x2 __attribute__((ext_vector_type(2)));
constexpr int NWAVES = 8;
constexpr int RING_BYTES = 131072;
constexpr int LDSCTL_OFF = RING_BYTES;
constexpr int TAB_OFF = RING_BYTES + 64;
constexpr int TAB_CNT = 0, TAB_TST = 32, TAB_TE = 96, TAB_WORDS = 96 + 576;
constexpr int RTAB_OFF = RING_BYTES + 8192;
constexpr int RT_STRIDE = 4096;
constexpr int LDS_BYTES = 147456;
static_assert(TAB_OFF + TAB_WORDS * 4 <= LDS_BYTES && RTAB_OFF + 2 * RT_STRIDE <= LDS_BYTES, "LDS map");
constexpr int CW_BAR = 4096;

#define XB_TMO      128
#define XB_XCNT(j)  (256  + 64 * (j))
#define XB_XSUB(j)  (1280 + 64 * (j))
#define XB_XGEN(j)  (2304 + 64 * (j))
#define XB_TOP      3328
#define XB_TOPGEN   3392
#define XCD_BAR_WORDS 3456
#define XB_SPIN_CAP (1u << 18)
__device__ __forceinline__ unsigned xb_ld(unsigned* p)              { return __hip_atomic_load(p, __ATOMIC_RELAXED, __HIP_MEMORY_SCOPE_AGENT); }
__device__ __forceinline__ unsigned xb_add(unsigned* p, unsigned v) { return __hip_atomic_fetch_add(p, v, __ATOMIC_RELAXED, __HIP_MEMORY_SCOPE_AGENT); }
__device__ __forceinline__ unsigned xb_xcc_id() { return (unsigned)__builtin_amdgcn_s_getreg((3 << 11) | 20) & 0xFu; }
#define XB_SPIN(cond, bar) do { unsigned _sp = 0; while (cond) { __builtin_amdgcn_s_sleep(1); \
    if ((++_sp & 255u) == 0u) { if (xb_ld(&(bar)[XB_TMO])) break; if (_sp > XB_SPIN_CAP) { atomicAdd(&(bar)[XB_TMO], 1u); break; } } } } while (0)
struct XcdBarrier { unsigned* bar; unsigned x; volatile LAS unsigned* st; };
__device__ __forceinline__ XcdBarrier xcd_barrier_post(unsigned* bar, volatile LAS unsigned* st) {
    XcdBarrier b; b.bar = bar; b.x = xb_xcc_id(); b.st = st;
    if (threadIdx.x == 0) (void)xb_add(&bar[XB_XCNT(b.x)], 1u);
    return b;
}
__device__ __forceinline__ void xcd_barrier_complete(unsigned* bar, unsigned x, unsigned& nloc, unsigned& nx) {
    const unsigned G = gridDim.x * gridDim.y * gridDim.z;
    unsigned sum, cnt, mine, sp = 0u;
    for (;;) {
        sum = 0u; cnt = 0u; mine = 0u;
#pragma unroll
        for (unsigned j = 0; j < 16; ++j) { const unsigned c = xb_ld(&bar[XB_XCNT(j)]); sum += c; cnt += (c > 0u) ? 1u : 0u; mine = (j == x) ? c : mine; }
        if (sum == G) break;
        __builtin_amdgcn_s_sleep(1);
        if ((++sp & 255u) == 0u) { if (xb_ld(&bar[XB_TMO])) break; if (sp > XB_SPIN_CAP) { atomicAdd(&bar[XB_TMO], 1u); break; } }
    }
    nloc = mine > 0u ? mine : 1u; nx = cnt > 0u ? cnt : 1u;
}
__device__ __forceinline__ void xcd_barrier(const XcdBarrier& b) {
    asm volatile("s_waitcnt vmcnt(0)" ::: "memory");
    __syncthreads();
    if (threadIdx.x == 0) {
        unsigned* bar = b.bar;
        __builtin_amdgcn_s_waitcnt(0);
        unsigned nloc = b.st[0], nx = b.st[1];
        if (nloc == 0u) { xcd_barrier_complete(bar, b.x, nloc, nx); b.st[0] = nloc; b.st[1] = nx; }
        const unsigned old = xb_add(&bar[XB_XSUB(b.x)], 1u);
        const unsigned gen = old / nloc;
        if (old + 1u == (gen + 1u) * nloc) {
            __builtin_amdgcn_fence(__ATOMIC_RELEASE, "agent");
            asm volatile("s_waitcnt vmcnt(0)" ::: "memory");
            const unsigned og = xb_add(&bar[XB_TOP], 1u);
            const unsigned tg = og / nx;
            if (og + 1u == (tg + 1u) * nx) xb_add(&bar[XB_TOPGEN], 1u);
            else XB_SPIN(xb_ld(&bar[XB_TOPGEN]) == tg, bar);
            __builtin_amdgcn_fence(__ATOMIC_ACQUIRE, "agent");
            xb_add(&bar[XB_XGEN(b.x)], 1u);
            asm volatile("s_waitcnt vmcnt(0)" ::: "memory");
        } else {
            XB_SPIN(xb_ld(&bar[XB_XGEN(b.x)]) == gen, bar);
            __builtin_amdgcn_fence(__ATOMIC_ACQUIRE, "agent");
            asm volatile("s_waitcnt vmcnt(0)" ::: "memory");
        }
    }
    __syncthreads();
}

#ifndef PG_ALIGN
#define PG_ALIGN true
#endif
namespace pg {
constexpr int BM = 256, BK = 64, HALF = 128, HTB = HALF * BK * 2, STAGE_BYTES = 8 * HTB, NXCD = 8, WGM = 8;
__host__ __device__ __forceinline__ int lds_byte(int r, int c) { const int st = (r >> 4) * 2 + (c >> 5), rr = r & 15, cc = c & 31, ob = rr * 64 + cc * 2; return st * 1024 + (ob ^ (((ob >> 9) & 1) << 5)); }
__host__ __device__ __forceinline__ void stage_rc(int b, int& R, int& C) { const int st = b / 1024, sb = b % 1024, swz = sb ^ (((sb >> 9) & 1) << 5); R = (st >> 1) * 16 + swz / 64; C = (st & 1) * 32 + (swz % 64) / 2; }
__host__ __device__ __forceinline__ int perm32(int rho) { const int n = rho >> 4, i = rho & 15; return 8 * (i >> 2) + 4 * n + (i & 3); }
struct Unit { int pm, pn, e, mt; };
__device__ __forceinline__ bool static_unit(long L, int nM, int nN, int& pm, int& pn) {
    const int nwg = nM * nN; if (L >= nwg) return false;
    int wgid = (int)L; { const int q = nwg / NXCD, r = nwg % NXCD, xcd = wgid % NXCD, off = wgid / NXCD; wgid = (xcd < r ? xcd * (q + 1) : r * (q + 1) + (xcd - r) * q) + off; }
    const int nig = WGM * nN, gid = wgid / nig, fm = gid * WGM, gsz = (nM - fm) < WGM ? (nM - fm) : WGM;
    pm = fm + ((wgid % nig) % gsz); pn = (wgid % nig) / gsz; return true;
}
typedef __bf16 bf16x2_hw __attribute__((ext_vector_type(2)));
__device__ __forceinline__ unsigned cvt_pk_bf16(float lo, float hi) { const bf16x2_hw b = __builtin_convertvector((f32x2){lo, hi}, bf16x2_hw); return __builtin_bit_cast(unsigned, b); }
__device__ __forceinline__ u32x4 pack8(const f32x4 v0, const f32x4 v1) { u32x4 w; w.x = cvt_pk_bf16(v0[0], v0[1]); w.y = cvt_pk_bf16(v0[2], v0[3]); w.z = cvt_pk_bf16(v1[0], v1[1]); w.w = cvt_pk_bf16(v1[2], v1[3]); return w; }
constexpr float YQ_SCALE = 32.0f, YQ_INV = 1.0f / 32.0f;
constexpr float WQ_SCALE = 64.0f, WQ_INV = 1.0f / 64.0f;
__device__ __forceinline__ uint2 pack8_fp8(const f32x4 v0, const f32x4 v1) { int a = 0, b = 0;
    a = __builtin_amdgcn_cvt_pk_fp8_f32(v0[0], v0[1], a, false); a = __builtin_amdgcn_cvt_pk_fp8_f32(v0[2], v0[3], a, true);
    b = __builtin_amdgcn_cvt_pk_fp8_f32(v1[0], v1[1], b, false); b = __builtin_amdgcn_cvt_pk_fp8_f32(v1[2], v1[3], b, true); return make_uint2((unsigned)a, (unsigned)b); }
#ifndef EPI_NT
#define EPI_NT 0
#endif
__device__ __forceinline__ void st16(void* p, const u32x4 v) { if (EPI_NT) __builtin_nontemporal_store(v, (u32x4*)p); else *(u32x4*)p = v; }
__device__ __forceinline__ void st16f(void* p, const f32x4 v) { if (EPI_NT) __builtin_nontemporal_store(v, (f32x4*)p); else *(f32x4*)p = v; }
__device__ __forceinline__ void st8(void* p, const uint2 v) { typedef unsigned u32x2 __attribute__((ext_vector_type(2))); const u32x2 w = {v.x, v.y}; if (EPI_NT) __builtin_nontemporal_store(w, (u32x2*)p); else *(u32x2*)p = w; }
__device__ __forceinline__ void unpack8(const u32x4 w, f32x4& v0, f32x4& v1) {
    v0[0] = __uint_as_float(w.x << 16); v0[1] = __uint_as_float(w.x & 0xffff0000u); v0[2] = __uint_as_float(w.y << 16); v0[3] = __uint_as_float(w.y & 0xffff0000u);
    v1[0] = __uint_as_float(w.z << 16); v1[1] = __uint_as_float(w.z & 0xffff0000u); v1[2] = __uint_as_float(w.w << 16); v1[3] = __uint_as_float(w.w & 0xffff0000u); }
__device__ __forceinline__ f32x2 gelu_pk(f32x2 v) {
    const f32x2 av = __builtin_elementwise_abs(v), d = av * 0.2316418882f + 1.0f;
    f32x2 t; t.x = __builtin_amdgcn_rcpf(d.x); t.y = __builtin_amdgcn_rcpf(d.y);
    f32x2 q = t * 0.5307027145f + (-0.7265760135f); q = q * t + 0.7107068705f; q = q * t + (-0.142248368f); q = q * t + 0.127414796f; q = q * t;
    const f32x2 s = (v * v) * (-0.72134752044f);
    f32x2 e; e.x = __builtin_amdgcn_exp2f(s.x); e.y = __builtin_amdgcn_exp2f(s.y);
    const f32x2 m = v * (q * e), r = v - m;
    f32x2 o; o.x = v.x < 0.f ? m.x : r.x; o.y = v.y < 0.f ? m.y : r.y; return o;
}
__device__ __forceinline__ f32x4 gelu4(f32x4 v) { const f32x2 a = gelu_pk((f32x2){v[0], v[1]}), b = gelu_pk((f32x2){v[2], v[3]}); return (f32x4){a.x, a.y, b.x, b.y}; }
__device__ __forceinline__ float sigm(float v) { return __builtin_amdgcn_rcpf(1.0f + __builtin_amdgcn_exp2f(v * -1.4426950408889634f)); }
__device__ __forceinline__ f32x4 sigm4(f32x4 v) { return (f32x4){sigm(v[0]), sigm(v[1]), sigm(v[2]), sigm(v[3])}; }

template <class Pol>
__device__ __forceinline__ void gemm_run(LAS unsigned char* lds, const Pol& P) {
    constexpr int KB = Pol::FP8 ? Pol::K : Pol::K * 2, nt = KB / (BK * 2);
    const int tid = threadIdx.x, wid = __builtin_amdgcn_readfirstlane(tid >> 6), lane = tid & 63, wr = wid >> 2, wc = wid & 3, fr = lane & 15, fq = lane >> 4;
    unsigned voffA[2], voffB[2]; int Rr[2], Cc[2];
#pragma unroll
    for (int i = 0; i < 2; ++i) { int R, C; stage_rc(tid * 16 + i * 8192, R, C); Rr[i] = R; Cc[i] = C; const int Rb = (R & ~31) + perm32(R & 31);
        voffA[i] = (unsigned)(R * KB + C * 2); voffB[i] = (unsigned)(Rb * KB + C * 2); }
    constexpr unsigned kstep = BK * 2, hstep = HALF * KB;
    const unsigned ldsw = (unsigned)wid * 1024u;
    const int aoff = lds_byte(wr * 64 + fr, fq * (Pol::FP8 ? 16 : 8)), boff = lds_byte(wc * 32 + fr, fq * (Pol::FP8 ? 16 : 8));
#define PG_SA(b, h) (((b) * 2 + (h)) * HTB)
#define PG_SB(b, h) ((4 + (b) * 2 + (h)) * HTB)
#define PG_AOFF(nx, h, i) (Pol::GATHER ? gC[h][i] : (voffA[i] + (unsigned)(h) * hstep))
#define PG_STAGE_A(bufoff, gbase, nx, h) do { _Pragma("unroll") for (int _i = 0; _i < 2; ++_i) \
        __builtin_amdgcn_global_load_lds((const unsigned*)((const char*)(gbase) + PG_AOFF(nx, h, _i)), (LAS unsigned*)(lds + (bufoff) + ldsw + _i * 8192), 16, 0, 0); } while (0)
#define PG_STAGE_B(bufoff, gbase) do { _Pragma("unroll") for (int _i = 0; _i < 2; ++_i) \
        __builtin_amdgcn_global_load_lds((const unsigned*)((const char*)(gbase) + voffB[_i]), (LAS unsigned*)(lds + (bufoff) + ldsw + _i * 8192), 16, 0, 0); } while (0)
#define PG_LD32(p) ({ const i32x4 _lo = *(const LAS i32x4*)(p), _hi = *(const LAS i32x4*)((p) + 16); (i32x8){_lo[0], _lo[1], _lo[2], _lo[3], _hi[0], _hi[1], _hi[2], _hi[3]}; })
#define PG_LDA(dst, b, h) do { if constexpr (Pol::FP8) { _Pragma("unroll") for (int m = 0; m < 4; ++m) dst##_8[m] = PG_LD32(lds + PG_SA(b, h) + aoff + m * 2048); } \
        else { _Pragma("unroll") for (int m = 0; m < 4; ++m) _Pragma("unroll") for (int k = 0; k < 2; ++k) dst[m][k] = *(const LAS bf16x8*)(lds + PG_SA(b, h) + aoff + m * 2048 + k * 1024); } } while (0)
#define PG_LDB(dst, b, h) do { if constexpr (Pol::FP8) { _Pragma("unroll") for (int n = 0; n < 2; ++n) dst##_8[n] = PG_LD32(lds + PG_SB(b, h) + boff + n * 2048); } \
        else { _Pragma("unroll") for (int n = 0; n < 2; ++n) _Pragma("unroll") for (int k = 0; k < 2; ++k) dst[n][k] = *(const LAS bf16x8*)(lds + PG_SB(b, h) + boff + n * 2048 + k * 1024); } } while (0)
#define PG_MMA(ai, bj, At, Bt) do { __builtin_amdgcn_s_setprio(1); \
        if constexpr (Pol::FP8) { _Pragma("unroll") for (int m = 0; m < 4; ++m) _Pragma("unroll") for (int n = 0; n < 2; ++n) \
            acc[ai][bj][m][n] = __builtin_amdgcn_mfma_scale_f32_16x16x128_f8f6f4(Bt##_8[n], At##_8[m], acc[ai][bj][m][n], 0, 0, 0, 0x7F7F7F7F, 0, 0x7F7F7F7F); } \
        else { _Pragma("unroll") for (int m = 0; m < 4; ++m) _Pragma("unroll") for (int n = 0; n < 2; ++n) _Pragma("unroll") for (int k = 0; k < 2; ++k) \
            acc[ai][bj][m][n] = __builtin_amdgcn_mfma_f32_16x16x32_bf16(Bt[n][k], At[m][k], acc[ai][bj][m][n], 0, 0, 0); } \
        __builtin_amdgcn_s_setprio(0); } while (0)
#define PG_WAIT_V(n) asm volatile("s_waitcnt vmcnt(" #n ")" ::: "memory")
#define PG_WAIT_L(n) asm volatile("s_waitcnt lgkmcnt(" #n ")" ::: "memory")
#define PG_BAR __builtin_amdgcn_s_barrier()
#define PG_SCHED __builtin_amdgcn_sched_barrier(0)
    Unit cur, nxt; int ui = 0;
    if (!P.next(0, cur)) return;
    f32x4 acc[2][2][4][2];
#pragma unroll
    for (int a = 0; a < 2; ++a)
#pragma unroll
        for (int b = 0; b < 2; ++b)
#pragma unroll
            for (int m = 0; m < 4; ++m)
#pragma unroll
                for (int n = 0; n < 2; ++n) acc[a][b][m][n] = (f32x4){0.f, 0.f, 0.f, 0.f};
    bf16x8 At[4][2], B0[2][2], B1[2][2];
    i32x8 At_8[4], B0_8[2], B1_8[2];
    unsigned gC[2][2] = {{0u, 0u}, {0u, 0u}};
    const char* cA = P.a_base(cur); const char* cB = P.b_base(cur);
    if constexpr (Pol::ROWTAB) { P.tab_issue(cur, 0); asm volatile("s_waitcnt vmcnt(0)" ::: "memory"); __builtin_amdgcn_s_barrier(); asm volatile("" ::: "memory"); }
    if constexpr (Pol::GATHER) P.a_offsets(cur, Rr, Cc, gC, 0);
    PG_STAGE_B(PG_SB(0, 0), cB); PG_STAGE_B(PG_SB(0, 1), cB + hstep); PG_STAGE_A(PG_SA(0, 0), cA, false, 0); PG_STAGE_A(PG_SA(0, 1), cA, false, 1);
    if (wr == 1) PG_BAR;
    PG_WAIT_V(2); PG_BAR;
    PG_STAGE_B(PG_SB(1, 0), cB + kstep); PG_STAGE_A(PG_SA(1, 0), cA + kstep, false, 0); PG_STAGE_B(PG_SB(1, 1), cB + hstep + kstep);
    PG_WAIT_V(6); PG_BAR;
    for (;;) {
        const bool has_next = P.next(ui + 1, nxt);
        const char* nA = has_next ? P.a_base(nxt) : cA; const char* nB = has_next ? P.b_base(nxt) : cB;
#pragma nounroll
        for (int t = 0; t < nt; t += 2) {
            const bool last = (t == nt - 2);
            if constexpr (Pol::ROWTAB) { if (t == 2 && has_next) P.tab_issue(nxt, (ui + 1) & 1); }
            if constexpr (Pol::HOOK) { if (t == Pol::H1 || t == Pol::H2) P.khook(t, acc, cur, wr, wc, fr, fq); }
            const char* a1 = cA + (size_t)(t + 1) * kstep;
            const char* a2 = last ? nA : cA + (size_t)(t + 2) * kstep; const char* b2 = last ? nB : cB + (size_t)(t + 2) * kstep;
            const char* a3 = a2 + kstep; const char* b3 = b2 + kstep;
            PG_LDB(B0, 0, 0); PG_LDB(B1, 0, 1); PG_SCHED; PG_LDA(At, 0, 0); PG_STAGE_A(PG_SA(1, 1), a1, false, 1);
            if constexpr (Pol::GATHER) { if (last && has_next) P.a_offsets(nxt, Rr, Cc, gC, (ui + 1) & 1); }
            PG_WAIT_V(8); PG_WAIT_L(0); PG_BAR; PG_MMA(0, 0, At, B0); PG_MMA(0, 1, At, B1); PG_BAR; PG_SCHED;
            PG_LDA(At, 0, 1); PG_STAGE_B(PG_SB(0, 0), b2); PG_STAGE_B(PG_SB(0, 1), b2 + hstep); PG_STAGE_A(PG_SA(0, 0), a2, last, 0);
            PG_WAIT_V(8); PG_WAIT_L(0); PG_BAR; PG_MMA(1, 0, At, B0); PG_MMA(1, 1, At, B1); PG_BAR; PG_SCHED;
            PG_LDB(B0, 1, 0); PG_LDB(B1, 1, 1); PG_SCHED; PG_LDA(At, 1, 0); PG_STAGE_A(PG_SA(0, 1), a2, last, 1);
            PG_WAIT_V(8); PG_WAIT_L(0); PG_BAR; PG_MMA(0, 0, At, B0); PG_MMA(0, 1, At, B1); PG_BAR; PG_SCHED;
            PG_LDA(At, 1, 1); PG_STAGE_B(PG_SB(1, 0), b3); PG_STAGE_B(PG_SB(1, 1), b3 + hstep); PG_STAGE_A(PG_SA(1, 0), a3, last, 0);
            PG_WAIT_V(8); PG_WAIT_L(0); PG_BAR; PG_MMA(1, 0, At, B0); PG_MMA(1, 1, At, B1); PG_BAR; PG_SCHED;
        }
        if constexpr (PG_ALIGN) { if (wr == 0) PG_BAR; }
        P.epi(acc, cur, wr, wc, fr, fq, ui & 1);
#ifdef DUP_EPI
        if (Pol::K == DUP_EPI_K) { asm volatile("" ::: "memory"); P.epi(acc, cur, wr, wc, fr, fq, ui & 1); }
#endif
        if (!has_next) break;
#pragma unroll
        for (int a = 0; a < 2; ++a)
#pragma unroll
            for (int b = 0; b < 2; ++b)
#pragma unroll
                for (int m = 0; m < 4; ++m)
#pragma unroll
                    for (int n = 0; n < 2; ++n) acc[a][b][m][n] = (f32x4){0.f, 0.f, 0.f, 0.f};
        cur = nxt; cA = nA; cB = nB; ++ui;
        if constexpr (PG_ALIGN) { if (wr == 1) PG_BAR; }
    }
    PG_WAIT_V(0);
    if constexpr (!PG_ALIGN) { if (wr == 0) PG_BAR; }
    PG_BAR;
#undef PG_SA
#undef PG_SB
#undef PG_AOFF
#undef PG_STAGE_A
#undef PG_STAGE_B
#undef PG_LDA
#undef PG_LD32
#undef PG_LDB
#undef PG_MMA
#undef PG_WAIT_V
#undef PG_WAIT_L
#undef PG_BAR
#undef PG_SCHED
}

__device__ __forceinline__ void glds4_asm(const void* gsrc, unsigned lds_dst) { unsigned keep;
    asm volatile("s_mov_b32 %0, m0\n\ts_mov_b32 m0, %2\n\ts_nop 0\n\tglobal_load_lds_dword %1, off\n\ts_mov_b32 m0, %0" : "=&s"(keep) : "v"(gsrc), "s"(lds_dst) : "memory"); }
__device__ __forceinline__ void glds16_asm(const void* gsrc, unsigned lds_dst) { unsigned keep;
    asm volatile("s_mov_b32 %0, m0\n\ts_mov_b32 m0, %2\n\ts_nop 0\n\tglobal_load_lds_dwordx4 %1, off\n\ts_mov_b32 m0, %0" : "=&s"(keep) : "v"(gsrc), "s"(lds_dst) : "memory"); }
struct PolBase { static constexpr bool GATHER = false, HOOK = false, FP8 = false, ROWTAB = false;
    __device__ __forceinline__ void tab_issue(const Unit&, int) const {} static constexpr int H1 = -1, H2 = -1;
    __device__ __forceinline__ void a_offsets(const Unit&, const int (&)[2], const int (&)[2], unsigned (&)[2][2], int) const {}
    __device__ __forceinline__ void khook(int, f32x4 (&)[2][2][4][2], const Unit&, int, int, int, int) const {} };

constexpr int GQ_OFF = OFF_G * 2;
__device__ __forceinline__ void gq_unpack(const uint2 w, f32x4& g0, f32x4& g1) {
    g0 = (f32x4){(float)(w.x & 0xffu), (float)((w.x >> 8) & 0xffu), (float)((w.x >> 16) & 0xffu), (float)(w.x >> 24)} * (1.0f / 256.0f) + (0.5f / 256.0f);
    g1 = (f32x4){(float)(w.y & 0xffu), (float)((w.y >> 8) & 0xffu), (float)((w.y >> 16) & 0xffu), (float)(w.y >> 24)} * (1.0f / 256.0f) + (0.5f / 256.0f); }
#ifndef P1_FP8_TILES
#define P1_FP8_TILES 0xFFFF0Cu
#endif
static_assert((P1_FP8_TILES & 0xF0u) == 0u, "the q_b / k_b tiles (head rmsnorm, block selection) stay bf16");
static_assert((P1_FP8_TILES & 0xFFF000u) == 0xFFF000u, "the gate tiles are written (as 8-bit codes) by the fp8 policy only");
static_assert((P1_FP8_TILES | 0xFFu) == 0xFFFFFFu, "bf16 weight rows are only prepared for column tiles 0..7");
constexpr int p1_popc(unsigned m) { int n = 0; for (int t = 0; t < 24; ++t) n += (m >> t) & 1u; return n; }
constexpr int P1_NF8 = p1_popc(P1_FP8_TILES), P1_NBF = 24 - P1_NF8;
__device__ __forceinline__ int p1_tile(unsigned mask, int j) { int t = 0;
    for (; t < 24; ++t) if ((mask >> t) & 1u) { if (j == 0) break; --j; }
    return t; }
struct PolP1 : PolBase {
    static constexpr int K = 1024;
    const bf16_t* A; const bf16_t* Bt; bf16_t* PROJ; float* KMP; const float* gq; const float* gk; int G, c;
    __device__ __forceinline__ bool next(int i, Unit& u) const { u.e = 0; u.mt = 0; if (!static_unit((long)i * G + c, T_TOK / 256, P1_NBF, u.pm, u.pn)) return false; u.pn = p1_tile(P1_FP8_TILES ^ 0xFFFFFFu, u.pn); return true; }
    __device__ __forceinline__ const char* a_base(const Unit& u) const { return (const char*)A + (size_t)u.pm * 256 * K * 2; }
    __device__ __forceinline__ const char* b_base(const Unit& u) const { return (const char*)Bt + (size_t)u.pn * 256 * K * 2; }
    __device__ __forceinline__ void epi(const f32x4 (&acc)[2][2][4][2], const Unit& u, int wr, int wc, int fr, int fq, int) const {
        const int row0 = u.pm * 256 + wr * 64 + fr, pn = u.pn;
        if (pn >= 4 && pn < 8) {
            const float* g = (pn < 6) ? gq : gk;
            f32x4 gv[2][2], cs[2][2];
#pragma unroll
            for (int bj = 0; bj < 2; ++bj)
#pragma unroll
                for (int n = 0; n < 2; ++n) { gv[bj][n] = *(const f32x4*)(g + 32 * bj + 8 * fq + 4 * n); cs[bj][n] = (f32x4){0.f, 0.f, 0.f, 0.f}; }
#pragma unroll
            for (int ai = 0; ai < 2; ++ai)
#pragma unroll
                for (int m = 0; m < 4; ++m) {
                    float ss = 0.f;
#pragma unroll
                    for (int bj = 0; bj < 2; ++bj)
#pragma unroll
                        for (int n = 0; n < 2; ++n) { const f32x4 x = acc[ai][bj][m][n]; ss += (x[0] * x[0] + x[1] * x[1]) + (x[2] * x[2] + x[3] * x[3]); }
                    ss += __shfl_xor(ss, 16); ss += __shfl_xor(ss, 32);
                    const float rstd = rsqrtf(ss * (1.0f / 64.0f) + EPS) * ((pn < 6) ? 0.18033688011112042f : 1.0f);
                    bf16_t* rowp = PROJ + (size_t)(row0 + ai * HALF + m * 16) * INW + 1024 + (pn - 4) * 256 + 64 * wc + 8 * fq;
#pragma unroll
                    for (int bj = 0; bj < 2; ++bj) { const f32x4 v0 = acc[ai][bj][m][0] * rstd * gv[bj][0], v1 = acc[ai][bj][m][1] * rstd * gv[bj][1];
                        cs[bj][0] += v0; cs[bj][1] += v1; st16(rowp + 32 * bj, pack8(v0, v1)); }
                }
            if (pn >= 6) {
#pragma unroll
                for (int bj = 0; bj < 2; ++bj)
#pragma unroll
                    for (int n = 0; n < 2; ++n)
#pragma unroll
                        for (int j = 0; j < 4; ++j) { float s = cs[bj][n][j]; s += __shfl_xor(s, 1); s += __shfl_xor(s, 2); s += __shfl_xor(s, 4); s += __shfl_xor(s, 8); cs[bj][n][j] = s; }
                if (fr == 0) {
                    float* kp = KMP + ((size_t)u.pm * 2 + wr) * 512 + (pn - 6) * 256 + 64 * wc + 8 * fq;
#pragma unroll
                    for (int bj = 0; bj < 2; ++bj) { *(f32x4*)(kp + 32 * bj) = cs[bj][0]; *(f32x4*)(kp + 32 * bj + 4) = cs[bj][1]; }
                }
            }
        } else {
            const int col0 = pn * 256 + wc * 32 + 8 * fq;
#pragma unroll
            for (int ai = 0; ai < 2; ++ai)
#pragma unroll
                for (int m = 0; m < 4; ++m) { bf16_t* rowp = PROJ + (size_t)(row0 + ai * HALF + m * 16) * INW + col0;
#pragma unroll
                    for (int bj = 0; bj < 2; ++bj) { f32x4 v0 = acc[ai][bj][m][0], v1 = acc[ai][bj][m][1];
                        if (pn < 4) { v0 = gelu4(v0); v1 = gelu4(v1); } else if (pn >= 12) { v0 = sigm4(v0); v1 = sigm4(v1); }
                        st16(rowp + bj * HALF, pack8(v0, v1)); } }
        }
    }
};

struct PolP1G : PolBase {
    static constexpr int K = 1024; static constexpr bool FP8 = true, GATHER = true;
    const unsigned char* A; const unsigned char* Bt; bf16_t* PROJ; int G, c;
    __device__ __forceinline__ bool next(int i, Unit& u) const { u.e = 0; u.mt = 0; constexpr int NU = T_TOK / 256 * P1_NF8; long L = (long)i * G + c;
        if (G == 256 && NU % 256 == 0 && NU / 256 >= 2) { constexpr int R = NU / 256; if (i < R - 1) L = (long)i * 256 + c; else if (c >= 128 && i < R + 1) L = (long)(R - 1) * 256 + (i - (R - 1)) * 128 + (c - 128); else return false; }
        if (!static_unit(L, T_TOK / 256, P1_NF8, u.pm, u.pn)) return false; u.pn = p1_tile(P1_FP8_TILES, u.pn); return true; }
    __device__ __forceinline__ const char* a_base(const Unit&) const { return (const char*)A; }
    __device__ __forceinline__ const char* b_base(const Unit& u) const { return (const char*)Bt + (size_t)u.pn * 256 * K; }
    __device__ __forceinline__ void a_offsets(const Unit& u, const int (&Rr)[2], const int (&Cc)[2], unsigned (&g)[2][2], int) const {
#pragma unroll
        for (int h = 0; h < 2; ++h)
#pragma unroll
            for (int i = 0; i < 2; ++i) g[h][i] = (unsigned)(u.pm * 256 + h * HALF + Rr[i]) * (unsigned)K + (unsigned)Cc[i] * 2u;
    }
    __device__ __forceinline__ void epi(const f32x4 (&acc)[2][2][4][2], const Unit& u, int wr, int wc, int fr, int fq, int) const {
        const int row0 = u.pm * 256 + wr * 64 + fr, pn = u.pn, col0 = pn * 256 + wc * 32 + 8 * fq;
        if (pn >= 12) {
#pragma unroll
            for (int ai = 0; ai < 2; ++ai)
#pragma unroll
                for (int m = 0; m < 4; ++m) { unsigned char* rowq = (unsigned char*)PROJ + (size_t)(row0 + ai * HALF + m * 16) * (INW * 2) + GQ_OFF + (col0 - OFF_G);
#pragma unroll
                    for (int bj = 0; bj < 2; ++bj) { unsigned w[2] = {0u, 0u};
#pragma unroll
                        for (int n = 0; n < 2; ++n)
#pragma unroll
                            for (int j = 0; j < 4; ++j) { const float g = __builtin_amdgcn_rcpf(1.0f + __builtin_amdgcn_exp2f(acc[ai][bj][m][n][j] * (-1.4426950408889634f * WQ_INV)));
                                w[n] = __builtin_amdgcn_cvt_pk_u8_f32(__builtin_floorf(g * 256.0f), j, w[n]); }
                        st8(rowq + bj * HALF, make_uint2(w[0], w[1])); } }
        } else {
#pragma unroll
            for (int ai = 0; ai < 2; ++ai)
#pragma unroll
                for (int m = 0; m < 4; ++m) { bf16_t* rowp = PROJ + (size_t)(row0 + ai * HALF + m * 16) * INW + col0;
#pragma unroll
                    for (int bj = 0; bj < 2; ++bj) { f32x4 v0 = acc[ai][bj][m][0] * WQ_INV, v1 = acc[ai][bj][m][1] * WQ_INV;
                        if (pn < 4) { v0 = gelu4(v0); v1 = gelu4(v1); }
                        st16(rowp + bj * HALF, pack8(v0, v1)); } }
        }
    }
};
struct PolP3 : PolBase {
    static constexpr int K = 1536; static constexpr bool HOOK = true; static constexpr int H1 = 8, H2 = 16;
    const bf16_t* A; const bf16_t* Bt; const bf16_t* PROJ; bf16_t* MERGED; int G, c;
    __device__ __forceinline__ bool next(int i, Unit& u) const { u.e = 0; u.mt = 0; return static_unit((long)i * G + c, T_TOK / 256, DM / 256, u.pm, u.pn); }
    __device__ __forceinline__ const char* a_base(const Unit& u) const { return (const char*)A + (size_t)u.pm * 256 * K * 2; }
    __device__ __forceinline__ const char* b_base(const Unit& u) const { return (const char*)Bt + (size_t)u.pn * 256 * K * 2; }
    __device__ __forceinline__ void khook(int t, f32x4 (&acc)[2][2][4][2], const Unit& u, int wr, int wc, int fr, int fq) const {
        const int gnum = (t == 8) ? 0 : 1024;
        int zero = 0; asm volatile("" : "+v"(zero));
        const int row0 = u.pm * 256 + wr * 64 + fr + zero, col0 = GQ_OFF + u.pn * 256 + wc * 32 + 8 * fq;
#pragma unroll
        for (int ai = 0; ai < 2; ++ai) {
            uint2 wn[4][2], wd[4][2];
#pragma unroll
            for (int m = 0; m < 4; ++m) { const unsigned char* rowp = (const unsigned char*)PROJ + (size_t)(row0 + ai * HALF + m * 16) * (INW * 2) + col0;
#pragma unroll
                for (int bj = 0; bj < 2; ++bj) { wn[m][bj] = *(const uint2*)(rowp + gnum + bj * HALF); wd[m][bj] = *(const uint2*)(rowp + gnum + 1024 + bj * HALF); } }
#pragma unroll
            for (int m = 0; m < 4; ++m)
#pragma unroll
                for (int bj = 0; bj < 2; ++bj) { f32x4 n0, n1, d0, d1; gq_unpack(wn[m][bj], n0, n1); gq_unpack(wd[m][bj], d0, d1);
#pragma unroll
                    for (int j = 0; j < 4; ++j) { acc[ai][bj][m][0][j] *= n0[j] * __builtin_amdgcn_rcpf(d0[j]); acc[ai][bj][m][1][j] *= n1[j] * __builtin_amdgcn_rcpf(d1[j]); } }
            asm volatile("" ::: "memory");
        }
    }
    __device__ __forceinline__ void epi(const f32x4 (&acc)[2][2][4][2], const Unit& u, int wr, int wc, int fr, int fq, int) const {
        const int row0 = u.pm * 256 + wr * 64 + fr, colt = u.pn * 256 + wc * 32 + 8 * fq;
#pragma unroll
        for (int ai = 0; ai < 2; ++ai)
#pragma unroll
            for (int m = 0; m < 4; ++m) { const size_t r = (size_t)(row0 + ai * HALF + m * 16);
#pragma unroll
                for (int bj = 0; bj < 2; ++bj) { const uint2 wg = *(const uint2*)((const unsigned char*)PROJ + r * (INW * 2) + GQ_OFF + 2048 + colt + bj * HALF); f32x4 g0, g1; gq_unpack(wg, g0, g1);
                    st16(MERGED + r * DM + colt + bj * HALF, pack8(acc[ai][bj][m][0] * g0, acc[ai][bj][m][1] * g1)); }
                if (m == 3) asm volatile("" ::: "memory"); }
    }
};
struct PolP4 : PolBase {
    static constexpr int K = 1024;
    const bf16_t* A; const bf16_t* Bt; const float* x; bf16_t* X1H; unsigned char* X1Q; const float* gffn; int G, c;
    __device__ __forceinline__ bool next(int i, Unit& u) const { u.e = 0; u.mt = 0; return static_unit((long)i * G + c, T_TOK / 256, DM / 256, u.pm, u.pn); }
    __device__ __forceinline__ const char* a_base(const Unit& u) const { return (const char*)A + (size_t)u.pm * 256 * K * 2; }
    __device__ __forceinline__ const char* b_base(const Unit& u) const { return (const char*)Bt + (size_t)u.pn * 256 * K * 2; }
    __device__ __forceinline__ void epi(const f32x4 (&acc)[2][2][4][2], const Unit& u, int wr, int wc, int fr, int fq, int) const {
        const int row0 = u.pm * 256 + wr * 64 + fr, colt = u.pn * 256 + wc * 32 + 8 * fq;
#pragma unroll
        for (int ai = 0; ai < 2; ++ai)
#pragma unroll
            for (int m = 0; m < 4; ++m) { const size_t o = (size_t)(row0 + ai * HALF + m * 16) * DM + colt;
#pragma unroll
                for (int bj = 0; bj < 2; ++bj) { const f32x4 x0 = *(const f32x4*)(x + o + bj * HALF), x1 = *(const f32x4*)(x + o + bj * HALF + 4);
                    const f32x4 v0 = x0 + acc[ai][bj][m][0], v1 = x1 + acc[ai][bj][m][1];
                    st16(X1H + o + bj * HALF, pack8(v0, v1));
                    const f32x4 g0 = *(const f32x4*)(gffn + colt + bj * HALF), g1 = *(const f32x4*)(gffn + colt + bj * HALF + 4);
                    st8(X1Q + o + bj * HALF, pack8_fp8(v0 * g0, v1 * g1)); }
                if (m & 1) asm volatile("" ::: "memory"); }
    }
};
struct GroupTab { const LAS int* tab; __device__ __forceinline__ int cnt(int e) const { return tab[TAB_CNT + e]; } __device__ __forceinline__ int tstart(int e) const { return tab[TAB_TST + e]; }
    __device__ __forceinline__ int tile_e(int vt) const { return tab[TAB_TE + vt]; } __device__ __forceinline__ int NT() const { return tab[TAB_TST + 32]; } };
struct PolP6 : PolBase {
    static constexpr int K = 1024; static constexpr bool GATHER = true, FP8 = true, ROWTAB = true;
    const unsigned char* X1Q; const unsigned char* W1Q; const int* LIST; const float* RSTDS; const float* b1; unsigned char* ACTQ; GroupTab tb; int G, c; LAS unsigned char* rtab;
    __device__ __forceinline__ void tab_issue(const Unit& u, int buf) const {
        const int tid = threadIdx.x;
        if (tid < 256) { const int valid = tb.cnt(u.e) - u.mt * 256, rc = tid < valid ? tid : 0; const size_t o = (size_t)u.e * 32768 + u.mt * 256 + rc;
            const unsigned dst = (unsigned)__builtin_amdgcn_readfirstlane((int)((unsigned)(size_t)rtab + buf * RT_STRIDE + (tid & ~63) * 4));
            glds4_asm(LIST + o, dst); glds4_asm(RSTDS + o, dst + 1024u);
            glds4_asm(b1 + (size_t)u.e * 2048 + u.pn * 128 + (tid < 128 ? tid : 1024 + (tid - 128)), dst + 2048u); }
    }
    __device__ __forceinline__ bool next(int i, Unit& u) const { if (!static_unit((long)i * G + c, tb.NT(), 8, u.pm, u.pn)) return false; u.e = tb.tile_e(u.pm); u.mt = u.pm - tb.tstart(u.e); return true; }
    __device__ __forceinline__ const char* a_base(const Unit&) const { return (const char*)X1Q; }
    __device__ __forceinline__ const char* b_base(const Unit& u) const { return (const char*)W1Q + ((size_t)u.e * 2048 + (size_t)u.pn * 256) * K; }
    __device__ __forceinline__ void a_offsets(const Unit&, const int (&Rr)[2], const int (&Cc)[2], unsigned (&g)[2][2], int buf) const {
        const LAS int* lp = (const LAS int*)(rtab + buf * RT_STRIDE);
#pragma unroll
        for (int h = 0; h < 2; ++h)
#pragma unroll
            for (int i = 0; i < 2; ++i) { const int tok = lp[h * HALF + Rr[i]] >> 2; g[h][i] = (unsigned)tok * (unsigned)K + (unsigned)Cc[i] * 2u; }
    }
    __device__ __forceinline__ void epi(const f32x4 (&acc)[2][2][4][2], const Unit& u, int wr, int wc, int fr, int fq, int buf) const {
        int zero = 0; asm volatile("" : "+v"(zero)); fr += zero;
        const int valid = tb.cnt(u.e) - u.mt * 256, colg = u.pn * 128 + wc * 32 + 8 * fq;
        const LAS float* rp = (const LAS float*)(rtab + buf * RT_STRIDE + 1024); const LAS float* bp = (const LAS float*)(rtab + buf * RT_STRIDE + 2048) + wc * 32 + 8 * fq;
        const f32x4 bg0 = *(const LAS f32x4*)bp, bg1 = *(const LAS f32x4*)(bp + 4), bl0 = *(const LAS f32x4*)(bp + 128), bl1 = *(const LAS f32x4*)(bp + 132);
        float rsv[8];
#pragma unroll
        for (int i = 0; i < 8; ++i) rsv[i] = rp[(i >> 2) * HALF + wr * 64 + (i & 3) * 16 + fr];
#pragma unroll
        for (int i = 0; i < 8; ++i) { const int ai = i >> 2, m = i & 3, r = ai * HALF + wr * 64 + m * 16 + fr; const float rs = (r < valid) ? rsv[i] * WQ_INV : 0.f;
            f32x4 o[2];
#pragma unroll
            for (int n = 0; n < 2; ++n) { const f32x4 gv = acc[ai][0][m][n] * rs + (n ? bg1 : bg0), lv = acc[ai][1][m][n] * rs + (n ? bl1 : bl0);
                f32x4 gg, ll, d;
#pragma unroll
                for (int j = 0; j < 4; ++j) { gg[j] = fminf(gv[j], 7.0f); ll[j] = __builtin_amdgcn_fmed3f(lv[j], -7.0f, 7.0f); }
                const f32x4 e = gg * (-1.702f * 1.4426950408889634f);
#pragma unroll
                for (int j = 0; j < 4; ++j) d[j] = __builtin_amdgcn_exp2f(e[j]);
                d = d + 1.0f;
#pragma unroll
                for (int j = 0; j < 4; ++j) d[j] = __builtin_amdgcn_rcpf(d[j]);
                const f32x4 t = gg * d;
                o[n] = t * ll + t; }
            st8(ACTQ + (size_t)(u.pm * 256 + r) * DFF + colg, pack8_fp8(o[0], o[1])); }
    }
};
struct PolP7 : PolBase {
    static constexpr int K = 1024; static constexpr bool FP8 = true, GATHER = true;
    const unsigned char* ACTQ; const unsigned char* W2Q; const int* LIST; const float* TOPWS; const float* b2; bf16_t* YS; GroupTab tb; int G, c; LAS unsigned char* rtab;
    static constexpr bool ROWTAB = true;
    __device__ __forceinline__ void tab_issue(const Unit& u, int buf) const {
        const int tid = threadIdx.x;
        if (tid < 256) { const int valid = tb.cnt(u.e) - u.mt * 256, rc = tid < valid ? tid : 0; const size_t o = (size_t)u.e * 32768 + u.mt * 256 + rc;
            const unsigned dst = (unsigned)__builtin_amdgcn_readfirstlane((int)((unsigned)(size_t)rtab + buf * RT_STRIDE + (tid & ~63) * 4));
            glds4_asm(LIST + o, dst); glds4_asm(TOPWS + o, dst + 1024u);
            glds4_asm(b2 + (size_t)u.e * 1024 + u.pn * 256 + tid, dst + 2048u); }
    }
    __device__ __forceinline__ bool next(int i, Unit& u) const { if (!static_unit((long)i * G + c, tb.NT(), 4, u.pm, u.pn)) return false; u.e = tb.tile_e(u.pm); u.mt = u.pm - tb.tstart(u.e); return true; }
    __device__ __forceinline__ const char* a_base(const Unit&) const { return (const char*)ACTQ; }
    __device__ __forceinline__ void a_offsets(const Unit& u, const int (&Rr)[2], const int (&Cc)[2], unsigned (&g)[2][2], int) const {
#pragma unroll
        for (int h = 0; h < 2; ++h)
#pragma unroll
            for (int i = 0; i < 2; ++i) g[h][i] = (unsigned)(u.pm * 256 + h * HALF + Rr[i]) * (unsigned)K + (unsigned)Cc[i] * 2u;
    }
    __device__ __forceinline__ const char* b_base(const Unit& u) const { return (const char*)W2Q + ((size_t)u.e * 1024 + (size_t)u.pn * 256) * K; }
    __device__ __forceinline__ void epi(const f32x4 (&acc)[2][2][4][2], const Unit& u, int wr, int wc, int fr, int fq, int buf) const {
        int zero = 0; asm volatile("" : "+v"(zero)); fr += zero;
        const int valid = tb.cnt(u.e) - u.mt * 256, colt = u.pn * 256 + wc * 32 + 8 * fq;
        const LAS float* bp = (const LAS float*)(rtab + buf * RT_STRIDE + 2048) + wc * 32 + 8 * fq; const LAS int* lp = (const LAS int*)(rtab + buf * RT_STRIDE); const LAS float* wp = (const LAS float*)(rtab + buf * RT_STRIDE + 1024);
        int slot[8]; float wv[8];
#pragma unroll
        for (int i = 0; i < 8; ++i) { const int r = (i >> 2) * HALF + wr * 64 + (i & 3) * 16 + fr; const bool ok = r < valid; const int rc = ok ? r : 0; const int sl = lp[rc]; wv[i] = wp[rc]; slot[i] = ok ? sl : -1; }
        f32x4 bv[2][2];
#pragma unroll
        for (int bj = 0; bj < 2; ++bj) { bv[bj][0] = *(const LAS f32x4*)(bp + bj * HALF); bv[bj][1] = *(const LAS f32x4*)(bp + bj * HALF + 4); }
#pragma unroll
        for (int i = 0; i < 8; ++i) { const int ai = i >> 2, m = i & 3;
            if (slot[i] >= 0) { const float w = wv[i] * YQ_SCALE, wq = w * WQ_INV;
#pragma unroll
                for (int bj = 0; bj < 2; ++bj) st8((unsigned char*)YS + (size_t)slot[i] * DM + colt + bj * HALF, pack8_fp8(acc[ai][bj][m][0] * wq + bv[bj][0] * w, acc[ai][bj][m][1] * wq + bv[bj][1] * w)); } }
    }
};
}

__device__ __forceinline__ void grouped_setup(LAS int* tab, const unsigned* cnt) {
    const int tid = threadIdx.x;
    if (tid < 32) tab[TAB_CNT + tid] = (int)__hip_atomic_load(cnt + tid, __ATOMIC_RELAXED, __HIP_MEMORY_SCOPE_AGENT);
    __syncthreads();
    if (tid == 0) { int s = 0; for (int e = 0; e < 32; ++e) { tab[TAB_TST + e] = s; s += (tab[TAB_CNT + e] + 255) >> 8; } tab[TAB_TST + 32] = s; }
    __syncthreads();
    const int NT = tab[TAB_TST + 32];
    for (int vt = tid; vt < NT; vt += NWAVES * 64) { int e = 0; for (int k = 1; k < 32; ++k) if (tab[TAB_TST + k] <= vt) e = k; tab[TAB_TE + vt] = e; }
    __syncthreads();
}

__device__ __forceinline__ void lds_fence() { asm volatile("s_waitcnt lgkmcnt(0)" ::: "memory"); }
template <int MAPK> __device__ __forceinline__ int p0_map(int n) {
    if (MAPK == 1) return (n >= 1024 && n < 2048) ? (n & ~255) + 128 * ((n >> 5) & 1) + 32 * ((n >> 6) & 3) + (n & 31) : n;
    if (MAPK == 2) { const int m = n & 1023; return (m >> 7) * 256 + (n >> 10) * 128 + (m & 127); }
    return n;
}
template <int MAPK, bool Q8 = false> __device__ __forceinline__ void p0_transpose_item(const float* W, int N, bf16_t* WT, int ldo, int koff, const float* gk, LAS float* scr, int item, int lane, int nblk_ = 0) {
    const int nblk = nblk_ ? nblk_ : N / 32, kb = item / nblk, nb = item % nblk, k0 = 64 * kb, n0 = 32 * nb;
    float tv[32];
#pragma unroll
    for (int i = 0; i < 32; ++i) tv[i] = __builtin_nontemporal_load(W + (size_t)(k0 + 2 * i + (lane >> 5)) * N + n0 + (lane & 31));
    if (gk) {
#pragma unroll
        for (int i = 0; i < 32; ++i) tv[i] *= gk[k0 + 2 * i + (lane >> 5)];
    }
#pragma unroll
    for (int i = 0; i < 32; ++i) scr[(2 * i + (lane >> 5)) * 33 + (lane & 31)] = tv[i];
    lds_fence();
    const int c8 = lane & 7;
#pragma unroll
    for (int j = 0; j < 4; ++j) { const int n = (lane >> 3) + 8 * j; const LAS float* s = scr + (8 * c8) * 33 + n;
        if constexpr (Q8) {
            const f32x4 a = (f32x4){s[0 * 33], s[1 * 33], s[2 * 33], s[3 * 33]} * pg::WQ_SCALE, b = (f32x4){s[4 * 33], s[5 * 33], s[6 * 33], s[7 * 33]} * pg::WQ_SCALE;
            *(uint2*)((unsigned char*)WT + (size_t)p0_map<MAPK>(n0 + n) * ldo + koff + k0 + 8 * c8) = pg::pack8_fp8(a, b);
        } else {
        u32x4 o; o.x = pg::cvt_pk_bf16(s[0 * 33], s[1 * 33]); o.y = pg::cvt_pk_bf16(s[2 * 33], s[3 * 33]); o.z = pg::cvt_pk_bf16(s[4 * 33], s[5 * 33]); o.w = pg::cvt_pk_bf16(s[6 * 33], s[7 * 33]);
        *(u32x4*)(WT + (size_t)p0_map<MAPK>(n0 + n) * ldo + koff + k0 + 8 * c8) = o; } }
    lds_fence();
}
__device__ __forceinline__ void p0_rmsnorm_row(const float* xrow, const float* g, bf16_t* orow, int lane) {
    const f32x4* xr = (const f32x4*)xrow;
    f32x4 v[4]; float s = 0.f;
#pragma unroll
    for (int j = 0; j < 4; ++j) { v[j] = xr[lane + 64 * j]; s += (v[j].x * v[j].x + v[j].y * v[j].y) + (v[j].z * v[j].z + v[j].w * v[j].w); }
    const float rstd = rsqrtf(wave_sum(s) * (1.0f / DM) + EPS);
#pragma unroll
    for (int j = 0; j < 4; ++j) { const f32x4 gv = ((const f32x4*)g)[lane + 64 * j];
        unsigned long long o = (unsigned long long)pg::cvt_pk_bf16(v[j].x * rstd * gv.x, v[j].y * rstd * gv.y) | ((unsigned long long)pg::cvt_pk_bf16(v[j].z * rstd * gv.z, v[j].w * rstd * gv.w) << 32);
        ((unsigned long long*)orow)[lane + 64 * j] = o; }
}
struct P0Args { const float *x, *mem, *g_mix, *g_mem, *w_in, *w_br0, *w_br1, *w_br2, *w_out, *w_mem_kv, *w_gate_up, *w_down, *g_ffn, *w_router, *w_spatial;
    bf16_t *HB, *MEMN, *WinT, *WbrT, *WoutT, *WmemT, *W1T, *W2T, *WSB; float* WrT; unsigned char *HBQ, *WINQ; };
__device__ __forceinline__ void p0_prologue(const P0Args a, LAS unsigned char* lds, int G, int c) {
    const int tid = threadIdx.x, lane = tid & 63, wave = __builtin_amdgcn_readfirstlane(tid >> 6);
    LAS float* scr = (LAS float*)(lds + wave * 16384);
    const int gw = c * NWAVES + wave, NGW = G * NWAVES;
    constexpr int I_IN = 16 * 64, I_G = 16 * 192, I_BR = 8 * 32, I_O = 16 * 32, I_1 = 16 * 64, I_2 = 16 * 32;
    constexpr int NITEMS = I_IN + I_G + 3 * I_BR + 2 * I_O;
    for (int it = gw; it < NITEMS; it += NGW) {
        int r = it;
        if (r < I_IN) { p0_transpose_item<1>(a.w_in, INW, a.WinT, DM, 0, nullptr, scr, r, lane, 64); continue; } r -= I_IN;
        if (r < I_G) { p0_transpose_item<0, true>(a.w_in, INW, (bf16_t*)a.WINQ, DM, 0, nullptr, scr, r, lane); continue; } r -= I_G;
        if (r < 3 * I_BR) { const int br = r / I_BR; const float* wsrc = (br == 0) ? a.w_br0 : (br == 1) ? a.w_br1 : a.w_br2; p0_transpose_item<0>(wsrc, DM, a.WbrT, 1536, br * 512, nullptr, scr, r - br * I_BR, lane); continue; } r -= 3 * I_BR;
        if (r < I_O) { p0_transpose_item<0>(a.w_out, DM, a.WoutT, DM, 0, nullptr, scr, r, lane); continue; } r -= I_O;
        p0_transpose_item<0>(a.w_mem_kv, DM, a.WmemT, DM, 0, nullptr, scr, r, lane);
    }
    for (int m = gw; m < T_TOK; m += 2 * NGW) {
        const int m2 = (m + NGW < T_TOK) ? m + NGW : m;
        const f32x4* xa = (const f32x4*)(a.x + (size_t)m * DM); const f32x4* xb = (const f32x4*)(a.x + (size_t)m2 * DM);
        f32x4 va[4], vb[4]; float sa = 0.f, sb = 0.f;
#pragma unroll
        for (int j = 0; j < 4; ++j) { va[j] = __builtin_nontemporal_load(xa + lane + 64 * j); vb[j] = __builtin_nontemporal_load(xb + lane + 64 * j); }
#pragma unroll
        for (int j = 0; j < 4; ++j) { sa += (va[j].x * va[j].x + va[j].y * va[j].y) + (va[j].z * va[j].z + va[j].w * va[j].w); sb += (vb[j].x * vb[j].x + vb[j].y * vb[j].y) + (vb[j].z * vb[j].z + vb[j].w * vb[j].w); }
        const float ra = rsqrtf(wave_sum(sa) * (1.0f / DM) + EPS), rb = rsqrtf(wave_sum(sb) * (1.0f / DM) + EPS);
#pragma unroll
        for (int j = 0; j < 4; ++j) { const f32x4 gv = ((const f32x4*)a.g_mix)[lane + 64 * j];
            ((unsigned long long*)(a.HB + (size_t)m * DM))[lane + 64 * j] = (unsigned long long)pg::cvt_pk_bf16(va[j].x * ra * gv.x, va[j].y * ra * gv.y) | ((unsigned long long)pg::cvt_pk_bf16(va[j].z * ra * gv.z, va[j].w * ra * gv.w) << 32);
            ((unsigned long long*)(a.HB + (size_t)m2 * DM))[lane + 64 * j] = (unsigned long long)pg::cvt_pk_bf16(vb[j].x * rb * gv.x, vb[j].y * rb * gv.y) | ((unsigned long long)pg::cvt_pk_bf16(vb[j].z * rb * gv.z, vb[j].w * rb * gv.w) << 32);
            { int qa = 0, qb = 0; qa = __builtin_amdgcn_cvt_pk_fp8_f32(va[j].x * ra * gv.x, va[j].y * ra * gv.y, qa, false); qa = __builtin_amdgcn_cvt_pk_fp8_f32(va[j].z * ra * gv.z, va[j].w * ra * gv.w, qa, true);
              qb = __builtin_amdgcn_cvt_pk_fp8_f32(vb[j].x * rb * gv.x, vb[j].y * rb * gv.y, qb, false); qb = __builtin_amdgcn_cvt_pk_fp8_f32(vb[j].z * rb * gv.z, vb[j].w * rb * gv.w, qb, true);
              ((int*)(a.HBQ + (size_t)m * DM))[lane + 64 * j] = qa; ((int*)(a.HBQ + (size_t)m2 * DM))[lane + 64 * j] = qb; } }
    }
    for (int m = gw; m < NBATCH * MEML; m += NGW) p0_rmsnorm_row(a.mem + (size_t)m * DM, a.g_mem, a.MEMN + (size_t)m * DM, lane);
    const int gt = c * NWAVES * 64 + tid, NGT = G * NWAVES * 64;
    for (int i = gt; i < 32 * 1024; i += NGT) { const int e = i >> 10, k = i & 1023; const float w = a.w_router[k * 32 + e] * a.g_ffn[k]; a.WrT[i] = w;
        bf16_t* pl = (bf16_t*)(a.WrT + 32 * 1024); const bf16_t hi = f2bf(w); pl[i] = hi; pl[32 * 1024 + i] = f2bf(w - __uint_as_float((unsigned)hi << 16)); }
    for (int i = gt; i < 4 * 128 * 128; i += NGT) { const int s = i & 127, t = (i >> 7) & 127; a.WSB[i] = (s <= t) ? f2bf(a.w_spatial[i]) : (bf16_t)0; }
}
__device__ __forceinline__ void p1_memkv(const bf16_t* MEMN, const bf16_t* WmemT, const float* gk, bf16_t* MKV, int G, int c, LAS unsigned char* lds) {
    int tid_ = threadIdx.x; asm volatile("" : "+v"(tid_));
    const int tid = tid_, lane = tid & 63, wave = __builtin_amdgcn_readfirstlane(tid >> 6), fr = lane & 15, fq = lane >> 4;
    constexpr int LDB = 72;
    for (int unit = c; unit < 128; unit += G) {
        const int rt = unit >> 3, ct = unit & 7;
        f32x4 acc[8];
#pragma unroll
        for (int j = 0; j < 8; ++j) acc[j] = (f32x4){0.f, 0.f, 0.f, 0.f};
        const bf16_t* ap = MEMN + (size_t)(rt * 128 + wave * 16 + fr) * DM + fq * 8;
        const bf16_t* bsrc = WmemT + (size_t)(ct * 128 + (tid >> 3)) * DM + (tid & 7) * 8;
        const int bdst = ((tid >> 3) * LDB + (tid & 7) * 8) * 2;
        u32x4 r0 = *(const u32x4*)bsrc, r1 = *(const u32x4*)(bsrc + (size_t)64 * DM);
        __syncthreads();
        *(LAS u32x4*)(lds + bdst) = r0; *(LAS u32x4*)(lds + bdst + 64 * LDB * 2) = r1;
        __syncthreads();
#pragma nounroll
        for (int kc = 0; kc < 16; ++kc) {
            const int buf = (kc & 1) * (128 * LDB * 2);
            if (kc + 1 < 16) { r0 = *(const u32x4*)(bsrc + (kc + 1) * 64); r1 = *(const u32x4*)(bsrc + (size_t)64 * DM + (kc + 1) * 64); }
#pragma unroll
            for (int ks = 0; ks < 2; ++ks) { const bf16x8 af = *(const bf16x8*)(ap + kc * 64 + ks * 32);
#pragma unroll
                for (int j = 0; j < 8; ++j) { const bf16x8 bf = *(const LAS bf16x8*)(lds + buf + ((16 * j + fr) * LDB + ks * 32 + fq * 8) * 2); acc[j] = __builtin_amdgcn_mfma_f32_16x16x32_bf16(af, bf, acc[j], 0, 0, 0); } }
            if (kc + 1 < 16) { *(LAS u32x4*)(lds + (buf ^ (128 * LDB * 2)) + bdst) = r0; *(LAS u32x4*)(lds + (buf ^ (128 * LDB * 2)) + bdst + 64 * LDB * 2) = r1; }
            __syncthreads();
        }
        float rstd[4] = {1.f, 1.f, 1.f, 1.f};
        if (ct < 4) {
#pragma unroll
            for (int r = 0; r < 4; ++r) { float ss = 0.f;
#pragma unroll
                for (int j = 0; j < 8; ++j) ss += acc[j][r] * acc[j][r];
                ss += __shfl_xor(ss, 1); ss += __shfl_xor(ss, 2); ss += __shfl_xor(ss, 4); ss += __shfl_xor(ss, 8);
                rstd[r] = rsqrtf(ss * (1.0f / 128.0f) + EPS); }
        }
#pragma unroll
        for (int j = 0; j < 8; ++j) { const float gg = (ct < 4) ? gk[16 * j + fr] : 1.0f;
#pragma unroll
            for (int r = 0; r < 4; ++r) MKV[(size_t)(rt * 128 + wave * 16 + fq * 4 + r) * 1024 + ct * 128 + 16 * j + fr] = f2bf(acc[j][r] * rstd[r] * gg); }
    }
}
__device__ __forceinline__ void p5_router(const bf16_t* X1, const float* WrT, const float* br, int* LIST, float* RSTDS, float* TOPWS, unsigned* cnt, int G, int c, LAS unsigned char* lds) {
    const int tid = threadIdx.x, lane = tid & 63, wave = __builtin_amdgcn_readfirstlane(tid >> 6), r = lane & 15, qd = lane >> 4;
    LAS unsigned* lcnt = (LAS unsigned*)(lds + RING_BYTES + 2048);
    { const bf16_t* pl = (const bf16_t*)(WrT + 32 * 1024);
#pragma unroll 4
      for (int j = 0; j < 16; ++j) { const int g = tid + 512 * j, p = g >> 12, e = (g >> 7) & 31, ch = g & 127;
          *(LAS u32x4*)(lds + p * 65536 + e * 2048 + ((ch ^ (e & 15)) << 4)) = *(const u32x4*)(pl + (size_t)g * 8); } }
    for (int gbase = c * NWAVES; gbase < T_TOK / 16; gbase += G * NWAVES) {
        const int t0 = (gbase + wave) * 16;
        if (tid < 32) lcnt[tid] = 0u;
        __syncthreads();
        const bf16_t* xp = X1 + (size_t)(t0 + r) * DM + 8 * qd;
        f32x4 acc0 = (f32x4){0.f, 0.f, 0.f, 0.f}, acc1 = acc0; float ss = 0.f;
#pragma unroll
        for (int hf = 0; hf < 2; ++hf) {
            u32x4 xa[16];
#pragma unroll
            for (int i = 0; i < 16; ++i) xa[i] = *(const u32x4*)(xp + 32 * (16 * hf + i));
#pragma unroll
            for (int i = 0; i < 16; ++i) { const int it = 16 * hf + i;
                f32x4 a0, a1; pg::unpack8(xa[i], a0, a1);
                ss += (a0[0] * a0[0] + a0[1] * a0[1]) + (a0[2] * a0[2] + a0[3] * a0[3]) + (a1[0] * a1[0] + a1[1] * a1[1]) + (a1[2] * a1[2] + a1[3] * a1[3]);
                const int off = r * 2048 + (((4 * it + qd) ^ r) << 4);
#pragma unroll
                for (int p = 1; p >= 0; --p) { const bf16x8 b0 = *(const LAS bf16x8*)(lds + p * 65536 + off), b1 = *(const LAS bf16x8*)(lds + p * 65536 + 16 * 2048 + off);
                    acc0 = __builtin_amdgcn_mfma_f32_16x16x32_bf16(__builtin_bit_cast(bf16x8, xa[i]), b0, acc0, 0, 0, 0); acc1 = __builtin_amdgcn_mfma_f32_16x16x32_bf16(__builtin_bit_cast(bf16x8, xa[i]), b1, acc1, 0, 0, 0); }
            }
        }
        ss += __shfl_xor(ss, 16); ss += __shfl_xor(ss, 32);
        const float rstd_r = rsqrtf(ss * (1.0f / DM) + EPS);
        const float bias0 = br[r], bias1 = br[16 + r];
        float rs[4], l0[4], l1[4];
#pragma unroll
        for (int g = 0; g < 4; ++g) { rs[g] = __shfl(rstd_r, 4 * qd + g); l0[g] = acc0[g] * rs[g] + bias0; l1[g] = acc1[g] * rs[g] + bias1; }
        float sv[4][4]; int se[4][4];
#pragma unroll
        for (int rank = 0; rank < 4; ++rank)
#pragma unroll
            for (int g = 0; g < 4; ++g) {
                float v = l0[g]; int ix = r; if (l1[g] > v) { v = l1[g]; ix = r + 16; }
#pragma unroll
                for (int o = 1; o < 16; o <<= 1) { const float ov = __shfl_xor(v, o); const int oi = __shfl_xor(ix, o); if (ov > v || (ov == v && oi < ix)) { v = ov; ix = oi; } }
                sv[rank][g] = v; se[rank][g] = ix;
                if (ix == r) l0[g] = -INFINITY; if (ix == r + 16) l1[g] = -INFINITY;
            }
        float wgt[4]; int mye[4]; unsigned lp[4];
        if (r < 4) {
#pragma unroll
            for (int g = 0; g < 4; ++g) {
                const float den = 1.0f + __expf(sv[1][g] - sv[0][g]) + __expf(sv[2][g] - sv[0][g]) + __expf(sv[3][g] - sv[0][g]);
                const float myv = (r == 0) ? sv[0][g] : (r == 1) ? sv[1][g] : (r == 2) ? sv[2][g] : sv[3][g];
                mye[g] = (r == 0) ? se[0][g] : (r == 1) ? se[1][g] : (r == 2) ? se[2][g] : se[3][g];
                wgt[g] = __expf(myv - sv[0][g]) / den;
                lp[g] = __hip_atomic_fetch_add(lcnt + mye[g], 1u, __ATOMIC_RELAXED, __HIP_MEMORY_SCOPE_WORKGROUP);
            }
        }
        __syncthreads();
        if (tid < 32) lcnt[32 + tid] = atomicAdd(cnt + tid, lcnt[tid]);
        __syncthreads();
        if (r < 4) {
#pragma unroll
            for (int g = 0; g < 4; ++g) { const unsigned pos = lcnt[32 + mye[g]] + lp[g]; const int t = t0 + 4 * qd + g;
                LIST[mye[g] * 32768 + pos] = t * 4 + r; RSTDS[mye[g] * 32768 + pos] = rs[g]; TOPWS[mye[g] * 32768 + pos] = wgt[g]; }
        }
        __syncthreads();
    }
}
__device__ __forceinline__ void p8_combine(float* out, const bf16_t* X1H, const bf16_t* YS, int G, int c, float dscale) {
    typedef float f32x2v __attribute__((ext_vector_type(2)));
    const unsigned char* YQ = (const unsigned char*)YS;
    const size_t gt = (size_t)c * NWAVES * 64 + threadIdx.x, NGT = (size_t)G * NWAVES * 64;
    for (size_t i = gt; i < (size_t)T_TOK * DM / 8; i += NGT) {
        const size_t t = i >> 7, c8 = (i & 127) * 8;
        f32x4 o0, o1; pg::unpack8(*(const u32x4*)(X1H + t * DM + c8), o0, o1);
        if (dscale < 0.f) { o0 = *(const f32x4*)(out + t * DM + c8); o1 = *(const f32x4*)(out + t * DM + c8 + 4); }
        f32x4 s0 = (f32x4){0.f, 0.f, 0.f, 0.f}, s1 = s0;
#pragma unroll
        for (int k = 0; k < 4; ++k) { typedef unsigned u32x2v __attribute__((ext_vector_type(2))); const u32x2v w = __builtin_nontemporal_load((const u32x2v*)(YQ + (t * 4 + k) * DM + c8));
            const f32x2v a0 = __builtin_amdgcn_cvt_pk_f32_fp8((int)w.x, false), a1 = __builtin_amdgcn_cvt_pk_f32_fp8((int)w.x, true), b0 = __builtin_amdgcn_cvt_pk_f32_fp8((int)w.y, false), b1 = __builtin_amdgcn_cvt_pk_f32_fp8((int)w.y, true);
            s0 += (f32x4){a0[0], a0[1], a1[0], a1[1]}; s1 += (f32x4){b0[0], b0[1], b1[0], b1[1]}; }
        s0 = s0 * pg::YQ_INV; s1 = s1 * pg::YQ_INV;
        if (dscale < 0.f) { o0 = (o0 - s0) + s0; o1 = (o1 - s1) + s1; } else { o0 = (o0 + s0) * dscale; o1 = (o1 + s1) * dscale; }
        *(f32x4*)(out + t * DM + c8) = o0; *(f32x4*)(out + t * DM + c8 + 4) = o1;
    }
}


struct ConvJob { const float* w1; const float* w2; const float* gf; unsigned char* W1Q; unsigned char* W2Q; LAS float* scr; int item, end, stride; };
constexpr int CV_W1 = NEXP * 32 * 64, CV_W2 = NEXP * 32 * 32, CV_TOTAL = CV_W1 + CV_W2;
__device__ __forceinline__ void conv_issue(const ConvJob& J, float (&tv)[16], int lane) {
    const int h = J.item; const float* src; int N;
    if (h < CV_W1) { const int e = h >> 11, rem = h & 2047, kb = rem >> 6, nb = rem & 63; N = 2048; src = J.w1 + (size_t)e * DM * 2048 + (size_t)(32 * kb) * 2048 + 32 * nb; }
    else { const int h2 = h - CV_W1, e = h2 >> 10, rem = h2 & 1023, kb = rem >> 5, nb = rem & 31; N = 1024; src = J.w2 + (size_t)e * DFF * DM + (size_t)(32 * kb) * 1024 + 32 * nb; }
    src += (size_t)(16 * (lane >> 5)) * N + (lane & 31);
#pragma unroll
    for (int i = 0; i < 16; ++i) tv[i] = __builtin_nontemporal_load(src + (size_t)i * N);
}
__device__ __forceinline__ void conv_finish(ConvJob& J, const float (&tv)[16], int lane) {
    const int h = J.item; const bool is1 = h < CV_W1;
    int e, kb, nb; if (is1) { e = h >> 11; const int rem = h & 2047; kb = rem >> 6; nb = rem & 63; } else { const int h2 = h - CV_W1; e = h2 >> 10; const int rem = h2 & 1023; kb = rem >> 5; nb = rem & 31; }
    const int n = lane & 31, kh = lane >> 5;
    const f32x4 a = (f32x4){tv[0], tv[1], tv[2], tv[3]} * pg::WQ_SCALE, b = (f32x4){tv[4], tv[5], tv[6], tv[7]} * pg::WQ_SCALE;
    const f32x4 c = (f32x4){tv[8], tv[9], tv[10], tv[11]} * pg::WQ_SCALE, d = (f32x4){tv[12], tv[13], tv[14], tv[15]} * pg::WQ_SCALE;
    const uint2 lo = pg::pack8_fp8(a, b), hi2 = pg::pack8_fp8(c, d);
    const int ncol = 32 * nb + n;
    unsigned char* dst = is1 ? J.W1Q + ((size_t)e * 2048 + p0_map<2>(ncol)) * DM + 32 * kb + 16 * kh : J.W2Q + ((size_t)e * 1024 + ncol) * DFF + 32 * kb + 16 * kh;
    *(u32x4*)dst = (u32x4){lo.x, lo.y, hi2.x, hi2.y};
    asm volatile("s_waitcnt lgkmcnt(0)" ::: "memory");
    J.item += J.stride;
}
namespace at {
typedef __attribute__((address_space(3))) const char* lds_cptr;
typedef short s16x4 __attribute__((ext_vector_type(4)));
typedef float f32x16 __attribute__((ext_vector_type(16)));
__device__ __forceinline__ int crow(int r, int hi) { return (r & 3) + 8 * (r >> 2) + 4 * hi; }
__device__ __forceinline__ s16x4 vtr(lds_cptr p) { return __builtin_bit_cast(s16x4, __builtin_amdgcn_ds_read_tr16_b64_v4i16((__attribute__((address_space(3))) s16x4*)p)); }
template <int ND0> __device__ __forceinline__ void qk_step(f32x16& p0, f32x16& p1, lds_cptr kb, int kch2, const bf16x8 (&qr)[ND0]) {
#pragma unroll
    for (int d0 = 0; d0 < ND0; ++d0) {
        const bf16x8 b0 = *(const __attribute__((address_space(3))) bf16x8*)(kb + d0 * kch2);
        const bf16x8 b1 = *(const __attribute__((address_space(3))) bf16x8*)(kb + d0 * kch2 + 512);
        p0 = __builtin_amdgcn_mfma_f32_32x32x16_bf16(b0, qr[d0], p0, 0, 0, 0);
        p1 = __builtin_amdgcn_mfma_f32_32x32x16_bf16(b1, qr[d0], p1, 0, 0, 0);
        if ((d0 & 1) == 1) __builtin_amdgcn_sched_barrier(0);
    }
}
template <int NDB> __device__ __forceinline__ void softmax_step(f32x16& s0, f32x16& s1, float& m, float& l, f32x16 (&o)[NDB], LAS float* wsf, int r32, int hi, u32x4 (&pw)[4]) {
    float tm = fmaxf(s0[0], s1[0]);
#pragma unroll
    for (int r = 1; r < 16; ++r) tm = fmaxf(tm, fmaxf(s0[r], s1[r]));
    tm = fmaxf(tm, __shfl_xor(tm, 32));
    const float mn = fmaxf(m, tm);
    if (__any(mn > m)) {
        const float alpha = __builtin_amdgcn_exp2f(m - mn);
        l *= alpha; m = mn;
        if (hi == 0) wsf[r32] = alpha;
        asm volatile("s_waitcnt lgkmcnt(0)" ::: "memory");
#pragma unroll
        for (int r = 0; r < 16; ++r) { const float f = wsf[crow(r, hi)];
#pragma unroll
            for (int db = 0; db < NDB; ++db) o[db][r] *= f; }
    }
    float sum = 0.f;
#pragma unroll
    for (int r = 0; r < 16; ++r) { s0[r] = __builtin_amdgcn_exp2f(s0[r] - m); s1[r] = __builtin_amdgcn_exp2f(s1[r] - m); sum += s0[r] + s1[r]; }
    l += sum;
    pw[0] = (u32x4){pg::cvt_pk_bf16(s0[0], s0[1]), pg::cvt_pk_bf16(s0[2], s0[3]), pg::cvt_pk_bf16(s0[4], s0[5]), pg::cvt_pk_bf16(s0[6], s0[7])};
    pw[1] = (u32x4){pg::cvt_pk_bf16(s0[8], s0[9]), pg::cvt_pk_bf16(s0[10], s0[11]), pg::cvt_pk_bf16(s0[12], s0[13]), pg::cvt_pk_bf16(s0[14], s0[15])};
    pw[2] = (u32x4){pg::cvt_pk_bf16(s1[0], s1[1]), pg::cvt_pk_bf16(s1[2], s1[3]), pg::cvt_pk_bf16(s1[4], s1[5]), pg::cvt_pk_bf16(s1[6], s1[7])};
    pw[3] = (u32x4){pg::cvt_pk_bf16(s1[8], s1[9]), pg::cvt_pk_bf16(s1[10], s1[11]), pg::cvt_pk_bf16(s1[12], s1[13]), pg::cvt_pk_bf16(s1[14], s1[15])};
}
template <int NDB> __device__ __forceinline__ void softmax_rel_a(f32x16& s0, f32x16& s1, float& m, float& l, f32x16 (&o)[NDB], LAS float* wsf, int r32, int hi) {
    constexpr float THR = 4.0f;
#define AT_MX3(a, b, c) __builtin_fmaxf(__builtin_fmaxf((a), (b)), (c))
    float ta = AT_MX3(s0[0], s0[1], s1[0]), tb = AT_MX3(s0[2], s0[3], s1[1]); ta = AT_MX3(ta, s1[2], s1[3]);
#pragma unroll
    for (int r = 4; r < 16; r += 4) { ta = AT_MX3(ta, s0[r], s0[r + 1]); tb = AT_MX3(tb, s0[r + 2], s0[r + 3]); ta = AT_MX3(ta, s1[r], s1[r + 1]); tb = AT_MX3(tb, s1[r + 2], s1[r + 3]); }
    float rm = __builtin_fmaxf(ta, tb);
    { const auto rr = __builtin_amdgcn_permlane32_swap(__float_as_uint(rm), __float_as_uint(rm), false, false); rm = __builtin_fmaxf(__uint_as_float(rr[0]), __uint_as_float(rr[1])); }
#undef AT_MX3
    if (__any(rm > THR)) {
        const float dl = rm > THR ? rm : 0.f;
        m += dl;
#pragma unroll
        for (int r = 0; r < 16; ++r) { s0[r] -= dl; s1[r] -= dl; }
        const float f = __builtin_amdgcn_exp2f(-dl);
        l *= f;
        if (hi == 0) wsf[r32] = f;
        asm volatile("s_waitcnt lgkmcnt(0)" ::: "memory");
#pragma unroll
        for (int r = 0; r < 16; ++r) { const float g = wsf[crow(r, hi)];
#pragma unroll
            for (int db = 0; db < NDB; ++db) o[db][r] *= g; }
    }
}
template <int NDB> __device__ __forceinline__ void softmax_rel(f32x16& s0, f32x16& s1, float& m, float& l, f32x16 (&o)[NDB], LAS float* wsf, int r32, int hi, u32x4 (&pw)[4]) {
    constexpr float THR = 4.0f;
#define AT_MX3(a, b, c) __builtin_fmaxf(__builtin_fmaxf((a), (b)), (c))
    float ta = AT_MX3(s0[0], s0[1], s1[0]), tb = AT_MX3(s0[2], s0[3], s1[1]); ta = AT_MX3(ta, s1[2], s1[3]);
#pragma unroll
    for (int r = 4; r < 16; r += 4) { ta = AT_MX3(ta, s0[r], s0[r + 1]); tb = AT_MX3(tb, s0[r + 2], s0[r + 3]); ta = AT_MX3(ta, s1[r], s1[r + 1]); tb = AT_MX3(tb, s1[r + 2], s1[r + 3]); }
    float rm = __builtin_fmaxf(ta, tb);
    { const auto rr = __builtin_amdgcn_permlane32_swap(__float_as_uint(rm), __float_as_uint(rm), false, false); rm = __builtin_fmaxf(__uint_as_float(rr[0]), __uint_as_float(rr[1])); }
#undef AT_MX3
    if (__any(rm > THR)) {
        const float dl = rm > THR ? rm : 0.f;
        m += dl;
#pragma unroll
        for (int r = 0; r < 16; ++r) { s0[r] -= dl; s1[r] -= dl; }
        const float f = __builtin_amdgcn_exp2f(-dl);
        l *= f;
        if (hi == 0) wsf[r32] = f;
        asm volatile("s_waitcnt lgkmcnt(0)" ::: "memory");
#pragma unroll
        for (int r = 0; r < 16; ++r) { const float g = wsf[crow(r, hi)];
#pragma unroll
            for (int db = 0; db < NDB; ++db) o[db][r] *= g; }
    }
    float sa = 0.f, sb = 0.f;
#pragma unroll
    for (int r = 0; r < 16; ++r) { s0[r] = __builtin_amdgcn_exp2f(s0[r]); s1[r] = __builtin_amdgcn_exp2f(s1[r]); sa += s0[r]; sb += s1[r]; }
    l += sa + sb;
    pw[0] = (u32x4){pg::cvt_pk_bf16(s0[0], s0[1]), pg::cvt_pk_bf16(s0[2], s0[3]), pg::cvt_pk_bf16(s0[4], s0[5]), pg::cvt_pk_bf16(s0[6], s0[7])};
    pw[1] = (u32x4){pg::cvt_pk_bf16(s0[8], s0[9]), pg::cvt_pk_bf16(s0[10], s0[11]), pg::cvt_pk_bf16(s0[12], s0[13]), pg::cvt_pk_bf16(s0[14], s0[15])};
    pw[2] = (u32x4){pg::cvt_pk_bf16(s1[0], s1[1]), pg::cvt_pk_bf16(s1[2], s1[3]), pg::cvt_pk_bf16(s1[4], s1[5]), pg::cvt_pk_bf16(s1[6], s1[7])};
    pw[3] = (u32x4){pg::cvt_pk_bf16(s1[8], s1[9]), pg::cvt_pk_bf16(s1[10], s1[11]), pg::cvt_pk_bf16(s1[12], s1[13]), pg::cvt_pk_bf16(s1[14], s1[15])};
}
template <int NDB> __device__ __forceinline__ void pv_step(f32x16 (&o)[NDB], const u32x4 (&pw)[4], lds_cptr vb, int vdb_stride) {
#pragma unroll
    for (int db = 0; db < NDB; ++db)
#pragma unroll
        for (int ks = 0; ks < 4; ++ks) {
            const s16x4 lo = vtr(vb + db * vdb_stride + ks * 1024), hh = vtr(vb + db * vdb_stride + ks * 1024 + 512);
            const bf16x8 vf = (bf16x8){lo[0], lo[1], lo[2], lo[3], hh[0], hh[1], hh[2], hh[3]};
            o[db] = __builtin_amdgcn_mfma_f32_32x32x16_bf16(__builtin_bit_cast(bf16x8, pw[ks]), vf, o[db], 0, 0, 0);
            if (ks == 3) __builtin_amdgcn_sched_barrier(0);
        }
}
__device__ __forceinline__ void exp_pv(f32x16& s0, f32x16& s1, float& l, f32x16 (&o)[2], lds_cptr vb) {
    s16x4 vl[2][4], vh[2][4];
#pragma unroll
    for (int db = 0; db < 2; ++db)
#pragma unroll
        for (int ks = 0; ks < 4; ++ks) { vl[db][ks] = vtr(vb + db * 4096 + ks * 1024); vh[db][ks] = vtr(vb + db * 4096 + ks * 1024 + 512); }
    float sa = 0.f, sb = 0.f;
    __builtin_amdgcn_sched_barrier(0);
#pragma unroll
    for (int ks = 0; ks < 4; ++ks) {
        float e[8];
#pragma unroll
        for (int j = 0; j < 8; ++j) e[j] = __builtin_amdgcn_exp2f(ks < 2 ? s0[(ks & 1) * 8 + j] : s1[(ks & 1) * 8 + j]);
        sa += (e[0] + e[1]) + (e[2] + e[3]); sb += (e[4] + e[5]) + (e[6] + e[7]);
        u32x4 pw = (u32x4){pg::cvt_pk_bf16(e[0], e[1]), pg::cvt_pk_bf16(e[2], e[3]), pg::cvt_pk_bf16(e[4], e[5]), pg::cvt_pk_bf16(e[6], e[7])};
        asm volatile("" : "+v"(pw));
#pragma unroll
        for (int db = 0; db < 2; ++db) { const bf16x8 vf = (bf16x8){vl[db][ks][0], vl[db][ks][1], vl[db][ks][2], vl[db][ks][3], vh[db][ks][0], vh[db][ks][1], vh[db][ks][2], vh[db][ks][3]};
            o[db] = __builtin_amdgcn_mfma_f32_32x32x16_bf16(__builtin_bit_cast(bf16x8, pw), vf, o[db], 0, 0, 0); }
        __builtin_amdgcn_sched_barrier(0);
    }
    l += sa + sb;
}
template <int NDB> __device__ __forceinline__ void store_o(const f32x16 (&o)[NDB], float l, LAS float* wsf, int r32, int hi, bf16_t* yrow0  , int ldy) {
    l += __shfl_xor(l, 32);
    if (hi == 0) wsf[r32] = __builtin_amdgcn_rcpf(l);
    asm volatile("s_waitcnt lgkmcnt(0)" ::: "memory");
#pragma unroll
    for (int r = 0; r < 16; ++r) { const int q = crow(r, hi); const float inv = wsf[q];
#pragma unroll
        for (int db = 0; db < NDB; ++db) yrow0[(size_t)q * ldy + db * 32 + r32] = f2bf(o[db][r] * inv); }
    asm volatile("s_waitcnt lgkmcnt(0)" ::: "memory");
}

__device__ __forceinline__ void moba_unit(int b, int h, int jb, const bf16_t* PROJ, const float* KMP, bf16_t* Y, LAS unsigned char* lds, ConvJob& J, float (&tv)[16]) {
    int tid_ = threadIdx.x; asm volatile("" : "+v"(tid_));
    const int tid = tid_, lane = tid & 63, r32 = lane & 31, hi = lane >> 5, w = __builtin_amdgcn_readfirstlane(tid >> 6);
    LAS float* kmean = (LAS float*)(lds + 32768);
    LAS float* wsf = (LAS float*)(lds + 36864) + w * 64;
    const size_t rowbase = (size_t)b * SEQ; const int q0 = jb * 256; const int t = q0 + 32 * w + r32;
    for (int i = tid; i < jb * 64; i += NWAVES * 64) { const int n = i >> 6, d = i & 63; const float* p = KMP + ((size_t)(b * 16 + n) * 2) * 512 + h * 64 + d; kmean[i] = (p[0] + p[512]) * (1.0f / 256.0f); }
    const bf16_t* qp = PROJ + (rowbase + t) * INW + OFF_QB + h * 64 + hi * 8;
    bf16x8 qr[4];
#pragma unroll
    for (int d0 = 0; d0 < 4; ++d0) qr[d0] = *(const bf16x8*)(qp + d0 * 16);
    const bf16_t* kg = PROJ + (rowbase + 8 * w + (lane >> 3)) * INW + OFF_KB + h * 64 + (((lane & 7) ^ ((4 * w + (lane >> 4)) & 7)) << 3);
    const bf16_t* vg = PROJ + (rowbase + 16 * (w & 3) + (lane >> 2)) * INW + OFF_VB + h * 64 + (w >> 2) * 32 + (lane & 3) * 8;
    const unsigned kdst = (unsigned)__builtin_amdgcn_readfirstlane((int)((unsigned)(size_t)lds + w * 1024)), vdst = kdst + 8192u;
    __syncthreads();
    pg::glds16_asm(kg, kdst); pg::glds16_asm(vg, vdst);
    unsigned selmask = 0u;
    {
        float qf[32];
#pragma unroll
        for (int d0 = 0; d0 < 4; ++d0) { f32x4 a, c; pg::unpack8(__builtin_bit_cast(u32x4, qr[d0]), a, c);
#pragma unroll
            for (int j = 0; j < 4; ++j) { qf[d0 * 8 + j] = a[j]; qf[d0 * 8 + 4 + j] = c[j]; } }
        float v0 = -INFINITY, v1 = -INFINITY, v2 = -INFINITY; int i0 = -1, i1 = -1, i2 = -1;
        for (int n = 0; n < jb; ++n) {
            const LAS float* km = kmean + n * 64 + hi * 8; float g = 0.f;
#pragma unroll
            for (int d0 = 0; d0 < 4; ++d0) { const f32x4 ka = *(const LAS f32x4*)(km + d0 * 16), kc = *(const LAS f32x4*)(km + d0 * 16 + 4);
#pragma unroll
                for (int j = 0; j < 4; ++j) g += qf[d0 * 8 + j] * ka[j] + qf[d0 * 8 + 4 + j] * kc[j]; }
            g += __shfl_xor(g, 32);
            if (g > v0) { v2 = v1; i2 = i1; v1 = v0; i1 = i0; v0 = g; i0 = n; } else if (g > v1) { v2 = v1; i2 = i1; v1 = g; i1 = n; } else if (g > v2) { v2 = g; i2 = n; }
        }
        if (i0 >= 0) selmask |= 1u << i0; if (i1 >= 0) selmask |= 1u << i1; if (i2 >= 0) selmask |= 1u << i2;
    }
    asm volatile("s_waitcnt vmcnt(0)" ::: "memory");
    __syncthreads();
    const float slope2 = exp2f(-(float)(h + 1)) * 1.4426950408889634f;
    float m = 0.f, l = 0.f; f32x16 o[2];
#pragma unroll
    for (int r = 0; r < 16; ++r) { o[0][r] = 0.f; o[1][r] = 0.f; }
    const int qrel = 32 * w + r32;
    const int NT = 4 * (jb + 1);
    const lds_cptr lb = (lds_cptr)lds;
    const int voff = 8192 + ((lane >> 4) & 1) * 32 + (lane & 3) * 8 + (4 * hi + ((lane & 15) >> 2)) * 64;
#pragma nounroll
    for (int T = 0; T < NT; ++T) {
        const int slot = (T & 1) * 16384;
        if (T + 1 < NT) { pg::glds16_asm(kg + (size_t)(T + 1) * 64 * INW, kdst + (unsigned)(slot ^ 16384)); pg::glds16_asm(vg + (size_t)(T + 1) * 64 * INW, vdst + (unsigned)(slot ^ 16384)); }
        const bool cv_issue = (J.item < J.end) && ((T & 1) == 0);
        if (cv_issue) conv_issue(J, tv, lane);
        const int n = T >> 2, kt = T & 3;
        const bool own = (n == jb);
        const bool sel = own || ((selmask >> n) & 1u);
        const bool need = own ? (64 * kt <= 32 * w + 31) : (__any(sel) != 0);
        if (need) {
            const float lbias = sel ? (slope2 * (float)(T * 64 + 4 * hi - t) - m) : -INFINITY;
            f32x16 s0, s1;
#pragma unroll
            for (int r = 0; r < 16; ++r) { s0[r] = slope2 * (float)((r & 3) + 8 * (r >> 2)) + lbias; s1[r] = slope2 * (float)((r & 3) + 8 * (r >> 2) + 32) + lbias; }
            if (own && 64 * kt + 63 > 32 * w) {
                const int kr = kt * 64 + 4 * hi;
#pragma unroll
                for (int r = 0; r < 16; ++r) { const int kk = kr + (r & 3) + 8 * (r >> 2); if (kk > qrel) s0[r] = -INFINITY; if (kk + 32 > qrel) s1[r] = -INFINITY; }
            }
            bf16x8 kf[8];
#pragma unroll
            for (int d0 = 0; d0 < 4; ++d0) { const lds_cptr kp = lb + slot + r32 * 128 + (((2 * d0 + hi) ^ ((r32 >> 1) & 7)) << 4);
                kf[2 * d0] = *(const __attribute__((address_space(3))) bf16x8*)kp; kf[2 * d0 + 1] = *(const __attribute__((address_space(3))) bf16x8*)(kp + 32 * 128); }
            __builtin_amdgcn_sched_barrier(0);
#pragma unroll
            for (int d0 = 0; d0 < 4; ++d0) { s0 = __builtin_amdgcn_mfma_f32_32x32x16_bf16(kf[2 * d0], qr[d0], s0, 0, 0, 0); s1 = __builtin_amdgcn_mfma_f32_32x32x16_bf16(kf[2 * d0 + 1], qr[d0], s1, 0, 0, 0); }
            __builtin_amdgcn_sched_barrier(0);
            softmax_rel_a<2>(s0, s1, m, l, o, wsf, r32, hi);
            exp_pv(s0, s1, l, o, lb + slot + voff);
        }
        const bool cv_fin = (J.item < J.end) && ((T & 1) == 1);
        if (cv_fin) conv_finish(J, tv, lane);
        if (cv_issue) asm volatile("s_waitcnt vmcnt(16) lgkmcnt(0)" ::: "memory");
        else if (cv_fin) asm volatile("s_waitcnt vmcnt(1) lgkmcnt(0)" ::: "memory");
        else asm volatile("s_waitcnt vmcnt(0) lgkmcnt(0)" ::: "memory");
        __builtin_amdgcn_s_barrier(); asm volatile("" ::: "memory");
    }
    store_o<2>(o, l, wsf, r32, hi, Y + (rowbase + q0 + 32 * w) * 1536 + 512 + h * 64, 1536);
}

__device__ __forceinline__ void mem_units(int b, int h, int qt0, int nqt, const bf16_t* PROJ, const bf16_t* MKV, const float* gq, bf16_t* Y, LAS unsigned char* lds) {
    int tid_ = threadIdx.x; asm volatile("" : "+v"(tid_));
    const int tid = tid_, lane = tid & 63, r32 = lane & 31, hi = lane >> 5, w = __builtin_amdgcn_readfirstlane(tid >> 6);
    LAS float* wsf = (LAS float*)(lds + RING_BYTES + 4096) + w * 64;
    __syncthreads();
#pragma unroll 2
    for (int i = 0; i < 8; ++i) { const int p = tid + 512 * i, key = p >> 4, ch = p & 15;
        const u32x4 wv = *(const u32x4*)(MKV + ((size_t)b * MEML + key) * 1024 + h * 128 + ch * 8); f32x4 a, c; pg::unpack8(wv, a, c);
        const f32x4 g0 = *(const f32x4*)(gq + ch * 8), g1 = *(const f32x4*)(gq + ch * 8 + 4);
        *(LAS u32x4*)(lds + key * 256 + ((ch ^ (key & 15)) << 4)) = pg::pack8(a * g0, c * g1); }
#pragma unroll 4
    for (int i = 0; i < 8; ++i) { const int p = tid + 512 * i, key = p >> 4, c16 = p & 15;
        const u32x4 wv = *(const u32x4*)(MKV + ((size_t)b * MEML + key) * 1024 + 512 + h * 128 + c16 * 8);
        *(LAS u32x4*)(lds + 65536 + (c16 >> 2) * 16384 + (key >> 4) * 1024 + (key & 15) * 64 + (c16 & 3) * 16) = wv; }
    __syncthreads();
    const lds_cptr lb = (lds_cptr)lds;
    const int voff = 65536 + ((lane >> 4) & 1) * 32 + (lane & 3) * 8 + (4 * hi + ((lane & 15) >> 2)) * 64;
#pragma nounroll
    for (int qi = 0; qi < nqt; ++qi) {
        const size_t row0 = (size_t)b * SEQ + (size_t)(qt0 + qi) * 256 + 32 * w;
        const bf16_t* qp = PROJ + (row0 + r32) * INW + OFF_QM + h * 128 + hi * 8;
        bf16x8 qr[8]; float ss = 0.f;
#pragma unroll
        for (int d0 = 0; d0 < 8; ++d0) { qr[d0] = *(const bf16x8*)(qp + d0 * 16); f32x4 a, c; pg::unpack8(__builtin_bit_cast(u32x4, qr[d0]), a, c);
            ss += (a[0] * a[0] + a[1] * a[1]) + (a[2] * a[2] + a[3] * a[3]) + (c[0] * c[0] + c[1] * c[1]) + (c[2] * c[2] + c[3] * c[3]); }
        ss += __shfl_xor(ss, 32);
        const float cs = rsqrtf(ss * (1.0f / 128.0f) + EPS) * (0.08838834764831845f * 1.4426950408889634f);
        float m = -1e30f, l = 0.f; f32x16 o[4];
#pragma unroll
        for (int r = 0; r < 16; ++r) { o[0][r] = 0.f; o[1][r] = 0.f; o[2][r] = 0.f; o[3][r] = 0.f; }
#pragma nounroll
        for (int kt = 0; kt < 4; ++kt) {
            f32x16 s0, s1;
#pragma unroll
            for (int r = 0; r < 16; ++r) { s0[r] = 0.f; s1[r] = 0.f; }
#pragma unroll
            for (int d0 = 0; d0 < 8; ++d0) {
                const lds_cptr kp = lb + (kt * 64 + r32) * 256 + (((2 * d0 + hi) ^ (r32 & 15)) << 4);
                const bf16x8 b0 = *(const __attribute__((address_space(3))) bf16x8*)kp, b1 = *(const __attribute__((address_space(3))) bf16x8*)(kp + 32 * 256);
                s0 = __builtin_amdgcn_mfma_f32_32x32x16_bf16(b0, qr[d0], s0, 0, 0, 0); s1 = __builtin_amdgcn_mfma_f32_32x32x16_bf16(b1, qr[d0], s1, 0, 0, 0);
                if ((d0 & 1) == 1) __builtin_amdgcn_sched_barrier(0); }
#pragma unroll
            for (int r = 0; r < 16; ++r) { s0[r] *= cs; s1[r] *= cs; }
            u32x4 pw[4];
            softmax_step<4>(s0, s1, m, l, o, wsf, r32, hi, pw);
            pv_step<4>(o, pw, lb + voff + kt * 4096, 16384);
        }
        store_o<4>(o, l, wsf, r32, hi, Y + row0 * 1536 + 1024 + h * 128, 1536);
    }
    __syncthreads();
}
}


__device__ __forceinline__ void sgu_chunk(int chunk, const bf16_t* PROJ, const float* gsv, const bf16_t* WSB, const float* bs, bf16_t* Y, LAS unsigned char* lds) {
    int tid_ = threadIdx.x; asm volatile("" : "+v"(tid_));
    const int tid = tid_, lane = tid & 63, r32 = lane & 31, hi = lane >> 5, w = __builtin_amdgcn_readfirstlane(tid >> 6);
    const int t0 = chunk * 128;
    LAS float* rs = (LAS float*)(lds + 32768);
    for (int i = 0; i < 16; ++i) { const int tl = w * 16 + i;
        const u32x4 wv = *(const u32x4*)(PROJ + (size_t)(t0 + tl) * INW + OFF_V + lane * 8); f32x4 a, b; pg::unpack8(wv, a, b);
        float ss = (a[0] * a[0] + a[1] * a[1]) + (a[2] * a[2] + a[3] * a[3]) + (b[0] * b[0] + b[1] * b[1]) + (b[2] * b[2] + b[3] * b[3]);
        ss = wave_sum(ss); if (lane == 0) rs[tl] = rsqrtf(ss * (1.0f / 512.0f) + EPS); }
    __syncthreads();
    const int tt = w & 3, dh = w >> 2;
    const at::lds_cptr vb = (at::lds_cptr)lds + ((lane >> 4) & 1) * 32 + (lane & 3) * 8 + (4 * hi + ((lane & 15) >> 2)) * 64 + dh * 16384;
#pragma nounroll
    for (int g = 0; g < 4; ++g) {
        { const int c8 = tid & 15; const f32x4 g0 = *(const f32x4*)(gsv + g * 128 + c8 * 8), g1 = *(const f32x4*)(gsv + g * 128 + c8 * 8 + 4);
#pragma unroll
            for (int j = 0; j < 4; ++j) { const int s = (tid >> 4) + 32 * j; const float r = rs[s];
                const u32x4 wv = *(const u32x4*)(PROJ + (size_t)(t0 + s) * INW + OFF_V + g * 128 + c8 * 8); f32x4 a, b; pg::unpack8(wv, a, b);
                *(LAS u32x4*)(lds + (c8 >> 2) * 8192 + (s >> 4) * 1024 + (s & 15) * 64 + (c8 & 3) * 16) = pg::pack8(a * r * g0, b * r * g1); } }
        __syncthreads();
        at::f32x16 o[2];
#pragma unroll
        for (int r = 0; r < 16; ++r) { o[0][r] = 0.f; o[1][r] = 0.f; }
        const bf16_t* wrow = WSB + ((size_t)g * 128 + 32 * tt + r32) * 128 + 4 * hi;
        const int nks = 2 * tt + 2;
        for (int ks = 0; ks < nks; ++ks) {
            const uint2 alo = *(const uint2*)(wrow + 16 * ks), ahi = *(const uint2*)(wrow + 16 * ks + 8);
            const bf16x8 af = __builtin_bit_cast(bf16x8, (u32x4){alo.x, alo.y, ahi.x, ahi.y});
#pragma unroll
            for (int dbl = 0; dbl < 2; ++dbl) { const at::s16x4 lo = at::vtr(vb + dbl * 8192 + ks * 1024), hh = at::vtr(vb + dbl * 8192 + ks * 1024 + 512);
                const bf16x8 vf = (bf16x8){lo[0], lo[1], lo[2], lo[3], hh[0], hh[1], hh[2], hh[3]};
                o[dbl] = __builtin_amdgcn_mfma_f32_32x32x16_bf16(af, vf, o[dbl], 0, 0, 0); }
        }
        LAS float* stg = (LAS float*)(lds + 40960);
#pragma unroll
        for (int r = 0; r < 16; ++r) { const int t = 32 * tt + at::crow(r, hi); const float bias = bs[g * 128 + t];
#pragma unroll
            for (int dbl = 0; dbl < 2; ++dbl) stg[t * 128 + (2 * dh + dbl) * 32 + r32] = o[dbl][r] + bias; }
        __syncthreads();
#pragma unroll
        for (int j = 0; j < 4; ++j) { const int p = tid + 512 * j, t = p >> 4, c8 = (p & 15) * 8; const size_t row = (size_t)(t0 + t);
            const f32x4 m0 = *(const LAS f32x4*)(stg + t * 128 + c8), m1 = *(const LAS f32x4*)(stg + t * 128 + c8 + 4);
            f32x4 u0, u1; pg::unpack8(*(const u32x4*)(PROJ + row * INW + OFF_U + g * 128 + c8), u0, u1);
            *(u32x4*)(Y + row * 1536 + g * 128 + c8) = pg::pack8(u0 * m0, u1 * m1); }
        __syncthreads();
    }
}

struct MArgs { const float* in[24]; float* out; unsigned char* ws; int ph_lo, ph_hi; };
__global__ void __launch_bounds__(NWAVES * 64, 2) mk_fwd(MArgs a) {
    extern __shared__ __attribute__((aligned(16))) unsigned char lds_raw[];
    LAS unsigned char* lds = (LAS unsigned char*)lds_raw;
    const int tid = threadIdx.x;
    for (int u = tid; u < (LDS_BYTES - LDSCTL_OFF) / 4; u += NWAVES * 64) ((LAS unsigned*)(lds + LDSCTL_OFF))[u] = 0u;
    __syncthreads();
    unsigned char* ws = a.ws; unsigned* ctl = (unsigned*)(ws + WS_CTL);
    const int lo = a.ph_lo, hi = a.ph_hi; const int G = gridDim.x, c = blockIdx.x;
    XcdBarrier bar; bar.bar = ctl + CW_BAR; bar.x = 0; bar.st = nullptr;
    if (hi - lo > 1) bar = xcd_barrier_post(ctl + CW_BAR, (volatile LAS unsigned*)(lds + LDSCTL_OFF));
typedef const MArgs __attribute__((address_space(4))) * kargp_t;
    const kargp_t kargs = (kargp_t)__builtin_amdgcn_kernarg_segment_ptr();
#define KA_BEGIN() kargp_t q = kargs; asm volatile("" : "+s"(q))
#ifdef DIAG_PHASE
    if (c == 0 && tid == 0) *(LAS unsigned long long*)(lds + LDSCTL_OFF + 16) = wall_clock64();
#define DIAG_STAMP(k) do { if ((k) == DIAG_PHASE && c == 0 && tid == 0) ctl[CW_DIAG] = (unsigned)(wall_clock64() - *(LAS unsigned long long*)(lds + LDSCTL_OFF + 16)); } while (0)
#else
#define DIAG_STAMP(k) do { } while (0)
#endif
#define IN(k) (lo <= (k) && (k) < hi)
#define BOTH(k) (IN(k) && IN((k) + 1))
    bf16_t *WinT = (bf16_t*)(ws + WS_WIN), *WbrT = (bf16_t*)(ws + WS_WBR), *WoutT = (bf16_t*)(ws + WS_WOUT);
    bf16_t *W1T = (bf16_t*)(ws + WS_W1), *W2T = (bf16_t*)(ws + WS_W2);
    bf16_t *MERGED = (bf16_t*)(ws + WS_MERGED), *X1B = (bf16_t*)(ws + WS_X1B), *HB = (bf16_t*)(ws + WS_HB), *PROJ = (bf16_t*)(ws + WS_PROJ), *Y = (bf16_t*)(ws + WS_Y);
    bf16_t *ACT = (bf16_t*)(ws + WS_ACT), *YS = (bf16_t*)(ws + WS_YS);
    float* KMP = (float*)(ws + WS_KMP); int* LIST = (int*)(ws + WS_LIST); float* RSTDS = (float*)(ws + WS_RSTDS); float* TOPWS = (float*)(ws + WS_TOPWS);

    bf16_t *WmemT = (bf16_t*)(ws + WS_WMEM), *MEMN = (bf16_t*)(ws + WS_MEMN), *MKV = (bf16_t*)(ws + WS_MKV), *WSB = (bf16_t*)(ws + WS_WSB); float* WrT = (float*)(ws + WS_WR);
#if !defined(ONLY) || ONLY == 0
    if (IN(0)) {
        KA_BEGIN();
        {
        P0Args p; p.x = q->in[0]; p.mem = q->in[1]; p.g_mix = q->in[2]; p.g_mem = q->in[9]; p.w_in = q->in[3]; p.w_br0 = q->in[13]; p.w_br1 = q->in[14]; p.w_br2 = q->in[15]; p.w_out = q->in[16];
        p.w_mem_kv = q->in[10]; p.w_gate_up = q->in[20]; p.w_down = q->in[22]; p.g_ffn = q->in[17]; p.w_router = q->in[18]; p.w_spatial = q->in[5];
        p.HBQ = ws + WS_HBQ; p.WINQ = ws + WS_WINQ; p.HB = HB; p.MEMN = MEMN; p.WinT = WinT; p.WbrT = WbrT; p.WoutT = WoutT; p.WmemT = WmemT; p.W1T = W1T; p.W2T = W2T; p.WSB = WSB; p.WrT = WrT;
        p0_prologue(p, lds, G, c);
        }
#if DUP_PHASE == 0
        {
        P0Args p; p.x = q->in[0]; p.mem = q->in[1]; p.g_mix = q->in[2]; p.g_mem = q->in[9]; p.w_in = q->in[3]; p.w_br0 = q->in[13]; p.w_br1 = q->in[14]; p.w_br2 = q->in[15]; p.w_out = q->in[16];
        p.w_mem_kv = q->in[10]; p.w_gate_up = q->in[20]; p.w_down = q->in[22]; p.g_ffn = q->in[17]; p.w_router = q->in[18]; p.w_spatial = q->in[5];
        p.HBQ = ws + WS_HBQ; p.WINQ = ws + WS_WINQ; p.HB = HB; p.MEMN = MEMN; p.WinT = WinT; p.WbrT = WbrT; p.WoutT = WoutT; p.WmemT = WmemT; p.W1T = W1T; p.W2T = W2T; p.WSB = WSB; p.WrT = WrT;
        p0_prologue(p, lds, G, c);
        }
#endif
        if (BOTH(0)) xcd_barrier(bar);
        DIAG_STAMP(0);
    }
#endif
#if !defined(ONLY) || ONLY == 1
    if (IN(1)) {
        KA_BEGIN();
        {
        pg::PolP1 P; P.A = HB; P.Bt = WinT; P.PROJ = PROJ; P.KMP = KMP; P.gq = q->in[7]; P.gk = q->in[8]; P.G = G; P.c = c;
        pg::gemm_run(lds, P);
        { pg::PolP1G Pg; Pg.A = ws + WS_HBQ; Pg.Bt = ws + WS_WINQ; Pg.PROJ = PROJ; Pg.G = G; Pg.c = c; pg::gemm_run(lds, Pg); }
        p1_memkv(MEMN, WmemT, q->in[12], MKV, G, c, lds);
        }
#if DUP_PHASE == 1
        {
        pg::PolP1 P; P.A = HB; P.Bt = WinT; P.PROJ = PROJ; P.KMP = KMP; P.gq = q->in[7]; P.gk = q->in[8]; P.G = G; P.c = c;
        pg::gemm_run(lds, P);
        p1_memkv(MEMN, WmemT, q->in[12], MKV, G, c, lds);
        }
#endif
        if (BOTH(1)) xcd_barrier(bar);
        DIAG_STAMP(1);
    }
#endif
#if !defined(ONLY) || ONLY == 2
    if (IN(2)) {
        KA_BEGIN();
        {
        const int wave = __builtin_amdgcn_readfirstlane(tid >> 6), lane = tid & 63;
        const int vcu = (G % 8 == 0) ? (c % 8) * (G / 8) + c / 8 : c;
        for (int u = vcu; u < 256; u += G) at::mem_units(u >> 5, (u >> 3) & 3, (u & 7) * 2, 2, PROJ, MKV, q->in[11], Y, lds);
#if DUP_P2 == 1
        for (int u = vcu; u < 256; u += G) at::mem_units(u >> 5, (u >> 3) & 3, (u & 7) * 2, 2, PROJ, MKV, q->in[11], Y, lds);
#endif
        ConvJob J; J.w1 = q->in[20]; J.w2 = q->in[22]; J.gf = q->in[17]; J.W1Q = (unsigned char*)W1T; J.W2Q = (unsigned char*)W2T; J.scr = (LAS float*)(lds + 40960 + wave * 4352);
        J.item = c * NWAVES + wave; J.end = CV_TOTAL; J.stride = G * NWAVES; float tv[16];
        for (int u = vcu; u < 256; u += G) { const int bh = u >> 2, s4 = u & 3;
            for (int i = 0; i < 4; ++i) { const int jb = (i == 0) ? 15 - s4 : (i == 1) ? 8 + s4 : (i == 2) ? 7 - s4 : s4; at::moba_unit(bh >> 3, bh & 7, jb, PROJ, KMP, Y, lds, J, tv); } }
#if DUP_P2 == 2
        for (int u = vcu; u < 256; u += G) { const int bh = u >> 2, s4 = u & 3;
            for (int i = 0; i < 4; ++i) { const int jb = (i == 0) ? 15 - s4 : (i == 1) ? 8 + s4 : (i == 2) ? 7 - s4 : s4; at::moba_unit(bh >> 3, bh & 7, jb, PROJ, KMP, Y, lds, J, tv); } }
#endif
        while (J.item < J.end) { conv_issue(J, tv, lane); conv_finish(J, tv, lane); }
        __syncthreads();
        for (int ch = vcu; ch < 256; ch += G) sgu_chunk(ch, PROJ, q->in[4], WSB, q->in[6], Y, lds);
#if DUP_P2 == 3
        for (int ch = vcu; ch < 256; ch += G) sgu_chunk(ch, PROJ, q->in[4], WSB, q->in[6], Y, lds);
#endif
        }
#if DUP_PHASE == 2
        {
        const int wave = __builtin_amdgcn_readfirstlane(tid >> 6), lane = tid & 63;
        const int vcu = (G % 8 == 0) ? (c % 8) * (G / 8) + c / 8 : c;
        for (int u = vcu; u < 256; u += G) at::mem_units(u >> 5, (u >> 3) & 3, (u & 7) * 2, 2, PROJ, MKV, q->in[11], Y, lds);
        for (int u = vcu; u < 256; u += G) { const int bh = u >> 2, s4 = u & 3;
            for (int i = 0; i < 4; ++i) { const int jb = (i == 0) ? 15 - s4 : (i == 1) ? 8 + s4 : (i == 2) ? 7 - s4 : s4; at::moba_unit(bh >> 3, bh & 7, jb, PROJ, KMP, Y, lds, J, tv); } }
        __syncthreads();
        for (int ch = vcu; ch < 256; ch += G) sgu_chunk(ch, PROJ, q->in[4], WSB, q->in[6], Y, lds);
        }
#endif
        if (BOTH(2)) xcd_barrier(bar);
        DIAG_STAMP(2);
    }
#endif
#if !defined(ONLY) || ONLY == 3
    if (IN(3)) {
        KA_BEGIN();
        {
        pg::PolP3 P; P.A = Y; P.Bt = WbrT; P.PROJ = PROJ; P.MERGED = MERGED; P.G = G; P.c = c;
        pg::gemm_run(lds, P);
        }
#if DUP_PHASE == 3
        {
        pg::PolP3 P; P.A = Y; P.Bt = WbrT; P.PROJ = PROJ; P.MERGED = MERGED; P.G = G; P.c = c;
        pg::gemm_run(lds, P);
        }
#endif
        if (BOTH(3)) xcd_barrier(bar);
        DIAG_STAMP(3);
    }
#endif
#if !defined(ONLY) || ONLY == 4
    if (IN(4)) {
        KA_BEGIN();
        {
        pg::PolP4 P; P.A = MERGED; P.Bt = WoutT; P.x = q->in[0]; P.X1H = (bf16_t*)(ws + WS_X1H); P.X1Q = (unsigned char*)X1B; P.gffn = q->in[17]; P.G = G; P.c = c;
        pg::gemm_run(lds, P);
        }
#if DUP_PHASE == 4
        {
        pg::PolP4 P; P.A = MERGED; P.Bt = WoutT; P.x = q->in[0]; P.X1H = (bf16_t*)(ws + WS_X1H); P.X1Q = (unsigned char*)X1B; P.gffn = q->in[17]; P.G = G; P.c = c;
        pg::gemm_run(lds, P);
        }
#endif
        if (BOTH(4)) xcd_barrier(bar);
#ifdef DUP_BAR
        for (int i_ = 0; i_ < DUP_BAR; ++i_) xcd_barrier(bar);
#endif
        DIAG_STAMP(4);
    }
#endif
#if !defined(ONLY) || ONLY == 5
    if (IN(5)) {
        KA_BEGIN();
        {
        p5_router((const bf16_t*)(ws + WS_X1H), WrT, q->in[19], LIST, RSTDS, TOPWS, ctl + CW_CNT, G, c, lds);
        }
#if DUP_PHASE == 5
        {
        p5_router((const bf16_t*)(ws + WS_X1H), WrT, q->in[19], (int*)(ws + WS_SCR), (float*)(ws + WS_SCR + 4 * MiB), (float*)(ws + WS_SCR + 8 * MiB), ctl + 512, G, c, lds);
        }
#endif
        if (BOTH(5)) xcd_barrier(bar);
        DIAG_STAMP(5);
    }
#endif
#if !defined(ONLY) || ONLY == 6
    if (IN(6)) {
        KA_BEGIN();
        {
        grouped_setup((LAS int*)(lds + TAB_OFF), ctl + CW_CNT);
        pg::PolP6 P; P.X1Q = (const unsigned char*)X1B; P.W1Q = (const unsigned char*)W1T; P.LIST = LIST; P.RSTDS = RSTDS; P.b1 = q->in[21]; P.ACTQ = (unsigned char*)ACT; P.tb.tab = (const LAS int*)(lds + TAB_OFF); P.G = G; P.c = c; P.rtab = lds + RTAB_OFF;
        pg::gemm_run(lds, P);
        }
#if DUP_PHASE == 6
        {
        grouped_setup((LAS int*)(lds + TAB_OFF), ctl + CW_CNT);
        pg::PolP6 P; P.X1Q = (const unsigned char*)X1B; P.W1Q = (const unsigned char*)W1T; P.LIST = LIST; P.RSTDS = RSTDS; P.b1 = q->in[21]; P.ACTQ = (unsigned char*)ACT; P.tb.tab = (const LAS int*)(lds + TAB_OFF); P.G = G; P.c = c; P.rtab = lds + RTAB_OFF;
        pg::gemm_run(lds, P);
        }
#endif
        if (BOTH(6)) xcd_barrier(bar);
        DIAG_STAMP(6);
    }
#endif
#if !defined(ONLY) || ONLY == 7
    if (IN(7)) {
        KA_BEGIN();
        {
        grouped_setup((LAS int*)(lds + TAB_OFF), ctl + CW_CNT);
        pg::PolP7 P; P.ACTQ = (const unsigned char*)ACT; P.W2Q = (const unsigned char*)W2T; P.LIST = LIST; P.TOPWS = TOPWS; P.b2 = q->in[23]; P.YS = YS; P.tb.tab = (const LAS int*)(lds + TAB_OFF); P.G = G; P.c = c; P.rtab = lds + RTAB_OFF;
        pg::gemm_run(lds, P);
        }
#if DUP_PHASE == 7
        {
        grouped_setup((LAS int*)(lds + TAB_OFF), ctl + CW_CNT);
        pg::PolP7 P; P.ACTQ = (const unsigned char*)ACT; P.W2Q = (const unsigned char*)W2T; P.LIST = LIST; P.TOPWS = TOPWS; P.b2 = q->in[23]; P.YS = YS; P.tb.tab = (const LAS int*)(lds + TAB_OFF); P.G = G; P.c = c; P.rtab = lds + RTAB_OFF;
        pg::gemm_run(lds, P);
        }
#endif
        if (BOTH(7)) xcd_barrier(bar);
        DIAG_STAMP(7);
    }
#endif
#if !defined(ONLY) || ONLY == 8
    if (IN(8)) { KA_BEGIN();
#ifdef DIAG_PHASE
        p8_combine(q->out, (const bf16_t*)(ws + WS_X1H), YS, G, c, 1.0f + sqrtf((float)ctl[CW_DIAG] * 1e-5f));
#else
        p8_combine(q->out, (const bf16_t*)(ws + WS_X1H), YS, G, c, 1.0f);
#if DUP_PHASE == 8
        p8_combine(q->out, (const bf16_t*)(ws + WS_X1H), YS, G, c, -1.0f);
#endif
#endif
    }
#endif
#undef IN
#undef BOTH
}

static int g_grid = 0;
static void launch_mk(const MArgs& base, int lo, int hi, hipStream_t stream) {
    MArgs a = base; a.ph_lo = lo; a.ph_hi = hi;
    hipLaunchKernelGGL(mk_fwd, dim3(g_grid), dim3(NWAVES * 64), LDS_BYTES, stream, a);
}
extern "C" void kernel_launch(void* const* d_in, const int* in_sizes, int n_in, void* d_out, int out_size, void* d_ws, size_t ws_size, hipStream_t stream) {
    if (n_in != 24 || ws_size < WS_END) { fprintf(stderr, "kernel_launch: unexpected n_in %d or ws %zu\n", n_in, ws_size); return; }
    if (g_grid == 0) {
        int dev = 0, cus = 0, per_cu = 0;
        (void)hipGetDevice(&dev); (void)hipDeviceGetAttribute(&cus, hipDeviceAttributeMultiprocessorCount, dev);
        if (hipFuncSetAttribute((const void*)mk_fwd, hipFuncAttributeMaxDynamicSharedMemorySize, LDS_BYTES) != hipSuccess) fprintf(stderr, "kernel_launch: hipFuncSetAttribute failed\n");
        if (hipOccupancyMaxActiveBlocksPerMultiprocessor(&per_cu, (const void*)mk_fwd, NWAVES * 64, LDS_BYTES) != hipSuccess || per_cu < 1) fprintf(stderr, "kernel_launch: occupancy query says %d\n", per_cu);
        (void)hipGetLastError();
        g_grid = cus > 0 ? cus : 256;
    }
    unsigned char* ws = (unsigned char*)d_ws; float* out = (float*)d_out;
    MArgs base{}; for (int i = 0; i < 24; ++i) base.in[i] = (const float*)d_in[i]; base.out = out; base.ws = ws;

    (void)hipMemsetAsync(ws + WS_CTL, 0, 1 * MiB, stream);
    launch_mk(base, 0, 9, stream);
}
```

```cpp
#include <hip/hip_runtime.h>
#include <stdint.h>
#include <cstdio>
#ifndef DUP_P2
#define DUP_P2 0
#endif
#ifndef DUP_PHASE
#define DUP_PHASE -1
#endif

typedef unsigned short bf16_t;
typedef short bf16x8 __attribute__((ext_vector_type(8)));
typedef float f32x4 __attribute__((ext_vector_type(4)));
typedef unsigned u32x4 __attribute__((ext_vector_type(4)));
typedef int i32x8 __attribute__((ext_vector_type(8)));
typedef int i32x4 __attribute__((ext_vector_type(4)));

constexpr int NBATCH = 8, SEQ = 4096, DM = 1024, T_TOK = NBATCH * SEQ, INW = 6144, MEML = 256;
constexpr int OFF_U = 0, OFF_V = 512, OFF_QB = 1024, OFF_KB = 1536, OFF_VB = 2048, OFF_QM = 2560, OFF_G = 3072;
constexpr int NEXP = 32, TOPK = 4, DFF = 1024;
constexpr float EPS = 1e-6f;
constexpr int ACT_ROWS = T_TOK * TOPK + NEXP * 256;

constexpr size_t MiB = 1ull << 20;
constexpr size_t WS_CTL = 0;
constexpr size_t WS_WIN = 1 * MiB;
constexpr size_t WS_WBR = 13 * MiB;
constexpr size_t WS_WOUT = 16 * MiB;
constexpr size_t WS_WMEM = 18 * MiB;
constexpr size_t WS_WR = 20 * MiB;
constexpr size_t WS_RSTD2 = 21 * MiB;
constexpr size_t WS_WSB = 21 * MiB + 256 * 1024;
constexpr size_t WS_KMP = 22 * MiB;
constexpr size_t WS_TOPW = 23 * MiB;
constexpr size_t WS_LIST = 24 * MiB;
constexpr size_t WS_RSTDS = 28 * MiB;
constexpr size_t WS_TOPWS = 32 * MiB;
constexpr size_t WS_MEMN = 36 * MiB;
constexpr size_t WS_MKV = 40 * MiB;
constexpr size_t WS_W1 = 44 * MiB;
constexpr size_t WS_W2 = 172 * MiB;
constexpr size_t WS_MERGED = 236 * MiB;
constexpr size_t WS_X1B = 300 * MiB;
constexpr size_t WS_HB = 364 * MiB;
constexpr size_t WS_PROJ = 428 * MiB;
constexpr size_t WS_Y = 812 * MiB;
constexpr size_t WS_ACT = 364 * MiB;
constexpr size_t WS_YS = 636 * MiB;
constexpr size_t WS_X1H = 500 * MiB;
constexpr size_t WS_HBQ = 908 * MiB;
constexpr size_t WS_WINQ = 944 * MiB;
constexpr size_t WS_SCR = 960 * MiB;
constexpr size_t WS_END = 1024 * MiB;
constexpr int CW_CNT = 64;
constexpr int CW_DIAG = 128;

__device__ __forceinline__ float bf2f(bf16_t b) { return __uint_as_float(((unsigned)b) << 16); }
__device__ __forceinline__ bf16_t f2bf(float f) { unsigned u = __float_as_uint(f); u += 0x7fffu + ((u >> 16) & 1u); return (bf16_t)(u >> 16); }
__device__ __forceinline__ float wave_sum(float v) {
#pragma unroll
    for (int o = 1; o < 64; o <<= 1) v += __shfl_xor(v, o);
    return v;
}
__device__ __forceinline__ float wave_max(float v) {
#pragma unroll
    for (int o = 1; o < 64; o <<= 1) v = fmaxf(v, __shfl_xor(v, o));
    return v;
}
__device__ __forceinline__ float gelu_exact(float v) { return 0.5f * v * (1.0f + erff(v * 0.70710678118654752f)); }
__device__ __forceinline__ float sigmoidf_(float v) { return 1.0f / (1.0f + __expf(-v)); }

#define LAS __attribute__((address_space(3)))
typedef float f32x2 __attribute__((ext_vector_type(2)));
constexpr int NWAVES = 8;
constexpr int RING_BYTES = 131072;
constexpr int LDSCTL_OFF = RING_BYTES;
constexpr int TAB_OFF = RING_BYTES + 64;
constexpr int TAB_CNT = 0, TAB_TST = 32, TAB_TE = 96, TAB_WORDS = 96 + 576;
constexpr int RTAB_OFF = RING_BYTES + 8192;
constexpr int RT_STRIDE = 4096;
constexpr int LDS_BYTES = 147456;
static_assert(TAB_OFF + TAB_WORDS * 4 <= LDS_BYTES && RTAB_OFF + 2 * RT_STRIDE <= LDS_BYTES, "LDS map");
constexpr int CW_BAR = 4096;

#define XB_TMO      128
#define XB_XCNT(j)  (256  + 64 * (j))
#define XB_XSUB(j)  (1280 + 64 * (j))
#define XB_XGEN(j)  (2304 + 64 * (j))
#define XB_TOP      3328
#define XB_TOPGEN   3392
#define XCD_BAR_WORDS 3456
#define XB_SPIN_CAP (1u << 18)
__device__ __forceinline__ unsigned xb_ld(unsigned* p)              { return __hip_atomic_load(p, __ATOMIC_RELAXED, __HIP_MEMORY_SCOPE_AGENT); }
__device__ __forceinline__ unsigned xb_add(unsigned* p, unsigned v) { return __hip_atomic_fetch_add(p, v, __ATOMIC_RELAXED, __HIP_MEMORY_SCOPE_AGENT); }
__device__ __forceinline__ unsigned xb_xcc_id() { return (unsigned)__builtin_amdgcn_s_getreg((3 << 11) | 20) & 0xFu; }
#define XB_SPIN(cond, bar) do { unsigned _sp = 0; while (cond) { __builtin_amdgcn_s_sleep(1); \
    if ((++_sp & 255u) == 0u) { if (xb_ld(&(bar)[XB_TMO])) break; if (_sp > XB_SPIN_CAP) { atomicAdd(&(bar)[XB_TMO], 1u); break; } } } } while (0)
struct XcdBarrier { unsigned* bar; unsigned x; volatile LAS unsigned* st; };
__device__ __forceinline__ XcdBarrier xcd_barrier_post(unsigned* bar, volatile LAS unsigned* st) {
    XcdBarrier b; b.bar = bar; b.x = xb_xcc_id(); b.st = st;
    if (threadIdx.x == 0) (void)xb_add(&bar[XB_XCNT(b.x)], 1u);
    return b;
}
__device__ __forceinline__ void xcd_barrier_complete(unsigned* bar, unsigned x, unsigned& nloc, unsigned& nx) {
    const unsigned G = gridDim.x * gridDim.y * gridDim.z;
    unsigned sum, cnt, mine, sp = 0u;
    for (;;) {
        sum = 0u; cnt = 0u; mine = 0u;
#pragma unroll
        for (unsigned j = 0; j < 16; ++j) { const unsigned c = xb_ld(&bar[XB_XCNT(j)]); sum += c; cnt += (c > 0u) ? 1u : 0u; mine = (j == x) ? c : mine; }
        if (sum == G) break;
        __builtin_amdgcn_s_sleep(1);
        if ((++sp & 255u) == 0u) { if (xb_ld(&bar[XB_TMO])) break; if (sp > XB_SPIN_CAP) { atomicAdd(&bar[XB_TMO], 1u); break; } }
    }
    nloc = mine > 0u ? mine : 1u; nx = cnt > 0u ? cnt : 1u;
}
__device__ __forceinline__ void xcd_barrier(const XcdBarrier& b) {
    asm volatile("s_waitcnt vmcnt(0)" ::: "memory");
    __syncthreads();
    if (threadIdx.x == 0) {
        unsigned* bar = b.bar;
        __builtin_amdgcn_s_waitcnt(0);
        unsigned nloc = b.st[0], nx = b.st[1];
        if (nloc == 0u) { xcd_barrier_complete(bar, b.x, nloc, nx); b.st[0] = nloc; b.st[1] = nx; }
        const unsigned old = xb_add(&bar[XB_XSUB(b.x)], 1u);
        const unsigned gen = old / nloc;
        if (old + 1u == (gen + 1u) * nloc) {
            __builtin_amdgcn_fence(__ATOMIC_RELEASE, "agent");
            asm volatile("s_waitcnt vmcnt(0)" ::: "memory");
            const unsigned og = xb_add(&bar[XB_TOP], 1u);
            const unsigned tg = og / nx;
            if (og + 1u == (tg + 1u) * nx) xb_add(&bar[XB_TOPGEN], 1u);
            else XB_SPIN(xb_ld(&bar[XB_TOPGEN]) == tg, bar);
            __builtin_amdgcn_fence(__ATOMIC_ACQUIRE, "agent");
            xb_add(&bar[XB_XGEN(b.x)], 1u);
            asm volatile("s_waitcnt vmcnt(0)" ::: "memory");
        } else {
            XB_SPIN(xb_ld(&bar[XB_XGEN(b.x)]) == gen, bar);
            __builtin_amdgcn_fence(__ATOMIC_ACQUIRE, "agent");
            asm volatile("s_waitcnt vmcnt(0)" ::: "memory");
        }
    }
    __syncthreads();
}

#ifndef PG_ALIGN
#define PG_ALIGN true
#endif
namespace pg {
constexpr int BM = 256, BK = 64, HALF = 128, HTB = HALF * BK * 2, STAGE_BYTES = 8 * HTB, NXCD = 8, WGM = 8;
__host__ __device__ __forceinline__ int lds_byte(int r, int c) { const int st = (r >> 4) * 2 + (c >> 5), rr = r & 15, cc = c & 31, ob = rr * 64 + cc * 2; return st * 1024 + (ob ^ (((ob >> 9) & 1) << 5)); }
__host__ __device__ __forceinline__ void stage_rc(int b, int& R, int& C) { const int st = b / 1024, sb = b % 1024, swz = sb ^ (((sb >> 9) & 1) << 5); R = (st >> 1) * 16 + swz / 64; C = (st & 1) * 32 + (swz % 64) / 2; }
__host__ __device__ __forceinline__ int perm32(int rho) { const int n = rho >> 4, i = rho & 15; return 8 * (i >> 2) + 4 * n + (i & 3); }
struct Unit { int pm, pn, e, mt; };
__device__ __forceinline__ bool static_unit(long L, int nM, int nN, int& pm, int& pn) {
    const int nwg = nM * nN; if (L >= nwg) return false;
    int wgid = (int)L; { const int q = nwg / NXCD, r = nwg % NXCD, xcd = wgid % NXCD, off = wgid / NXCD; wgid = (xcd < r ? xcd * (q + 1) : r * (q + 1) + (xcd - r) * q) + off; }
    const int nig = WGM * nN, gid = wgid / nig, fm = gid * WGM, gsz = (nM - fm) < WGM ? (nM - fm) : WGM;
    pm = fm + ((wgid % nig) % gsz); pn = (wgid % nig) / gsz; return true;
}
typedef __bf16 bf16x2_hw __attribute__((ext_vector_type(2)));
__device__ __forceinline__ unsigned cvt_pk_bf16(float lo, float hi) { const bf16x2_hw b = __builtin_convertvector((f32x2){lo, hi}, bf16x2_hw); return __builtin_bit_cast(unsigned, b); }
__device__ __forceinline__ u32x4 pack8(const f32x4 v0, const f32x4 v1) { u32x4 w; w.x = cvt_pk_bf16(v0[0], v0[1]); w.y = cvt_pk_bf16(v0[2], v0[3]); w.z = cvt_pk_bf16(v1[0], v1[1]); w.w = cvt_pk_bf16(v1[2], v1[3]); return w; }
constexpr float YQ_SCALE = 32.0f, YQ_INV = 1.0f / 32.0f;
constexpr float WQ_SCALE = 64.0f, WQ_INV = 1.0f / 64.0f;
__device__ __forceinline__ uint2 pack8_fp8(const f32x4 v0, const f32x4 v1) { int a = 0, b = 0;
    a = __builtin_amdgcn_cvt_pk_fp8_f32(v0[0], v0[1], a, false); a = __builtin_amdgcn_cvt_pk_fp8_f32(v0[2], v0[3], a, true);
    b = __builtin_amdgcn_cvt_pk_fp8_f32(v1[0], v1[1], b, false); b = __builtin_amdgcn_cvt_pk_fp8_f32(v1[2], v1[3], b, true); return make_uint2((unsigned)a, (unsigned)b); }
#ifndef EPI_NT
#define EPI_NT 0
#endif
__device__ __forceinline__ void st16(void* p, const u32x4 v) { if (EPI_NT) __builtin_nontemporal_store(v, (u32x4*)p); else *(u32x4*)p = v; }
__device__ __forceinline__ void st16f(void* p, const f32x4 v) { if (EPI_NT) __builtin_nontemporal_store(v, (f32x4*)p); else *(f32x4*)p = v; }
__device__ __forceinline__ void st8(void* p, const uint2 v) { typedef unsigned u32x2 __attribute__((ext_vector_type(2))); const u32x2 w = {v.x, v.y}; if (EPI_NT) __builtin_nontemporal_store(w, (u32x2*)p); else *(u32x2*)p = w; }
__device__ __forceinline__ void unpack8(const u32x4 w, f32x4& v0, f32x4& v1) {
    v0[0] = __uint_as_float(w.x << 16); v0[1] = __uint_as_float(w.x & 0xffff0000u); v0[2] = __uint_as_float(w.y << 16); v0[3] = __uint_as_float(w.y & 0xffff0000u);
    v1[0] = __uint_as_float(w.z << 16); v1[1] = __uint_as_float(w.z & 0xffff0000u); v1[2] = __uint_as_float(w.w << 16); v1[3] = __uint_as_float(w.w & 0xffff0000u); }
__device__ __forceinline__ f32x2 gelu_pk(f32x2 v) {
    const f32x2 av = __builtin_elementwise_abs(v), d = av * 0.2316418882f + 1.0f;
    f32x2 t; t.x = __builtin_amdgcn_rcpf(d.x); t.y = __builtin_amdgcn_rcpf(d.y);
    f32x2 q = t * 0.5307027145f + (-0.7265760135f); q = q * t + 0.7107068705f; q = q * t + (-0.142248368f); q = q * t + 0.127414796f; q = q * t;
    const f32x2 s = (v * v) * (-0.72134752044f);
    f32x2 e; e.x = __builtin_amdgcn_exp2f(s.x); e.y = __builtin_amdgcn_exp2f(s.y);
    const f32x2 m = v * (q * e), r = v - m;
    f32x2 o; o.x = v.x < 0.f ? m.x : r.x; o.y = v.y < 0.f ? m.y : r.y; return o;
}
__device__ __forceinline__ f32x4 gelu4(f32x4 v) { const f32x2 a = gelu_pk((f32x2){v[0], v[1]}), b = gelu_pk((f32x2){v[2], v[3]}); return (f32x4){a.x, a.y, b.x, b.y}; }
__device__ __forceinline__ float sigm(float v) { return __builtin_amdgcn_rcpf(1.0f + __builtin_amdgcn_exp2f(v * -1.4426950408889634f)); }
__device__ __forceinline__ f32x4 sigm4(f32x4 v) { return (f32x4){sigm(v[0]), sigm(v[1]), sigm(v[2]), sigm(v[3])}; }

template <class Pol>
__device__ __forceinline__ void gemm_run(LAS unsigned char* lds, const Pol& P) {
    constexpr int KB = Pol::FP8 ? Pol::K : Pol::K * 2, nt = KB / (BK * 2);
    const int tid = threadIdx.x, wid = __builtin_amdgcn_readfirstlane(tid >> 6), lane = tid & 63, wr = wid >> 2, wc = wid & 3, fr = lane & 15, fq = lane >> 4;
    unsigned voffA[2], voffB[2]; int Rr[2], Cc[2];
#pragma unroll
    for (int i = 0; i < 2; ++i) { int R, C; stage_rc(tid * 16 + i * 8192, R, C); Rr[i] = R; Cc[i] = C; const int Rb = (R & ~31) + perm32(R & 31);
        voffA[i] = (unsigned)(R * KB + C * 2); voffB[i] = (unsigned)(Rb * KB + C * 2); }
    constexpr unsigned kstep = BK * 2, hstep = HALF * KB;
    const unsigned ldsw = (unsigned)wid * 1024u;
    const int aoff = lds_byte(wr * 64 + fr, fq * (Pol::FP8 ? 16 : 8)), boff = lds_byte(wc * 32 + fr, fq * (Pol::FP8 ? 16 : 8));
#define PG_SA(b, h) (((b) * 2 + (h)) * HTB)
#define PG_SB(b, h) ((4 + (b) * 2 + (h)) * HTB)
#define PG_AOFF(nx, h, i) (Pol::GATHER ? gC[h][i] : (voffA[i] + (unsigned)(h) * hstep))
#define PG_STAGE_A(bufoff, gbase, nx, h) do { _Pragma("unroll") for (int _i = 0; _i < 2; ++_i) \
        __builtin_amdgcn_global_load_lds((const unsigned*)((const char*)(gbase) + PG_AOFF(nx, h, _i)), (LAS unsigned*)(lds + (bufoff) + ldsw + _i * 8192), 16, 0, 0); } while (0)
#define PG_STAGE_B(bufoff, gbase) do { _Pragma("unroll") for (int _i = 0; _i < 2; ++_i) \
        __builtin_amdgcn_global_load_lds((const unsigned*)((const char*)(gbase) + voffB[_i]), (LAS unsigned*)(lds + (bufoff) + ldsw + _i * 8192), 16, 0, 0); } while (0)
#define PG_LD32(p) ({ const i32x4 _lo = *(const LAS i32x4*)(p), _hi = *(const LAS i32x4*)((p) + 16); (i32x8){_lo[0], _lo[1], _lo[2], _lo[3], _hi[0], _hi[1], _hi[2], _hi[3]}; })
#define PG_LDA(dst, b, h) do { if constexpr (Pol::FP8) { _Pragma("unroll") for (int m = 0; m < 4; ++m) dst##_8[m] = PG_LD32(lds + PG_SA(b, h) + aoff + m * 2048); } \
        else { _Pragma("unroll") for (int m = 0; m < 4; ++m) _Pragma("unroll") for (int k = 0; k < 2; ++k) dst[m][k] = *(const LAS bf16x8*)(lds + PG_SA(b, h) + aoff + m * 2048 + k * 1024); } } while (0)
#define PG_LDB(dst, b, h) do { if constexpr (Pol::FP8) { _Pragma("unroll") for (int n = 0; n < 2; ++n) dst##_8[n] = PG_LD32(lds + PG_SB(b, h) + boff + n * 2048); } \
        else { _Pragma("unroll") for (int n = 0; n < 2; ++n) _Pragma("unroll") for (int k = 0; k < 2; ++k) dst[n][k] = *(const LAS bf16x8*)(lds + PG_SB(b, h) + boff + n * 2048 + k * 1024); } } while (0)
#define PG_MMA(ai, bj, At, Bt) do { __builtin_amdgcn_s_setprio(1); \
        if constexpr (Pol::FP8) { _Pragma("unroll") for (int m = 0; m < 4; ++m) _Pragma("unroll") for (int n = 0; n < 2; ++n) \
            acc[ai][bj][m][n] = __builtin_amdgcn_mfma_scale_f32_16x16x128_f8f6f4(Bt##_8[n], At##_8[m], acc[ai][bj][m][n], 0, 0, 0, 0x7F7F7F7F, 0, 0x7F7F7F7F); } \
        else { _Pragma("unroll") for (int m = 0; m < 4; ++m) _Pragma("unroll") for (int n = 0; n < 2; ++n) _Pragma("unroll") for (int k = 0; k < 2; ++k) \
            acc[ai][bj][m][n] = __builtin_amdgcn_mfma_f32_16x16x32_bf16(Bt[n][k], At[m][k], acc[ai][bj][m][n], 0, 0, 0); } \
        __builtin_amdgcn_s_setprio(0); } while (0)
#define PG_WAIT_V(n) asm volatile("s_waitcnt vmcnt(" #n ")" ::: "memory")
#define PG_WAIT_L(n) asm volatile("s_waitcnt lgkmcnt(" #n ")" ::: "memory")
#define PG_BAR __builtin_amdgcn_s_barrier()
#define PG_SCHED __builtin_amdgcn_sched_barrier(0)
    Unit cur, nxt; int ui = 0;
    if (!P.next(0, cur)) return;
    f32x4 acc[2][2][4][2];
#pragma unroll
    for (int a = 0; a < 2; ++a)
#pragma unroll
        for (int b = 0; b < 2; ++b)
#pragma unroll
            for (int m = 0; m < 4; ++m)
#pragma unroll
                for (int n = 0; n < 2; ++n) acc[a][b][m][n] = (f32x4){0.f, 0.f, 0.f, 0.f};
    bf16x8 At[4][2], B0[2][2], B1[2][2];
    i32x8 At_8[4], B0_8[2], B1_8[2];
    unsigned gC[2][2] = {{0u, 0u}, {0u, 0u}};
    const char* cA = P.a_base(cur); const char* cB = P.b_base(cur);
    if constexpr (Pol::ROWTAB) { P.tab_issue(cur, 0); asm volatile("s_waitcnt vmcnt(0)" ::: "memory"); __builtin_amdgcn_s_barrier(); asm volatile("" ::: "memory"); }
    if constexpr (Pol::GATHER) P.a_offsets(cur, Rr, Cc, gC, 0);
    PG_STAGE_B(PG_SB(0, 0), cB); PG_STAGE_B(PG_SB(0, 1), cB + hstep); PG_STAGE_A(PG_SA(0, 0), cA, false, 0); PG_STAGE_A(PG_SA(0, 1), cA, false, 1);
    if (wr == 1) PG_BAR;
    PG_WAIT_V(2); PG_BAR;
    PG_STAGE_B(PG_SB(1, 0), cB + kstep); PG_STAGE_A(PG_SA(1, 0), cA + kstep, false, 0); PG_STAGE_B(PG_SB(1, 1), cB + hstep + kstep);
    PG_WAIT_V(6); PG_BAR;
    for (;;) {
        const bool has_next = P.next(ui + 1, nxt);
        const char* nA = has_next ? P.a_base(nxt) : cA; const char* nB = has_next ? P.b_base(nxt) : cB;
#pragma nounroll
        for (int t = 0; t < nt; t += 2) {
            const bool last = (t == nt - 2);
            if constexpr (Pol::ROWTAB) { if (t == 2 && has_next) P.tab_issue(nxt, (ui + 1) & 1); }
            if constexpr (Pol::HOOK) { if (t == Pol::H1 || t == Pol::H2) P.khook(t, acc, cur, wr, wc, fr, fq); }
            const char* a1 = cA + (size_t)(t + 1) * kstep;
            const char* a2 = last ? nA : cA + (size_t)(t + 2) * kstep; const char* b2 = last ? nB : cB + (size_t)(t + 2) * kstep;
            const char* a3 = a2 + kstep; const char* b3 = b2 + kstep;
            PG_LDB(B0, 0, 0); PG_LDB(B1, 0, 1); PG_SCHED; PG_LDA(At, 0, 0); PG_STAGE_A(PG_SA(1, 1), a1, false, 1);
            if constexpr (Pol::GATHER) { if (last && has_next) P.a_offsets(nxt, Rr, Cc, gC, (ui + 1) & 1); }
            PG_WAIT_V(8); PG_WAIT_L(0); PG_BAR; PG_MMA(0, 0, At, B0); PG_MMA(0, 1, At, B1); PG_BAR; PG_SCHED;
            PG_LDA(At, 0, 1); PG_STAGE_B(PG_SB(0, 0), b2); PG_STAGE_B(PG_SB(0, 1), b2 + hstep); PG_STAGE_A(PG_SA(0, 0), a2, last, 0);
            PG_WAIT_V(8); PG_WAIT_L(0); PG_BAR; PG_MMA(1, 0, At, B0); PG_MMA(1, 1, At, B1); PG_BAR; PG_SCHED;
            PG_LDB(B0, 1, 0); PG_LDB(B1, 1, 1); PG_SCHED; PG_LDA(At, 1, 0); PG_STAGE_A(PG_SA(0, 1), a2, last, 1);
            PG_WAIT_V(8); PG_WAIT_L(0); PG_BAR; PG_MMA(0, 0, At, B0); PG_MMA(0, 1, At, B1); PG_BAR; PG_SCHED;
            PG_LDA(At, 1, 1); PG_STAGE_B(PG_SB(1, 0), b3); PG_STAGE_B(PG_SB(1, 1), b3 + hstep); PG_STAGE_A(PG_SA(1, 0), a3, last, 0);
            PG_WAIT_V(8); PG_WAIT_L(0); PG_BAR; PG_MMA(1, 0, At, B0); PG_MMA(1, 1, At, B1); PG_BAR; PG_SCHED;
        }
        if constexpr (PG_ALIGN) { if (wr == 0) PG_BAR; }
        P.epi(acc, cur, wr, wc, fr, fq, ui & 1);
#ifdef DUP_EPI
        if (Pol::K == DUP_EPI_K) { asm volatile("" ::: "memory"); P.epi(acc, cur, wr, wc, fr, fq, ui & 1); }
#endif
        if (!has_next) break;
#pragma unroll
        for (int a = 0; a < 2; ++a)
#pragma unroll
            for (int b = 0; b < 2; ++b)
#pragma unroll
                for (int m = 0; m < 4; ++m)
#pragma unroll
                    for (int n = 0; n < 2; ++n) acc[a][b][m][n] = (f32x4){0.f, 0.f, 0.f, 0.f};
        cur = nxt; cA = nA; cB = nB; ++ui;
        if constexpr (PG_ALIGN) { if (wr == 1) PG_BAR; }
    }
    PG_WAIT_V(0);
    if constexpr (!PG_ALIGN) { if (wr == 0) PG_BAR; }
    PG_BAR;
#undef PG_SA
#undef PG_SB
#undef PG_AOFF
#undef PG_STAGE_A
#undef PG_STAGE_B
#undef PG_LDA
#undef PG_LD32
#undef PG_LDB
#undef PG_MMA
#undef PG_WAIT_V
#undef PG_WAIT_L
#undef PG_BAR
#undef PG_SCHED
}

__device__ __forceinline__ void glds4_asm(const void* gsrc, unsigned lds_dst) { unsigned keep;
    asm volatile("s_mov_b32 %0, m0\n\ts_mov_b32 m0, %2\n\ts_nop 0\n\tglobal_load_lds_dword %1, off\n\ts_mov_b32 m0, %0" : "=&s"(keep) : "v"(gsrc), "s"(lds_dst) : "memory"); }
__device__ __forceinline__ void glds16_asm(const void* gsrc, unsigned lds_dst) { unsigned keep;
    asm volatile("s_mov_b32 %0, m0\n\ts_mov_b32 m0, %2\n\ts_nop 0\n\tglobal_load_lds_dwordx4 %1, off\n\ts_mov_b32 m0, %0" : "=&s"(keep) : "v"(gsrc), "s"(lds_dst) : "memory"); }
struct PolBase { static constexpr bool GATHER = false, HOOK = false, FP8 = false, ROWTAB = false;
    __device__ __forceinline__ void tab_issue(const Unit&, int) const {} static constexpr int H1 = -1, H2 = -1;
    __device__ __forceinline__ void a_offsets(const Unit&, const int (&)[2], const int (&)[2], unsigned (&)[2][2], int) const {}
    __device__ __forceinline__ void khook(int, f32x4 (&)[2][2][4][2], const Unit&, int, int, int, int) const {} };

constexpr int GQ_OFF = OFF_G * 2;
__device__ __forceinline__ void gq_unpack(const uint2 w, f32x4& g0, f32x4& g1) {
    g0 = (f32x4){(float)(w.x & 0xffu), (float)((w.x >> 8) & 0xffu), (float)((w.x >> 16) & 0xffu), (float)(w.x >> 24)} * (1.0f / 256.0f) + (0.5f / 256.0f);
    g1 = (f32x4){(float)(w.y & 0xffu), (float)((w.y >> 8) & 0xffu), (float)((w.y >> 16) & 0xffu), (float)(w.y >> 24)} * (1.0f / 256.0f) + (0.5f / 256.0f); }
#ifndef P1_FP8_TILES
#define P1_FP8_TILES 0xFFFF0Cu
#endif
static_assert((P1_FP8_TILES & 0xF0u) == 0u, "the q_b / k_b tiles (head rmsnorm, block selection) stay bf16");
static_assert((P1_FP8_TILES & 0xFFF000u) == 0xFFF000u, "the gate tiles are written (as 8-bit codes) by the fp8 policy only");
static_assert((P1_FP8_TILES | 0xFFu) == 0xFFFFFFu, "bf16 weight rows are only prepared for column tiles 0..7");
constexpr int p1_popc(unsigned m) { int n = 0; for (int t = 0; t < 24; ++t) n += (m >> t) & 1u; return n; }
constexpr int P1_NF8 = p1_popc(P1_FP8_TILES), P1_NBF = 24 - P1_NF8;
__device__ __forceinline__ int p1_tile(unsigned mask, int j) { int t = 0;
    for (; t < 24; ++t) if ((mask >> t) & 1u) { if (j == 0) break; --j; }
    return t; }
struct PolP1 : PolBase {
    static constexpr int K = 1024;
    const bf16_t* A; const bf16_t* Bt; bf16_t* PROJ; float* KMP; const float* gq; const float* gk; int G, c;
    __device__ __forceinline__ bool next(int i, Unit& u) const { u.e = 0; u.mt = 0; if (!static_unit((long)i * G + c, T_TOK / 256, P1_NBF, u.pm, u.pn)) return false; u.pn = p1_tile(P1_FP8_TILES ^ 0xFFFFFFu, u.pn); return true; }
    __device__ __forceinline__ const char* a_base(const Unit& u) const { return (const char*)A + (size_t)u.pm * 256 * K * 2; }
    __device__ __forceinline__ const char* b_base(const Unit& u) const { return (const char*)Bt + (size_t)u.pn * 256 * K * 2; }
    __device__ __forceinline__ void epi(const f32x4 (&acc)[2][2][4][2], const Unit& u, int wr, int wc, int fr, int fq, int) const {
        const int row0 = u.pm * 256 + wr * 64 + fr, pn = u.pn;
        if (pn >= 4 && pn < 8) {
            const float* g = (pn < 6) ? gq : gk;
            f32x4 gv[2][2], cs[2][2];
#pragma unroll
            for (int bj = 0; bj < 2; ++bj)
#pragma unroll
                for (int n = 0; n < 2; ++n) { gv[bj][n] = *(const f32x4*)(g + 32 * bj + 8 * fq + 4 * n); cs[bj][n] = (f32x4){0.f, 0.f, 0.f, 0.f}; }
#pragma unroll
            for (int ai = 0; ai < 2; ++ai)
#pragma unroll
                for (int m = 0; m < 4; ++m) {
                    float ss = 0.f;
#pragma unroll
                    for (int bj = 0; bj < 2; ++bj)
#pragma unroll
                        for (int n = 0; n < 2; ++n) { const f32x4 x = acc[ai][bj][m][n]; ss += (x[0] * x[0] + x[1] * x[1]) + (x[2] * x[2] + x[3] * x[3]); }
                    ss += __shfl_xor(ss, 16); ss += __shfl_xor(ss, 32);
                    const float rstd = rsqrtf(ss * (1.0f / 64.0f) + EPS) * ((pn < 6) ? 0.18033688011112042f : 1.0f);
                    bf16_t* rowp = PROJ + (size_t)(row0 + ai * HALF + m * 16) * INW + 1024 + (pn - 4) * 256 + 64 * wc + 8 * fq;
#pragma unroll
                    for (int bj = 0; bj < 2; ++bj) { const f32x4 v0 = acc[ai][bj][m][0] * rstd * gv[bj][0], v1 = acc[ai][bj][m][1] * rstd * gv[bj][1];
                        cs[bj][0] += v0; cs[bj][1] += v1; st16(rowp + 32 * bj, pack8(v0, v1)); }
                }
            if (pn >= 6) {
#pragma unroll
                for (int bj = 0; bj < 2; ++bj)
#pragma unroll
                    for (int n = 0; n < 2; ++n)
#pragma unroll
                        for (int j = 0; j < 4; ++j) { float s = cs[bj][n][j]; s += __shfl_xor(s, 1); s += __shfl_xor(s, 2); s += __shfl_xor(s, 4); s += __shfl_xor(s, 8); cs[bj][n][j] = s; }
                if (fr == 0) {
                    float* kp = KMP + ((size_t)u.pm * 2 + wr) * 512 + (pn - 6) * 256 + 64 * wc + 8 * fq;
#pragma unroll
                    for (int bj = 0; bj < 2; ++bj) { *(f32x4*)(kp + 32 * bj) = cs[bj][0]; *(f32x4*)(kp + 32 * bj + 4) = cs[bj][1]; }
                }
            }
        } else {
            const int col0 = pn * 256 + wc * 32 + 8 * fq;
#pragma unroll
            for (int ai = 0; ai < 2; ++ai)
#pragma unroll
                for (int m = 0; m < 4; ++m) { bf16_t* rowp = PROJ + (size_t)(row0 + ai * HALF + m * 16) * INW + col0;
#pragma unroll
                    for (int bj = 0; bj < 2; ++bj) { f32x4 v0 = acc[ai][bj][m][0], v1 = acc[ai][bj][m][1];
                        if (pn < 4) { v0 = gelu4(v0); v1 = gelu4(v1); } else if (pn >= 12) { v0 = sigm4(v0); v1 = sigm4(v1); }
                        st16(rowp + bj * HALF, pack8(v0, v1)); } }
        }
    }
};

struct PolP1G : PolBase {
    static constexpr int K = 1024; static constexpr bool FP8 = true, GATHER = true;
    const unsigned char* A; const unsigned char* Bt; bf16_t* PROJ; int G, c;
    __device__ __forceinline__ bool next(int i, Unit& u) const { u.e = 0; u.mt = 0; constexpr int NU = T_TOK / 256 * P1_NF8; long L = (long)i * G + c;
        if (G == 256 && NU % 256 == 0 && NU / 256 >= 2) { constexpr int R = NU / 256; if (i < R - 1) L = (long)i * 256 + c; else if (c >= 128 && i < R + 1) L = (long)(R - 1) * 256 + (i - (R - 1)) * 128 + (c - 128); else return false; }
        if (!static_unit(L, T_TOK / 256, P1_NF8, u.pm, u.pn)) return false; u.pn = p1_tile(P1_FP8_TILES, u.pn); return true; }
    __device__ __forceinline__ const char* a_base(const Unit&) const { return (const char*)A; }
    __device__ __forceinline__ const char* b_base(const Unit& u) const { return (const char*)Bt + (size_t)u.pn * 256 * K; }
    __device__ __forceinline__ void a_offsets(const Unit& u, const int (&Rr)[2], const int (&Cc)[2], unsigned (&g)[2][2], int) const {
#pragma unroll
        for (int h = 0; h < 2; ++h)
#pragma unroll
            for (int i = 0; i < 2; ++i) g[h][i] = (unsigned)(u.pm * 256 + h * HALF + Rr[i]) * (unsigned)K + (unsigned)Cc[i] * 2u;
    }
    __device__ __forceinline__ void epi(const f32x4 (&acc)[2][2][4][2], const Unit& u, int wr, int wc, int fr, int fq, int) const {
        const int row0 = u.pm * 256 + wr * 64 + fr, pn = u.pn, col0 = pn * 256 + wc * 32 + 8 * fq;
        if (pn >= 12) {
#pragma unroll
            for (int ai = 0; ai < 2; ++ai)
#pragma unroll
                for (int m = 0; m < 4; ++m) { unsigned char* rowq = (unsigned char*)PROJ + (size_t)(row0 + ai * HALF + m * 16) * (INW * 2) + GQ_OFF + (col0 - OFF_G);
#pragma unroll
                    for (int bj = 0; bj < 2; ++bj) { unsigned w[2] = {0u, 0u};
#pragma unroll
                        for (int n = 0; n < 2; ++n)
#pragma unroll
                            for (int j = 0; j < 4; ++j) { const float g = __builtin_amdgcn_rcpf(1.0f + __builtin_amdgcn_exp2f(acc[ai][bj][m][n][j] * (-1.4426950408889634f * WQ_INV)));
                                w[n] = __builtin_amdgcn_cvt_pk_u8_f32(__builtin_floorf(g * 256.0f), j, w[n]); }
                        st8(rowq + bj * HALF, make_uint2(w[0], w[1])); } }
        } else {
#pragma unroll
            for (int ai = 0; ai < 2; ++ai)
#pragma unroll
                for (int m = 0; m < 4; ++m) { bf16_t* rowp = PROJ + (size_t)(row0 + ai * HALF + m * 16) * INW + col0;
#pragma unroll
                    for (int bj = 0; bj < 2; ++bj) { f32x4 v0 = acc[ai][bj][m][0] * WQ_INV, v1 = acc[ai][bj][m][1] * WQ_INV;
                        if (pn < 4) { v0 = gelu4(v0); v1 = gelu4(v1); }
                        st16(rowp + bj * HALF, pack8(v0, v1)); } }
        }
    }
};
struct PolP3 : PolBase {
    static constexpr int K = 1536; static constexpr bool HOOK = true; static constexpr int H1 = 8, H2 = 16;
    const bf16_t* A; const bf16_t* Bt; const bf16_t* PROJ; bf16_t* MERGED; int G, c;
    __device__ __forceinline__ bool next(int i, Unit& u) const { u.e = 0; u.mt = 0; return static_unit((long)i * G + c, T_TOK / 256, DM / 256, u.pm, u.pn); }
    __device__ __forceinline__ const char* a_base(const Unit& u) const { return (const char*)A + (size_t)u.pm * 256 * K * 2; }
    __device__ __forceinline__ const char* b_base(const Unit& u) const { return (const char*)Bt + (size_t)u.pn * 256 * K * 2; }
    __device__ __forceinline__ void khook(int t, f32x4 (&acc)[2][2][4][2], const Unit& u, int wr, int wc, int fr, int fq) const {
        const int gnum = (t == 8) ? 0 : 1024;
        int zero = 0; asm volatile("" : "+v"(zero));
        const int row0 = u.pm * 256 + wr * 64 + fr + zero, col0 = GQ_OFF + u.pn * 256 + wc * 32 + 8 * fq;
#pragma unroll
        for (int ai = 0; ai < 2; ++ai) {
            uint2 wn[4][2], wd[4][2];
#pragma unroll
            for (int m = 0; m < 4; ++m) { const unsigned char* rowp = (const unsigned char*)PROJ + (size_t)(row0 + ai * HALF + m * 16) * (INW * 2) + col0;
#pragma unroll
                for (int bj = 0; bj < 2; ++bj) { wn[m][bj] = *(const uint2*)(rowp + gnum + bj * HALF); wd[m][bj] = *(const uint2*)(rowp + gnum + 1024 + bj * HALF); } }
#pragma unroll
            for (int m = 0; m < 4; ++m)
#pragma unroll
                for (int bj = 0; bj < 2; ++bj) { f32x4 n0, n1, d0, d1; gq_unpack(wn[m][bj], n0, n1); gq_unpack(wd[m][bj], d0, d1);
#pragma unroll
                    for (int j = 0; j < 4; ++j) { acc[ai][bj][m][0][j] *= n0[j] * __builtin_amdgcn_rcpf(d0[j]); acc[ai][bj][m][1][j] *= n1[j] * __builtin_amdgcn_rcpf(d1[j]); } }
            asm volatile("" ::: "memory");
        }
    }
    __device__ __forceinline__ void epi(const f32x4 (&acc)[2][2][4][2], const Unit& u, int wr, int wc, int fr, int fq, int) const {
        const int row0 = u.pm * 256 + wr * 64 + fr, colt = u.pn * 256 + wc * 32 + 8 * fq;
#pragma unroll
        for (int ai = 0; ai < 2; ++ai)
#pragma unroll
            for (int m = 0; m < 4; ++m) { const size_t r = (size_t)(row0 + ai * HALF + m * 16);
#pragma unroll
                for (int bj = 0; bj < 2; ++bj) { const uint2 wg = *(const uint2*)((const unsigned char*)PROJ + r * (INW * 2) + GQ_OFF + 2048 + colt + bj * HALF); f32x4 g0, g1; gq_unpack(wg, g0, g1);
                    st16(MERGED + r * DM + colt + bj * HALF, pack8(acc[ai][bj][m][0] * g0, acc[ai][bj][m][1] * g1)); }
                if (m == 3) asm volatile("" ::: "memory"); }
    }
};
struct PolP4 : PolBase {
    static constexpr int K = 1024;
    const bf16_t* A; const bf16_t* Bt; const float* x; bf16_t* X1H; unsigned char* X1Q; const float* gffn; int G, c;
    __device__ __forceinline__ bool next(int i, Unit& u) const { u.e = 0; u.mt = 0; return static_unit((long)i * G + c, T_TOK / 256, DM / 256, u.pm, u.pn); }
    __device__ __forceinline__ const char* a_base(const Unit& u) const { return (const char*)A + (size_t)u.pm * 256 * K * 2; }
    __device__ __forceinline__ const char* b_base(const Unit& u) const { return (const char*)Bt + (size_t)u.pn * 256 * K * 2; }
    __device__ __forceinline__ void epi(const f32x4 (&acc)[2][2][4][2], const Unit& u, int wr, int wc, int fr, int fq, int) const {
        const int row0 = u.pm * 256 + wr * 64 + fr, colt = u.pn * 256 + wc * 32 + 8 * fq;
#pragma unroll
        for (int ai = 0; ai < 2; ++ai)
#pragma unroll
            for (int m = 0; m < 4; ++m) { const size_t o = (size_t)(row0 + ai * HALF + m * 16) * DM + colt;
#pragma unroll
                for (int bj = 0; bj < 2; ++bj) { const f32x4 x0 = *(const f32x4*)(x + o + bj * HALF), x1 = *(const f32x4*)(x + o + bj * HALF + 4);
                    const f32x4 v0 = x0 + acc[ai][bj][m][0], v1 = x1 + acc[ai][bj][m][1];
                    st16(X1H + o + bj * HALF, pack8(v0, v1));
                    const f32x4 g0 = *(const f32x4*)(gffn + colt + bj * HALF), g1 = *(const f32x4*)(gffn + colt + bj * HALF + 4);
                    st8(X1Q + o + bj * HALF, pack8_fp8(v0 * g0, v1 * g1)); }
                if (m & 1) asm volatile("" ::: "memory"); }
    }
};
struct GroupTab { const LAS int* tab; __device__ __forceinline__ int cnt(int e) const { return tab[TAB_CNT + e]; } __device__ __forceinline__ int tstart(int e) const { return tab[TAB_TST + e]; }
    __device__ __forceinline__ int tile_e(int vt) const { return tab[TAB_TE + vt]; } __device__ __forceinline__ int NT() const { return tab[TAB_TST + 32]; } };
struct PolP6 : PolBase {
    static constexpr int K = 1024; static constexpr bool GATHER = true, FP8 = true, ROWTAB = true;
    const unsigned char* X1Q; const unsigned char* W1Q; const int* LIST; const float* RSTDS; const float* b1; unsigned char* ACTQ; GroupTab tb; int G, c; LAS unsigned char* rtab;
    __device__ __forceinline__ void tab_issue(const Unit& u, int buf) const {
        const int tid = threadIdx.x;
        if (tid < 256) { const int valid = tb.cnt(u.e) - u.mt * 256, rc = tid < valid ? tid : 0; const size_t o = (size_t)u.e * 32768 + u.mt * 256 + rc;
            const unsigned dst = (unsigned)__builtin_amdgcn_readfirstlane((int)((unsigned)(size_t)rtab + buf * RT_STRIDE + (tid & ~63) * 4));
            glds4_asm(LIST + o, dst); glds4_asm(RSTDS + o, dst + 1024u);
            glds4_asm(b1 + (size_t)u.e * 2048 + u.pn * 128 + (tid < 128 ? tid : 1024 + (tid - 128)), dst + 2048u); }
    }
    __device__ __forceinline__ bool next(int i, Unit& u) const { if (!static_unit((long)i * G + c, tb.NT(), 8, u.pm, u.pn)) return false; u.e = tb.tile_e(u.pm); u.mt = u.pm - tb.tstart(u.e); return true; }
    __device__ __forceinline__ const char* a_base(const Unit&) const { return (const char*)X1Q; }
    __device__ __forceinline__ const char* b_base(const Unit& u) const { return (const char*)W1Q + ((size_t)u.e * 2048 + (size_t)u.pn * 256) * K; }
    __device__ __forceinline__ void a_offsets(const Unit&, const int (&Rr)[2], const int (&Cc)[2], unsigned (&g)[2][2], int buf) const {
        const LAS int* lp = (const LAS int*)(rtab + buf * RT_STRIDE);
#pragma unroll
        for (int h = 0; h < 2; ++h)
#pragma unroll
            for (int i = 0; i < 2; ++i) { const int tok = lp[h * HALF + Rr[i]] >> 2; g[h][i] = (unsigned)tok * (unsigned)K + (unsigned)Cc[i] * 2u; }
    }
    __device__ __forceinline__ void epi(const f32x4 (&acc)[2][2][4][2], const Unit& u, int wr, int wc, int fr, int fq, int buf) const {
        int zero = 0; asm volatile("" : "+v"(zero)); fr += zero;
        const int valid = tb.cnt(u.e) - u.mt * 256, colg = u.pn * 128 + wc * 32 + 8 * fq;
        const LAS float* rp = (const LAS float*)(rtab + buf * RT_STRIDE + 1024); const LAS float* bp = (const LAS float*)(rtab + buf * RT_STRIDE + 2048) + wc * 32 + 8 * fq;
        const f32x4 bg0 = *(const LAS f32x4*)bp, bg1 = *(const LAS f32x4*)(bp + 4), bl0 = *(const LAS f32x4*)(bp + 128), bl1 = *(const LAS f32x4*)(bp + 132);
        float rsv[8];
#pragma unroll
        for (int i = 0; i < 8; ++i) rsv[i] = rp[(i >> 2) * HALF + wr * 64 + (i & 3) * 16 + fr];
#pragma unroll
        for (int i = 0; i < 8; ++i) { const int ai = i >> 2, m = i & 3, r = ai * HALF + wr * 64 + m * 16 + fr; const float rs = (r < valid) ? rsv[i] * WQ_INV : 0.f;
            f32x4 o[2];
#pragma unroll
            for (int n = 0; n < 2; ++n) { const f32x4 gv = acc[ai][0][m][n] * rs + (n ? bg1 : bg0), lv = acc[ai][1][m][n] * rs + (n ? bl1 : bl0);
                f32x4 gg, ll, d;
#pragma unroll
                for (int j = 0; j < 4; ++j) { gg[j] = fminf(gv[j], 7.0f); ll[j] = __builtin_amdgcn_fmed3f(lv[j], -7.0f, 7.0f); }
                const f32x4 e = gg * (-1.702f * 1.4426950408889634f);
#pragma unroll
                for (int j = 0; j < 4; ++j) d[j] = __builtin_amdgcn_exp2f(e[j]);
                d = d + 1.0f;
#pragma unroll
                for (int j = 0; j < 4; ++j) d[j] = __builtin_amdgcn_rcpf(d[j]);
                const f32x4 t = gg * d;
                o[n] = t * ll + t; }
            st8(ACTQ + (size_t)(u.pm * 256 + r) * DFF + colg, pack8_fp8(o[0], o[1])); }
    }
};
struct PolP7 : PolBase {
    static constexpr int K = 1024; static constexpr bool FP8 = true, GATHER = true;
    const unsigned char* ACTQ; const unsigned char* W2Q; const int* LIST; const float* TOPWS; const float* b2; bf16_t* YS; GroupTab tb; int G, c; LAS unsigned char* rtab;
    static constexpr bool ROWTAB = true;
    __device__ __forceinline__ void tab_issue(const Unit& u, int buf) const {
        const int tid = threadIdx.x;
        if (tid < 256) { const int valid = tb.cnt(u.e) - u.mt * 256, rc = tid < valid ? tid : 0; const size_t o = (size_t)u.e * 32768 + u.mt * 256 + rc;
            const unsigned dst = (unsigned)__builtin_amdgcn_readfirstlane((int)((unsigned)(size_t)rtab + buf * RT_STRIDE + (tid & ~63) * 4));
            glds4_asm(LIST + o, dst); glds4_asm(TOPWS + o, dst + 1024u);
            glds4_asm(b2 + (size_t)u.e * 1024 + u.pn * 256 + tid, dst + 2048u); }
    }
    __device__ __forceinline__ bool next(int i, Unit& u) const { if (!static_unit((long)i * G + c, tb.NT(), 4, u.pm, u.pn)) return false; u.e = tb.tile_e(u.pm); u.mt = u.pm - tb.tstart(u.e); return true; }
    __device__ __forceinline__ const char* a_base(const Unit&) const { return (const char*)ACTQ; }
    __device__ __forceinline__ void a_offsets(const Unit& u, const int (&Rr)[2], const int (&Cc)[2], unsigned (&g)[2][2], int) const {
#pragma unroll
        for (int h = 0; h < 2; ++h)
#pragma unroll
            for (int i = 0; i < 2; ++i) g[h][i] = (unsigned)(u.pm * 256 + h * HALF + Rr[i]) * (unsigned)K + (unsigned)Cc[i] * 2u;
    }
    __device__ __forceinline__ const char* b_base(const Unit& u) const { return (const char*)W2Q + ((size_t)u.e * 1024 + (size_t)u.pn * 256) * K; }
    __device__ __forceinline__ void epi(const f32x4 (&acc)[2][2][4][2], const Unit& u, int wr, int wc, int fr, int fq, int buf) const {
        int zero = 0; asm volatile("" : "+v"(zero)); fr += zero;
        const int valid = tb.cnt(u.e) - u.mt * 256, colt = u.pn * 256 + wc * 32 + 8 * fq;
        const LAS float* bp = (const LAS float*)(rtab + buf * RT_STRIDE + 2048) + wc * 32 + 8 * fq; const LAS int* lp = (const LAS int*)(rtab + buf * RT_STRIDE); const LAS float* wp = (const LAS float*)(rtab + buf * RT_STRIDE + 1024);
        int slot[8]; float wv[8];
#pragma unroll
        for (int i = 0; i < 8; ++i) { const int r = (i >> 2) * HALF + wr * 64 + (i & 3) * 16 + fr; const bool ok = r < valid; const int rc = ok ? r : 0; const int sl = lp[rc]; wv[i] = wp[rc]; slot[i] = ok ? sl : -1; }
        f32x4 bv[2][2];
#pragma unroll
        for (int bj = 0; bj < 2; ++bj) { bv[bj][0] = *(const LAS f32x4*)(bp + bj * HALF); bv[bj][1] = *(const LAS f32x4*)(bp + bj * HALF + 4); }
#pragma unroll
        for (int i = 0; i < 8; ++i) { const int ai = i >> 2, m = i & 3;
            if (slot[i] >= 0) { const float w = wv[i] * YQ_SCALE, wq = w * WQ_INV;
#pragma unroll
                for (int bj = 0; bj < 2; ++bj) st8((unsigned char*)YS + (size_t)slot[i] * DM + colt + bj * HALF, pack8_fp8(acc[ai][bj][m][0] * wq + bv[bj][0] * w, acc[ai][bj][m][1] * wq + bv[bj][1] * w)); } }
    }
};
}

__device__ __forceinline__ void grouped_setup(LAS int* tab, const unsigned* cnt) {
    const int tid = threadIdx.x;
    if (tid < 32) tab[TAB_CNT + tid] = (int)__hip_atomic_load(cnt + tid, __ATOMIC_RELAXED, __HIP_MEMORY_SCOPE_AGENT);
    __syncthreads();
    if (tid == 0) { int s = 0; for (int e = 0; e < 32; ++e) { tab[TAB_TST + e] = s; s += (tab[TAB_CNT + e] + 255) >> 8; } tab[TAB_TST + 32] = s; }
    __syncthreads();
    const int NT = tab[TAB_TST + 32];
    for (int vt = tid; vt < NT; vt += NWAVES * 64) { int e = 0; for (int k = 1; k < 32; ++k) if (tab[TAB_TST + k] <= vt) e = k; tab[TAB_TE + vt] = e; }
    __syncthreads();
}

__device__ __forceinline__ void lds_fence() { asm volatile("s_waitcnt lgkmcnt(0)" ::: "memory"); }
template <int MAPK> __device__ __forceinline__ int p0_map(int n) {
    if (MAPK == 1) return (n >= 1024 && n < 2048) ? (n & ~255) + 128 * ((n >> 5) & 1) + 32 * ((n >> 6) & 3) + (n & 31) : n;
    if (MAPK == 2) { const int m = n & 1023; return (m >> 7) * 256 + (n >> 10) * 128 + (m & 127); }
    return n;
}
template <int MAPK, bool Q8 = false> __device__ __forceinline__ void p0_transpose_item(const float* W, int N, bf16_t* WT, int ldo, int koff, const float* gk, LAS float* scr, int item, int lane, int nblk_ = 0) {
    const int nblk = nblk_ ? nblk_ : N / 32, kb = item / nblk, nb = item % nblk, k0 = 64 * kb, n0 = 32 * nb;
    float tv[32];
#pragma unroll
    for (int i = 0; i < 32; ++i) tv[i] = __builtin_nontemporal_load(W + (size_t)(k0 + 2 * i + (lane >> 5)) * N + n0 + (lane & 31));
    if (gk) {
#pragma unroll
        for (int i = 0; i < 32; ++i) tv[i] *= gk[k0 + 2 * i + (lane >> 5)];
    }
#pragma unroll
    for (int i = 0; i < 32; ++i) scr[(2 * i + (lane >> 5)) * 33 + (lane & 31)] = tv[i];
    lds_fence();
    const int c8 = lane & 7;
#pragma unroll
    for (int j = 0; j < 4; ++j) { const int n = (lane >> 3) + 8 * j; const LAS float* s = scr + (8 * c8) * 33 + n;
        if constexpr (Q8) {
            const f32x4 a = (f32x4){s[0 * 33], s[1 * 33], s[2 * 33], s[3 * 33]} * pg::WQ_SCALE, b = (f32x4){s[4 * 33], s[5 * 33], s[6 * 33], s[7 * 33]} * pg::WQ_SCALE;
            *(uint2*)((unsigned char*)WT + (size_t)p0_map<MAPK>(n0 + n) * ldo + koff + k0 + 8 * c8) = pg::pack8_fp8(a, b);
        } else {
        u32x4 o; o.x = pg::cvt_pk_bf16(s[0 * 33], s[1 * 33]); o.y = pg::cvt_pk_bf16(s[2 * 33], s[3 * 33]); o.z = pg::cvt_pk_bf16(s[4 * 33], s[5 * 33]); o.w = pg::cvt_pk_bf16(s[6 * 33], s[7 * 33]);
        *(u32x4*)(WT + (size_t)p0_map<MAPK>(n0 + n) * ldo + koff + k0 + 8 * c8) = o; } }
    lds_fence();
}
__device__ __forceinline__ void p0_rmsnorm_row(const float* xrow, const float* g, bf16_t* orow, int lane) {
    const f32x4* xr = (const f32x4*)xrow;
    f32x4 v[4]; float s = 0.f;
#pragma unroll
    for (int j = 0; j < 4; ++j) { v[j] = xr[lane + 64 * j]; s += (v[j].x * v[j].x + v[j].y * v[j].y) + (v[j].z * v[j].z + v[j].w * v[j].w); }
    const float rstd = rsqrtf(wave_sum(s) * (1.0f / DM) + EPS);
#pragma unroll
    for (int j = 0; j < 4; ++j) { const f32x4 gv = ((const f32x4*)g)[lane + 64 * j];
        unsigned long long o = (unsigned long long)pg::cvt_pk_bf16(v[j].x * rstd * gv.x, v[j].y * rstd * gv.y) | ((unsigned long long)pg::cvt_pk_bf16(v[j].z * rstd * gv.z, v[j].w * rstd * gv.w) << 32);
        ((unsigned long long*)orow)[lane + 64 * j] = o; }
}
struct P0Args { const float *x, *mem, *g_mix, *g_mem, *w_in, *w_br0, *w_br1, *w_br2, *w_out, *w_mem_kv, *w_gate_up, *w_down, *g_ffn, *w_router, *w_spatial;
    bf16_t *HB, *MEMN, *WinT, *WbrT, *WoutT, *WmemT, *W1T, *W2T, *WSB; float* WrT; unsigned char *HBQ, *WINQ; };
__device__ __forceinline__ void p0_prologue(const P0Args a, LAS unsigned char* lds, int G, int c) {
    const int tid = threadIdx.x, lane = tid & 63, wave = __builtin_amdgcn_readfirstlane(tid >> 6);
    LAS float* scr = (LAS float*)(lds + wave * 16384);
    const int gw = c * NWAVES + wave, NGW = G * NWAVES;
    constexpr int I_IN = 16 * 64, I_G = 16 * 192, I_BR = 8 * 32, I_O = 16 * 32, I_1 = 16 * 64, I_2 = 16 * 32;
    constexpr int NITEMS = I_IN + I_G + 3 * I_BR + 2 * I_O;
    for (int it = gw; it < NITEMS; it += NGW) {
        int r = it;
        if (r < I_IN) { p0_transpose_item<1>(a.w_in, INW, a.WinT, DM, 0, nullptr, scr, r, lane, 64); continue; } r -= I_IN;
        if (r < I_G) { p0_transpose_item<0, true>(a.w_in, INW, (bf16_t*)a.WINQ, DM, 0, nullptr, scr, r, lane); continue; } r -= I_G;
        if (r < 3 * I_BR) { const int br = r / I_BR; const float* wsrc = (br == 0) ? a.w_br0 : (br == 1) ? a.w_br1 : a.w_br2; p0_transpose_item<0>(wsrc, DM, a.WbrT, 1536, br * 512, nullptr, scr, r - br * I_BR, lane); continue; } r -= 3 * I_BR;
        if (r < I_O) { p0_transpose_item<0>(a.w_out, DM, a.WoutT, DM, 0, nullptr, scr, r, lane); continue; } r -= I_O;
        p0_transpose_item<0>(a.w_mem_kv, DM, a.WmemT, DM, 0, nullptr, scr, r, lane);
    }
    for (int m = gw; m < T_TOK; m += 2 * NGW) {
        const int m2 = (m + NGW < T_TOK) ? m + NGW : m;
        const f32x4* xa = (const f32x4*)(a.x + (size_t)m * DM); const f32x4* xb = (const f32x4*)(a.x + (size_t)m2 * DM);
        f32x4 va[4], vb[4]; float sa = 0.f, sb = 0.f;
#pragma unroll
        for (int j = 0; j < 4; ++j) { va[j] = __builtin_nontemporal_load(xa + lane + 64 * j); vb[j] = __builtin_nontemporal_load(xb + lane + 64 * j); }
#pragma unroll
        for (int j = 0; j < 4; ++j) { sa += (va[j].x * va[j].x + va[j].y * va[j].y) + (va[j].z * va[j].z + va[j].w * va[j].w); sb += (vb[j].x * vb[j].x + vb[j].y * vb[j].y) + (vb[j].z * vb[j].z + vb[j].w * vb[j].w); }
        const float ra = rsqrtf(wave_sum(sa) * (1.0f / DM) + EPS), rb = rsqrtf(wave_sum(sb) * (1.0f / DM) + EPS);
#pragma unroll
        for (int j = 0; j < 4; ++j) { const f32x4 gv = ((const f32x4*)a.g_mix)[lane + 64 * j];
            ((unsigned long long*)(a.HB + (size_t)m * DM))[lane + 64 * j] = (unsigned long long)pg::cvt_pk_bf16(va[j].x * ra * gv.x, va[j].y * ra * gv.y) | ((unsigned long long)pg::cvt_pk_bf16(va[j].z * ra * gv.z, va[j].w * ra * gv.w) << 32);
            ((unsigned long long*)(a.HB + (size_t)m2 * DM))[lane + 64 * j] = (unsigned long long)pg::cvt_pk_bf16(vb[j].x * rb * gv.x, vb[j].y * rb * gv.y) | ((unsigned long long)pg::cvt_pk_bf16(vb[j].z * rb * gv.z, vb[j].w * rb * gv.w) << 32);
            { int qa = 0, qb = 0; qa = __builtin_amdgcn_cvt_pk_fp8_f32(va[j].x * ra * gv.x, va[j].y * ra * gv.y, qa, false); qa = __builtin_amdgcn_cvt_pk_fp8_f32(va[j].z * ra * gv.z, va[j].w * ra * gv.w, qa, true);
              qb = __builtin_amdgcn_cvt_pk_fp8_f32(vb[j].x * rb * gv.x, vb[j].y * rb * gv.y, qb, false); qb = __builtin_amdgcn_cvt_pk_fp8_f32(vb[j].z * rb * gv.z, vb[j].w * rb * gv.w, qb, true);
              ((int*)(a.HBQ + (size_t)m * DM))[lane + 64 * j] = qa; ((int*)(a.HBQ + (size_t)m2 * DM))[lane + 64 * j] = qb; } }
    }
    for (int m = gw; m < NBATCH * MEML; m += NGW) p0_rmsnorm_row(a.mem + (size_t)m * DM, a.g_mem, a.MEMN + (size_t)m * DM, lane);
    const int gt = c * NWAVES * 64 + tid, NGT = G * NWAVES * 64;
    for (int i = gt; i < 32 * 1024; i += NGT) { const int e = i >> 10, k = i & 1023; const float w = a.w_router[k * 32 + e] * a.g_ffn[k]; a.WrT[i] = w;
        bf16_t* pl = (bf16_t*)(a.WrT + 32 * 1024); const bf16_t hi = f2bf(w); pl[i] = hi; pl[32 * 1024 + i] = f2bf(w - __uint_as_float((unsigned)hi << 16)); }
    for (int i = gt; i < 4 * 128 * 128; i += NGT) { const int s = i & 127, t = (i >> 7) & 127; a.WSB[i] = (s <= t) ? f2bf(a.w_spatial[i]) : (bf16_t)0; }
}
__device__ __forceinline__ void p1_memkv(const bf16_t* MEMN, const bf16_t* WmemT, const float* gk, bf16_t* MKV, int G, int c, LAS unsigned char* lds) {
    int tid_ = threadIdx.x; asm volatile("" : "+v"(tid_));
    const int tid = tid_, lane = tid & 63, wave = __builtin_amdgcn_readfirstlane(tid >> 6), fr = lane & 15, fq = lane >> 4;
    constexpr int LDB = 72;
    for (int unit = c; unit < 128; unit += G) {
        const int rt = unit >> 3, ct = unit & 7;
        f32x4 acc[8];
#pragma unroll
        for (int j = 0; j < 8; ++j) acc[j] = (f32x4){0.f, 0.f, 0.f, 0.f};
        const bf16_t* ap = MEMN + (size_t)(rt * 128 + wave * 16 + fr) * DM + fq * 8;
        const bf16_t* bsrc = WmemT + (size_t)(ct * 128 + (tid >> 3)) * DM + (tid & 7) * 8;
        const int bdst = ((tid >> 3) * LDB + (tid & 7) * 8) * 2;
        u32x4 r0 = *(const u32x4*)bsrc, r1 = *(const u32x4*)(bsrc + (size_t)64 * DM);
        bf16x8 afn[2] = {*(const bf16x8*)ap, *(const bf16x8*)(ap + 32)};
        __syncthreads();
        *(LAS u32x4*)(lds + bdst) = r0; *(LAS u32x4*)(lds + bdst + 64 * LDB * 2) = r1;
        __syncthreads();
#pragma nounroll
        for (int kc = 0; kc < 16; ++kc) {
            const int buf = (kc & 1) * (128 * LDB * 2);
            const bf16x8 afc[2] = {afn[0], afn[1]};
            if (kc + 1 < 16) { r0 = *(const u32x4*)(bsrc + (kc + 1) * 64); r1 = *(const u32x4*)(bsrc + (size_t)64 * DM + (kc + 1) * 64); afn[0] = *(const bf16x8*)(ap + (kc + 1) * 64); afn[1] = *(const bf16x8*)(ap + (kc + 1) * 64 + 32); }
#pragma unroll
            for (int ks = 0; ks < 2; ++ks) { const bf16x8 af = afc[ks];
#pragma unroll
                for (int j = 0; j < 8; ++j) { const bf16x8 bf = *(const LAS bf16x8*)(lds + buf + ((16 * j + fr) * LDB + ks * 32 + fq * 8) * 2); acc[j] = __builtin_amdgcn_mfma_f32_16x16x32_bf16(af, bf, acc[j], 0, 0, 0); } }
            if (kc + 1 < 16) { *(LAS u32x4*)(lds + (buf ^ (128 * LDB * 2)) + bdst) = r0; *(LAS u32x4*)(lds + (buf ^ (128 * LDB * 2)) + bdst + 64 * LDB * 2) = r1; }
            __syncthreads();
        }
        float rstd[4] = {1.f, 1.f, 1.f, 1.f};
        if (ct < 4) {
#pragma unroll
            for (int r = 0; r < 4; ++r) { float ss = 0.f;
#pragma unroll
                for (int j = 0; j < 8; ++j) ss += acc[j][r] * acc[j][r];
                ss += __shfl_xor(ss, 1); ss += __shfl_xor(ss, 2); ss += __shfl_xor(ss, 4); ss += __shfl_xor(ss, 8);
                rstd[r] = rsqrtf(ss * (1.0f / 128.0f) + EPS); }
        }
#pragma unroll
        for (int j = 0; j < 8; ++j) { const float gg = (ct < 4) ? gk[16 * j + fr] : 1.0f;
#pragma unroll
            for (int r = 0; r < 4; ++r) MKV[(size_t)(rt * 128 + wave * 16 + fq * 4 + r) * 1024 + ct * 128 + 16 * j + fr] = f2bf(acc[j][r] * rstd[r] * gg); }
    }
}
__device__ __forceinline__ void p5_router(const bf16_t* X1, const float* WrT, const float* br, int* LIST, float* RSTDS, float* TOPWS, unsigned* cnt, int G, int c, LAS unsigned char* lds) {
    const int tid = threadIdx.x, lane = tid & 63, wave = __builtin_amdgcn_readfirstlane(tid >> 6), r = lane & 15, qd = lane >> 4;
    LAS unsigned* lcnt = (LAS unsigned*)(lds + RING_BYTES + 2048);
    { const bf16_t* pl = (const bf16_t*)(WrT + 32 * 1024);
#pragma unroll 4
      for (int j = 0; j < 16; ++j) { const int g = tid + 512 * j, p = g >> 12, e = (g >> 7) & 31, ch = g & 127;
          *(LAS u32x4*)(lds + p * 65536 + e * 2048 + ((ch ^ (e & 15)) << 4)) = *(const u32x4*)(pl + (size_t)g * 8); } }
    for (int gbase = c * NWAVES; gbase < T_TOK / 16; gbase += G * NWAVES) {
        const int t0 = (gbase + wave) * 16;
        if (tid < 32) lcnt[tid] = 0u;
        __syncthreads();
        const bf16_t* xp = X1 + (size_t)(t0 + r) * DM + 8 * qd;
        f32x4 acc0 = (f32x4){0.f, 0.f, 0.f, 0.f}, acc1 = acc0; float ss = 0.f;
#pragma unroll
        for (int hf = 0; hf < 2; ++hf) {
            u32x4 xa[16];
#pragma unroll
            for (int i = 0; i < 16; ++i) xa[i] = *(const u32x4*)(xp + 32 * (16 * hf + i));
#pragma unroll
            for (int i = 0; i < 16; ++i) { const int it = 16 * hf + i;
                f32x4 a0, a1; pg::unpack8(xa[i], a0, a1);
                ss += (a0[0] * a0[0] + a0[1] * a0[1]) + (a0[2] * a0[2] + a0[3] * a0[3]) + (a1[0] * a1[0] + a1[1] * a1[1]) + (a1[2] * a1[2] + a1[3] * a1[3]);
                const int off = r * 2048 + (((4 * it + qd) ^ r) << 4);
#pragma unroll
                for (int p = 1; p >= 0; --p) { const bf16x8 b0 = *(const LAS bf16x8*)(lds + p * 65536 + off), b1 = *(const LAS bf16x8*)(lds + p * 65536 + 16 * 2048 + off);
                    acc0 = __builtin_amdgcn_mfma_f32_16x16x32_bf16(__builtin_bit_cast(bf16x8, xa[i]), b0, acc0, 0, 0, 0); acc1 = __builtin_amdgcn_mfma_f32_16x16x32_bf16(__builtin_bit_cast(bf16x8, xa[i]), b1, acc1, 0, 0, 0); }
            }
        }
        ss += __shfl_xor(ss, 16); ss += __shfl_xor(ss, 32);
        const float rstd_r = rsqrtf(ss * (1.0f / DM) + EPS);
        const float bias0 = br[r], bias1 = br[16 + r];
        float rs[4], l0[4], l1[4];
#pragma unroll
        for (int g = 0; g < 4; ++g) { rs[g] = __shfl(rstd_r, 4 * qd + g); l0[g] = acc0[g] * rs[g] + bias0; l1[g] = acc1[g] * rs[g] + bias1; }
        float sv[4][4]; int se[4][4];
#pragma unroll
        for (int rank = 0; rank < 4; ++rank)
#pragma unroll
            for (int g = 0; g < 4; ++g) {
                float v = l0[g]; int ix = r; if (l1[g] > v) { v = l1[g]; ix = r + 16; }
#pragma unroll
                for (int o = 1; o < 16; o <<= 1) { const float ov = __shfl_xor(v, o); const int oi = __shfl_xor(ix, o); if (ov > v || (ov == v && oi < ix)) { v = ov; ix = oi; } }
                sv[rank][g] = v; se[rank][g] = ix;
                if (ix == r) l0[g] = -INFINITY; if (ix == r + 16) l1[g] = -INFINITY;
            }
        float wgt[4]; int mye[4]; unsigned lp[4];
        if (r < 4) {
#pragma unroll
            for (int g = 0; g < 4; ++g) {
                const float den = 1.0f + __expf(sv[1][g] - sv[0][g]) + __expf(sv[2][g] - sv[0][g]) + __expf(sv[3][g] - sv[0][g]);
                const float myv = (r == 0) ? sv[0][g] : (r == 1) ? sv[1][g] : (r == 2) ? sv[2][g] : sv[3][g];
                mye[g] = (r == 0) ? se[0][g] : (r == 1) ? se[1][g] : (r == 2) ? se[2][g] : se[3][g];
                wgt[g] = __expf(myv - sv[0][g]) / den;
                lp[g] = __hip_atomic_fetch_add(lcnt + mye[g], 1u, __ATOMIC_RELAXED, __HIP_MEMORY_SCOPE_WORKGROUP);
            }
        }
        __syncthreads();
        if (tid < 32) lcnt[32 + tid] = atomicAdd(cnt + tid, lcnt[tid]);
        __syncthreads();
        if (r < 4) {
#pragma unroll
            for (int g = 0; g < 4; ++g) { const unsigned pos = lcnt[32 + mye[g]] + lp[g]; const int t = t0 + 4 * qd + g;
                LIST[mye[g] * 32768 + pos] = t * 4 + r; RSTDS[mye[g] * 32768 + pos] = rs[g]; TOPWS[mye[g] * 32768 + pos] = wgt[g]; }
        }
        __syncthreads();
    }
}
__device__ __forceinline__ void p8_combine(float* out, const bf16_t* X1H, const bf16_t* YS, int G, int c, float dscale) {
    typedef float f32x2v __attribute__((ext_vector_type(2)));
    const unsigned char* YQ = (const unsigned char*)YS;
    const size_t gt = (size_t)c * NWAVES * 64 + threadIdx.x, NGT = (size_t)G * NWAVES * 64;
    for (size_t i = gt; i < (size_t)T_TOK * DM / 8; i += NGT) {
        const size_t t = i >> 7, c8 = (i & 127) * 8;
        f32x4 o0, o1; pg::unpack8(*(const u32x4*)(X1H + t * DM + c8), o0, o1);
        if (dscale < 0.f) { o0 = *(const f32x4*)(out + t * DM + c8); o1 = *(const f32x4*)(out + t * DM + c8 + 4); }
        f32x4 s0 = (f32x4){0.f, 0.f, 0.f, 0.f}, s1 = s0;
#pragma unroll
        for (int k = 0; k < 4; ++k) { typedef unsigned u32x2v __attribute__((ext_vector_type(2))); const u32x2v w = __builtin_nontemporal_load((const u32x2v*)(YQ + (t * 4 + k) * DM + c8));
            const f32x2v a0 = __builtin_amdgcn_cvt_pk_f32_fp8((int)w.x, false), a1 = __builtin_amdgcn_cvt_pk_f32_fp8((int)w.x, true), b0 = __builtin_amdgcn_cvt_pk_f32_fp8((int)w.y, false), b1 = __builtin_amdgcn_cvt_pk_f32_fp8((int)w.y, true);
            s0 += (f32x4){a0[0], a0[1], a1[0], a1[1]}; s1 += (f32x4){b0[0], b0[1], b1[0], b1[1]}; }
        s0 = s0 * pg::YQ_INV; s1 = s1 * pg::YQ_INV;
        if (dscale < 0.f) { o0 = (o0 - s0) + s0; o1 = (o1 - s1) + s1; } else { o0 = (o0 + s0) * dscale; o1 = (o1 + s1) * dscale; }
        *(f32x4*)(out + t * DM + c8) = o0; *(f32x4*)(out + t * DM + c8 + 4) = o1;
    }
}


struct ConvJob { const float* w1; const float* w2; const float* gf; unsigned char* W1Q; unsigned char* W2Q; LAS float* scr; int item, end, stride; };
constexpr int CV_W1 = NEXP * 32 * 64, CV_W2 = NEXP * 32 * 32, CV_TOTAL = CV_W1 + CV_W2;
__device__ __forceinline__ void conv_issue(const ConvJob& J, float (&tv)[16], int lane) {
    const int h = J.item; const float* src; int N;
    if (h < CV_W1) { const int e = h >> 11, rem = h & 2047, kb = rem >> 6, nb = rem & 63; N = 2048; src = J.w1 + (size_t)e * DM * 2048 + (size_t)(32 * kb) * 2048 + 32 * nb; }
    else { const int h2 = h - CV_W1, e = h2 >> 10, rem = h2 & 1023, kb = rem >> 5, nb = rem & 31; N = 1024; src = J.w2 + (size_t)e * DFF * DM + (size_t)(32 * kb) * 1024 + 32 * nb; }
    src += (size_t)(16 * (lane >> 5)) * N + (lane & 31);
#pragma unroll
    for (int i = 0; i < 16; ++i) tv[i] = __builtin_nontemporal_load(src + (size_t)i * N);
}
__device__ __forceinline__ void conv_finish(ConvJob& J, const float (&tv)[16], int lane) {
    const int h = J.item; const bool is1 = h < CV_W1;
    int e, kb, nb; if (is1) { e = h >> 11; const int rem = h & 2047; kb = rem >> 6; nb = rem & 63; } else { const int h2 = h - CV_W1; e = h2 >> 10; const int rem = h2 & 1023; kb = rem >> 5; nb = rem & 31; }
    const int n = lane & 31, kh = lane >> 5;
    const f32x4 a = (f32x4){tv[0], tv[1], tv[2], tv[3]} * pg::WQ_SCALE, b = (f32x4){tv[4], tv[5], tv[6], tv[7]} * pg::WQ_SCALE;
    const f32x4 c = (f32x4){tv[8], tv[9], tv[10], tv[11]} * pg::WQ_SCALE, d = (f32x4){tv[12], tv[13], tv[14], tv[15]} * pg::WQ_SCALE;
    const uint2 lo = pg::pack8_fp8(a, b), hi2 = pg::pack8_fp8(c, d);
    const int ncol = 32 * nb + n;
    unsigned char* dst = is1 ? J.W1Q + ((size_t)e * 2048 + p0_map<2>(ncol)) * DM + 32 * kb + 16 * kh : J.W2Q + ((size_t)e * 1024 + ncol) * DFF + 32 * kb + 16 * kh;
    *(u32x4*)dst = (u32x4){lo.x, lo.y, hi2.x, hi2.y};
    asm volatile("s_waitcnt lgkmcnt(0)" ::: "memory");
    J.item += J.stride;
}
namespace at {
typedef __attribute__((address_space(3))) const char* lds_cptr;
typedef short s16x4 __attribute__((ext_vector_type(4)));
typedef float f32x16 __attribute__((ext_vector_type(16)));
__device__ __forceinline__ int crow(int r, int hi) { return (r & 3) + 8 * (r >> 2) + 4 * hi; }
__device__ __forceinline__ s16x4 vtr(lds_cptr p) { return __builtin_bit_cast(s16x4, __builtin_amdgcn_ds_read_tr16_b64_v4i16((__attribute__((address_space(3))) s16x4*)p)); }
template <int ND0> __device__ __forceinline__ void qk_step(f32x16& p0, f32x16& p1, lds_cptr kb, int kch2, const bf16x8 (&qr)[ND0]) {
#pragma unroll
    for (int d0 = 0; d0 < ND0; ++d0) {
        const bf16x8 b0 = *(const __attribute__((address_space(3))) bf16x8*)(kb + d0 * kch2);
        const bf16x8 b1 = *(const __attribute__((address_space(3))) bf16x8*)(kb + d0 * kch2 + 512);
        p0 = __builtin_amdgcn_mfma_f32_32x32x16_bf16(b0, qr[d0], p0, 0, 0, 0);
        p1 = __builtin_amdgcn_mfma_f32_32x32x16_bf16(b1, qr[d0], p1, 0, 0, 0);
        if ((d0 & 1) == 1) __builtin_amdgcn_sched_barrier(0);
    }
}
template <int NDB> __device__ __forceinline__ void softmax_step(f32x16& s0, f32x16& s1, float& m, float& l, f32x16 (&o)[NDB], LAS float* wsf, int r32, int hi, u32x4 (&pw)[4]) {
    float tm = fmaxf(s0[0], s1[0]);
#pragma unroll
    for (int r = 1; r < 16; ++r) tm = fmaxf(tm, fmaxf(s0[r], s1[r]));
    tm = fmaxf(tm, __shfl_xor(tm, 32));
    const float mn = fmaxf(m, tm);
    if (__any(mn > m)) {
        const float alpha = __builtin_amdgcn_exp2f(m - mn);
        l *= alpha; m = mn;
        if (hi == 0) wsf[r32] = alpha;
        asm volatile("s_waitcnt lgkmcnt(0)" ::: "memory");
#pragma unroll
        for (int r = 0; r < 16; ++r) { const float f = wsf[crow(r, hi)];
#pragma unroll
            for (int db = 0; db < NDB; ++db) o[db][r] *= f; }
    }
    float sum = 0.f;
#pragma unroll
    for (int r = 0; r < 16; ++r) { s0[r] = __builtin_amdgcn_exp2f(s0[r] - m); s1[r] = __builtin_amdgcn_exp2f(s1[r] - m); sum += s0[r] + s1[r]; }
    l += sum;
    pw[0] = (u32x4){pg::cvt_pk_bf16(s0[0], s0[1]), pg::cvt_pk_bf16(s0[2], s0[3]), pg::cvt_pk_bf16(s0[4], s0[5]), pg::cvt_pk_bf16(s0[6], s0[7])};
    pw[1] = (u32x4){pg::cvt_pk_bf16(s0[8], s0[9]), pg::cvt_pk_bf16(s0[10], s0[11]), pg::cvt_pk_bf16(s0[12], s0[13]), pg::cvt_pk_bf16(s0[14], s0[15])};
    pw[2] = (u32x4){pg::cvt_pk_bf16(s1[0], s1[1]), pg::cvt_pk_bf16(s1[2], s1[3]), pg::cvt_pk_bf16(s1[4], s1[5]), pg::cvt_pk_bf16(s1[6], s1[7])};
    pw[3] = (u32x4){pg::cvt_pk_bf16(s1[8], s1[9]), pg::cvt_pk_bf16(s1[10], s1[11]), pg::cvt_pk_bf16(s1[12], s1[13]), pg::cvt_pk_bf16(s1[14], s1[15])};
}
template <int NDB> __device__ __forceinline__ void softmax_rel_a(f32x16& s0, f32x16& s1, float& m, float& l, f32x16 (&o)[NDB], LAS float* wsf, int r32, int hi) {
    constexpr float THR = 4.0f;
#define AT_MX3(a, b, c) __builtin_fmaxf(__builtin_fmaxf((a), (b)), (c))
    float ta = AT_MX3(s0[0], s0[1], s1[0]), tb = AT_MX3(s0[2], s0[3], s1[1]); ta = AT_MX3(ta, s1[2], s1[3]);
#pragma unroll
    for (int r = 4; r < 16; r += 4) { ta = AT_MX3(ta, s0[r], s0[r + 1]); tb = AT_MX3(tb, s0[r + 2], s0[r + 3]); ta = AT_MX3(ta, s1[r], s1[r + 1]); tb = AT_MX3(tb, s1[r + 2], s1[r + 3]); }
    float rm = __builtin_fmaxf(ta, tb);
    { const auto rr = __builtin_amdgcn_permlane32_swap(__float_as_uint(rm), __float_as_uint(rm), false, false); rm = __builtin_fmaxf(__uint_as_float(rr[0]), __uint_as_float(rr[1])); }
#undef AT_MX3
    if (__any(rm > THR)) {
        const float dl = rm > THR ? rm : 0.f;
        m += dl;
#pragma unroll
        for (int r = 0; r < 16; ++r) { s0[r] -= dl; s1[r] -= dl; }
        const float f = __builtin_amdgcn_exp2f(-dl);
        l *= f;
        if (hi == 0) wsf[r32] = f;
        asm volatile("s_waitcnt lgkmcnt(0)" ::: "memory");
#pragma unroll
        for (int r = 0; r < 16; ++r) { const float g = wsf[crow(r, hi)];
#pragma unroll
            for (int db = 0; db < NDB; ++db) o[db][r] *= g; }
    }
}
template <int NDB> __device__ __forceinline__ void softmax_rel(f32x16& s0, f32x16& s1, float& m, float& l, f32x16 (&o)[NDB], LAS float* wsf, int r32, int hi, u32x4 (&pw)[4]) {
    constexpr float THR = 4.0f;
#define AT_MX3(a, b, c) __builtin_fmaxf(__builtin_fmaxf((a), (b)), (c))
    float ta = AT_MX3(s0[0], s0[1], s1[0]), tb = AT_MX3(s0[2], s0[3], s1[1]); ta = AT_MX3(ta, s1[2], s1[3]);
#pragma unroll
    for (int r = 4; r < 16; r += 4) { ta = AT_MX3(ta, s0[r], s0[r + 1]); tb = AT_MX3(tb, s0[r + 2], s0[r + 3]); ta = AT_MX3(ta, s1[r], s1[r + 1]); tb = AT_MX3(tb, s1[r + 2], s1[r + 3]); }
    float rm = __builtin_fmaxf(ta, tb);
    { const auto rr = __builtin_amdgcn_permlane32_swap(__float_as_uint(rm), __float_as_uint(rm), false, false); rm = __builtin_fmaxf(__uint_as_float(rr[0]), __uint_as_float(rr[1])); }
#undef AT_MX3
    if (__any(rm > THR)) {
        const float dl = rm > THR ? rm : 0.f;
        m += dl;
#pragma unroll
        for (int r = 0; r < 16; ++r) { s0[r] -= dl; s1[r] -= dl; }
        const float f = __builtin_amdgcn_exp2f(-dl);
        l *= f;
        if (hi == 0) wsf[r32] = f;
        asm volatile("s_waitcnt lgkmcnt(0)" ::: "memory");
#pragma unroll
        for (int r = 0; r < 16; ++r) { const float g = wsf[crow(r, hi)];
#pragma unroll
            for (int db = 0; db < NDB; ++db) o[db][r] *= g; }
    }
    float sa = 0.f, sb = 0.f;
#pragma unroll
    for (int r = 0; r < 16; ++r) { s0[r] = __builtin_amdgcn_exp2f(s0[r]); s1[r] = __builtin_amdgcn_exp2f(s1[r]); sa += s0[r]; sb += s1[r]; }
    l += sa + sb;
    pw[0] = (u32x4){pg::cvt_pk_bf16(s0[0], s0[1]), pg::cvt_pk_bf16(s0[2], s0[3]), pg::cvt_pk_bf16(s0[4], s0[5]), pg::cvt_pk_bf16(s0[6], s0[7])};
    pw[1] = (u32x4){pg::cvt_pk_bf16(s0[8], s0[9]), pg::cvt_pk_bf16(s0[10], s0[11]), pg::cvt_pk_bf16(s0[12], s0[13]), pg::cvt_pk_bf16(s0[14], s0[15])};
    pw[2] = (u32x4){pg::cvt_pk_bf16(s1[0], s1[1]), pg::cvt_pk_bf16(s1[2], s1[3]), pg::cvt_pk_bf16(s1[4], s1[5]), pg::cvt_pk_bf16(s1[6], s1[7])};
    pw[3] = (u32x4){pg::cvt_pk_bf16(s1[8], s1[9]), pg::cvt_pk_bf16(s1[10], s1[11]), pg::cvt_pk_bf16(s1[12], s1[13]), pg::cvt_pk_bf16(s1[14], s1[15])};
}
template <int NDB> __device__ __forceinline__ void pv_step(f32x16 (&o)[NDB], const u32x4 (&pw)[4], lds_cptr vb, int vdb_stride) {
#pragma unroll
    for (int db = 0; db < NDB; ++db)
#pragma unroll
        for (int ks = 0; ks < 4; ++ks) {
            const s16x4 lo = vtr(vb + db * vdb_stride + ks * 1024), hh = vtr(vb + db * vdb_stride + ks * 1024 + 512);
            const bf16x8 vf = (bf16x8){lo[0], lo[1], lo[2], lo[3], hh[0], hh[1], hh[2], hh[3]};
            o[db] = __builtin_amdgcn_mfma_f32_32x32x16_bf16(__builtin_bit_cast(bf16x8, pw[ks]), vf, o[db], 0, 0, 0);
            if (ks == 3) __builtin_amdgcn_sched_barrier(0);
        }
}
__device__ __forceinline__ void exp_pv(f32x16& s0, f32x16& s1, float& l, f32x16 (&o)[2], lds_cptr vb) {
    s16x4 vl[2][4], vh[2][4];
#pragma unroll
    for (int db = 0; db < 2; ++db)
#pragma unroll
        for (int ks = 0; ks < 4; ++ks) { vl[db][ks] = vtr(vb + db * 4096 + ks * 1024); vh[db][ks] = vtr(vb + db * 4096 + ks * 1024 + 512); }
    float sa = 0.f, sb = 0.f;
    __builtin_amdgcn_sched_barrier(0);
#pragma unroll
    for (int ks = 0; ks < 4; ++ks) {
        float e[8];
#pragma unroll
        for (int j = 0; j < 8; ++j) e[j] = __builtin_amdgcn_exp2f(ks < 2 ? s0[(ks & 1) * 8 + j] : s1[(ks & 1) * 8 + j]);
        sa += (e[0] + e[1]) + (e[2] + e[3]); sb += (e[4] + e[5]) + (e[6] + e[7]);
        u32x4 pw = (u32x4){pg::cvt_pk_bf16(e[0], e[1]), pg::cvt_pk_bf16(e[2], e[3]), pg::cvt_pk_bf16(e[4], e[5]), pg::cvt_pk_bf16(e[6], e[7])};
        asm volatile("" : "+v"(pw));
#pragma unroll
        for (int db = 0; db < 2; ++db) { const bf16x8 vf = (bf16x8){vl[db][ks][0], vl[db][ks][1], vl[db][ks][2], vl[db][ks][3], vh[db][ks][0], vh[db][ks][1], vh[db][ks][2], vh[db][ks][3]};
            o[db] = __builtin_amdgcn_mfma_f32_32x32x16_bf16(__builtin_bit_cast(bf16x8, pw), vf, o[db], 0, 0, 0); }
        __builtin_amdgcn_sched_barrier(0);
    }
    l += sa + sb;
}
template <int NDB> __device__ __forceinline__ void store_o(const f32x16 (&o)[NDB], float l, LAS float* wsf, int r32, int hi, bf16_t* yrow0  , int ldy) {
    l += __shfl_xor(l, 32);
    if (hi == 0) wsf[r32] = __builtin_amdgcn_rcpf(l);
    asm volatile("s_waitcnt lgkmcnt(0)" ::: "memory");
#pragma unroll
    for (int r = 0; r < 16; ++r) { const int q = crow(r, hi); const float inv = wsf[q];
#pragma unroll
        for (int db = 0; db < NDB; ++db) yrow0[(size_t)q * ldy + db * 32 + r32] = f2bf(o[db][r] * inv); }
    asm volatile("s_waitcnt lgkmcnt(0)" ::: "memory");
}

__device__ __forceinline__ void moba_unit(int b, int h, int jb, const bf16_t* PROJ, const float* KMP, bf16_t* Y, LAS unsigned char* lds, ConvJob& J, float (&tv)[16]) {
    int tid_ = threadIdx.x; asm volatile("" : "+v"(tid_));
    const int tid = tid_, lane = tid & 63, r32 = lane & 31, hi = lane >> 5, w = __builtin_amdgcn_readfirstlane(tid >> 6);
    LAS float* kmean = (LAS float*)(lds + 32768);
    LAS float* wsf = (LAS float*)(lds + 36864) + w * 64;
    const size_t rowbase = (size_t)b * SEQ; const int q0 = jb * 256; const int t = q0 + 32 * w + r32;
    for (int i = tid; i < jb * 64; i += NWAVES * 64) { const int n = i >> 6, d = i & 63; const float* p = KMP + ((size_t)(b * 16 + n) * 2) * 512 + h * 64 + d; kmean[i] = (p[0] + p[512]) * (1.0f / 256.0f); }
    const bf16_t* qp = PROJ + (rowbase + t) * INW + OFF_QB + h * 64 + hi * 8;
    bf16x8 qr[4];
#pragma unroll
    for (int d0 = 0; d0 < 4; ++d0) qr[d0] = *(const bf16x8*)(qp + d0 * 16);
    const bf16_t* kg = PROJ + (rowbase + 8 * w + (lane >> 3)) * INW + OFF_KB + h * 64 + (((lane & 7) ^ ((4 * w + (lane >> 4)) & 7)) << 3);
    const bf16_t* vg = PROJ + (rowbase + 16 * (w & 3) + (lane >> 2)) * INW + OFF_VB + h * 64 + (w >> 2) * 32 + (lane & 3) * 8;
    const unsigned kdst = (unsigned)__builtin_amdgcn_readfirstlane((int)((unsigned)(size_t)lds + w * 1024)), vdst = kdst + 8192u;
    __syncthreads();
    pg::glds16_asm(kg, kdst); pg::glds16_asm(vg, vdst);
    unsigned selmask = 0u;
    {
        float qf[32];
#pragma unroll
        for (int d0 = 0; d0 < 4; ++d0) { f32x4 a, c; pg::unpack8(__builtin_bit_cast(u32x4, qr[d0]), a, c);
#pragma unroll
            for (int j = 0; j < 4; ++j) { qf[d0 * 8 + j] = a[j]; qf[d0 * 8 + 4 + j] = c[j]; } }
        float v0 = -INFINITY, v1 = -INFINITY, v2 = -INFINITY; int i0 = -1, i1 = -1, i2 = -1;
        for (int n = 0; n < jb; ++n) {
            const LAS float* km = kmean + n * 64 + hi * 8; float g = 0.f;
#pragma unroll
            for (int d0 = 0; d0 < 4; ++d0) { const f32x4 ka = *(const LAS f32x4*)(km + d0 * 16), kc = *(const LAS f32x4*)(km + d0 * 16 + 4);
#pragma unroll
                for (int j = 0; j < 4; ++j) g += qf[d0 * 8 + j] * ka[j] + qf[d0 * 8 + 4 + j] * kc[j]; }
            g += __shfl_xor(g, 32);
            if (g > v0) { v2 = v1; i2 = i1; v1 = v0; i1 = i0; v0 = g; i0 = n; } else if (g > v1) { v2 = v1; i2 = i1; v1 = g; i1 = n; } else if (g > v2) { v2 = g; i2 = n; }
        }
        if (i0 >= 0) selmask |= 1u << i0; if (i1 >= 0) selmask |= 1u << i1; if (i2 >= 0) selmask |= 1u << i2;
    }
    asm volatile("s_waitcnt vmcnt(0)" ::: "memory");
    __syncthreads();
    const float slope2 = exp2f(-(float)(h + 1)) * 1.4426950408889634f;
    float m = 0.f, l = 0.f; f32x16 o[2];
#pragma unroll
    for (int r = 0; r < 16; ++r) { o[0][r] = 0.f; o[1][r] = 0.f; }
    const int qrel = 32 * w + r32;
    const int NT = 4 * (jb + 1);
    const lds_cptr lb = (lds_cptr)lds;
    const int voff = 8192 + ((lane >> 4) & 1) * 32 + (lane & 3) * 8 + (4 * hi + ((lane & 15) >> 2)) * 64;
#pragma nounroll
    for (int T = 0; T < NT; ++T) {
        const int slot = (T & 1) * 16384;
        if (T + 1 < NT) { pg::glds16_asm(kg + (size_t)(T + 1) * 64 * INW, kdst + (unsigned)(slot ^ 16384)); pg::glds16_asm(vg + (size_t)(T + 1) * 64 * INW, vdst + (unsigned)(slot ^ 16384)); }
        const bool cv_issue = (J.item < J.end) && ((T & 1) == 0);
        if (cv_issue) conv_issue(J, tv, lane);
        const int n = T >> 2, kt = T & 3;
        const bool own = (n == jb);
        const bool sel = own || ((selmask >> n) & 1u);
        const bool need = own ? (64 * kt <= 32 * w + 31) : (__any(sel) != 0);
        if (need) {
            const float lbias = sel ? (slope2 * (float)(T * 64 + 4 * hi - t) - m) : -INFINITY;
            f32x16 s0, s1;
#pragma unroll
            for (int r = 0; r < 16; ++r) { s0[r] = slope2 * (float)((r & 3) + 8 * (r >> 2)) + lbias; s1[r] = slope2 * (float)((r & 3) + 8 * (r >> 2) + 32) + lbias; }
            if (own && 64 * kt + 63 > 32 * w) {
                const int kr = kt * 64 + 4 * hi;
#pragma unroll
                for (int r = 0; r < 16; ++r) { const int kk = kr + (r & 3) + 8 * (r >> 2); if (kk > qrel) s0[r] = -INFINITY; if (kk + 32 > qrel) s1[r] = -INFINITY; }
            }
            bf16x8 kf[8];
#pragma unroll
            for (int d0 = 0; d0 < 4; ++d0) { const lds_cptr kp = lb + slot + r32 * 128 + (((2 * d0 + hi) ^ ((r32 >> 1) & 7)) << 4);
                kf[2 * d0] = *(const __attribute__((address_space(3))) bf16x8*)kp; kf[2 * d0 + 1] = *(const __attribute__((address_space(3))) bf16x8*)(kp + 32 * 128); }
            __builtin_amdgcn_sched_barrier(0);
#pragma unroll
            for (int d0 = 0; d0 < 4; ++d0) { s0 = __builtin_amdgcn_mfma_f32_32x32x16_bf16(kf[2 * d0], qr[d0], s0, 0, 0, 0); s1 = __builtin_amdgcn_mfma_f32_32x32x16_bf16(kf[2 * d0 + 1], qr[d0], s1, 0, 0, 0); }
            __builtin_amdgcn_sched_barrier(0);
            softmax_rel_a<2>(s0, s1, m, l, o, wsf, r32, hi);
            exp_pv(s0, s1, l, o, lb + slot + voff);
        }
        const bool cv_fin = (J.item < J.end) && ((T & 1) == 1);
        if (cv_fin) conv_finish(J, tv, lane);
        if (cv_issue) asm volatile("s_waitcnt vmcnt(16) lgkmcnt(0)" ::: "memory");
        else if (cv_fin) asm volatile("s_waitcnt vmcnt(1) lgkmcnt(0)" ::: "memory");
        else asm volatile("s_waitcnt vmcnt(0) lgkmcnt(0)" ::: "memory");
        __builtin_amdgcn_s_barrier(); asm volatile("" ::: "memory");
    }
    store_o<2>(o, l, wsf, r32, hi, Y + (rowbase + q0 + 32 * w) * 1536 + 512 + h * 64, 1536);
}

__device__ __forceinline__ void mem_units(int b, int h, int qt0, int nqt, const bf16_t* PROJ, const bf16_t* MKV, const float* gq, bf16_t* Y, LAS unsigned char* lds) {
    int tid_ = threadIdx.x; asm volatile("" : "+v"(tid_));
    const int tid = tid_, lane = tid & 63, r32 = lane & 31, hi = lane >> 5, w = __builtin_amdgcn_readfirstlane(tid >> 6);
    LAS float* wsf = (LAS float*)(lds + RING_BYTES + 4096) + w * 64;
    __syncthreads();
#pragma unroll 4
    for (int i = 0; i < 8; ++i) { const int p = tid + 512 * i, key = p >> 4, ch = p & 15;
        const u32x4 wv = *(const u32x4*)(MKV + ((size_t)b * MEML + key) * 1024 + h * 128 + ch * 8); f32x4 a, c; pg::unpack8(wv, a, c);
        const f32x4 g0 = *(const f32x4*)(gq + ch * 8), g1 = *(const f32x4*)(gq + ch * 8 + 4);
        *(LAS u32x4*)(lds + key * 256 + ((ch ^ (key & 15)) << 4)) = pg::pack8(a * g0, c * g1); }
#pragma unroll
    for (int i = 0; i < 8; ++i) { const int p = tid + 512 * i, key = p >> 4, c16 = p & 15;
        const u32x4 wv = *(const u32x4*)(MKV + ((size_t)b * MEML + key) * 1024 + 512 + h * 128 + c16 * 8);
        *(LAS u32x4*)(lds + 65536 + (c16 >> 2) * 16384 + (key >> 4) * 1024 + (key & 15) * 64 + (c16 & 3) * 16) = wv; }
    __syncthreads();
    const lds_cptr lb = (lds_cptr)lds;
    const int voff = 65536 + ((lane >> 4) & 1) * 32 + (lane & 3) * 8 + (4 * hi + ((lane & 15) >> 2)) * 64;
#pragma nounroll
    for (int qi = 0; qi < nqt; ++qi) {
        const size_t row0 = (size_t)b * SEQ + (size_t)(qt0 + qi) * 256 + 32 * w;
        const bf16_t* qp = PROJ + (row0 + r32) * INW + OFF_QM + h * 128 + hi * 8;
        bf16x8 qr[8]; float ss = 0.f;
#pragma unroll
        for (int d0 = 0; d0 < 8; ++d0) { qr[d0] = *(const bf16x8*)(qp + d0 * 16); f32x4 a, c; pg::unpack8(__builtin_bit_cast(u32x4, qr[d0]), a, c);
            ss += (a[0] * a[0] + a[1] * a[1]) + (a[2] * a[2] + a[3] * a[3]) + (c[0] * c[0] + c[1] * c[1]) + (c[2] * c[2] + c[3] * c[3]); }
        ss += __shfl_xor(ss, 32);
        const float cs = rsqrtf(ss * (1.0f / 128.0f) + EPS) * (0.08838834764831845f * 1.4426950408889634f);
        float m = -1e30f, l = 0.f; f32x16 o[4];
#pragma unroll
        for (int r = 0; r < 16; ++r) { o[0][r] = 0.f; o[1][r] = 0.f; o[2][r] = 0.f; o[3][r] = 0.f; }
#pragma nounroll
        for (int kt = 0; kt < 4; ++kt) {
            f32x16 s0, s1;
#pragma unroll
            for (int r = 0; r < 16; ++r) { s0[r] = 0.f; s1[r] = 0.f; }
#pragma unroll
            for (int d0 = 0; d0 < 8; ++d0) {
                const lds_cptr kp = lb + (kt * 64 + r32) * 256 + (((2 * d0 + hi) ^ (r32 & 15)) << 4);
                const bf16x8 b0 = *(const __attribute__((address_space(3))) bf16x8*)kp, b1 = *(const __attribute__((address_space(3))) bf16x8*)(kp + 32 * 256);
                s0 = __builtin_amdgcn_mfma_f32_32x32x16_bf16(b0, qr[d0], s0, 0, 0, 0); s1 = __builtin_amdgcn_mfma_f32_32x32x16_bf16(b1, qr[d0], s1, 0, 0, 0);
                if ((d0 & 1) == 1) __builtin_amdgcn_sched_barrier(0); }
#pragma unroll
            for (int r = 0; r < 16; ++r) { s0[r] *= cs; s1[r] *= cs; }
            u32x4 pw[4];
            softmax_step<4>(s0, s1, m, l, o, wsf, r32, hi, pw);
            pv_step<4>(o, pw, lb + voff + kt * 4096, 16384);
        }
        store_o<4>(o, l, wsf, r32, hi, Y + row0 * 1536 + 1024 + h * 128, 1536);
    }
    __syncthreads();
}
}


__device__ __forceinline__ void sgu_chunk(int chunk, const bf16_t* PROJ, const float* gsv, const bf16_t* WSB, const float* bs, bf16_t* Y, LAS unsigned char* lds) {
    int tid_ = threadIdx.x; asm volatile("" : "+v"(tid_));
    const int tid = tid_, lane = tid & 63, r32 = lane & 31, hi = lane >> 5, w = __builtin_amdgcn_readfirstlane(tid >> 6);
    const int t0 = chunk * 128;
    LAS float* rs = (LAS float*)(lds + 32768);
    { u32x4 wv[16];
#pragma unroll
      for (int i = 0; i < 16; ++i) wv[i] = *(const u32x4*)(PROJ + (size_t)(t0 + w * 16 + i) * INW + OFF_V + lane * 8);
#pragma unroll
      for (int i = 0; i < 16; ++i) { const int tl = w * 16 + i; f32x4 a, b; pg::unpack8(wv[i], a, b);
        float ss = (a[0] * a[0] + a[1] * a[1]) + (a[2] * a[2] + a[3] * a[3]) + (b[0] * b[0] + b[1] * b[1]) + (b[2] * b[2] + b[3] * b[3]);
        ss = wave_sum(ss); if (lane == 0) rs[tl] = rsqrtf(ss * (1.0f / 512.0f) + EPS); } }
    __syncthreads();
    const int tt = w & 3, dh = w >> 2;
    const at::lds_cptr vb = (at::lds_cptr)lds + ((lane >> 4) & 1) * 32 + (lane & 3) * 8 + (4 * hi + ((lane & 15) >> 2)) * 64 + dh * 16384;
#pragma nounroll
    for (int g = 0; g < 4; ++g) {
        { const int c8 = tid & 15; const f32x4 g0 = *(const f32x4*)(gsv + g * 128 + c8 * 8), g1 = *(const f32x4*)(gsv + g * 128 + c8 * 8 + 4);
#pragma unroll
            for (int j = 0; j < 4; ++j) { const int s = (tid >> 4) + 32 * j; const float r = rs[s];
                const u32x4 wv = *(const u32x4*)(PROJ + (size_t)(t0 + s) * INW + OFF_V + g * 128 + c8 * 8); f32x4 a, b; pg::unpack8(wv, a, b);
                *(LAS u32x4*)(lds + (c8 >> 2) * 8192 + (s >> 4) * 1024 + (s & 15) * 64 + (c8 & 3) * 16) = pg::pack8(a * r * g0, b * r * g1); } }
        __syncthreads();
        at::f32x16 o[2];
#pragma unroll
        for (int r = 0; r < 16; ++r) { o[0][r] = 0.f; o[1][r] = 0.f; }
        const bf16_t* wrow = WSB + ((size_t)g * 128 + 32 * tt + r32) * 128 + 4 * hi;
        const int nks = 2 * tt + 2;
        uint2 alo8[8], ahi8[8];
#pragma unroll
        for (int ks = 0; ks < 8; ++ks) { alo8[ks] = *(const uint2*)(wrow + 16 * ks); ahi8[ks] = *(const uint2*)(wrow + 16 * ks + 8); }
#pragma unroll
        for (int ks = 0; ks < 8; ++ks) { if (ks >= nks) break;
            const uint2 alo = alo8[ks], ahi = ahi8[ks];
            const bf16x8 af = __builtin_bit_cast(bf16x8, (u32x4){alo.x, alo.y, ahi.x, ahi.y});
#pragma unroll
            for (int dbl = 0; dbl < 2; ++dbl) { const at::s16x4 lo = at::vtr(vb + dbl * 8192 + ks * 1024), hh = at::vtr(vb + dbl * 8192 + ks * 1024 + 512);
                const bf16x8 vf = (bf16x8){lo[0], lo[1], lo[2], lo[3], hh[0], hh[1], hh[2], hh[3]};
                o[dbl] = __builtin_amdgcn_mfma_f32_32x32x16_bf16(af, vf, o[dbl], 0, 0, 0); }
        }
        LAS float* stg = (LAS float*)(lds + 40960);
#pragma unroll
        for (int r = 0; r < 16; ++r) { const int t = 32 * tt + at::crow(r, hi); const float bias = bs[g * 128 + t];
#pragma unroll
            for (int dbl = 0; dbl < 2; ++dbl) stg[t * 128 + (2 * dh + dbl) * 32 + r32] = o[dbl][r] + bias; }
        __syncthreads();
#pragma unroll
        for (int j = 0; j < 4; ++j) { const int p = tid + 512 * j, t = p >> 4, c8 = (p & 15) * 8; const size_t row = (size_t)(t0 + t);
            const f32x4 m0 = *(const LAS f32x4*)(stg + t * 128 + c8), m1 = *(const LAS f32x4*)(stg + t * 128 + c8 + 4);
            f32x4 u0, u1; pg::unpack8(*(const u32x4*)(PROJ + row * INW + OFF_U + g * 128 + c8), u0, u1);
            *(u32x4*)(Y + row * 1536 + g * 128 + c8) = pg::pack8(u0 * m0, u1 * m1); }
        __syncthreads();
    }
}

struct MArgs { const float* in[24]; float* out; unsigned char* ws; int ph_lo, ph_hi; };
__global__ void __launch_bounds__(NWAVES * 64, 2) mk_fwd(MArgs a) {
    extern __shared__ __attribute__((aligned(16))) unsigned char lds_raw[];
    LAS unsigned char* lds = (LAS unsigned char*)lds_raw;
    const int tid = threadIdx.x;
    for (int u = tid; u < (LDS_BYTES - LDSCTL_OFF) / 4; u += NWAVES * 64) ((LAS unsigned*)(lds + LDSCTL_OFF))[u] = 0u;
    __syncthreads();
    unsigned char* ws = a.ws; unsigned* ctl = (unsigned*)(ws + WS_CTL);
    const int lo = a.ph_lo, hi = a.ph_hi; const int G = gridDim.x, c = blockIdx.x;
    XcdBarrier bar; bar.bar = ctl + CW_BAR; bar.x = 0; bar.st = nullptr;
    if (hi - lo > 1) bar = xcd_barrier_post(ctl + CW_BAR, (volatile LAS unsigned*)(lds + LDSCTL_OFF));
typedef const MArgs __attribute__((address_space(4))) * kargp_t;
    const kargp_t kargs = (kargp_t)__builtin_amdgcn_kernarg_segment_ptr();
#define KA_BEGIN() kargp_t q = kargs; asm volatile("" : "+s"(q))
#ifdef DIAG_PHASE
    if (c == 0 && tid == 0) *(LAS unsigned long long*)(lds + LDSCTL_OFF + 16) = wall_clock64();
#define DIAG_STAMP(k) do { if ((k) == DIAG_PHASE && c == 0 && tid == 0) ctl[CW_DIAG] = (unsigned)(wall_clock64() - *(LAS unsigned long long*)(lds + LDSCTL_OFF + 16)); } while (0)
#else
#define DIAG_STAMP(k) do { } while (0)
#endif
#define IN(k) (lo <= (k) && (k) < hi)
#define BOTH(k) (IN(k) && IN((k) + 1))
    bf16_t *WinT = (bf16_t*)(ws + WS_WIN), *WbrT = (bf16_t*)(ws + WS_WBR), *WoutT = (bf16_t*)(ws + WS_WOUT);
    bf16_t *W1T = (bf16_t*)(ws + WS_W1), *W2T = (bf16_t*)(ws + WS_W2);
    bf16_t *MERGED = (bf16_t*)(ws + WS_MERGED), *X1B = (bf16_t*)(ws + WS_X1B), *HB = (bf16_t*)(ws + WS_HB), *PROJ = (bf16_t*)(ws + WS_PROJ), *Y = (bf16_t*)(ws + WS_Y);
    bf16_t *ACT = (bf16_t*)(ws + WS_ACT), *YS = (bf16_t*)(ws + WS_YS);
    float* KMP = (float*)(ws + WS_KMP); int* LIST = (int*)(ws + WS_LIST); float* RSTDS = (float*)(ws + WS_RSTDS); float* TOPWS = (float*)(ws + WS_TOPWS);

    bf16_t *WmemT = (bf16_t*)(ws + WS_WMEM), *MEMN = (bf16_t*)(ws + WS_MEMN), *MKV = (bf16_t*)(ws + WS_MKV), *WSB = (bf16_t*)(ws + WS_WSB); float* WrT = (float*)(ws + WS_WR);
#if !defined(ONLY) || ONLY == 0
    if (IN(0)) {
        KA_BEGIN();
        {
        P0Args p; p.x = q->in[0]; p.mem = q->in[1]; p.g_mix = q->in[2]; p.g_mem = q->in[9]; p.w_in = q->in[3]; p.w_br0 = q->in[13]; p.w_br1 = q->in[14]; p.w_br2 = q->in[15]; p.w_out = q->in[16];
        p.w_mem_kv = q->in[10]; p.w_gate_up = q->in[20]; p.w_down = q->in[22]; p.g_ffn = q->in[17]; p.w_router = q->in[18]; p.w_spatial = q->in[5];
        p.HBQ = ws + WS_HBQ; p.WINQ = ws + WS_WINQ; p.HB = HB; p.MEMN = MEMN; p.WinT = WinT; p.WbrT = WbrT; p.WoutT = WoutT; p.WmemT = WmemT; p.W1T = W1T; p.W2T = W2T; p.WSB = WSB; p.WrT = WrT;
        p0_prologue(p, lds, G, c);
        }
#if DUP_PHASE == 0
        {
        P0Args p; p.x = q->in[0]; p.mem = q->in[1]; p.g_mix = q->in[2]; p.g_mem = q->in[9]; p.w_in = q->in[3]; p.w_br0 = q->in[13]; p.w_br1 = q->in[14]; p.w_br2 = q->in[15]; p.w_out = q->in[16];
        p.w_mem_kv = q->in[10]; p.w_gate_up = q->in[20]; p.w_down = q->in[22]; p.g_ffn = q->in[17]; p.w_router = q->in[18]; p.w_spatial = q->in[5];
        p.HBQ = ws + WS_HBQ; p.WINQ = ws + WS_WINQ; p.HB = HB; p.MEMN = MEMN; p.WinT = WinT; p.WbrT = WbrT; p.WoutT = WoutT; p.WmemT = WmemT; p.W1T = W1T; p.W2T = W2T; p.WSB = WSB; p.WrT = WrT;
        p0_prologue(p, lds, G, c);
        }
#endif
        if (BOTH(0)) xcd_barrier(bar);
        DIAG_STAMP(0);
    }
#endif
#if !defined(ONLY) || ONLY == 1
    if (IN(1)) {
        KA_BEGIN();
        {
        pg::PolP1 P; P.A = HB; P.Bt = WinT; P.PROJ = PROJ; P.KMP = KMP; P.gq = q->in[7]; P.gk = q->in[8]; P.G = G; P.c = c;
        pg::gemm_run(lds, P);
        { pg::PolP1G Pg; Pg.A = ws + WS_HBQ; Pg.Bt = ws + WS_WINQ; Pg.PROJ = PROJ; Pg.G = G; Pg.c = c; pg::gemm_run(lds, Pg); }
        p1_memkv(MEMN, WmemT, q->in[12], MKV, G, c, lds);
        }
#if DUP_PHASE == 1
        {
        pg::PolP1 P; P.A = HB; P.Bt = WinT; P.PROJ = PROJ; P.KMP = KMP; P.gq = q->in[7]; P.gk = q->in[8]; P.G = G; P.c = c;
        pg::gemm_run(lds, P);
        p1_memkv(MEMN, WmemT, q->in[12], MKV, G, c, lds);
        }
#endif
        if (BOTH(1)) xcd_barrier(bar);
        DIAG_STAMP(1);
    }
#endif
#if !defined(ONLY) || ONLY == 2
    if (IN(2)) {
        KA_BEGIN();
        {
        const int wave = __builtin_amdgcn_readfirstlane(tid >> 6), lane = tid & 63;
        const int vcu = (G % 8 == 0) ? (c % 8) * (G / 8) + c / 8 : c;
        for (int u = vcu; u < 256; u += G) at::mem_units(u >> 5, (u >> 3) & 3, (u & 7) * 2, 2, PROJ, MKV, q->in[11], Y, lds);
#if DUP_P2 == 1
        for (int u = vcu; u < 256; u += G) at::mem_units(u >> 5, (u >> 3) & 3, (u & 7) * 2, 2, PROJ, MKV, q->in[11], Y, lds);
#endif
        ConvJob J; J.w1 = q->in[20]; J.w2 = q->in[22]; J.gf = q->in[17]; J.W1Q = (unsigned char*)W1T; J.W2Q = (unsigned char*)W2T; J.scr = (LAS float*)(lds + 40960 + wave * 4352);
        J.item = c * NWAVES + wave; J.end = CV_TOTAL; J.stride = G * NWAVES; float tv[16];
        for (int u = vcu; u < 256; u += G) { const int bh = u >> 2, s4 = u & 3;
            for (int i = 0; i < 4; ++i) { const int jb = (i == 0) ? 15 - s4 : (i == 1) ? 8 + s4 : (i == 2) ? 7 - s4 : s4; at::moba_unit(bh >> 3, bh & 7, jb, PROJ, KMP, Y, lds, J, tv); } }
#if DUP_P2 == 2
        for (int u = vcu; u < 256; u += G) { const int bh = u >> 2, s4 = u & 3;
            for (int i = 0; i < 4; ++i) { const int jb = (i == 0) ? 15 - s4 : (i == 1) ? 8 + s4 : (i == 2) ? 7 - s4 : s4; at::moba_unit(bh >> 3, bh & 7, jb, PROJ, KMP, Y, lds, J, tv); } }
#endif
        while (J.item < J.end) { conv_issue(J, tv, lane); conv_finish(J, tv, lane); }
        __syncthreads();
        for (int ch = vcu; ch < 256; ch += G) sgu_chunk(ch, PROJ, q->in[4], WSB, q->in[6], Y, lds);
#if DUP_P2 == 3
        for (int ch = vcu; ch < 256; ch += G) sgu_chunk(ch, PROJ, q->in[4], WSB, q->in[6], Y, lds);
#endif
        }
#if DUP_PHASE == 2
        {
        const int wave = __builtin_amdgcn_readfirstlane(tid >> 6), lane = tid & 63;
        const int vcu = (G % 8 == 0) ? (c % 8) * (G / 8) + c / 8 : c;
        for (int u = vcu; u < 256; u += G) at::mem_units(u >> 5, (u >> 3) & 3, (u & 7) * 2, 2, PROJ, MKV, q->in[11], Y, lds);
        for (int u = vcu; u < 256; u += G) { const int bh = u >> 2, s4 = u & 3;
            for (int i = 0; i < 4; ++i) { const int jb = (i == 0) ? 15 - s4 : (i == 1) ? 8 + s4 : (i == 2) ? 7 - s4 : s4; at::moba_unit(bh >> 3, bh & 7, jb, PROJ, KMP, Y, lds, J, tv); } }
        __syncthreads();
        for (int ch = vcu; ch < 256; ch += G) sgu_chunk(ch, PROJ, q->in[4], WSB, q->in[6], Y, lds);
        }
#endif
        if (BOTH(2)) xcd_barrier(bar);
        DIAG_STAMP(2);
    }
#endif
#if !defined(ONLY) || ONLY == 3
    if (IN(3)) {
        KA_BEGIN();
        {
        pg::PolP3 P; P.A = Y; P.Bt = WbrT; P.PROJ = PROJ; P.MERGED = MERGED; P.G = G; P.c = c;
        pg::gemm_run(lds, P);
        }
#if DUP_PHASE == 3
        {
        pg::PolP3 P; P.A = Y; P.Bt = WbrT; P.PROJ = PROJ; P.MERGED = MERGED; P.G = G; P.c = c;
        pg::gemm_run(lds, P);
        }
#endif
        if (BOTH(3)) xcd_barrier(bar);
        DIAG_STAMP(3);
    }
#endif
#if !defined(ONLY) || ONLY == 4
    if (IN(4)) {
        KA_BEGIN();
        {
        pg::PolP4 P; P.A = MERGED; P.Bt = WoutT; P.x = q->in[0]; P.X1H = (bf16_t*)(ws + WS_X1H); P.X1Q = (unsigned char*)X1B; P.gffn = q->in[17]; P.G = G; P.c = c;
        pg::gemm_run(lds, P);
        }
#if DUP_PHASE == 4
        {
        pg::PolP4 P; P.A = MERGED; P.Bt = WoutT; P.x = q->in[0]; P.X1H = (bf16_t*)(ws + WS_X1H); P.X1Q = (unsigned char*)X1B; P.gffn = q->in[17]; P.G = G; P.c = c;
        pg::gemm_run(lds, P);
        }
#endif
        if (BOTH(4)) xcd_barrier(bar);
#ifdef DUP_BAR
        for (int i_ = 0; i_ < DUP_BAR; ++i_) xcd_barrier(bar);
#endif
        DIAG_STAMP(4);
    }
#endif
#if !defined(ONLY) || ONLY == 5
    if (IN(5)) {
        KA_BEGIN();
        {
        p5_router((const bf16_t*)(ws + WS_X1H), WrT, q->in[19], LIST, RSTDS, TOPWS, ctl + CW_CNT, G, c, lds);
        }
#if DUP_PHASE == 5
        {
        p5_router((const bf16_t*)(ws + WS_X1H), WrT, q->in[19], (int*)(ws + WS_SCR), (float*)(ws + WS_SCR + 4 * MiB), (float*)(ws + WS_SCR + 8 * MiB), ctl + 512, G, c, lds);
        }
#endif
        if (BOTH(5)) xcd_barrier(bar);
        DIAG_STAMP(5);
    }
#endif
#if !defined(ONLY) || ONLY == 6
    if (IN(6)) {
        KA_BEGIN();
        {
        grouped_setup((LAS int*)(lds + TAB_OFF), ctl + CW_CNT);
        pg::PolP6 P; P.X1Q = (const unsigned char*)X1B; P.W1Q = (const unsigned char*)W1T; P.LIST = LIST; P.RSTDS = RSTDS; P.b1 = q->in[21]; P.ACTQ = (unsigned char*)ACT; P.tb.tab = (const LAS int*)(lds + TAB_OFF); P.G = G; P.c = c; P.rtab = lds + RTAB_OFF;
        pg::gemm_run(lds, P);
        }
#if DUP_PHASE == 6
        {
        grouped_setup((LAS int*)(lds + TAB_OFF), ctl + CW_CNT);
        pg::PolP6 P; P.X1Q = (const unsigned char*)X1B; P.W1Q = (const unsigned char*)W1T; P.LIST = LIST; P.RSTDS = RSTDS; P.b1 = q->in[21]; P.ACTQ = (unsigned char*)ACT; P.tb.tab = (const LAS int*)(lds + TAB_OFF); P.G = G; P.c = c; P.rtab = lds + RTAB_OFF;
        pg::gemm_run(lds, P);
        }
#endif
        if (BOTH(6)) xcd_barrier(bar);
        DIAG_STAMP(6);
    }
#endif
#if !defined(ONLY) || ONLY == 7
    if (IN(7)) {
        KA_BEGIN();
        {
        grouped_setup((LAS int*)(lds + TAB_OFF), ctl + CW_CNT);
        pg::PolP7 P; P.ACTQ = (const unsigned char*)ACT; P.W2Q = (const unsigned char*)W2T; P.LIST = LIST; P.TOPWS = TOPWS; P.b2 = q->in[23]; P.YS = YS; P.tb.tab = (const LAS int*)(lds + TAB_OFF); P.G = G; P.c = c; P.rtab = lds + RTAB_OFF;
        pg::gemm_run(lds, P);
        }
#if DUP_PHASE == 7
        {
        grouped_setup((LAS int*)(lds + TAB_OFF), ctl + CW_CNT);
        pg::PolP7 P; P.ACTQ = (const unsigned char*)ACT; P.W2Q = (const unsigned char*)W2T; P.LIST = LIST; P.TOPWS = TOPWS; P.b2 = q->in[23]; P.YS = YS; P.tb.tab = (const LAS int*)(lds + TAB_OFF); P.G = G; P.c = c; P.rtab = lds + RTAB_OFF;
        pg::gemm_run(lds, P);
        }
#endif
        if (BOTH(7)) xcd_barrier(bar);
        DIAG_STAMP(7);
    }
#endif
#if !defined(ONLY) || ONLY == 8
    if (IN(8)) { KA_BEGIN();
#ifdef DIAG_PHASE
        p8_combine(q->out, (const bf16_t*)(ws + WS_X1H), YS, G, c, 1.0f + sqrtf((float)ctl[CW_DIAG] * 1e-5f));
#else
        p8_combine(q->out, (const bf16_t*)(ws + WS_X1H), YS, G, c, 1.0f);
#if DUP_PHASE == 8
        p8_combine(q->out, (const bf16_t*)(ws + WS_X1H), YS, G, c, -1.0f);
#endif
#endif
    }
#endif
#undef IN
#undef BOTH
}

static int g_grid = 0;
static void launch_mk(const MArgs& base, int lo, int hi, hipStream_t stream) {
    MArgs a = base; a.ph_lo = lo; a.ph_hi = hi;
    hipLaunchKernelGGL(mk_fwd, dim3(g_grid), dim3(NWAVES * 64), LDS_BYTES, stream, a);
}
extern "C" void kernel_launch(void* const* d_in, const int* in_sizes, int n_in, void* d_out, int out_size, void* d_ws, size_t ws_size, hipStream_t stream) {
    if (n_in != 24 || ws_size < WS_END) { fprintf(stderr, "kernel_launch: unexpected n_in %d or ws %zu\n", n_in, ws_size); return; }
    if (g_grid == 0) {
        int dev = 0, cus = 0, per_cu = 0;
        (void)hipGetDevice(&dev); (void)hipDeviceGetAttribute(&cus, hipDeviceAttributeMultiprocessorCount, dev);
        if (hipFuncSetAttribute((const void*)mk_fwd, hipFuncAttributeMaxDynamicSharedMemorySize, LDS_BYTES) != hipSuccess) fprintf(stderr, "kernel_launch: hipFuncSetAttribute failed\n");
        if (hipOccupancyMaxActiveBlocksPerMultiprocessor(&per_cu, (const void*)mk_fwd, NWAVES * 64, LDS_BYTES) != hipSuccess || per_cu < 1) fprintf(stderr, "kernel_launch: occupancy query says %d\n", per_cu);
        (void)hipGetLastError();
        g_grid = cus > 0 ? cus : 256;
    }
    unsigned char* ws = (unsigned char*)d_ws; float* out = (float*)d_out;
    MArgs base{}; for (int i = 0; i < 24; ++i) base.in[i] = (const float*)d_in[i]; base.out = out; base.ws = ws;

    (void)hipMemsetAsync(ws + WS_CTL, 0, 1 * MiB, stream);
    launch_mk(base, 0, 9, stream);
}
```

```cpp
#include <hip/hip_runtime.h>
#include <stdint.h>
#include <cstdio>
#ifndef DUP_P2
#define DUP_P2 0
#endif
#ifndef DUP_PHASE
#define DUP_PHASE -1
#endif

typedef unsigned short bf16_t;
typedef short bf16x8 __attribute__((ext_vector_type(8)));
typedef float f32x4 __attribute__((ext_vector_type(4)));
typedef unsigned u32x4 __attribute__((ext_vector_type(4)));
typedef int i32x8 __attribute__((ext_vector_type(8)));
typedef int i32x4 __attribute__((ext_vector_type(4)));

constexpr int NBATCH = 8, SEQ = 4096, DM = 1024, T_TOK = NBATCH * SEQ, INW = 6144, MEML = 256;
constexpr int OFF_U = 0, OFF_V = 512, OFF_QB = 1024, OFF_KB = 1536, OFF_VB = 2048, OFF_QM = 2560, OFF_G = 3072;
constexpr int NEXP = 32, TOPK = 4, DFF = 1024;
constexpr float EPS = 1e-6f;
constexpr int ACT_ROWS = T_TOK * TOPK + NEXP * 256;

constexpr size_t MiB = 1ull << 20;
constexpr size_t WS_CTL = 0;
constexpr size_t WS_WIN = 1 * MiB;
constexpr size_t WS_WBR = 13 * MiB;
constexpr size_t WS_WOUT = 16 * MiB;
constexpr size_t WS_WMEM = 18 * MiB;
constexpr size_t WS_WR = 20 * MiB;
constexpr size_t WS_RSTD2 = 21 * MiB;
constexpr size_t WS_WSB = 21 * MiB + 256 * 1024;
constexpr size_t WS_KMP = 22 * MiB;
constexpr size_t WS_TOPW = 23 * MiB;
constexpr size_t WS_LIST = 24 * MiB;
constexpr size_t WS_RSTDS = 28 * MiB;
constexpr size_t WS_TOPWS = 32 * MiB;
constexpr size_t WS_MEMN = 36 * MiB;
constexpr size_t WS_MKV = 40 * MiB;
constexpr size_t WS_W1 = 44 * MiB;
constexpr size_t WS_W2 = 172 * MiB;
constexpr size_t WS_MERGED = 236 * MiB;
constexpr size_t WS_X1B = 300 * MiB;
constexpr size_t WS_HB = 364 * MiB;
constexpr size_t WS_PROJ = 428 * MiB;
constexpr size_t WS_Y = 812 * MiB;
constexpr size_t WS_ACT = 364 * MiB;
constexpr size_t WS_YS = 636 * MiB;
constexpr size_t WS_X1H = 500 * MiB;
constexpr size_t WS_HBQ = 908 * MiB;
constexpr size_t WS_WINQ = 944 * MiB;
constexpr size_t WS_SCR = 960 * MiB;
constexpr size_t WS_END = 1024 * MiB;
constexpr int CW_CNT = 64;
constexpr int CW_DIAG = 128;

__device__ __forceinline__ float bf2f(bf16_t b) { return __uint_as_float(((unsigned)b) << 16); }
__device__ __forceinline__ bf16_t f2bf(float f) { unsigned u = __float_as_uint(f); u += 0x7fffu + ((u >> 16) & 1u); return (bf16_t)(u >> 16); }
__device__ __forceinline__ float wave_sum(float v) {
#pragma unroll
    for (int o = 1; o < 64; o <<= 1) v += __shfl_xor(v, o);
    return v;
}
__device__ __forceinline__ float wave_max(float v) {
#pragma unroll
    for (int o = 1; o < 64; o <<= 1) v = fmaxf(v, __shfl_xor(v, o));
    return v;
}
__device__ __forceinline__ float gelu_exact(float v) { return 0.5f * v * (1.0f + erff(v * 0.70710678118654752f)); }
__device__ __forceinline__ float sigmoidf_(float v) { return 1.0f / (1.0f + __expf(-v)); }

#define LAS __attribute__((address_space(3)))
typedef float f32x2 __attribute__((ext_vector_type(2)));
constexpr int NWAVES = 8;
constexpr int RING_BYTES = 131072;
constexpr int LDSCTL_OFF = RING_BYTES;
constexpr int TAB_OFF = RING_BYTES + 64;
constexpr int TAB_CNT = 0, TAB_TST = 32, TAB_TE = 96, TAB_WORDS = 96 + 576;
constexpr int RTAB_OFF = RING_BYTES + 8192;
constexpr int RT_STRIDE = 4096;
constexpr int LDS_BYTES = 147456;
static_assert(TAB_OFF + TAB_WORDS * 4 <= LDS_BYTES && RTAB_OFF + 2 * RT_STRIDE <= LDS_BYTES, "LDS map");
constexpr int CW_BAR = 4096;

#define XB_TMO      128
#define XB_XCNT(j)  (256  + 64 * (j))
#define XB_XSUB(j)  (1280 + 64 * (j))
#define XB_XGEN(j)  (2304 + 64 * (j))
#define XB_TOP      3328
#define XB_TOPGEN   3392
#define XCD_BAR_WORDS 3456
#define XB_SPIN_CAP (1u << 18)
__device__ __forceinline__ unsigned xb_ld(unsigned* p)              { return __hip_atomic_load(p, __ATOMIC_RELAXED, __HIP_MEMORY_SCOPE_AGENT); }
__device__ __forceinline__ unsigned xb_add(unsigned* p, unsigned v) { return __hip_atomic_fetch_add(p, v, __ATOMIC_RELAXED, __HIP_MEMORY_SCOPE_AGENT); }
__device__ __forceinline__ unsigned xb_xcc_id() { return (unsigned)__builtin_amdgcn_s_getreg((3 << 11) | 20) & 0xFu; }
#define XB_SPIN(cond, bar) do { unsigned _sp = 0; while (cond) { __builtin_amdgcn_s_sleep(1); \
    if ((++_sp & 255u) == 0u) { if (xb_ld(&(bar)[XB_TMO])) break; if (_sp > XB_SPIN_CAP) { atomicAdd(&(bar)[XB_TMO], 1u); break; } } } } while (0)
struct XcdBarrier { unsigned* bar; unsigned x; volatile LAS unsigned* st; };
__device__ __forceinline__ XcdBarrier xcd_barrier_post(unsigned* bar, volatile LAS unsigned* st) {
    XcdBarrier b; b.bar = bar; b.x = xb_xcc_id(); b.st = st;
    if (threadIdx.x == 0) (void)xb_add(&bar[XB_XCNT(b.x)], 1u);
    return b;
}
__device__ __forceinline__ void xcd_barrier_complete(unsigned* bar, unsigned x, unsigned& nloc, unsigned& nx) {
    const unsigned G = gridDim.x * gridDim.y * gridDim.z;
    unsigned sum, cnt, mine, sp = 0u;
    for (;;) {
        sum = 0u; cnt = 0u; mine = 0u;
#pragma unroll
        for (unsigned j = 0; j < 16; ++j) { const unsigned c = xb_ld(&bar[XB_XCNT(j)]); sum += c; cnt += (c > 0u) ? 1u : 0u; mine = (j == x) ? c : mine; }
        if (sum == G) break;
        __builtin_amdgcn_s_sleep(1);
        if ((++sp & 255u) == 0u) { if (xb_ld(&bar[XB_TMO])) break; if (sp > XB_SPIN_CAP) { atomicAdd(&bar[XB_TMO], 1u); break; } }
    }
    nloc = mine > 0u ? mine : 1u; nx = cnt > 0u ? cnt : 1u;
}
__device__ __forceinline__ void xcd_barrier(const XcdBarrier& b) {
    asm volatile("s_waitcnt vmcnt(0)" ::: "memory");
    __syncthreads();
    if (threadIdx.x == 0) {
        unsigned* bar = b.bar;
        __builtin_amdgcn_s_waitcnt(0);
        unsigned nloc = b.st[0], nx = b.st[1];
        if (nloc == 0u) { xcd_barrier_complete(bar, b.x, nloc, nx); b.st[0] = nloc; b.st[1] = nx; }
        const unsigned old = xb_add(&bar[XB_XSUB(b.x)], 1u);
        const unsigned gen = old / nloc;
        if (old + 1u == (gen + 1u) * nloc) {
            __builtin_amdgcn_fence(__ATOMIC_RELEASE, "agent");
            asm volatile("s_waitcnt vmcnt(0)" ::: "memory");
            const unsigned og = xb_add(&bar[XB_TOP], 1u);
            const unsigned tg = og / nx;
            if (og + 1u == (tg + 1u) * nx) xb_add(&bar[XB_TOPGEN], 1u);
            else XB_SPIN(xb_ld(&bar[XB_TOPGEN]) == tg, bar);
            __builtin_amdgcn_fence(__ATOMIC_ACQUIRE, "agent");
            xb_add(&bar[XB_XGEN(b.x)], 1u);
            asm volatile("s_waitcnt vmcnt(0)" ::: "memory");
        } else {
            XB_SPIN(xb_ld(&bar[XB_XGEN(b.x)]) == gen, bar);
            __builtin_amdgcn_fence(__ATOMIC_ACQUIRE, "agent");
            asm volatile("s_waitcnt vmcnt(0)" ::: "memory");
        }
    }
    __syncthreads();
}

#ifndef PG_ALIGN
#define PG_ALIGN true
#endif
namespace pg {
constexpr int BM = 256, BK = 64, HALF = 128, HTB = HALF * BK * 2, STAGE_BYTES = 8 * HTB, NXCD = 8, WGM = 8;
__host__ __device__ __forceinline__ int lds_byte(int r, int c) { const int st = (r >> 4) * 2 + (c >> 5), rr = r & 15, cc = c & 31, ob = rr * 64 + cc * 2; return st * 1024 + (ob ^ (((ob >> 9) & 1) << 5)); }
__host__ __device__ __forceinline__ void stage_rc(int b, int& R, int& C) { const int st = b / 1024, sb = b % 1024, swz = sb ^ (((sb >> 9) & 1) << 5); R = (st >> 1) * 16 + swz / 64; C = (st & 1) * 32 + (swz % 64) / 2; }
__host__ __device__ __forceinline__ int perm32(int rho) { const int n = rho >> 4, i = rho & 15; return 8 * (i >> 2) + 4 * n + (i & 3); }
struct Unit { int pm, pn, e, mt; };
__device__ __forceinline__ bool static_unit(long L, int nM, int nN, int& pm, int& pn) {
    const int nwg = nM * nN; if (L >= nwg) return false;
    int wgid = (int)L; { const int q = nwg / NXCD, r = nwg % NXCD, xcd = wgid % NXCD, off = wgid / NXCD; wgid = (xcd < r ? xcd * (q + 1) : r * (q + 1) + (xcd - r) * q) + off; }
    const int nig = WGM * nN, gid = wgid / nig, fm = gid * WGM, gsz = (nM - fm) < WGM ? (nM - fm) : WGM;
    pm = fm + ((wgid % nig) % gsz); pn = (wgid % nig) / gsz; return true;
}
typedef __bf16 bf16x2_hw __attribute__((ext_vector_type(2)));
__device__ __forceinline__ unsigned cvt_pk_bf16(float lo, float hi) { const bf16x2_hw b = __builtin_convertvector((f32x2){lo, hi}, bf16x2_hw); return __builtin_bit_cast(unsigned, b); }
__device__ __forceinline__ u32x4 pack8(const f32x4 v0, const f32x4 v1) { u32x4 w; w.x = cvt_pk_bf16(v0[0], v0[1]); w.y = cvt_pk_bf16(v0[2], v0[3]); w.z = cvt_pk_bf16(v1[0], v1[1]); w.w = cvt_pk_bf16(v1[2], v1[3]); return w; }
constexpr float YQ_SCALE = 32.0f, YQ_INV = 1.0f / 32.0f;
constexpr float WQ_SCALE = 64.0f, WQ_INV = 1.0f / 64.0f;
__device__ __forceinline__ uint2 pack8_fp8(const f32x4 v0, const f32x4 v1) { int a = 0, b = 0;
    a = __builtin_amdgcn_cvt_pk_fp8_f32(v0[0], v0[1], a, false); a = __builtin_amdgcn_cvt_pk_fp8_f32(v0[2], v0[3], a, true);
    b = __builtin_amdgcn_cvt_pk_fp8_f32(v1[0], v1[1], b, false); b = __builtin_amdgcn_cvt_pk_fp8_f32(v1[2], v1[3], b, true); return make_uint2((unsigned)a, (unsigned)b); }
#ifndef EPI_NT
#define EPI_NT 0
#endif
__device__ __forceinline__ void st16(void* p, const u32x4 v) { if (EPI_NT) __builtin_nontemporal_store(v, (u32x4*)p); else *(u32x4*)p = v; }
__device__ __forceinline__ void st16f(void* p, const f32x4 v) { if (EPI_NT) __builtin_nontemporal_store(v, (f32x4*)p); else *(f32x4*)p = v; }
__device__ __forceinline__ void st8(void* p, const uint2 v) { typedef unsigned u32x2 __attribute__((ext_vector_type(2))); const u32x2 w = {v.x, v.y}; if (EPI_NT) __builtin_nontemporal_store(w, (u32x2*)p); else *(u32x2*)p = w; }
__device__ __forceinline__ void unpack8(const u32x4 w, f32x4& v0, f32x4& v1) {
    v0[0] = __uint_as_float(w.x << 16); v0[1] = __uint_as_float(w.x & 0xffff0000u); v0[2] = __uint_as_float(w.y << 16); v0[3] = __uint_as_float(w.y & 0xffff0000u);
    v1[0] = __uint_as_float(w.z << 16); v1[1] = __uint_as_float(w.z & 0xffff0000u); v1[2] = __uint_as_float(w.w << 16); v1[3] = __uint_as_float(w.w & 0xffff0000u); }
__device__ __forceinline__ f32x2 gelu_pk(f32x2 v) {
    const f32x2 av = __builtin_elementwise_abs(v), d = av * 0.2316418882f + 1.0f;
    f32x2 t; t.x = __builtin_amdgcn_rcpf(d.x); t.y = __builtin_amdgcn_rcpf(d.y);
    f32x2 q = t * 0.5307027145f + (-0.7265760135f); q = q * t + 0.7107068705f; q = q * t + (-0.142248368f); q = q * t + 0.127414796f; q = q * t;
    const f32x2 s = (v * v) * (-0.72134752044f);
    f32x2 e; e.x = __builtin_amdgcn_exp2f(s.x); e.y = __builtin_amdgcn_exp2f(s.y);
    const f32x2 m = v * (q * e), r = v - m;
    f32x2 o; o.x = v.x < 0.f ? m.x : r.x; o.y = v.y < 0.f ? m.y : r.y; return o;
}
__device__ __forceinline__ f32x4 gelu4(f32x4 v) { const f32x2 a = gelu_pk((f32x2){v[0], v[1]}), b = gelu_pk((f32x2){v[2], v[3]}); return (f32x4){a.x, a.y, b.x, b.y}; }
__device__ __forceinline__ float sigm(float v) { return __builtin_amdgcn_rcpf(1.0f + __builtin_amdgcn_exp2f(v * -1.4426950408889634f)); }
__device__ __forceinline__ f32x4 sigm4(f32x4 v) { return (f32x4){sigm(v[0]), sigm(v[1]), sigm(v[2]), sigm(v[3])}; }

template <class Pol>
__device__ __forceinline__ void gemm_run(LAS unsigned char* lds, const Pol& P) {
    constexpr int KB = Pol::FP8 ? Pol::K : Pol::K * 2, nt = KB / (BK * 2);
    const int tid = threadIdx.x, wid = __builtin_amdgcn_readfirstlane(tid >> 6), lane = tid & 63, wr = wid >> 2, wc = wid & 3, fr = lane & 15, fq = lane >> 4;
    unsigned voffA[2], voffB[2]; int Rr[2], Cc[2];
#pragma unroll
    for (int i = 0; i < 2; ++i) { int R, C; stage_rc(tid * 16 + i * 8192, R, C); Rr[i] = R; Cc[i] = C; const int Rb = (R & ~31) + perm32(R & 31);
        voffA[i] = (unsigned)(R * KB + C * 2); voffB[i] = (unsigned)(Rb * KB + C * 2); }
    constexpr unsigned kstep = BK * 2, hstep = HALF * KB;
    const unsigned ldsw = (unsigned)wid * 1024u;
    const int aoff = lds_byte(wr * 64 + fr, fq * (Pol::FP8 ? 16 : 8)), boff = lds_byte(wc * 32 + fr, fq * (Pol::FP8 ? 16 : 8));
#define PG_SA(b, h) (((b) * 2 + (h)) * HTB)
#define PG_SB(b, h) ((4 + (b) * 2 + (h)) * HTB)
#define PG_AOFF(nx, h, i) (Pol::GATHER ? gC[h][i] : (voffA[i] + (unsigned)(h) * hstep))
#define PG_STAGE_A(bufoff, gbase, nx, h) do { _Pragma("unroll") for (int _i = 0; _i < 2; ++_i) \
        __builtin_amdgcn_global_load_lds((const unsigned*)((const char*)(gbase) + PG_AOFF(nx, h, _i)), (LAS unsigned*)(lds + (bufoff) + ldsw + _i * 8192), 16, 0, 0); } while (0)
#define PG_STAGE_B(bufoff, gbase) do { _Pragma("unroll") for (int _i = 0; _i < 2; ++_i) \
        __builtin_amdgcn_global_load_lds((const unsigned*)((const char*)(gbase) + voffB[_i]), (LAS unsigned*)(lds + (bufoff) + ldsw + _i * 8192), 16, 0, 0); } while (0)
#define PG_LD32(p) ({ const i32x4 _lo = *(const LAS i32x4*)(p), _hi = *(const LAS i32x4*)((p) + 16); (i32x8){_lo[0], _lo[1], _lo[2], _lo[3], _hi[0], _hi[1], _hi[2], _hi[3]}; })
#define PG_LDA(dst, b, h) do { if constexpr (Pol::FP8) { _Pragma("unroll") for (int m = 0; m < 4; ++m) dst##_8[m] = PG_LD32(lds + PG_SA(b, h) + aoff + m * 2048); } \
        else { _Pragma("unroll") for (int m = 0; m < 4; ++m) _Pragma("unroll") for (int k = 0; k < 2; ++k) dst[m][k] = *(const LAS bf16x8*)(lds + PG_SA(b, h) + aoff + m * 2048 + k * 1024); } } while (0)
#define PG_LDB(dst, b, h) do { if constexpr (Pol::FP8) { _Pragma("unroll") for (int n = 0; n < 2; ++n) dst##_8[n] = PG_LD32(lds + PG_SB(b, h) + boff + n * 2048); } \
        else { _Pragma("unroll") for (int n = 0; n < 2; ++n) _Pragma("unroll") for (int k = 0; k < 2; ++k) dst[n][k] = *(const LAS bf16x8*)(lds + PG_SB(b, h) + boff + n * 2048 + k * 1024); } } while (0)
#define PG_MMA(ai, bj, At, Bt) do { __builtin_amdgcn_s_setprio(1); \
        if constexpr (Pol::FP8) { _Pragma("unroll") for (int m = 0; m < 4; ++m) _Pragma("unroll") for (int n = 0; n < 2; ++n) \
            acc[ai][bj][m][n] = __builtin_amdgcn_mfma_scale_f32_16x16x128_f8f6f4(Bt##_8[n], At##_8[m], acc[ai][bj][m][n], 0, 0, 0, 0x7F7F7F7F, 0, 0x7F7F7F7F); } \
        else { _Pragma("unroll") for (int m = 0; m < 4; ++m) _Pragma("unroll") for (int n = 0; n < 2; ++n) _Pragma("unroll") for (int k = 0; k < 2; ++k) \
            acc[ai][bj][m][n] = __builtin_amdgcn_mfma_f32_16x16x32_bf16(Bt[n][k], At[m][k], acc[ai][bj][m][n], 0, 0, 0); } \
        __builtin_amdgcn_s_setprio(0); } while (0)
#define PG_WAIT_V(n) asm volatile("s_waitcnt vmcnt(" #n ")" ::: "memory")
#define PG_WAIT_L(n) asm volatile("s_waitcnt lgkmcnt(" #n ")" ::: "memory")
#define PG_BAR __builtin_amdgcn_s_barrier()
#define PG_SCHED __builtin_amdgcn_sched_barrier(0)
    Unit cur, nxt; int ui = 0;
    if (!P.next(0, cur)) return;
    f32x4 acc[2][2][4][2];
#pragma unroll
    for (int a = 0; a < 2; ++a)
#pragma unroll
        for (int b = 0; b < 2; ++b)
#pragma unroll
            for (int m = 0; m < 4; ++m)
#pragma unroll
                for (int n = 0; n < 2; ++n) acc[a][b][m][n] = (f32x4){0.f, 0.f, 0.f, 0.f};
    bf16x8 At[4][2], B0[2][2], B1[2][2];
    i32x8 At_8[4], B0_8[2], B1_8[2];
    unsigned gC[2][2] = {{0u, 0u}, {0u, 0u}};
    const char* cA = P.a_base(cur); const char* cB = P.b_base(cur);
    if constexpr (Pol::ROWTAB) { P.tab_issue(cur, 0); asm volatile("s_waitcnt vmcnt(0)" ::: "memory"); __builtin_amdgcn_s_barrier(); asm volatile("" ::: "memory"); }
    if constexpr (Pol::GATHER) P.a_offsets(cur, Rr, Cc, gC, 0);
    PG_STAGE_B(PG_SB(0, 0), cB); PG_STAGE_B(PG_SB(0, 1), cB + hstep); PG_STAGE_A(PG_SA(0, 0), cA, false, 0); PG_STAGE_A(PG_SA(0, 1), cA, false, 1);
    if (wr == 1) PG_BAR;
    PG_WAIT_V(2); PG_BAR;
    PG_STAGE_B(PG_SB(1, 0), cB + kstep); PG_STAGE_A(PG_SA(1, 0), cA + kstep, false, 0); PG_STAGE_B(PG_SB(1, 1), cB + hstep + kstep);
    PG_WAIT_V(6); PG_BAR;
    for (;;) {
        const bool has_next = P.next(ui + 1, nxt);
        const char* nA = has_next ? P.a_base(nxt) : cA; const char* nB = has_next ? P.b_base(nxt) : cB;
#pragma nounroll
        for (int t = 0; t < nt; t += 2) {
            const bool last = (t == nt - 2);
            if constexpr (Pol::ROWTAB) { if (t == 2 && has_next) P.tab_issue(nxt, (ui + 1) & 1); }
            if constexpr (Pol::HOOK) { if (t == Pol::H1 || t == Pol::H2) P.khook(t, acc, cur, wr, wc, fr, fq); }
            const char* a1 = cA + (size_t)(t + 1) * kstep;
            const char* a2 = last ? nA : cA + (size_t)(t + 2) * kstep; const char* b2 = last ? nB : cB + (size_t)(t + 2) * kstep;
            const char* a3 = a2 + kstep; const char* b3 = b2 + kstep;
            PG_LDB(B0, 0, 0); PG_LDB(B1, 0, 1); PG_SCHED; PG_LDA(At, 0, 0); PG_STAGE_A(PG_SA(1, 1), a1, false, 1);
            if constexpr (Pol::GATHER) { if (last && has_next) P.a_offsets(nxt, Rr, Cc, gC, (ui + 1) & 1); }
            PG_WAIT_V(8); PG_WAIT_L(0); PG_BAR; PG_MMA(0, 0, At, B0); PG_MMA(0, 1, At, B1); PG_BAR; PG_SCHED;
            PG_LDA(At, 0, 1); PG_STAGE_B(PG_SB(0, 0), b2); PG_STAGE_B(PG_SB(0, 1), b2 + hstep); PG_STAGE_A(PG_SA(0, 0), a2, last, 0);
            PG_WAIT_V(8); PG_WAIT_L(0); PG_BAR; PG_MMA(1, 0, At, B0); PG_MMA(1, 1, At, B1); PG_BAR; PG_SCHED;
            PG_LDB(B0, 1, 0); PG_LDB(B1, 1, 1); PG_SCHED; PG_LDA(At, 1, 0); PG_STAGE_A(PG_SA(0, 1), a2, last, 1);
            PG_WAIT_V(8); PG_WAIT_L(0); PG_BAR; PG_MMA(0, 0, At, B0); PG_MMA(0, 1, At, B1); PG_BAR; PG_SCHED;
            PG_LDA(At, 1, 1); PG_STAGE_B(PG_SB(1, 0), b3); PG_STAGE_B(PG_SB(1, 1), b3 + hstep); PG_STAGE_A(PG_SA(1, 0), a3, last, 0);
            PG_WAIT_V(8); PG_WAIT_L(0); PG_BAR; PG_MMA(1, 0, At, B0); PG_MMA(1, 1, At, B1); PG_BAR; PG_SCHED;
        }
        if constexpr (PG_ALIGN) { if (wr == 0) PG_BAR; }
        P.epi(acc, cur, wr, wc, fr, fq, ui & 1);
#ifdef DUP_EPI
        if (Pol::K == DUP_EPI_K) { asm volatile("" ::: "memory"); P.epi(acc, cur, wr, wc, fr, fq, ui & 1); }
#endif
        if (!has_next) break;
#pragma unroll
        for (int a = 0; a < 2; ++a)
#pragma unroll
            for (int b = 0; b < 2; ++b)
#pragma unroll
                for (int m = 0; m < 4; ++m)
#pragma unroll
                    for (int n = 0; n < 2; ++n) acc[a][b][m][n] = (f32x4){0.f, 0.f, 0.f, 0.f};
        cur = nxt; cA = nA; cB = nB; ++ui;
        if constexpr (PG_ALIGN) { if (wr == 1) PG_BAR; }
    }
    PG_WAIT_V(0);
    if constexpr (!PG_ALIGN) { if (wr == 0) PG_BAR; }
    PG_BAR;
#undef PG_SA
#undef PG_SB
#undef PG_AOFF
#undef PG_STAGE_A
#undef PG_STAGE_B
#undef PG_LDA
#undef PG_LD32
#undef PG_LDB
#undef PG_MMA
#undef PG_WAIT_V
#undef PG_WAIT_L
#undef PG_BAR
#undef PG_SCHED
}

__device__ __forceinline__ void glds4_asm(const void* gsrc, unsigned lds_dst) { unsigned keep;
    asm volatile("s_mov_b32 %0, m0\n\ts_mov_b32 m0, %2\n\ts_nop 0\n\tglobal_load_lds_dword %1, off\n\ts_mov_b32 m0, %0" : "=&s"(keep) : "v"(gsrc), "s"(lds_dst) : "memory"); }
__device__ __forceinline__ void glds16_asm(const void* gsrc, unsigned lds_dst) { unsigned keep;
    asm volatile("s_mov_b32 %0, m0\n\ts_mov_b32 m0, %2\n\ts_nop 0\n\tglobal_load_lds_dwordx4 %1, off\n\ts_mov_b32 m0, %0" : "=&s"(keep) : "v"(gsrc), "s"(lds_dst) : "memory"); }
struct PolBase { static constexpr bool GATHER = false, HOOK = false, FP8 = false, ROWTAB = false;
    __device__ __forceinline__ void tab_issue(const Unit&, int) const {} static constexpr int H1 = -1, H2 = -1;
    __device__ __forceinline__ void a_offsets(const Unit&, const int (&)[2], const int (&)[2], unsigned (&)[2][2], int) const {}
    __device__ __forceinline__ void khook(int, f32x4 (&)[2][2][4][2], const Unit&, int, int, int, int) const {} };

constexpr int GQ_OFF = OFF_G * 2;
__device__ __forceinline__ void gq_unpack(const uint2 w, f32x4& g0, f32x4& g1) {
    g0 = (f32x4){(float)(w.x & 0xffu), (float)((w.x >> 8) & 0xffu), (float)((w.x >> 16) & 0xffu), (float)(w.x >> 24)} * (1.0f / 256.0f) + (0.5f / 256.0f);
    g1 = (f32x4){(float)(w.y & 0xffu), (float)((w.y >> 8) & 0xffu), (float)((w.y >> 16) & 0xffu), (float)(w.y >> 24)} * (1.0f / 256.0f) + (0.5f / 256.0f); }
#ifndef P1_FP8_TILES
#define P1_FP8_TILES 0xFFFF0Cu
#endif
static_assert((P1_FP8_TILES & 0xF0u) == 0u, "the q_b / k_b tiles (head rmsnorm, block selection) stay bf16");
static_assert((P1_FP8_TILES & 0xFFF000u) == 0xFFF000u, "the gate tiles are written (as 8-bit codes) by the fp8 policy only");
static_assert((P1_FP8_TILES | 0xFFu) == 0xFFFFFFu, "bf16 weight rows are only prepared for column tiles 0..7");
constexpr int p1_popc(unsigned m) { int n = 0; for (int t = 0; t < 24; ++t) n += (m >> t) & 1u; return n; }
constexpr int P1_NF8 = p1_popc(P1_FP8_TILES), P1_NBF = 24 - P1_NF8;
__device__ __forceinline__ int p1_tile(unsigned mask, int j) { int t = 0;
    for (; t < 24; ++t) if ((mask >> t) & 1u) { if (j == 0) break; --j; }
    return t; }
struct PolP1 : PolBase {
    static constexpr int K = 1024;
    const bf16_t* A; const bf16_t* Bt; bf16_t* PROJ; float* KMP; const float* gq; const float* gk; int G, c;
    __device__ __forceinline__ bool next(int i, Unit& u) const { u.e = 0; u.mt = 0; if (!static_unit((long)i * G + c, T_TOK / 256, P1_NBF, u.pm, u.pn)) return false; u.pn = p1_tile(P1_FP8_TILES ^ 0xFFFFFFu, u.pn); return true; }
    __device__ __forceinline__ const char* a_base(const Unit& u) const { return (const char*)A + (size_t)u.pm * 256 * K * 2; }
    __device__ __forceinline__ const char* b_base(const Unit& u) const { return (const char*)Bt + (size_t)u.pn * 256 * K * 2; }
    __device__ __forceinline__ void epi(const f32x4 (&acc)[2][2][4][2], const Unit& u, int wr, int wc, int fr, int fq, int) const {
        const int row0 = u.pm * 256 + wr * 64 + fr, pn = u.pn;
        if (pn >= 4 && pn < 8) {
            const float* g = (pn < 6) ? gq : gk;
            f32x4 gv[2][2], cs[2][2];
#pragma unroll
            for (int bj = 0; bj < 2; ++bj)
#pragma unroll
                for (int n = 0; n < 2; ++n) { gv[bj][n] = *(const f32x4*)(g + 32 * bj + 8 * fq + 4 * n); cs[bj][n] = (f32x4){0.f, 0.f, 0.f, 0.f}; }
#pragma unroll
            for (int ai = 0; ai < 2; ++ai)
#pragma unroll
                for (int m = 0; m < 4; ++m) {
                    float ss = 0.f;
#pragma unroll
                    for (int bj = 0; bj < 2; ++bj)
#pragma unroll
                        for (int n = 0; n < 2; ++n) { const f32x4 x = acc[ai][bj][m][n]; ss += (x[0] * x[0] + x[1] * x[1]) + (x[2] * x[2] + x[3] * x[3]); }
                    ss += __shfl_xor(ss, 16); ss += __shfl_xor(ss, 32);
                    const float rstd = rsqrtf(ss * (1.0f / 64.0f) + EPS) * ((pn < 6) ? 0.18033688011112042f : 1.0f);
                    bf16_t* rowp = PROJ + (size_t)(row0 + ai * HALF + m * 16) * INW + 1024 + (pn - 4) * 256 + 64 * wc + 8 * fq;
#pragma unroll
                    for (int bj = 0; bj < 2; ++bj) { const f32x4 v0 = acc[ai][bj][m][0] * rstd * gv[bj][0], v1 = acc[ai][bj][m][1] * rstd * gv[bj][1];
                        cs[bj][0] += v0; cs[bj][1] += v1; st16(rowp + 32 * bj, pack8(v0, v1)); }
                }
            if (pn >= 6) {
#pragma unroll
                for (int bj = 0; bj < 2; ++bj)
#pragma unroll
                    for (int n = 0; n < 2; ++n)
#pragma unroll
                        for (int j = 0; j < 4; ++j) { float s = cs[bj][n][j]; s += __shfl_xor(s, 1); s += __shfl_xor(s, 2); s += __shfl_xor(s, 4); s += __shfl_xor(s, 8); cs[bj][n][j] = s; }
                if (fr == 0) {
                    float* kp = KMP + ((size_t)u.pm * 2 + wr) * 512 + (pn - 6) * 256 + 64 * wc + 8 * fq;
#pragma unroll
                    for (int bj = 0; bj < 2; ++bj) { *(f32x4*)(kp + 32 * bj) = cs[bj][0]; *(f32x4*)(kp + 32 * bj + 4) = cs[bj][1]; }
                }
            }
        } else {
            const int col0 = pn * 256 + wc * 32 + 8 * fq;
#pragma unroll
            for (int ai = 0; ai < 2; ++ai)
#pragma unroll
                for (int m = 0; m < 4; ++m) { bf16_t* rowp = PROJ + (size_t)(row0 + ai * HALF + m * 16) * INW + col0;
#pragma unroll
                    for (int bj = 0; bj < 2; ++bj) { f32x4 v0 = acc[ai][bj][m][0], v1 = acc[ai][bj][m][1];
                        if (pn < 4) { v0 = gelu4(v0); v1 = gelu4(v1); } else if (pn >= 12) { v0 = sigm4(v0); v1 = sigm4(v1); }
                        st16(rowp + bj * HALF, pack8(v0, v1)); } }
        }
    }
};

struct PolP1G : PolBase {
    static constexpr int K = 1024; static constexpr bool FP8 = true, GATHER = true;
    const unsigned char* A; const unsigned char* Bt; bf16_t* PROJ; int G, c;
    __device__ __forceinline__ bool next(int i, Unit& u) const { u.e = 0; u.mt = 0; constexpr int NU = T_TOK / 256 * P1_NF8; long L = (long)i * G + c;
        if (G == 256 && NU % 256 == 0 && NU / 256 >= 2) { constexpr int R = NU / 256; if (i < R - 1) L = (long)i * 256 + c; else if (c >= 128 && i < R + 1) L = (long)(R - 1) * 256 + (i - (R - 1)) * 128 + (c - 128); else return false; }
        if (!static_unit(L, T_TOK / 256, P1_NF8, u.pm, u.pn)) return false; u.pn = p1_tile(P1_FP8_TILES, u.pn); return true; }
    __device__ __forceinline__ const char* a_base(const Unit&) const { return (const char*)A; }
    __device__ __forceinline__ const char* b_base(const Unit& u) const { return (const char*)Bt + (size_t)u.pn * 256 * K; }
    __device__ __forceinline__ void a_offsets(const Unit& u, const int (&Rr)[2], const int (&Cc)[2], unsigned (&g)[2][2], int) const {
#pragma unroll
        for (int h = 0; h < 2; ++h)
#pragma unroll
            for (int i = 0; i < 2; ++i) g[h][i] = (unsigned)(u.pm * 256 + h * HALF + Rr[i]) * (unsigned)K + (unsigned)Cc[i] * 2u;
    }
    __device__ __forceinline__ void epi(const f32x4 (&acc)[2][2][4][2], const Unit& u, int wr, int wc, int fr, int fq, int) const {
        const int row0 = u.pm * 256 + wr * 64 + fr, pn = u.pn, col0 = pn * 256 + wc * 32 + 8 * fq;
        if (pn >= 12) {
#pragma unroll
            for (int ai = 0; ai < 2; ++ai)
#pragma unroll
                for (int m = 0; m < 4; ++m) { unsigned char* rowq = (unsigned char*)PROJ + (size_t)(row0 + ai * HALF + m * 16) * (INW * 2) + GQ_OFF + (col0 - OFF_G);
#pragma unroll
                    for (int bj = 0; bj < 2; ++bj) { unsigned w[2] = {0u, 0u};
#pragma unroll
                        for (int n = 0; n < 2; ++n)
#pragma unroll
                            for (int j = 0; j < 4; ++j) { const float g = __builtin_amdgcn_rcpf(1.0f + __builtin_amdgcn_exp2f(acc[ai][bj][m][n][j] * (-1.4426950408889634f * WQ_INV)));
                                w[n] = __builtin_amdgcn_cvt_pk_u8_f32(__builtin_floorf(g * 256.0f), j, w[n]); }
                        st8(rowq + bj * HALF, make_uint2(w[0], w[1])); } }
        } else {
#pragma unroll
            for (int ai = 0; ai < 2; ++ai)
#pragma unroll
                for (int m = 0; m < 4; ++m) { bf16_t* rowp = PROJ + (size_t)(row0 + ai * HALF + m * 16) * INW + col0;
#pragma unroll
                    for (int bj = 0; bj < 2; ++bj) { f32x4 v0 = acc[ai][bj][m][0] * WQ_INV, v1 = acc[ai][bj][m][1] * WQ_INV;
                        if (pn < 4) { v0 = gelu4(v0); v1 = gelu4(v1); }
                        st16(rowp + bj * HALF, pack8(v0, v1)); } }
        }
    }
};
struct PolP3 : PolBase {
    static constexpr int K = 1536; static constexpr bool HOOK = true; static constexpr int H1 = 8, H2 = 16;
    const bf16_t* A; const bf16_t* Bt; const bf16_t* PROJ; bf16_t* MERGED; int G, c;
    __device__ __forceinline__ bool next(int i, Unit& u) const { u.e = 0; u.mt = 0; return static_unit((long)i * G + c, T_TOK / 256, DM / 256, u.pm, u.pn); }
    __device__ __forceinline__ const char* a_base(const Unit& u) const { return (const char*)A + (size_t)u.pm * 256 * K * 2; }
    __device__ __forceinline__ const char* b_base(const Unit& u) const { return (const char*)Bt + (size_t)u.pn * 256 * K * 2; }
    __device__ __forceinline__ void khook(int t, f32x4 (&acc)[2][2][4][2], const Unit& u, int wr, int wc, int fr, int fq) const {
        const int gnum = (t == 8) ? 0 : 1024;
        int zero = 0; asm volatile("" : "+v"(zero));
        const int row0 = u.pm * 256 + wr * 64 + fr + zero, col0 = GQ_OFF + u.pn * 256 + wc * 32 + 8 * fq;
#pragma unroll
        for (int ai = 0; ai < 2; ++ai) {
            uint2 wn[4][2], wd[4][2];
#pragma unroll
            for (int m = 0; m < 4; ++m) { const unsigned char* rowp = (const unsigned char*)PROJ + (size_t)(row0 + ai * HALF + m * 16) * (INW * 2) + col0;
#pragma unroll
                for (int bj = 0; bj < 2; ++bj) { wn[m][bj] = *(const uint2*)(rowp + gnum + bj * HALF); wd[m][bj] = *(const uint2*)(rowp + gnum + 1024 + bj * HALF); } }
#pragma unroll
            for (int m = 0; m < 4; ++m)
#pragma unroll
                for (int bj = 0; bj < 2; ++bj) { f32x4 n0, n1, d0, d1; gq_unpack(wn[m][bj], n0, n1); gq_unpack(wd[m][bj], d0, d1);
#pragma unroll
                    for (int j = 0; j < 4; ++j) { acc[ai][bj][m][0][j] *= n0[j] * __builtin_amdgcn_rcpf(d0[j]); acc[ai][bj][m][1][j] *= n1[j] * __builtin_amdgcn_rcpf(d1[j]); } }
            asm volatile("" ::: "memory");
        }
    }
    __device__ __forceinline__ void epi(const f32x4 (&acc)[2][2][4][2], const Unit& u, int wr, int wc, int fr, int fq, int) const {
        const int row0 = u.pm * 256 + wr * 64 + fr, colt = u.pn * 256 + wc * 32 + 8 * fq;
#pragma unroll
        for (int ai = 0; ai < 2; ++ai)
#pragma unroll
            for (int m = 0; m < 4; ++m) { const size_t r = (size_t)(row0 + ai * HALF + m * 16);
#pragma unroll
                for (int bj = 0; bj < 2; ++bj) { const uint2 wg = *(const uint2*)((const unsigned char*)PROJ + r * (INW * 2) + GQ_OFF + 2048 + colt + bj * HALF); f32x4 g0, g1; gq_unpack(wg, g0, g1);
                    st16(MERGED + r * DM + colt + bj * HALF, pack8(acc[ai][bj][m][0] * g0, acc[ai][bj][m][1] * g1)); }
                if (m == 3) asm volatile("" ::: "memory"); }
    }
};
struct PolP4 : PolBase {
    static constexpr int K = 1024;
    const bf16_t* A; const bf16_t* Bt; const float* x; bf16_t* X1H; unsigned char* X1Q; const float* gffn; int G, c;
    __device__ __forceinline__ bool next(int i, Unit& u) const { u.e = 0; u.mt = 0; return static_unit((long)i * G + c, T_TOK / 256, DM / 256, u.pm, u.pn); }
    __device__ __forceinline__ const char* a_base(const Unit& u) const { return (const char*)A + (size_t)u.pm * 256 * K * 2; }
    __device__ __forceinline__ const char* b_base(const Unit& u) const { return (const char*)Bt + (size_t)u.pn * 256 * K * 2; }
    __device__ __forceinline__ void epi(const f32x4 (&acc)[2][2][4][2], const Unit& u, int wr, int wc, int fr, int fq, int) const {
        const int row0 = u.pm * 256 + wr * 64 + fr, colt = u.pn * 256 + wc * 32 + 8 * fq;
#pragma unroll
        for (int ai = 0; ai < 2; ++ai)
#pragma unroll
            for (int m = 0; m < 4; ++m) { const size_t o = (size_t)(row0 + ai * HALF + m * 16) * DM + colt;
#pragma unroll
                for (int bj = 0; bj < 2; ++bj) { const f32x4 x0 = *(const f32x4*)(x + o + bj * HALF), x1 = *(const f32x4*)(x + o + bj * HALF + 4);
                    const f32x4 v0 = x0 + acc[ai][bj][m][0], v1 = x1 + acc[ai][bj][m][1];
                    st16(X1H + o + bj * HALF, pack8(v0, v1));
                    const f32x4 g0 = *(const f32x4*)(gffn + colt + bj * HALF), g1 = *(const f32x4*)(gffn + colt + bj * HALF + 4);
                    st8(X1Q + o + bj * HALF, pack8_fp8(v0 * g0, v1 * g1)); }
                if (m & 1) asm volatile("" ::: "memory"); }
    }
};
struct GroupTab { const LAS int* tab; __device__ __forceinline__ int cnt(int e) const { return tab[TAB_CNT + e]; } __device__ __forceinline__ int tstart(int e) const { return tab[TAB_TST + e]; }
    __device__ __forceinline__ int tile_e(int vt) const { return tab[TAB_TE + vt]; } __device__ __forceinline__ int NT() const { return tab[TAB_TST + 32]; } };
struct PolP6 : PolBase {
    static constexpr int K = 1024; static constexpr bool GATHER = true, FP8 = true, ROWTAB = true;
    const unsigned char* X1Q; const unsigned char* W1Q; const int* LIST; const float* RSTDS; const float* b1; unsigned char* ACTQ; GroupTab tb; int G, c; LAS unsigned char* rtab;
    __device__ __forceinline__ void tab_issue(const Unit& u, int buf) const {
        const int tid = threadIdx.x;
        if (tid < 256) { const int valid = tb.cnt(u.e) - u.mt * 256, rc = tid < valid ? tid : 0; const size_t o = (size_t)u.e * 32768 + u.mt * 256 + rc;
            const unsigned dst = (unsigned)__builtin_amdgcn_readfirstlane((int)((unsigned)(size_t)rtab + buf * RT_STRIDE + (tid & ~63) * 4));
            glds4_asm(LIST + o, dst); glds4_asm(RSTDS + o, dst + 1024u);
            glds4_asm(b1 + (size_t)u.e * 2048 + u.pn * 128 + (tid < 128 ? tid : 1024 + (tid - 128)), dst + 2048u); }
    }
    __device__ __forceinline__ bool next(int i, Unit& u) const { if (!static_unit((long)i * G + c, tb.NT(), 8, u.pm, u.pn)) return false; u.e = tb.tile_e(u.pm); u.mt = u.pm - tb.tstart(u.e); return true; }
    __device__ __forceinline__ const char* a_base(const Unit&) const { return (const char*)X1Q; }
    __device__ __forceinline__ const char* b_base(const Unit& u) const { return (const char*)W1Q + ((size_t)u.e * 2048 + (size_t)u.pn * 256) * K; }
    __device__ __forceinline__ void a_offsets(const Unit&, const int (&Rr)[2], const int (&Cc)[2], unsigned (&g)[2][2], int buf) const {
        const LAS int* lp = (const LAS int*)(rtab + buf * RT_STRIDE);
#pragma unroll
        for (int h = 0; h < 2; ++h)
#pragma unroll
            for (int i = 0; i < 2; ++i) { const int tok = lp[h * HALF + Rr[i]] >> 2; g[h][i] = (unsigned)tok * (unsigned)K + (unsigned)Cc[i] * 2u; }
    }
    __device__ __forceinline__ void epi(const f32x4 (&acc)[2][2][4][2], const Unit& u, int wr, int wc, int fr, int fq, int buf) const {
        int zero = 0; asm volatile("" : "+v"(zero)); fr += zero;
        const int valid = tb.cnt(u.e) - u.mt * 256, colg = u.pn * 128 + wc * 32 + 8 * fq;
        const LAS float* rp = (const LAS float*)(rtab + buf * RT_STRIDE + 1024); const LAS float* bp = (const LAS float*)(rtab + buf * RT_STRIDE + 2048) + wc * 32 + 8 * fq;
        const f32x4 bg0 = *(const LAS f32x4*)bp, bg1 = *(const LAS f32x4*)(bp + 4), bl0 = *(const LAS f32x4*)(bp + 128), bl1 = *(const LAS f32x4*)(bp + 132);
        float rsv[8];
#pragma unroll
        for (int i = 0; i < 8; ++i) rsv[i] = rp[(i >> 2) * HALF + wr * 64 + (i & 3) * 16 + fr];
#pragma unroll
        for (int i = 0; i < 8; ++i) { const int ai = i >> 2, m = i & 3, r = ai * HALF + wr * 64 + m * 16 + fr; const float rs = (r < valid) ? rsv[i] * WQ_INV : 0.f;
            f32x4 o[2];
#pragma unroll
            for (int n = 0; n < 2; ++n) { const f32x4 gv = acc[ai][0][m][n] * rs + (n ? bg1 : bg0), lv = acc[ai][1][m][n] * rs + (n ? bl1 : bl0);
                f32x4 gg, ll, d;
#pragma unroll
                for (int j = 0; j < 4; ++j) { gg[j] = fminf(gv[j], 7.0f); ll[j] = __builtin_amdgcn_fmed3f(lv[j], -7.0f, 7.0f); }
                const f32x4 e = gg * (-1.702f * 1.4426950408889634f);
#pragma unroll
                for (int j = 0; j < 4; ++j) d[j] = __builtin_amdgcn_exp2f(e[j]);
                d = d + 1.0f;
#pragma unroll
                for (int j = 0; j < 4; ++j) d[j] = __builtin_amdgcn_rcpf(d[j]);
                const f32x4 t = gg * d;
                o[n] = t * ll + t; }
            st8(ACTQ + (size_t)(u.pm * 256 + r) * DFF + colg, pack8_fp8(o[0], o[1])); }
    }
};
struct PolP7 : PolBase {
    static constexpr int K = 1024; static constexpr bool FP8 = true, GATHER = true;
    const unsigned char* ACTQ; const unsigned char* W2Q; const int* LIST; const float* TOPWS; const float* b2; bf16_t* YS; GroupTab tb; int G, c; LAS unsigned char* rtab;
    static constexpr bool ROWTAB = true;
    __device__ __forceinline__ void tab_issue(const Unit& u, int buf) const {
        const int tid = threadIdx.x;
        if (tid < 256) { const int valid = tb.cnt(u.e) - u.mt * 256, rc = tid < valid ? tid : 0; const size_t o = (size_t)u.e * 32768 + u.mt * 256 + rc;
            const unsigned dst = (unsigned)__builtin_amdgcn_readfirstlane((int)((unsigned)(size_t)rtab + buf * RT_STRIDE + (tid & ~63) * 4));
            glds4_asm(LIST + o, dst); glds4_asm(TOPWS + o, dst + 1024u);
            glds4_asm(b2 + (size_t)u.e * 1024 + u.pn * 256 + tid, dst + 2048u); }
    }
    __device__ __forceinline__ bool next(int i, Unit& u) const { if (!static_unit((long)i * G + c, tb.NT(), 4, u.pm, u.pn)) return false; u.e = tb.tile_e(u.pm); u.mt = u.pm - tb.tstart(u.e); return true; }
    __device__ __forceinline__ const char* a_base(const Unit&) const { return (const char*)ACTQ; }
    __device__ __forceinline__ void a_offsets(const Unit& u, const int (&Rr)[2], const int (&Cc)[2], unsigned (&g)[2][2], int) const {
#pragma unroll
        for (int h = 0; h < 2; ++h)
#pragma unroll
            for (int i = 0; i < 2; ++i) g[h][i] = (unsigned)(u.pm * 256 + h * HALF + Rr[i]) * (unsigned)K + (unsigned)Cc[i] * 2u;
    }
    __device__ __forceinline__ const char* b_base(const Unit& u) const { return (const char*)W2Q + ((size_t)u.e * 1024 + (size_t)u.pn * 256) * K; }
    __device__ __forceinline__ void epi(const f32x4 (&acc)[2][2][4][2], const Unit& u, int wr, int wc, int fr, int fq, int buf) const {
        int zero = 0; asm volatile("" : "+v"(zero)); fr += zero;
        const int valid = tb.cnt(u.e) - u.mt * 256, colt = u.pn * 256 + wc * 32 + 8 * fq;
        const LAS float* bp = (const LAS float*)(rtab + buf * RT_STRIDE + 2048) + wc * 32 + 8 * fq; const LAS int* lp = (const LAS int*)(rtab + buf * RT_STRIDE); const LAS float* wp = (const LAS float*)(rtab + buf * RT_STRIDE + 1024);
        int slot[8]; float wv[8];
#pragma unroll
        for (int i = 0; i < 8; ++i) { const int r = (i >> 2) * HALF + wr * 64 + (i & 3) * 16 + fr; const bool ok = r < valid; const int rc = ok ? r : 0; const int sl = lp[rc]; wv[i] = wp[rc]; slot[i] = ok ? sl : -1; }
        f32x4 bv[2][2];
#pragma unroll
        for (int bj = 0; bj < 2; ++bj) { bv[bj][0] = *(const LAS f32x4*)(bp + bj * HALF); bv[bj][1] = *(const LAS f32x4*)(bp + bj * HALF + 4); }
#pragma unroll
        for (int i = 0; i < 8; ++i) { const int ai = i >> 2, m = i & 3;
            if (slot[i] >= 0) { const float w = wv[i] * YQ_SCALE, wq = w * WQ_INV;
#pragma unroll
                for (int bj = 0; bj < 2; ++bj) st8((unsigned char*)YS + (size_t)slot[i] * DM + colt + bj * HALF, pack8_fp8(acc[ai][bj][m][0] * wq + bv[bj][0] * w, acc[ai][bj][m][1] * wq + bv[bj][1] * w)); } }
    }
};
}

__device__ __forceinline__ void grouped_setup(LAS int* tab, const unsigned* cnt) {
    const int tid = threadIdx.x;
    if (tid < 32) tab[TAB_CNT + tid] = (int)__hip_atomic_load(cnt + tid, __ATOMIC_RELAXED, __HIP_MEMORY_SCOPE_AGENT);
    __syncthreads();
    if (tid == 0) { int s = 0; for (int e = 0; e < 32; ++e) { tab[TAB_TST + e] = s; s += (tab[TAB_CNT + e] + 255) >> 8; } tab[TAB_TST + 32] = s; }
    __syncthreads();
    const int NT = tab[TAB_TST + 32];
    for (int vt = tid; vt < NT; vt += NWAVES * 64) { int e = 0; for (int k = 1; k < 32; ++k) if (tab[TAB_TST + k] <= vt) e = k; tab[TAB_TE + vt] = e; }
    __syncthreads();
}

__device__ __forceinline__ void lds_fence() { asm volatile("s_waitcnt lgkmcnt(0)" ::: "memory"); }
template <int MAPK> __device__ __forceinline__ int p0_map(int n) {
    if (MAPK == 1) return (n >= 1024 && n < 2048) ? (n & ~255) + 128 * ((n >> 5) & 1) + 32 * ((n >> 6) & 3) + (n & 31) : n;
    if (MAPK == 2) { const int m = n & 1023; return (m >> 7) * 256 + (n >> 10) * 128 + (m & 127); }
    return n;
}
template <int MAPK, bool Q8 = false> __device__ __forceinline__ void p0_transpose_item(const float* W, int N, bf16_t* WT, int ldo, int koff, const float* gk, LAS float* scr, int item, int lane, int nblk_ = 0) {
    const int nblk = nblk_ ? nblk_ : N / 32, kb = item / nblk, nb = item % nblk, k0 = 64 * kb, n0 = 32 * nb;
    float tv[32];
#pragma unroll
    for (int i = 0; i < 32; ++i) tv[i] = __builtin_nontemporal_load(W + (size_t)(k0 + 2 * i + (lane >> 5)) * N + n0 + (lane & 31));
    if (gk) {
#pragma unroll
        for (int i = 0; i < 32; ++i) tv[i] *= gk[k0 + 2 * i + (lane >> 5)];
    }
#pragma unroll
    for (int i = 0; i < 32; ++i) scr[(2 * i + (lane >> 5)) * 33 + (lane & 31)] = tv[i];
    lds_fence();
    const int c8 = lane & 7;
#pragma unroll
    for (int j = 0; j < 4; ++j) { const int n = (lane >> 3) + 8 * j; const LAS float* s = scr + (8 * c8) * 33 + n;
        if constexpr (Q8) {
            const f32x4 a = (f32x4){s[0 * 33], s[1 * 33], s[2 * 33], s[3 * 33]} * pg::WQ_SCALE, b = (f32x4){s[4 * 33], s[5 * 33], s[6 * 33], s[7 * 33]} * pg::WQ_SCALE;
            *(uint2*)((unsigned char*)WT + (size_t)p0_map<MAPK>(n0 + n) * ldo + koff + k0 + 8 * c8) = pg::pack8_fp8(a, b);
        } else {
        u32x4 o; o.x = pg::cvt_pk_bf16(s[0 * 33], s[1 * 33]); o.y = pg::cvt_pk_bf16(s[2 * 33], s[3 * 33]); o.z = pg::cvt_pk_bf16(s[4 * 33], s[5 * 33]); o.w = pg::cvt_pk_bf16(s[6 * 33], s[7 * 33]);
        *(u32x4*)(WT + (size_t)p0_map<MAPK>(n0 + n) * ldo + koff + k0 + 8 * c8) = o; } }
    lds_fence();
}
__device__ __forceinline__ void p0_rmsnorm_row(const float* xrow, const float* g, bf16_t* orow, int lane) {
    const f32x4* xr = (const f32x4*)xrow;
    f32x4 v[4]; float s = 0.f;
#pragma unroll
    for (int j = 0; j < 4; ++j) { v[j] = xr[lane + 64 * j]; s += (v[j].x * v[j].x + v[j].y * v[j].y) + (v[j].z * v[j].z + v[j].w * v[j].w); }
    const float rstd = rsqrtf(wave_sum(s) * (1.0f / DM) + EPS);
#pragma unroll
    for (int j = 0; j < 4; ++j) { const f32x4 gv = ((const f32x4*)g)[lane + 64 * j];
        unsigned long long o = (unsigned long long)pg::cvt_pk_bf16(v[j].x * rstd * gv.x, v[j].y * rstd * gv.y) | ((unsigned long long)pg::cvt_pk_bf16(v[j].z * rstd * gv.z, v[j].w * rstd * gv.w) << 32);
        ((unsigned long long*)orow)[lane + 64 * j] = o; }
}
struct P0Args { const float *x, *mem, *g_mix, *g_mem, *w_in, *w_br0, *w_br1, *w_br2, *w_out, *w_mem_kv, *w_gate_up, *w_down, *g_ffn, *w_router, *w_spatial;
    bf16_t *HB, *MEMN, *WinT, *WbrT, *WoutT, *WmemT, *W1T, *W2T, *WSB; float* WrT; unsigned char *HBQ, *WINQ; };
__device__ __forceinline__ void p0_prologue(const P0Args a, LAS unsigned char* lds, int G, int c) {
    const int tid = threadIdx.x, lane = tid & 63, wave = __builtin_amdgcn_readfirstlane(tid >> 6);
    LAS float* scr = (LAS float*)(lds + wave * 16384);
    const int gw = c * NWAVES + wave, NGW = G * NWAVES;
    constexpr int I_IN = 16 * 64, I_G = 16 * 192, I_BR = 8 * 32, I_O = 16 * 32, I_1 = 16 * 64, I_2 = 16 * 32;
    constexpr int NITEMS = I_IN + I_G + 3 * I_BR + 2 * I_O;
    for (int it = gw; it < NITEMS; it += NGW) {
        int r = it;
        if (r < I_IN) { p0_transpose_item<1>(a.w_in, INW, a.WinT, DM, 0, nullptr, scr, r, lane, 64); continue; } r -= I_IN;
        if (r < I_G) { p0_transpose_item<0, true>(a.w_in, INW, (bf16_t*)a.WINQ, DM, 0, nullptr, scr, r, lane); continue; } r -= I_G;
        if (r < 3 * I_BR) { const int br = r / I_BR; const float* wsrc = (br == 0) ? a.w_br0 : (br == 1) ? a.w_br1 : a.w_br2; p0_transpose_item<0>(wsrc, DM, a.WbrT, 1536, br * 512, nullptr, scr, r - br * I_BR, lane); continue; } r -= 3 * I_BR;
        if (r < I_O) { p0_transpose_item<0>(a.w_out, DM, a.WoutT, DM, 0, nullptr, scr, r, lane); continue; } r -= I_O;
        p0_transpose_item<0>(a.w_mem_kv, DM, a.WmemT, DM, 0, nullptr, scr, r, lane);
    }
    for (int m = gw; m < T_TOK; m += 2 * NGW) {
        const int m2 = (m + NGW < T_TOK) ? m + NGW : m;
        const f32x4* xa = (const f32x4*)(a.x + (size_t)m * DM); const f32x4* xb = (const f32x4*)(a.x + (size_t)m2 * DM);
        f32x4 va[4], vb[4]; float sa = 0.f, sb = 0.f;
#pragma unroll
        for (int j = 0; j < 4; ++j) { va[j] = __builtin_nontemporal_load(xa + lane + 64 * j); vb[j] = __builtin_nontemporal_load(xb + lane + 64 * j); }
#pragma unroll
        for (int j = 0; j < 4; ++j) { sa += (va[j].x * va[j].x + va[j].y * va[j].y) + (va[j].z * va[j].z + va[j].w * va[j].w); sb += (vb[j].x * vb[j].x + vb[j].y * vb[j].y) + (vb[j].z * vb[j].z + vb[j].w * vb[j].w); }
        const float ra = rsqrtf(wave_sum(sa) * (1.0f / DM) + EPS), rb = rsqrtf(wave_sum(sb) * (1.0f / DM) + EPS);
#pragma unroll
        for (int j = 0; j < 4; ++j) { const f32x4 gv = ((const f32x4*)a.g_mix)[lane + 64 * j];
            ((unsigned long long*)(a.HB + (size_t)m * DM))[lane + 64 * j] = (unsigned long long)pg::cvt_pk_bf16(va[j].x * ra * gv.x, va[j].y * ra * gv.y) | ((unsigned long long)pg::cvt_pk_bf16(va[j].z * ra * gv.z, va[j].w * ra * gv.w) << 32);
            ((unsigned long long*)(a.HB + (size_t)m2 * DM))[lane + 64 * j] = (unsigned long long)pg::cvt_pk_bf16(vb[j].x * rb * gv.x, vb[j].y * rb * gv.y) | ((unsigned long long)pg::cvt_pk_bf16(vb[j].z * rb * gv.z, vb[j].w * rb * gv.w) << 32);
            { int qa = 0, qb = 0; qa = __builtin_amdgcn_cvt_pk_fp8_f32(va[j].x * ra * gv.x, va[j].y * ra * gv.y, qa, false); qa = __builtin_amdgcn_cvt_pk_fp8_f32(va[j].z * ra * gv.z, va[j].w * ra * gv.w, qa, true);
              qb = __builtin_amdgcn_cvt_pk_fp8_f32(vb[j].x * rb * gv.x, vb[j].y * rb * gv.y, qb, false); qb = __builtin_amdgcn_cvt_pk_fp8_f32(vb[j].z * rb * gv.z, vb[j].w * rb * gv.w, qb, true);
              ((int*)(a.HBQ + (size_t)m * DM))[lane + 64 * j] = qa; ((int*)(a.HBQ + (size_t)m2 * DM))[lane + 64 * j] = qb; } }
    }
    for (int m = gw; m < NBATCH * MEML; m += NGW) p0_rmsnorm_row(a.mem + (size_t)m * DM, a.g_mem, a.MEMN + (size_t)m * DM, lane);
    const int gt = c * NWAVES * 64 + tid, NGT = G * NWAVES * 64;
    for (int i = gt; i < 32 * 1024; i += NGT) { const int e = i >> 10, k = i & 1023; const float w = a.w_router[k * 32 + e] * a.g_ffn[k]; a.WrT[i] = w;
        bf16_t* pl = (bf16_t*)(a.WrT + 32 * 1024); const bf16_t hi = f2bf(w); pl[i] = hi; pl[32 * 1024 + i] = f2bf(w - __uint_as_float((unsigned)hi << 16)); }
    for (int i = gt; i < 4 * 128 * 128; i += NGT) { const int s = i & 127, t = (i >> 7) & 127; a.WSB[i] = (s <= t) ? f2bf(a.w_spatial[i]) : (bf16_t)0; }
}
__device__ __forceinline__ void p1_memkv(const bf16_t* MEMN, const bf16_t* WmemT, const float* gk, bf16_t* MKV, int G, int c, LAS unsigned char* lds) {
    int tid_ = threadIdx.x; asm volatile("" : "+v"(tid_));
    const int tid = tid_, lane = tid & 63, wave = __builtin_amdgcn_readfirstlane(tid >> 6), fr = lane & 15, fq = lane >> 4;
    constexpr int LDB = 72;
    for (int unit = c; unit < 128; unit += G) {
        const int rt = unit >> 3, ct = unit & 7;
        f32x4 acc[8];
#pragma unroll
        for (int j = 0; j < 8; ++j) acc[j] = (f32x4){0.f, 0.f, 0.f, 0.f};
        const bf16_t* ap = MEMN + (size_t)(rt * 128 + wave * 16 + fr) * DM + fq * 8;
        const bf16_t* bsrc = WmemT + (size_t)(ct * 128 + (tid >> 3)) * DM + (tid & 7) * 8;
        const int bdst = ((tid >> 3) * LDB + (tid & 7) * 8) * 2;
        u32x4 r0 = *(const u32x4*)bsrc, r1 = *(const u32x4*)(bsrc + (size_t)64 * DM);
        bf16x8 afn[2] = {*(const bf16x8*)ap, *(const bf16x8*)(ap + 32)};
        __syncthreads();
        *(LAS u32x4*)(lds + bdst) = r0; *(LAS u32x4*)(lds + bdst + 64 * LDB * 2) = r1;
        __syncthreads();
#pragma nounroll
        for (int kc = 0; kc < 16; ++kc) {
            const int buf = (kc & 1) * (128 * LDB * 2);
            const bf16x8 afc[2] = {afn[0], afn[1]};
            if (kc + 1 < 16) { r0 = *(const u32x4*)(bsrc + (kc + 1) * 64); r1 = *(const u32x4*)(bsrc + (size_t)64 * DM + (kc + 1) * 64); afn[0] = *(const bf16x8*)(ap + (kc + 1) * 64); afn[1] = *(const bf16x8*)(ap + (kc + 1) * 64 + 32); }
#pragma unroll
            for (int ks = 0; ks < 2; ++ks) { const bf16x8 af = afc[ks];
#pragma unroll
                for (int j = 0; j < 8; ++j) { const bf16x8 bf = *(const LAS bf16x8*)(lds + buf + ((16 * j + fr) * LDB + ks * 32 + fq * 8) * 2); acc[j] = __builtin_amdgcn_mfma_f32_16x16x32_bf16(af, bf, acc[j], 0, 0, 0); } }
            if (kc + 1 < 16) { *(LAS u32x4*)(lds + (buf ^ (128 * LDB * 2)) + bdst) = r0; *(LAS u32x4*)(lds + (buf ^ (128 * LDB * 2)) + bdst + 64 * LDB * 2) = r1; }
            __syncthreads();
        }
        float rstd[4] = {1.f, 1.f, 1.f, 1.f};
        if (ct < 4) {
#pragma unroll
            for (int r = 0; r < 4; ++r) { float ss = 0.f;
#pragma unroll
                for (int j = 0; j < 8; ++j) ss += acc[j][r] * acc[j][r];
                ss += __shfl_xor(ss, 1); ss += __shfl_xor(ss, 2); ss += __shfl_xor(ss, 4); ss += __shfl_xor(ss, 8);
                rstd[r] = rsqrtf(ss * (1.0f / 128.0f) + EPS); }
        }
#pragma unroll
        for (int j = 0; j < 8; ++j) { const float gg = (ct < 4) ? gk[16 * j + fr] : 1.0f;
#pragma unroll
            for (int r = 0; r < 4; ++r) MKV[(size_t)(rt * 128 + wave * 16 + fq * 4 + r) * 1024 + ct * 128 + 16 * j + fr] = f2bf(acc[j][r] * rstd[r] * gg); }
    }
}
__device__ __forceinline__ void p5_router(const bf16_t* X1, const float* WrT, const float* br, int* LIST, float* RSTDS, float* TOPWS, unsigned* cnt, int G, int c, LAS unsigned char* lds) {
    const int tid = threadIdx.x, lane = tid & 63, wave = __builtin_amdgcn_readfirstlane(tid >> 6), r = lane & 15, qd = lane >> 4;
    LAS unsigned* lcnt = (LAS unsigned*)(lds + RING_BYTES + 2048);
    { const bf16_t* pl = (const bf16_t*)(WrT + 32 * 1024);
#pragma unroll 4
      for (int j = 0; j < 16; ++j) { const int g = tid + 512 * j, p = g >> 12, e = (g >> 7) & 31, ch = g & 127;
          *(LAS u32x4*)(lds + p * 65536 + e * 2048 + ((ch ^ (e & 15)) << 4)) = *(const u32x4*)(pl + (size_t)g * 8); } }
    for (int gbase = c * NWAVES; gbase < T_TOK / 16; gbase += G * NWAVES) {
        const int t0 = (gbase + wave) * 16;
        if (tid < 32) lcnt[tid] = 0u;
        __syncthreads();
        const bf16_t* xp = X1 + (size_t)(t0 + r) * DM + 8 * qd;
        f32x4 acc0 = (f32x4){0.f, 0.f, 0.f, 0.f}, acc1 = acc0; float ss = 0.f;
#pragma unroll
        for (int hf = 0; hf < 2; ++hf) {
            u32x4 xa[16];
#pragma unroll
            for (int i = 0; i < 16; ++i) xa[i] = *(const u32x4*)(xp + 32 * (16 * hf + i));
#pragma unroll
            for (int i = 0; i < 16; ++i) { const int it = 16 * hf + i;
                f32x4 a0, a1; pg::unpack8(xa[i], a0, a1);
                ss += (a0[0] * a0[0] + a0[1] * a0[1]) + (a0[2] * a0[2] + a0[3] * a0[3]) + (a1[0] * a1[0] + a1[1] * a1[1]) + (a1[2] * a1[2] + a1[3] * a1[3]);
                const int off = r * 2048 + (((4 * it + qd) ^ r) << 4);
#pragma unroll
                for (int p = 1; p >= 0; --p) { const bf16x8 b0 = *(const LAS bf16x8*)(lds + p * 65536 + off), b1 = *(const LAS bf16x8*)(lds + p * 65536 + 16 * 2048 + off);
                    acc0 = __builtin_amdgcn_mfma_f32_16x16x32_bf16(__builtin_bit_cast(bf16x8, xa[i]), b0, acc0, 0, 0, 0); acc1 = __builtin_amdgcn_mfma_f32_16x16x32_bf16(__builtin_bit_cast(bf16x8, xa[i]), b1, acc1, 0, 0, 0); }
            }
        }
        ss += __shfl_xor(ss, 16); ss += __shfl_xor(ss, 32);
        const float rstd_r = rsqrtf(ss * (1.0f / DM) + EPS);
        const float bias0 = br[r], bias1 = br[16 + r];
        float rs[4], l0[4], l1[4];
#pragma unroll
        for (int g = 0; g < 4; ++g) { rs[g] = __shfl(rstd_r, 4 * qd + g); l0[g] = acc0[g] * rs[g] + bias0; l1[g] = acc1[g] * rs[g] + bias1; }
        float sv[4][4]; int se[4][4];
#pragma unroll
        for (int rank = 0; rank < 4; ++rank)
#pragma unroll
            for (int g = 0; g < 4; ++g) {
                float v = l0[g]; int ix = r; if (l1[g] > v) { v = l1[g]; ix = r + 16; }
#pragma unroll
                for (int o = 1; o < 16; o <<= 1) { const float ov = __shfl_xor(v, o); const int oi = __shfl_xor(ix, o); if (ov > v || (ov == v && oi < ix)) { v = ov; ix = oi; } }
                sv[rank][g] = v; se[rank][g] = ix;
                if (ix == r) l0[g] = -INFINITY; if (ix == r + 16) l1[g] = -INFINITY;
            }
        float wgt[4]; int mye[4]; unsigned lp[4];
        if (r < 4) {
#pragma unroll
            for (int g = 0; g < 4; ++g) {
                const float den = 1.0f + __expf(sv[1][g] - sv[0][g]) + __expf(sv[2][g] - sv[0][g]) + __expf(sv[3][g] - sv[0][g]);
                const float myv = (r == 0) ? sv[0][g] : (r == 1) ? sv[1][g] : (r == 2) ? sv[2][g] : sv[3][g];
                mye[g] = (r == 0) ? se[0][g] : (r == 1) ? se[1][g] : (r == 2) ? se[2][g] : se[3][g];
                wgt[g] = __expf(myv - sv[0][g]) / den;
                lp[g] = __hip_atomic_fetch_add(lcnt + mye[g], 1u, __ATOMIC_RELAXED, __HIP_MEMORY_SCOPE_WORKGROUP);
            }
        }
        __syncthreads();
        if (tid < 32) lcnt[32 + tid] = atomicAdd(cnt + tid, lcnt[tid]);
        __syncthreads();
        if (r < 4) {
#pragma unroll
            for (int g = 0; g < 4; ++g) { const unsigned pos = lcnt[32 + mye[g]] + lp[g]; const int t = t0 + 4 * qd + g;
                LIST[mye[g] * 32768 + pos] = t * 4 + r; RSTDS[mye[g] * 32768 + pos] = rs[g]; TOPWS[mye[g] * 32768 + pos] = wgt[g]; }
        }
        __syncthreads();
    }
}
__device__ __forceinline__ void p8_combine(float* out, const bf16_t* X1H, const bf16_t* YS, int G, int c, float dscale) {
    typedef float f32x2v __attribute__((ext_vector_type(2)));
    const unsigned char* YQ = (const unsigned char*)YS;
    const size_t gt = (size_t)c * NWAVES * 64 + threadIdx.x, NGT = (size_t)G * NWAVES * 64;
    for (size_t i = gt; i < (size_t)T_TOK * DM / 8; i += NGT) {
        const size_t t = i >> 7, c8 = (i & 127) * 8;
        f32x4 o0, o1; pg::unpack8(*(const u32x4*)(X1H + t * DM + c8), o0, o1);
        if (dscale < 0.f) { o0 = *(const f32x4*)(out + t * DM + c8); o1 = *(const f32x4*)(out + t * DM + c8 + 4); }
        f32x4 s0 = (f32x4){0.f, 0.f, 0.f, 0.f}, s1 = s0;
#pragma unroll
        for (int k = 0; k < 4; ++k) { typedef unsigned u32x2v __attribute__((ext_vector_type(2))); const u32x2v w = __builtin_nontemporal_load((const u32x2v*)(YQ + (t * 4 + k) * DM + c8));
            const f32x2v a0 = __builtin_amdgcn_cvt_pk_f32_fp8((int)w.x, false), a1 = __builtin_amdgcn_cvt_pk_f32_fp8((int)w.x, true), b0 = __builtin_amdgcn_cvt_pk_f32_fp8((int)w.y, false), b1 = __builtin_amdgcn_cvt_pk_f32_fp8((int)w.y, true);
            s0 += (f32x4){a0[0], a0[1], a1[0], a1[1]}; s1 += (f32x4){b0[0], b0[1], b1[0], b1[1]}; }
        s0 = s0 * pg::YQ_INV; s1 = s1 * pg::YQ_INV;
        if (dscale < 0.f) { o0 = (o0 - s0) + s0; o1 = (o1 - s1) + s1; } else { o0 = (o0 + s0) * dscale; o1 = (o1 + s1) * dscale; }
        *(f32x4*)(out + t * DM + c8) = o0; *(f32x4*)(out + t * DM + c8 + 4) = o1;
    }
}


struct ConvJob { const float* w1; const float* w2; const float* gf; unsigned char* W1Q; unsigned char* W2Q; LAS float* scr; int item, end, stride; };
constexpr int CV_W1 = NEXP * 32 * 64, CV_W2 = NEXP * 32 * 32, CV_TOTAL = CV_W1 + CV_W2;
__device__ __forceinline__ void conv_issue(const ConvJob& J, float (&tv)[16], int lane) {
    const int h = J.item; const float* src; int N;
    if (h < CV_W1) { const int e = h >> 11, rem = h & 2047, kb = rem >> 6, nb = rem & 63; N = 2048; src = J.w1 + (size_t)e * DM * 2048 + (size_t)(32 * kb) * 2048 + 32 * nb; }
    else { const int h2 = h - CV_W1, e = h2 >> 10, rem = h2 & 1023, kb = rem >> 5, nb = rem & 31; N = 1024; src = J.w2 + (size_t)e * DFF * DM + (size_t)(32 * kb) * 1024 + 32 * nb; }
    src += (size_t)(16 * (lane >> 5)) * N + (lane & 31);
#pragma unroll
    for (int i = 0; i < 16; ++i) tv[i] = __builtin_nontemporal_load(src + (size_t)i * N);
}
__device__ __forceinline__ void conv_finish(ConvJob& J, const float (&tv)[16], int lane) {
    const int h = J.item; const bool is1 = h < CV_W1;
    int e, kb, nb; if (is1) { e = h >> 11; const int rem = h & 2047; kb = rem >> 6; nb = rem & 63; } else { const int h2 = h - CV_W1; e = h2 >> 10; const int rem = h2 & 1023; kb = rem >> 5; nb = rem & 31; }
    const int n = lane & 31, kh = lane >> 5;
    const f32x4 a = (f32x4){tv[0], tv[1], tv[2], tv[3]} * pg::WQ_SCALE, b = (f32x4){tv[4], tv[5], tv[6], tv[7]} * pg::WQ_SCALE;
    const f32x4 c = (f32x4){tv[8], tv[9], tv[10], tv[11]} * pg::WQ_SCALE, d = (f32x4){tv[12], tv[13], tv[14], tv[15]} * pg::WQ_SCALE;
    const uint2 lo = pg::pack8_fp8(a, b), hi2 = pg::pack8_fp8(c, d);
    const int ncol = 32 * nb + n;
    unsigned char* dst = is1 ? J.W1Q + ((size_t)e * 2048 + p0_map<2>(ncol)) * DM + 32 * kb + 16 * kh : J.W2Q + ((size_t)e * 1024 + ncol) * DFF + 32 * kb + 16 * kh;
    *(u32x4*)dst = (u32x4){lo.x, lo.y, hi2.x, hi2.y};
    asm volatile("s_waitcnt lgkmcnt(0)" ::: "memory");
    J.item += J.stride;
}
namespace at {
typedef __attribute__((address_space(3))) const char* lds_cptr;
typedef short s16x4 __attribute__((ext_vector_type(4)));
typedef float f32x16 __attribute__((ext_vector_type(16)));
__device__ __forceinline__ int crow(int r, int hi) { return (r & 3) + 8 * (r >> 2) + 4 * hi; }
__device__ __forceinline__ s16x4 vtr(lds_cptr p) { return __builtin_bit_cast(s16x4, __builtin_amdgcn_ds_read_tr16_b64_v4i16((__attribute__((address_space(3))) s16x4*)p)); }
template <int ND0> __device__ __forceinline__ void qk_step(f32x16& p0, f32x16& p1, lds_cptr kb, int kch2, const bf16x8 (&qr)[ND0]) {
#pragma unroll
    for (int d0 = 0; d0 < ND0; ++d0) {
        const bf16x8 b0 = *(const __attribute__((address_space(3))) bf16x8*)(kb + d0 * kch2);
        const bf16x8 b1 = *(const __attribute__((address_space(3))) bf16x8*)(kb + d0 * kch2 + 512);
        p0 = __builtin_amdgcn_mfma_f32_32x32x16_bf16(b0, qr[d0], p0, 0, 0, 0);
        p1 = __builtin_amdgcn_mfma_f32_32x32x16_bf16(b1, qr[d0], p1, 0, 0, 0);
        if ((d0 & 1) == 1) __builtin_amdgcn_sched_barrier(0);
    }
}
template <int NDB> __device__ __forceinline__ void softmax_step(f32x16& s0, f32x16& s1, float& m, float& l, f32x16 (&o)[NDB], LAS float* wsf, int r32, int hi, u32x4 (&pw)[4]) {
    float tm = fmaxf(s0[0], s1[0]);
#pragma unroll
    for (int r = 1; r < 16; ++r) tm = fmaxf(tm, fmaxf(s0[r], s1[r]));
    tm = fmaxf(tm, __shfl_xor(tm, 32));
    const float mn = fmaxf(m, tm);
    if (__any(mn > m)) {
        const float alpha = __builtin_amdgcn_exp2f(m - mn);
        l *= alpha; m = mn;
        if (hi == 0) wsf[r32] = alpha;
        asm volatile("s_waitcnt lgkmcnt(0)" ::: "memory");
#pragma unroll
        for (int r = 0; r < 16; ++r) { const float f = wsf[crow(r, hi)];
#pragma unroll
            for (int db = 0; db < NDB; ++db) o[db][r] *= f; }
    }
    float sum = 0.f;
#pragma unroll
    for (int r = 0; r < 16; ++r) { s0[r] = __builtin_amdgcn_exp2f(s0[r] - m); s1[r] = __builtin_amdgcn_exp2f(s1[r] - m); sum += s0[r] + s1[r]; }
    l += sum;
    pw[0] = (u32x4){pg::cvt_pk_bf16(s0[0], s0[1]), pg::cvt_pk_bf16(s0[2], s0[3]), pg::cvt_pk_bf16(s0[4], s0[5]), pg::cvt_pk_bf16(s0[6], s0[7])};
    pw[1] = (u32x4){pg::cvt_pk_bf16(s0[8], s0[9]), pg::cvt_pk_bf16(s0[10], s0[11]), pg::cvt_pk_bf16(s0[12], s0[13]), pg::cvt_pk_bf16(s0[14], s0[15])};
    pw[2] = (u32x4){pg::cvt_pk_bf16(s1[0], s1[1]), pg::cvt_pk_bf16(s1[2], s1[3]), pg::cvt_pk_bf16(s1[4], s1[5]), pg::cvt_pk_bf16(s1[6], s1[7])};
    pw[3] = (u32x4){pg::cvt_pk_bf16(s1[8], s1[9]), pg::cvt_pk_bf16(s1[10], s1[11]), pg::cvt_pk_bf16(s1[12], s1[13]), pg::cvt_pk_bf16(s1[14], s1[15])};
}
template <int NDB> __device__ __forceinline__ void softmax_rel_a(f32x16& s0, f32x16& s1, float& m, float& l, f32x16 (&o)[NDB], LAS float* wsf, int r32, int hi) {
    constexpr float THR = 4.0f;
#define AT_MX3(a, b, c) __builtin_fmaxf(__builtin_fmaxf((a), (b)), (c))
    float ta = AT_MX3(s0[0], s0[1], s1[0]), tb = AT_MX3(s0[2], s0[3], s1[1]); ta = AT_MX3(ta, s1[2], s1[3]);
#pragma unroll
    for (int r = 4; r < 16; r += 4) { ta = AT_MX3(ta, s0[r], s0[r + 1]); tb = AT_MX3(tb, s0[r + 2], s0[r + 3]); ta = AT_MX3(ta, s1[r], s1[r + 1]); tb = AT_MX3(tb, s1[r + 2], s1[r + 3]); }
    float rm = __builtin_fmaxf(ta, tb);
    { const auto rr = __builtin_amdgcn_permlane32_swap(__float_as_uint(rm), __float_as_uint(rm), false, false); rm = __builtin_fmaxf(__uint_as_float(rr[0]), __uint_as_float(rr[1])); }
#undef AT_MX3
    if (__any(rm > THR)) {
        const float dl = rm > THR ? rm : 0.f;
        m += dl;
#pragma unroll
        for (int r = 0; r < 16; ++r) { s0[r] -= dl; s1[r] -= dl; }
        const float f = __builtin_amdgcn_exp2f(-dl);
        l *= f;
        if (hi == 0) wsf[r32] = f;
        asm volatile("s_waitcnt lgkmcnt(0)" ::: "memory");
#pragma unroll
        for (int r = 0; r < 16; ++r) { const float g = wsf[crow(r, hi)];
#pragma unroll
            for (int db = 0; db < NDB; ++db) o[db][r] *= g; }
    }
}
template <int NDB> __device__ __forceinline__ void softmax_rel(f32x16& s0, f32x16& s1, float& m, float& l, f32x16 (&o)[NDB], LAS float* wsf, int r32, int hi, u32x4 (&pw)[4]) {
    constexpr float THR = 4.0f;
#define AT_MX3(a, b, c) __builtin_fmaxf(__builtin_fmaxf((a), (b)), (c))
    float ta = AT_MX3(s0[0], s0[1], s1[0]), tb = AT_MX3(s0[2], s0[3], s1[1]); ta = AT_MX3(ta, s1[2], s1[3]);
#pragma unroll
    for (int r = 4; r < 16; r += 4) { ta = AT_MX3(ta, s0[r], s0[r + 1]); tb = AT_MX3(tb, s0[r + 2], s0[r + 3]); ta = AT_MX3(ta, s1[r], s1[r + 1]); tb = AT_MX3(tb, s1[r + 2], s1[r + 3]); }
    float rm = __builtin_fmaxf(ta, tb);
    { const auto rr = __builtin_amdgcn_permlane32_swap(__float_as_uint(rm), __float_as_uint(rm), false, false); rm = __builtin_fmaxf(__uint_as_float(rr[0]), __uint_as_float(rr[1])); }
#undef AT_MX3
    if (__any(rm > THR)) {
        const float dl = rm > THR ? rm : 0.f;
        m += dl;
#pragma unroll
        for (int r = 0; r < 16; ++r) { s0[r] -= dl; s1[r] -= dl; }
        const float f = __builtin_amdgcn_exp2f(-dl);
        l *= f;
        if (hi == 0) wsf[r32] = f;
        asm volatile("s_waitcnt lgkmcnt(0)" ::: "memory");
#pragma unroll
        for (int r = 0; r < 16; ++r) { const float g = wsf[crow(r, hi)];
#pragma unroll
            for (int db = 0; db < NDB; ++db) o[db][r] *= g; }
    }
    float sa = 0.f, sb = 0.f;
#pragma unroll
    for (int r = 0; r < 16; ++r) { s0[r] = __builtin_amdgcn_exp2f(s0[r]); s1[r] = __builtin_amdgcn_exp2f(s1[r]); sa += s0[r]; sb += s1[r]; }
    l += sa + sb;
    pw[0] = (u32x4){pg::cvt_pk_bf16(s0[0], s0[1]), pg::cvt_pk_bf16(s0[2], s0[3]), pg::cvt_pk_bf16(s0[4], s0[5]), pg::cvt_pk_bf16(s0[6], s0[7])};
    pw[1] = (u32x4){pg::cvt_pk_bf16(s0[8], s0[9]), pg::cvt_pk_bf16(s0[10], s0[11]), pg::cvt_pk_bf16(s0[12], s0[13]), pg::cvt_pk_bf16(s0[14], s0[15])};
    pw[2] = (u32x4){pg::cvt_pk_bf16(s1[0], s1[1]), pg::cvt_pk_bf16(s1[2], s1[3]), pg::cvt_pk_bf16(s1[4], s1[5]), pg::cvt_pk_bf16(s1[6], s1[7])};
    pw[3] = (u32x4){pg::cvt_pk_bf16(s1[8], s1[9]), pg::cvt_pk_bf16(s1[10], s1[11]), pg::cvt_pk_bf16(s1[12], s1[13]), pg::cvt_pk_bf16(s1[14], s1[15])};
}
template <int NDB> __device__ __forceinline__ void pv_step(f32x16 (&o)[NDB], const u32x4 (&pw)[4], lds_cptr vb, int vdb_stride) {
#pragma unroll
    for (int db = 0; db < NDB; ++db)
#pragma unroll
        for (int ks = 0; ks < 4; ++ks) {
            const s16x4 lo = vtr(vb + db * vdb_stride + ks * 1024), hh = vtr(vb + db * vdb_stride + ks * 1024 + 512);
            const bf16x8 vf = (bf16x8){lo[0], lo[1], lo[2], lo[3], hh[0], hh[1], hh[2], hh[3]};
            o[db] = __builtin_amdgcn_mfma_f32_32x32x16_bf16(__builtin_bit_cast(bf16x8, pw[ks]), vf, o[db], 0, 0, 0);
            if (ks == 3) __builtin_amdgcn_sched_barrier(0);
        }
}
__device__ __forceinline__ void exp_pv(f32x16& s0, f32x16& s1, float& l, f32x16 (&o)[2], lds_cptr vb) {
    s16x4 vl[2][4], vh[2][4];
#pragma unroll
    for (int db = 0; db < 2; ++db)
#pragma unroll
        for (int ks = 0; ks < 4; ++ks) { vl[db][ks] = vtr(vb + db * 4096 + ks * 1024); vh[db][ks] = vtr(vb + db * 4096 + ks * 1024 + 512); }
    float sa = 0.f, sb = 0.f;
    __builtin_amdgcn_sched_barrier(0);
#pragma unroll
    for (int ks = 0; ks < 4; ++ks) {
        float e[8];
#pragma unroll
        for (int j = 0; j < 8; ++j) e[j] = __builtin_amdgcn_exp2f(ks < 2 ? s0[(ks & 1) * 8 + j] : s1[(ks & 1) * 8 + j]);
        sa += (e[0] + e[1]) + (e[2] + e[3]); sb += (e[4] + e[5]) + (e[6] + e[7]);
        u32x4 pw = (u32x4){pg::cvt_pk_bf16(e[0], e[1]), pg::cvt_pk_bf16(e[2], e[3]), pg::cvt_pk_bf16(e[4], e[5]), pg::cvt_pk_bf16(e[6], e[7])};
        asm volatile("" : "+v"(pw));
#pragma unroll
        for (int db = 0; db < 2; ++db) { const bf16x8 vf = (bf16x8){vl[db][ks][0], vl[db][ks][1], vl[db][ks][2], vl[db][ks][3], vh[db][ks][0], vh[db][ks][1], vh[db][ks][2], vh[db][ks][3]};
            o[db] = __builtin_amdgcn_mfma_f32_32x32x16_bf16(__builtin_bit_cast(bf16x8, pw), vf, o[db], 0, 0, 0); }
        __builtin_amdgcn_sched_barrier(0);
    }
    l += sa + sb;
}
template <int NDB> __device__ __forceinline__ void store_o(const f32x16 (&o)[NDB], float l, LAS float* wsf, int r32, int hi, bf16_t* yrow0  , int ldy) {
    l += __shfl_xor(l, 32);
    if (hi == 0) wsf[r32] = __builtin_amdgcn_rcpf(l);
    asm volatile("s_waitcnt lgkmcnt(0)" ::: "memory");
#pragma unroll
    for (int r = 0; r < 16; ++r) { const int q = crow(r, hi); const float inv = wsf[q];
#pragma unroll
        for (int db = 0; db < NDB; ++db) yrow0[(size_t)q * ldy + db * 32 + r32] = f2bf(o[db][r] * inv); }
    asm volatile("s_waitcnt lgkmcnt(0)" ::: "memory");
}

__device__ __forceinline__ void moba_unit(int b, int h, int jb, const bf16_t* PROJ, const float* KMP, bf16_t* Y, LAS unsigned char* lds, ConvJob& J, float (&tv)[16]) {
    int tid_ = threadIdx.x; asm volatile("" : "+v"(tid_));
    const int tid = tid_, lane = tid & 63, r32 = lane & 31, hi = lane >> 5, w = __builtin_amdgcn_readfirstlane(tid >> 6);
    LAS float* kmean = (LAS float*)(lds + 32768);
    LAS float* wsf = (LAS float*)(lds + 36864) + w * 64;
    const size_t rowbase = (size_t)b * SEQ; const int q0 = jb * 256; const int t = q0 + 32 * w + r32;
    for (int i = tid; i < jb * 64; i += NWAVES * 64) { const int n = i >> 6, d = i & 63; const float* p = KMP + ((size_t)(b * 16 + n) * 2) * 512 + h * 64 + d; kmean[i] = (p[0] + p[512]) * (1.0f / 256.0f); }
    const bf16_t* qp = PROJ + (rowbase + t) * INW + OFF_QB + h * 64 + hi * 8;
    bf16x8 qr[4];
#pragma unroll
    for (int d0 = 0; d0 < 4; ++d0) qr[d0] = *(const bf16x8*)(qp + d0 * 16);
    const bf16_t* kg = PROJ + (rowbase + 8 * w + (lane >> 3)) * INW + OFF_KB + h * 64 + (((lane & 7) ^ ((4 * w + (lane >> 4)) & 7)) << 3);
    const bf16_t* vg = PROJ + (rowbase + 16 * (w & 3) + (lane >> 2)) * INW + OFF_VB + h * 64 + (w >> 2) * 32 + (lane & 3) * 8;
    const unsigned kdst = (unsigned)__builtin_amdgcn_readfirstlane((int)((unsigned)(size_t)lds + w * 1024)), vdst = kdst + 8192u;
    __syncthreads();
    pg::glds16_asm(kg, kdst); pg::glds16_asm(vg, vdst);
    unsigned selmask = 0u;
    {
        float qf[32];
#pragma unroll
        for (int d0 = 0; d0 < 4; ++d0) { f32x4 a, c; pg::unpack8(__builtin_bit_cast(u32x4, qr[d0]), a, c);
#pragma unroll
            for (int j = 0; j < 4; ++j) { qf[d0 * 8 + j] = a[j]; qf[d0 * 8 + 4 + j] = c[j]; } }
        float v0 = -INFINITY, v1 = -INFINITY, v2 = -INFINITY; int i0 = -1, i1 = -1, i2 = -1;
#pragma unroll 4
        for (int n = 0; n < jb; ++n) {
            const LAS float* km = kmean + n * 64 + hi * 8; float g = 0.f;
#pragma unroll
            for (int d0 = 0; d0 < 4; ++d0) { const f32x4 ka = *(const LAS f32x4*)(km + d0 * 16), kc = *(const LAS f32x4*)(km + d0 * 16 + 4);
#pragma unroll
                for (int j = 0; j < 4; ++j) g += qf[d0 * 8 + j] * ka[j] + qf[d0 * 8 + 4 + j] * kc[j]; }
            { const auto rr = __builtin_amdgcn_permlane32_swap(__float_as_uint(g), __float_as_uint(g), false, false); g = __uint_as_float(rr[0]) + __uint_as_float(rr[1]); }
            if (g > v0) { v2 = v1; i2 = i1; v1 = v0; i1 = i0; v0 = g; i0 = n; } else if (g > v1) { v2 = v1; i2 = i1; v1 = g; i1 = n; } else if (g > v2) { v2 = g; i2 = n; }
        }
        if (i0 >= 0) selmask |= 1u << i0; if (i1 >= 0) selmask |= 1u << i1; if (i2 >= 0) selmask |= 1u << i2;
    }
    asm volatile("s_waitcnt vmcnt(0)" ::: "memory");
    __syncthreads();
    const float slope2 = exp2f(-(float)(h + 1)) * 1.4426950408889634f;
    float m = 0.f, l = 0.f; f32x16 o[2];
#pragma unroll
    for (int r = 0; r < 16; ++r) { o[0][r] = 0.f; o[1][r] = 0.f; }
    const int qrel = 32 * w + r32;
    const int NT = 4 * (jb + 1);
    const lds_cptr lb = (lds_cptr)lds;
    const int voff = 8192 + ((lane >> 4) & 1) * 32 + (lane & 3) * 8 + (4 * hi + ((lane & 15) >> 2)) * 64;
#pragma nounroll
    for (int T = 0; T < NT; ++T) {
        const int slot = (T & 1) * 16384;
        if (T + 1 < NT) { pg::glds16_asm(kg + (size_t)(T + 1) * 64 * INW, kdst + (unsigned)(slot ^ 16384)); pg::glds16_asm(vg + (size_t)(T + 1) * 64 * INW, vdst + (unsigned)(slot ^ 16384)); }
        const bool cv_issue = (J.item < J.end) && ((T & 1) == 0);
        if (cv_issue) conv_issue(J, tv, lane);
        const int n = T >> 2, kt = T & 3;
        const bool own = (n == jb);
        const bool sel = own || ((selmask >> n) & 1u);
        const bool need = own ? (64 * kt <= 32 * w + 31) : (__any(sel) != 0);
        if (need) {
            const float lbias = sel ? (slope2 * (float)(T * 64 + 4 * hi - t) - m) : -INFINITY;
            f32x16 s0, s1;
#pragma unroll
            for (int r = 0; r < 16; ++r) { s0[r] = slope2 * (float)((r & 3) + 8 * (r >> 2)) + lbias; s1[r] = slope2 * (float)((r & 3) + 8 * (r >> 2) + 32) + lbias; }
            if (own && 64 * kt + 63 > 32 * w) {
                const int kr = kt * 64 + 4 * hi;
#pragma unroll
                for (int r = 0; r < 16; ++r) { const int kk = kr + (r & 3) + 8 * (r >> 2); if (kk > qrel) s0[r] = -INFINITY; if (kk + 32 > qrel) s1[r] = -INFINITY; }
            }
            bf16x8 kf[8];
#pragma unroll
            for (int d0 = 0; d0 < 4; ++d0) { const lds_cptr kp = lb + slot + r32 * 128 + (((2 * d0 + hi) ^ ((r32 >> 1) & 7)) << 4);
                kf[2 * d0] = *(const __attribute__((address_space(3))) bf16x8*)kp; kf[2 * d0 + 1] = *(const __attribute__((address_space(3))) bf16x8*)(kp + 32 * 128); }
            __builtin_amdgcn_sched_barrier(0);
#pragma unroll
            for (int d0 = 0; d0 < 4; ++d0) { s0 = __builtin_amdgcn_mfma_f32_32x32x16_bf16(kf[2 * d0], qr[d0], s0, 0, 0, 0); s1 = __builtin_amdgcn_mfma_f32_32x32x16_bf16(kf[2 * d0 + 1], qr[d0], s1, 0, 0, 0); }
            __builtin_amdgcn_sched_barrier(0);
            softmax_rel_a<2>(s0, s1, m, l, o, wsf, r32, hi);
            exp_pv(s0, s1, l, o, lb + slot + voff);
        }
        const bool cv_fin = (J.item < J.end) && ((T & 1) == 1);
        if (cv_fin) conv_finish(J, tv, lane);
        if (cv_issue) asm volatile("s_waitcnt vmcnt(16) lgkmcnt(0)" ::: "memory");
        else if (cv_fin) asm volatile("s_waitcnt vmcnt(1) lgkmcnt(0)" ::: "memory");
        else asm volatile("s_waitcnt vmcnt(0) lgkmcnt(0)" ::: "memory");
        __builtin_amdgcn_s_barrier(); asm volatile("" ::: "memory");
    }
    store_o<2>(o, l, wsf, r32, hi, Y + (rowbase + q0 + 32 * w) * 1536 + 512 + h * 64, 1536);
}

__device__ __forceinline__ void mem_units(int b, int h, int qt0, int nqt, const bf16_t* PROJ, const bf16_t* MKV, const float* gq, bf16_t* Y, LAS unsigned char* lds) {
    int tid_ = threadIdx.x; asm volatile("" : "+v"(tid_));
    const int tid = tid_, lane = tid & 63, r32 = lane & 31, hi = lane >> 5, w = __builtin_amdgcn_readfirstlane(tid >> 6);
    LAS float* wsf = (LAS float*)(lds + RING_BYTES + 4096) + w * 64;
    __syncthreads();
#pragma unroll 4
    for (int i = 0; i < 8; ++i) { const int p = tid + 512 * i, key = p >> 4, ch = p & 15;
        const u32x4 wv = *(const u32x4*)(MKV + ((size_t)b * MEML + key) * 1024 + h * 128 + ch * 8); f32x4 a, c; pg::unpack8(wv, a, c);
        const f32x4 g0 = *(const f32x4*)(gq + ch * 8), g1 = *(const f32x4*)(gq + ch * 8 + 4);
        *(LAS u32x4*)(lds + key * 256 + ((ch ^ (key & 15)) << 4)) = pg::pack8(a * g0, c * g1); }
#pragma unroll
    for (int i = 0; i < 8; ++i) { const int p = tid + 512 * i, key = p >> 4, c16 = p & 15;
        const u32x4 wv = *(const u32x4*)(MKV + ((size_t)b * MEML + key) * 1024 + 512 + h * 128 + c16 * 8);
        *(LAS u32x4*)(lds + 65536 + (c16 >> 2) * 16384 + (key >> 4) * 1024 + (key & 15) * 64 + (c16 & 3) * 16) = wv; }
    __syncthreads();
    const lds_cptr lb = (lds_cptr)lds;
    const int voff = 65536 + ((lane >> 4) & 1) * 32 + (lane & 3) * 8 + (4 * hi + ((lane & 15) >> 2)) * 64;
#pragma nounroll
    for (int qi = 0; qi < nqt; ++qi) {
        const size_t row0 = (size_t)b * SEQ + (size_t)(qt0 + qi) * 256 + 32 * w;
        const bf16_t* qp = PROJ + (row0 + r32) * INW + OFF_QM + h * 128 + hi * 8;
        bf16x8 qr[8]; float ss = 0.f;
#pragma unroll
        for (int d0 = 0; d0 < 8; ++d0) { qr[d0] = *(const bf16x8*)(qp + d0 * 16); f32x4 a, c; pg::unpack8(__builtin_bit_cast(u32x4, qr[d0]), a, c);
            ss += (a[0] * a[0] + a[1] * a[1]) + (a[2] * a[2] + a[3] * a[3]) + (c[0] * c[0] + c[1] * c[1]) + (c[2] * c[2] + c[3] * c[3]); }
        ss += __shfl_xor(ss, 32);
        const float cs = rsqrtf(ss * (1.0f / 128.0f) + EPS) * (0.08838834764831845f * 1.4426950408889634f);
        float m = -1e30f, l = 0.f; f32x16 o[4];
#pragma unroll
        for (int r = 0; r < 16; ++r) { o[0][r] = 0.f; o[1][r] = 0.f; o[2][r] = 0.f; o[3][r] = 0.f; }
#pragma nounroll
        for (int kt = 0; kt < 4; ++kt) {
            f32x16 s0, s1;
#pragma unroll
            for (int r = 0; r < 16; ++r) { s0[r] = 0.f; s1[r] = 0.f; }
#pragma unroll
            for (int d0 = 0; d0 < 8; ++d0) {
                const lds_cptr kp = lb + (kt * 64 + r32) * 256 + (((2 * d0 + hi) ^ (r32 & 15)) << 4);
                const bf16x8 b0 = *(const __attribute__((address_space(3))) bf16x8*)kp, b1 = *(const __attribute__((address_space(3))) bf16x8*)(kp + 32 * 256);
                s0 = __builtin_amdgcn_mfma_f32_32x32x16_bf16(b0, qr[d0], s0, 0, 0, 0); s1 = __builtin_amdgcn_mfma_f32_32x32x16_bf16(b1, qr[d0], s1, 0, 0, 0);
                if ((d0 & 1) == 1) __builtin_amdgcn_sched_barrier(0); }
#pragma unroll
            for (int r = 0; r < 16; ++r) { s0[r] *= cs; s1[r] *= cs; }
            u32x4 pw[4];
            softmax_step<4>(s0, s1, m, l, o, wsf, r32, hi, pw);
            pv_step<4>(o, pw, lb + voff + kt * 4096, 16384);
        }
        store_o<4>(o, l, wsf, r32, hi, Y + row0 * 1536 + 1024 + h * 128, 1536);
    }
    __syncthreads();
}
}


__device__ __forceinline__ void sgu_chunk(int chunk, const bf16_t* PROJ, const float* gsv, const bf16_t* WSB, const float* bs, bf16_t* Y, LAS unsigned char* lds) {
    int tid_ = threadIdx.x; asm volatile("" : "+v"(tid_));
    const int tid = tid_, lane = tid & 63, r32 = lane & 31, hi = lane >> 5, w = __builtin_amdgcn_readfirstlane(tid >> 6);
    const int t0 = chunk * 128;
    LAS float* rs = (LAS float*)(lds + 32768);
    { u32x4 wv[16];
#pragma unroll
      for (int i = 0; i < 16; ++i) wv[i] = *(const u32x4*)(PROJ + (size_t)(t0 + w * 16 + i) * INW + OFF_V + lane * 8);
#pragma unroll
      for (int i = 0; i < 16; ++i) { const int tl = w * 16 + i; f32x4 a, b; pg::unpack8(wv[i], a, b);
        float ss = (a[0] * a[0] + a[1] * a[1]) + (a[2] * a[2] + a[3] * a[3]) + (b[0] * b[0] + b[1] * b[1]) + (b[2] * b[2] + b[3] * b[3]);
        ss = wave_sum(ss); if (lane == 0) rs[tl] = rsqrtf(ss * (1.0f / 512.0f) + EPS); } }
    __syncthreads();
    const int tt = w & 3, dh = w >> 2;
    const at::lds_cptr vb = (at::lds_cptr)lds + ((lane >> 4) & 1) * 32 + (lane & 3) * 8 + (4 * hi + ((lane & 15) >> 2)) * 64 + dh * 16384;
#pragma nounroll
    for (int g = 0; g < 4; ++g) {
        { const int c8 = tid & 15; const f32x4 g0 = *(const f32x4*)(gsv + g * 128 + c8 * 8), g1 = *(const f32x4*)(gsv + g * 128 + c8 * 8 + 4);
#pragma unroll
            for (int j = 0; j < 4; ++j) { const int s = (tid >> 4) + 32 * j; const float r = rs[s];
                const u32x4 wv = *(const u32x4*)(PROJ + (size_t)(t0 + s) * INW + OFF_V + g * 128 + c8 * 8); f32x4 a, b; pg::unpack8(wv, a, b);
                *(LAS u32x4*)(lds + (c8 >> 2) * 8192 + (s >> 4) * 1024 + (s & 15) * 64 + (c8 & 3) * 16) = pg::pack8(a * r * g0, b * r * g1); } }
        __syncthreads();
        at::f32x16 o[2];
#pragma unroll
        for (int r = 0; r < 16; ++r) { o[0][r] = 0.f; o[1][r] = 0.f; }
        const bf16_t* wrow = WSB + ((size_t)g * 128 + 32 * tt + r32) * 128 + 4 * hi;
        const int nks = 2 * tt + 2;
        uint2 alo8[8], ahi8[8];
#pragma unroll
        for (int ks = 0; ks < 8; ++ks) { alo8[ks] = *(const uint2*)(wrow + 16 * ks); ahi8[ks] = *(const uint2*)(wrow + 16 * ks + 8); }
#pragma unroll
        for (int ks = 0; ks < 8; ++ks) { if (ks >= nks) break;
            const uint2 alo = alo8[ks], ahi = ahi8[ks];
            const bf16x8 af = __builtin_bit_cast(bf16x8, (u32x4){alo.x, alo.y, ahi.x, ahi.y});
#pragma unroll
            for (int dbl = 0; dbl < 2; ++dbl) { const at::s16x4 lo = at::vtr(vb + dbl * 8192 + ks * 1024), hh = at::vtr(vb + dbl * 8192 + ks * 1024 + 512);
                const bf16x8 vf = (bf16x8){lo[0], lo[1], lo[2], lo[3], hh[0], hh[1], hh[2], hh[3]};
                o[dbl] = __builtin_amdgcn_mfma_f32_32x32x16_bf16(af, vf, o[dbl], 0, 0, 0); }
        }
        LAS float* stg = (LAS float*)(lds + 40960);
#pragma unroll
        for (int r = 0; r < 16; ++r) { const int t = 32 * tt + at::crow(r, hi); const float bias = bs[g * 128 + t];
#pragma unroll
            for (int dbl = 0; dbl < 2; ++dbl) stg[t * 128 + (2 * dh + dbl) * 32 + r32] = o[dbl][r] + bias; }
        __syncthreads();
#pragma unroll
        for (int j = 0; j < 4; ++j) { const int p = tid + 512 * j, t = p >> 4, c8 = (p & 15) * 8; const size_t row = (size_t)(t0 + t);
            const f32x4 m0 = *(const LAS f32x4*)(stg + t * 128 + c8), m1 = *(const LAS f32x4*)(stg + t * 128 + c8 + 4);
            f32x4 u0, u1; pg::unpack8(*(const u32x4*)(PROJ + row * INW + OFF_U + g * 128 + c8), u0, u1);
            *(u32x4*)(Y + row * 1536 + g * 128 + c8) = pg::pack8(u0 * m0, u1 * m1); }
        __syncthreads();
    }
}

struct MArgs { const float* in[24]; float* out; unsigned char* ws; int ph_lo, ph_hi; };
__global__ void __launch_bounds__(NWAVES * 64, 2) mk_fwd(MArgs a) {
    extern __shared__ __attribute__((aligned(16))) unsigned char lds_raw[];
    LAS unsigned char* lds = (LAS unsigned char*)lds_raw;
    const int tid = threadIdx.x;
    for (int u = tid; u < (LDS_BYTES - LDSCTL_OFF) / 4; u += NWAVES * 64) ((LAS unsigned*)(lds + LDSCTL_OFF))[u] = 0u;
    __syncthreads();
    unsigned char* ws = a.ws; unsigned* ctl = (unsigned*)(ws + WS_CTL);
    const int lo = a.ph_lo, hi = a.ph_hi; const int G = gridDim.x, c = blockIdx.x;
    XcdBarrier bar; bar.bar = ctl + CW_BAR; bar.x = 0; bar.st = nullptr;
    if (hi - lo > 1) bar = xcd_barrier_post(ctl + CW_BAR, (volatile LAS unsigned*)(lds + LDSCTL_OFF));
typedef const MArgs __attribute__((address_space(4))) * kargp_t;
    const kargp_t kargs = (kargp_t)__builtin_amdgcn_kernarg_segment_ptr();
#define KA_BEGIN() kargp_t q = kargs; asm volatile("" : "+s"(q))
#ifdef DIAG_PHASE
    if (c == 0 && tid == 0) *(LAS unsigned long long*)(lds + LDSCTL_OFF + 16) = wall_clock64();
#define DIAG_STAMP(k) do { if ((k) == DIAG_PHASE && c == 0 && tid == 0) ctl[CW_DIAG] = (unsigned)(wall_clock64() - *(LAS unsigned long long*)(lds + LDSCTL_OFF + 16)); } while (0)
#else
#define DIAG_STAMP(k) do { } while (0)
#endif
#define IN(k) (lo <= (k) && (k) < hi)
#define BOTH(k) (IN(k) && IN((k) + 1))
    bf16_t *WinT = (bf16_t*)(ws + WS_WIN), *WbrT = (bf16_t*)(ws + WS_WBR), *WoutT = (bf16_t*)(ws + WS_WOUT);
    bf16_t *W1T = (bf16_t*)(ws + WS_W1), *W2T = (bf16_t*)(ws + WS_W2);
    bf16_t *MERGED = (bf16_t*)(ws + WS_MERGED), *X1B = (bf16_t*)(ws + WS_X1B), *HB = (bf16_t*)(ws + WS_HB), *PROJ = (bf16_t*)(ws + WS_PROJ), *Y = (bf16_t*)(ws + WS_Y);
    bf16_t *ACT = (bf16_t*)(ws + WS_ACT), *YS = (bf16_t*)(ws + WS_YS);
    float* KMP = (float*)(ws + WS_KMP); int* LIST = (int*)(ws + WS_LIST); float* RSTDS = (float*)(ws + WS_RSTDS); float* TOPWS = (float*)(ws + WS_TOPWS);

    bf16_t *WmemT = (bf16_t*)(ws + WS_WMEM), *MEMN = (bf16_t*)(ws + WS_MEMN), *MKV = (bf16_t*)(ws + WS_MKV), *WSB = (bf16_t*)(ws + WS_WSB); float* WrT = (float*)(ws + WS_WR);
#if !defined(ONLY) || ONLY == 0
    if (IN(0)) {
        KA_BEGIN();
        {
        P0Args p; p.x = q->in[0]; p.mem = q->in[1]; p.g_mix = q->in[2]; p.g_mem = q->in[9]; p.w_in = q->in[3]; p.w_br0 = q->in[13]; p.w_br1 = q->in[14]; p.w_br2 = q->in[15]; p.w_out = q->in[16];
        p.w_mem_kv = q->in[10]; p.w_gate_up = q->in[20]; p.w_down = q->in[22]; p.g_ffn = q->in[17]; p.w_router = q->in[18]; p.w_spatial = q->in[5];
        p.HBQ = ws + WS_HBQ; p.WINQ = ws + WS_WINQ; p.HB = HB; p.MEMN = MEMN; p.WinT = WinT; p.WbrT = WbrT; p.WoutT = WoutT; p.WmemT = WmemT; p.W1T = W1T; p.W2T = W2T; p.WSB = WSB; p.WrT = WrT;
        p0_prologue(p, lds, G, c);
        }
#if DUP_PHASE == 0
        {
        P0Args p; p.x = q->in[0]; p.mem = q->in[1]; p.g_mix = q->in[2]; p.g_mem = q->in[9]; p.w_in = q->in[3]; p.w_br0 = q->in[13]; p.w_br1 = q->in[14]; p.w_br2 = q->in[15]; p.w_out = q->in[16];
        p.w_mem_kv = q->in[10]; p.w_gate_up = q->in[20]; p.w_down = q->in[22]; p.g_ffn = q->in[17]; p.w_router = q->in[18]; p.w_spatial = q->in[5];
        p.HBQ = ws + WS_HBQ; p.WINQ = ws + WS_WINQ; p.HB = HB; p.MEMN = MEMN; p.WinT = WinT; p.WbrT = WbrT; p.WoutT = WoutT; p.WmemT = WmemT; p.W1T = W1T; p.W2T = W2T; p.WSB = WSB; p.WrT = WrT;
        p0_prologue(p, lds, G, c);
        }
#endif
        if (BOTH(0)) xcd_barrier(bar);
        DIAG_STAMP(0);
    }
#endif
#if !defined(ONLY) || ONLY == 1
    if (IN(1)) {
        KA_BEGIN();
        {
        pg::PolP1 P; P.A = HB; P.Bt = WinT; P.PROJ = PROJ; P.KMP = KMP; P.gq = q->in[7]; P.gk = q->in[8]; P.G = G; P.c = c;
        pg::gemm_run(lds, P);
        { pg::PolP1G Pg; Pg.A = ws + WS_HBQ; Pg.Bt = ws + WS_WINQ; Pg.PROJ = PROJ; Pg.G = G; Pg.c = c; pg::gemm_run(lds, Pg); }
        p1_memkv(MEMN, WmemT, q->in[12], MKV, G, c, lds);
        }
#if DUP_PHASE == 1
        {
        pg::PolP1 P; P.A = HB; P.Bt = WinT; P.PROJ = PROJ; P.KMP = KMP; P.gq = q->in[7]; P.gk = q->in[8]; P.G = G; P.c = c;
        pg::gemm_run(lds, P);
        p1_memkv(MEMN, WmemT, q->in[12], MKV, G, c, lds);
        }
#endif
        if (BOTH(1)) xcd_barrier(bar);
        DIAG_STAMP(1);
    }
#endif
#if !defined(ONLY) || ONLY == 2
    if (IN(2)) {
        KA_BEGIN();
        {
        const int wave = __builtin_amdgcn_readfirstlane(tid >> 6), lane = tid & 63;
        const int vcu = (G % 8 == 0) ? (c % 8) * (G / 8) + c / 8 : c;
        for (int u = vcu; u < 256; u += G) at::mem_units(u >> 5, (u >> 3) & 3, (u & 7) * 2, 2, PROJ, MKV, q->in[11], Y, lds);
#if DUP_P2 == 1
        for (int u = vcu; u < 256; u += G) at::mem_units(u >> 5, (u >> 3) & 3, (u & 7) * 2, 2, PROJ, MKV, q->in[11], Y, lds);
#endif
        ConvJob J; J.w1 = q->in[20]; J.w2 = q->in[22]; J.gf = q->in[17]; J.W1Q = (unsigned char*)W1T; J.W2Q = (unsigned char*)W2T; J.scr = (LAS float*)(lds + 40960 + wave * 4352);
        J.item = c * NWAVES + wave; J.end = CV_TOTAL; J.stride = G * NWAVES; float tv[16];
        for (int u = vcu; u < 256; u += G) { const int bh = u >> 2, s4 = u & 3;
            for (int i = 0; i < 4; ++i) { const int jb = (i == 0) ? 15 - s4 : (i == 1) ? 8 + s4 : (i == 2) ? 7 - s4 : s4; at::moba_unit(bh >> 3, bh & 7, jb, PROJ, KMP, Y, lds, J, tv); } }
#if DUP_P2 == 2
        for (int u = vcu; u < 256; u += G) { const int bh = u >> 2, s4 = u & 3;
            for (int i = 0; i < 4; ++i) { const int jb = (i == 0) ? 15 - s4 : (i == 1) ? 8 + s4 : (i == 2) ? 7 - s4 : s4; at::moba_unit(bh >> 3, bh & 7, jb, PROJ, KMP, Y, lds, J, tv); } }
#endif
        while (J.item < J.end) { conv_issue(J, tv, lane); conv_finish(J, tv, lane); }
        __syncthreads();
        for (int ch = vcu; ch < 256; ch += G) sgu_chunk(ch, PROJ, q->in[4], WSB, q->in[6], Y, lds);
#if DUP_P2 == 3
        for (int ch = vcu; ch < 256; ch += G) sgu_chunk(ch, PROJ, q->in[4], WSB, q->in[6], Y, lds);
#endif
        }
#if DUP_PHASE == 2
        {
        const int wave = __builtin_amdgcn_readfirstlane(tid >> 6), lane = tid & 63;
        const int vcu = (G % 8 == 0) ? (c % 8) * (G / 8) + c / 8 : c;
        for (int u = vcu; u < 256; u += G) at::mem_units(u >> 5, (u >> 3) & 3, (u & 7) * 2, 2, PROJ, MKV, q->in[11], Y, lds);
        for (int u = vcu; u < 256; u += G) { const int bh = u >> 2, s4 = u & 3;
            for (int i = 0; i < 4; ++i) { const int jb = (i == 0) ? 15 - s4 : (i == 1) ? 8 + s4 : (i == 2) ? 7 - s4 : s4; at::moba_unit(bh >> 3, bh & 7, jb, PROJ, KMP, Y, lds, J, tv); } }
        __syncthreads();
        for (int ch = vcu; ch < 256; ch += G) sgu_chunk(ch, PROJ, q->in[4], WSB, q->in[6], Y, lds);
        }
#endif
        if (BOTH(2)) xcd_barrier(bar);
        DIAG_STAMP(2);
    }
#endif
#if !defined(ONLY) || ONLY == 3
    if (IN(3)) {
        KA_BEGIN();
        {
        pg::PolP3 P; P.A = Y; P.Bt = WbrT; P.PROJ = PROJ; P.MERGED = MERGED; P.G = G; P.c = c;
        pg::gemm_run(lds, P);
        }
#if DUP_PHASE == 3
        {
        pg::PolP3 P; P.A = Y; P.Bt = WbrT; P.PROJ = PROJ; P.MERGED = MERGED; P.G = G; P.c = c;
        pg::gemm_run(lds, P);
        }
#endif
        if (BOTH(3)) xcd_barrier(bar);
        DIAG_STAMP(3);
    }
#endif
#if !defined(ONLY) || ONLY == 4
    if (IN(4)) {
        KA_BEGIN();
        {
        pg::PolP4 P; P.A = MERGED; P.Bt = WoutT; P.x = q->in[0]; P.X1H = (bf16_t*)(ws + WS_X1H); P.X1Q = (unsigned char*)X1B; P.gffn = q->in[17]; P.G = G; P.c = c;
        pg::gemm_run(lds, P);
        }
#if DUP_PHASE == 4
        {
        pg::PolP4 P; P.A = MERGED; P.Bt = WoutT; P.x = q->in[0]; P.X1H = (bf16_t*)(ws + WS_X1H); P.X1Q = (unsigned char*)X1B; P.gffn = q->in[17]; P.G = G; P.c = c;
        pg::gemm_run(lds, P);
        }
#endif
        if (BOTH(4)) xcd_barrier(bar);
#ifdef DUP_BAR
        for (int i_ = 0; i_ < DUP_BAR; ++i_) xcd_barrier(bar);
#endif
        DIAG_STAMP(4);
    }
#endif
#if !defined(ONLY) || ONLY == 5
    if (IN(5)) {
        KA_BEGIN();
        {
        p5_router((const bf16_t*)(ws + WS_X1H), WrT, q->in[19], LIST, RSTDS, TOPWS, ctl + CW_CNT, G, c, lds);
        }
#if DUP_PHASE == 5
        {
        p5_router((const bf16_t*)(ws + WS_X1H), WrT, q->in[19], (int*)(ws + WS_SCR), (float*)(ws + WS_SCR + 4 * MiB), (float*)(ws + WS_SCR + 8 * MiB), ctl + 512, G, c, lds);
        }
#endif
        if (BOTH(5)) xcd_barrier(bar);
        DIAG_STAMP(5);
    }
#endif
#if !defined(ONLY) || ONLY == 6
    if (IN(6)) {
        KA_BEGIN();
        {
        grouped_setup((LAS int*)(lds + TAB_OFF), ctl + CW_CNT);
        pg::PolP6 P; P.X1Q = (const unsigned char*)X1B; P.W1Q = (const unsigned char*)W1T; P.LIST = LIST; P.RSTDS = RSTDS; P.b1 = q->in[21]; P.ACTQ = (unsigned char*)ACT; P.tb.tab = (const LAS int*)(lds + TAB_OFF); P.G = G; P.c = c; P.rtab = lds + RTAB_OFF;
        pg::gemm_run(lds, P);
        }
#if DUP_PHASE == 6
        {
        grouped_setup((LAS int*)(lds + TAB_OFF), ctl + CW_CNT);
        pg::PolP6 P; P.X1Q = (const unsigned char*)X1B; P.W1Q = (const unsigned char*)W1T; P.LIST = LIST; P.RSTDS = RSTDS; P.b1 = q->in[21]; P.ACTQ = (unsigned char*)ACT; P.tb.tab = (const LAS int*)(lds + TAB_OFF); P.G = G; P.c = c; P.rtab = lds + RTAB_OFF;
        pg::gemm_run(lds, P);
        }
#endif
        if (BOTH(6)) xcd_barrier(bar);
        DIAG_STAMP(6);
    }
#endif
#if !defined(ONLY) || ONLY == 7
    if (IN(7)) {
        KA_BEGIN();
        {
        grouped_setup((LAS int*)(lds + TAB_OFF), ctl + CW_CNT);
        pg::PolP7 P; P.ACTQ = (const unsigned char*)ACT; P.W2Q = (const unsigned char*)W2T; P.LIST = LIST; P.TOPWS = TOPWS; P.b2 = q->in[23]; P.YS = YS; P.tb.tab = (const LAS int*)(lds + TAB_OFF); P.G = G; P.c = c; P.rtab = lds + RTAB_OFF;
        pg::gemm_run(lds, P);
        }
#if DUP_PHASE == 7
        {
        grouped_setup((LAS int*)(lds + TAB_OFF), ctl + CW_CNT);
        pg::PolP7 P; P.ACTQ = (const unsigned char*)ACT; P.W2Q = (const unsigned char*)W2T; P.LIST = LIST; P.TOPWS = TOPWS; P.b2 = q->in[23]; P.YS = YS; P.tb.tab = (const LAS int*)(lds + TAB_OFF); P.G = G; P.c = c; P.rtab = lds + RTAB_OFF;
        pg::gemm_run(lds, P);
        }
#endif
        if (BOTH(7)) xcd_barrier(bar);
        DIAG_STAMP(7);
    }
#endif
#if !defined(ONLY) || ONLY == 8
    if (IN(8)) { KA_BEGIN();
#ifdef DIAG_PHASE
        p8_combine(q->out, (const bf16_t*)(ws + WS_X1H), YS, G, c, 1.0f + sqrtf((float)ctl[CW_DIAG] * 1e-5f));
#else
        p8_combine(q->out, (const bf16_t*)(ws + WS_X1H), YS, G, c, 1.0f);
#if DUP_PHASE == 8
        p8_combine(q->out, (const bf16_t*)(ws + WS_X1H), YS, G, c, -1.0f);
#endif
#endif
    }
#endif
#undef IN
#undef BOTH
}

static int g_grid = 0;
static void launch_mk(const MArgs& base, int lo, int hi, hipStream_t stream) {
    MArgs a = base; a.ph_lo = lo; a.ph_hi = hi;
    hipLaunchKernelGGL(mk_fwd, dim3(g_grid), dim3(NWAVES * 64), LDS_BYTES, stream, a);
}
extern "C" void kernel_launch(void* const* d_in, const int* in_sizes, int n_in, void* d_out, int out_size, void* d_ws, size_t ws_size, hipStream_t stream) {
    if (n_in != 24 || ws_size < WS_END) { fprintf(stderr, "kernel_launch: unexpected n_in %d or ws %zu\n", n_in, ws_size); return; }
    if (g_grid == 0) {
        int dev = 0, cus = 0, per_cu = 0;
        (void)hipGetDevice(&dev); (void)hipDeviceGetAttribute(&cus, hipDeviceAttributeMultiprocessorCount, dev);
        if (hipFuncSetAttribute((const void*)mk_fwd, hipFuncAttributeMaxDynamicSharedMemorySize, LDS_BYTES) != hipSuccess) fprintf(stderr, "kernel_launch: hipFuncSetAttribute failed\n");
        if (hipOccupancyMaxActiveBlocksPerMultiprocessor(&per_cu, (const void*)mk_fwd, NWAVES * 64, LDS_BYTES) != hipSuccess || per_cu < 1) fprintf(stderr, "kernel_launch: occupancy query says %d\n", per_cu);
        (void)hipGetLastError();
        g_grid = cus > 0 ? cus : 256;
    }
    unsigned char* ws = (unsigned char*)d_ws; float* out = (float*)d_out;
    MArgs base{}; for (int i = 0; i < 24; ++i) base.in[i] = (const float*)d_in[i]; base.out = out; base.ws = ws;

    (void)hipMemsetAsync(ws + WS_CTL, 0, 1 * MiB, stream);
    launch_mk(base, 0, 9, stream);
}
```

```cpp
#include <hip/hip_runtime.h>
#include <stdint.h>
#include <cstdio>
#ifndef DUP_P2
#define DUP_P2 0
#endif
#ifndef DUP_PHASE
#define DUP_PHASE -1
#endif

typedef unsigned short bf16_t;
typedef short bf16x8 __attribute__((ext_vector_type(8)));
typedef float f32x4 __attribute__((ext_vector_type(4)));
typedef unsigned u32x4 __attribute__((ext_vector_type(4)));
typedef int i32x8 __attribute__((ext_vector_type(8)));
typedef int i32x4 __attribute__((ext_vector_type(4)));

constexpr int NBATCH = 8, SEQ = 4096, DM = 1024, T_TOK = NBATCH * SEQ, INW = 6144, MEML = 256;
constexpr int OFF_U = 0, OFF_V = 512, OFF_QB = 1024, OFF_KB = 1536, OFF_VB = 2048, OFF_QM = 2560, OFF_G = 3072;
constexpr int NEXP = 32, TOPK = 4, DFF = 1024;
constexpr float EPS = 1e-6f;
constexpr int ACT_ROWS = T_TOK * TOPK + NEXP * 256;

constexpr size_t MiB = 1ull << 20;
constexpr size_t WS_CTL = 0;
constexpr size_t WS_WIN = 1 * MiB;
constexpr size_t WS_WBR = 13 * MiB;
constexpr size_t WS_WOUT = 16 * MiB;
constexpr size_t WS_WMEM = 18 * MiB;
constexpr size_t WS_WR = 20 * MiB;
constexpr size_t WS_RSTD2 = 21 * MiB;
constexpr size_t WS_WSB = 21 * MiB + 256 * 1024;
constexpr size_t WS_KMP = 22 * MiB;
constexpr size_t WS_TOPW = 23 * MiB;
constexpr size_t WS_LIST = 24 * MiB;
constexpr size_t WS_RSTDS = 28 * MiB;
constexpr size_t WS_TOPWS = 32 * MiB;
constexpr size_t WS_MEMN = 36 * MiB;
constexpr size_t WS_MKV = 40 * MiB;
constexpr size_t WS_W1 = 44 * MiB;
constexpr size_t WS_W2 = 172 * MiB;
constexpr size_t WS_MERGED = 236 * MiB;
constexpr size_t WS_X1B = 300 * MiB;
constexpr size_t WS_HB = 364 * MiB;
constexpr size_t WS_PROJ = 428 * MiB;
constexpr size_t WS_Y = 812 * MiB;
constexpr size_t WS_ACT = 364 * MiB;
constexpr size_t WS_YS = 636 * MiB;
constexpr size_t WS_X1H = 500 * MiB;
constexpr size_t WS_HBQ = 908 * MiB;
constexpr size_t WS_WINQ = 944 * MiB;
constexpr size_t WS_SCR = 960 * MiB;
constexpr size_t WS_END = 1024 * MiB;
constexpr int CW_CNT = 64;
constexpr int CW_DIAG = 128;

__device__ __forceinline__ float bf2f(bf16_t b) { return __uint_as_float(((unsigned)b) << 16); }
__device__ __forceinline__ bf16_t f2bf(float f) { unsigned u = __float_as_uint(f); u += 0x7fffu + ((u >> 16) & 1u); return (bf16_t)(u >> 16); }
__device__ __forceinline__ float wave_sum(float v) {
#pragma unroll
    for (int o = 1; o < 64; o <<= 1) v += __shfl_xor(v, o);
    return v;
}
__device__ __forceinline__ float wave_max(float v) {
#pragma unroll
    for (int o = 1; o < 64; o <<= 1) v = fmaxf(v, __shfl_xor(v, o));
    return v;
}
__device__ __forceinline__ float gelu_exact(float v) { return 0.5f * v * (1.0f + erff(v * 0.70710678118654752f)); }
__device__ __forceinline__ float sigmoidf_(float v) { return 1.0f / (1.0f + __expf(-v)); }

#define LAS __attribute__((address_space(3)))
typedef float f32x2 __attribute__((ext_vector_type(2)));
constexpr int NWAVES = 8;
constexpr int RING_BYTES = 131072;
constexpr int LDSCTL_OFF = RING_BYTES;
constexpr int TAB_OFF = RING_BYTES + 64;
constexpr int TAB_CNT = 0, TAB_TST = 32, TAB_TE = 96, TAB_WORDS = 96 + 576;
constexpr int RTAB_OFF = RING_BYTES + 8192;
constexpr int RT_STRIDE = 4096;
constexpr int LDS_BYTES = 147456;
static_assert(TAB_OFF + TAB_WORDS * 4 <= LDS_BYTES && RTAB_OFF + 2 * RT_STRIDE <= LDS_BYTES, "LDS map");
constexpr int CW_BAR = 4096;

#define XB_TMO      128
#define XB_XCNT(j)  (256  + 64 * (j))
#define XB_XSUB(j)  (1280 + 64 * (j))
#define XB_XGEN(j)  (2304 + 64 * (j))
#define XB_TOP      3328
#define XB_TOPGEN   3392
#define XCD_BAR_WORDS 3456
#define XB_SPIN_CAP (1u << 18)
__device__ __forceinline__ unsigned xb_ld(unsigned* p)              { return __hip_atomic_load(p, __ATOMIC_RELAXED, __HIP_MEMORY_SCOPE_AGENT); }
__device__ __forceinline__ unsigned xb_add(unsigned* p, unsigned v) { return __hip_atomic_fetch_add(p, v, __ATOMIC_RELAXED, __HIP_MEMORY_SCOPE_AGENT); }
__device__ __forceinline__ unsigned xb_xcc_id() { return (unsigned)__builtin_amdgcn_s_getreg((3 << 11) | 20) & 0xFu; }
#define XB_SPIN(cond, bar) do { unsigned _sp = 0; while (cond) { __builtin_amdgcn_s_sleep(1); \
    if ((++_sp & 255u) == 0u) { if (xb_ld(&(bar)[XB_TMO])) break; if (_sp > XB_SPIN_CAP) { atomicAdd(&(bar)[XB_TMO], 1u); break; } } } } while (0)
struct XcdBarrier { unsigned* bar; unsigned x; volatile LAS unsigned* st; };
__device__ __forceinline__ XcdBarrier xcd_barrier_post(unsigned* bar, volatile LAS unsigned* st) {
    XcdBarrier b; b.bar = bar; b.x = xb_xcc_id(); b.st = st;
    if (threadIdx.x == 0) (void)xb_add(&bar[XB_XCNT(b.x)], 1u);
    return b;
}
__device__ __forceinline__ void xcd_barrier_complete(unsigned* bar, unsigned x, unsigned& nloc, unsigned& nx) {
    const unsigned G = gridDim.x * gridDim.y * gridDim.z;
    unsigned sum, cnt, mine, sp = 0u;
    for (;;) {
        sum = 0u; cnt = 0u; mine = 0u;
#pragma unroll
        for (unsigned j = 0; j < 16; ++j) { const unsigned c = xb_ld(&bar[XB_XCNT(j)]); sum += c; cnt += (c > 0u) ? 1u : 0u; mine = (j == x) ? c : mine; }
        if (sum == G) break;
        __builtin_amdgcn_s_sleep(1);
        if ((++sp & 255u) == 0u) { if (xb_ld(&bar[XB_TMO])) break; if (sp > XB_SPIN_CAP) { atomicAdd(&bar[XB_TMO], 1u); break; } }
    }
    nloc = mine > 0u ? mine : 1u; nx = cnt > 0u ? cnt : 1u;
}
__device__ __forceinline__ void xcd_barrier(const XcdBarrier& b) {
    asm volatile("s_waitcnt vmcnt(0)" ::: "memory");
    __syncthreads();
    if (threadIdx.x == 0) {
        unsigned* bar = b.bar;
        __builtin_amdgcn_s_waitcnt(0);
        unsigned nloc = b.st[0], nx = b.st[1];
        if (nloc == 0u) { xcd_barrier_complete(bar, b.x, nloc, nx); b.st[0] = nloc; b.st[1] = nx; }
        const unsigned old = xb_add(&bar[XB_XSUB(b.x)], 1u);
        const unsigned gen = old / nloc;
        if (old + 1u == (gen + 1u) * nloc) {
            __builtin_amdgcn_fence(__ATOMIC_RELEASE, "agent");
            asm volatile("s_waitcnt vmcnt(0)" ::: "memory");
            const unsigned og = xb_add(&bar[XB_TOP], 1u);
            const unsigned tg = og / nx;
            if (og + 1u == (tg + 1u) * nx) xb_add(&bar[XB_TOPGEN], 1u);
            else XB_SPIN(xb_ld(&bar[XB_TOPGEN]) == tg, bar);
            __builtin_amdgcn_fence(__ATOMIC_ACQUIRE, "agent");
            xb_add(&bar[XB_XGEN(b.x)], 1u);
            asm volatile("s_waitcnt vmcnt(0)" ::: "memory");
        } else {
            XB_SPIN(xb_ld(&bar[XB_XGEN(b.x)]) == gen, bar);
            __builtin_amdgcn_fence(__ATOMIC_ACQUIRE, "agent");
            asm volatile("s_waitcnt vmcnt(0)" ::: "memory");
        }
    }
    __syncthreads();
}

#ifndef PG_ALIGN
#define PG_ALIGN true
#endif
namespace pg {
constexpr int BM = 256, BK = 64, HALF = 128, HTB = HALF * BK * 2, STAGE_BYTES = 8 * HTB, NXCD = 8, WGM = 8;
__host__ __device__ __forceinline__ int lds_byte(int r, int c) { const int st = (r >> 4) * 2 + (c >> 5), rr = r & 15, cc = c & 31, ob = rr * 64 + cc * 2; return st * 1024 + (ob ^ (((ob >> 9) & 1) << 5)); }
__host__ __device__ __forceinline__ void stage_rc(int b, int& R, int& C) { const int st = b / 1024, sb = b % 1024, swz = sb ^ (((sb >> 9) & 1) << 5); R = (st >> 1) * 16 + swz / 64; C = (st & 1) * 32 + (swz % 64) / 2; }
__host__ __device__ __forceinline__ int perm32(int rho) { const int n = rho >> 4, i = rho & 15; return 8 * (i >> 2) + 4 * n + (i & 3); }
struct Unit { int pm, pn, e, mt; };
__device__ __forceinline__ bool static_unit(long L, int nM, int nN, int& pm, int& pn) {
    const int nwg = nM * nN; if (L >= nwg) return false;
    int wgid = (int)L; { const int q = nwg / NXCD, r = nwg % NXCD, xcd = wgid % NXCD, off = wgid / NXCD; wgid = (xcd < r ? xcd * (q + 1) : r * (q + 1) + (xcd - r) * q) + off; }
    const int nig = WGM * nN, gid = wgid / nig, fm = gid * WGM, gsz = (nM - fm) < WGM ? (nM - fm) : WGM;
    pm = fm + ((wgid % nig) % gsz); pn = (wgid % nig) / gsz; return true;
}
typedef __bf16 bf16x2_hw __attribute__((ext_vector_type(2)));
__device__ __forceinline__ unsigned cvt_pk_bf16(float lo, float hi) { const bf16x2_hw b = __builtin_convertvector((f32x2){lo, hi}, bf16x2_hw); return __builtin_bit_cast(unsigned, b); }
__device__ __forceinline__ u32x4 pack8(const f32x4 v0, const f32x4 v1) { u32x4 w; w.x = cvt_pk_bf16(v0[0], v0[1]); w.y = cvt_pk_bf16(v0[2], v0[3]); w.z = cvt_pk_bf16(v1[0], v1[1]); w.w = cvt_pk_bf16(v1[2], v1[3]); return w; }
constexpr float YQ_SCALE = 32.0f, YQ_INV = 1.0f / 32.0f;
constexpr float WQ_SCALE = 64.0f, WQ_INV = 1.0f / 64.0f;
__device__ __forceinline__ uint2 pack8_fp8(const f32x4 v0, const f32x4 v1) { int a = 0, b = 0;
    a = __builtin_amdgcn_cvt_pk_fp8_f32(v0[0], v0[1], a, false); a = __builtin_amdgcn_cvt_pk_fp8_f32(v0[2], v0[3], a, true);
    b = __builtin_amdgcn_cvt_pk_fp8_f32(v1[0], v1[1], b, false); b = __builtin_amdgcn_cvt_pk_fp8_f32(v1[2], v1[3], b, true); return make_uint2((unsigned)a, (unsigned)b); }
#ifndef EPI_NT
#define EPI_NT 0
#endif
__device__ __forceinline__ void st16(void* p, const u32x4 v) { if (EPI_NT) __builtin_nontemporal_store(v, (u32x4*)p); else *(u32x4*)p = v; }
__device__ __forceinline__ void st16f(void* p, const f32x4 v) { if (EPI_NT) __builtin_nontemporal_store(v, (f32x4*)p); else *(f32x4*)p = v; }
__device__ __forceinline__ void st8(void* p, const uint2 v) { typedef unsigned u32x2 __attribute__((ext_vector_type(2))); const u32x2 w = {v.x, v.y}; if (EPI_NT) __builtin_nontemporal_store(w, (u32x2*)p); else *(u32x2*)p = w; }
__device__ __forceinline__ void unpack8(const u32x4 w, f32x4& v0, f32x4& v1) {
    v0[0] = __uint_as_float(w.x << 16); v0[1] = __uint_as_float(w.x & 0xffff0000u); v0[2] = __uint_as_float(w.y << 16); v0[3] = __uint_as_float(w.y & 0xffff0000u);
    v1[0] = __uint_as_float(w.z << 16); v1[1] = __uint_as_float(w.z & 0xffff0000u); v1[2] = __uint_as_float(w.w << 16); v1[3] = __uint_as_float(w.w & 0xffff0000u); }
__device__ __forceinline__ f32x2 gelu_pk(f32x2 v) {
    const f32x2 av = __builtin_elementwise_abs(v), d = av * 0.2316418882f + 1.0f;
    f32x2 t; t.x = __builtin_amdgcn_rcpf(d.x); t.y = __builtin_amdgcn_rcpf(d.y);
    f32x2 q = t * 0.5307027145f + (-0.7265760135f); q = q * t + 0.7107068705f; q = q * t + (-0.142248368f); q = q * t + 0.127414796f; q = q * t;
    const f32x2 s = (v * v) * (-0.72134752044f);
    f32x2 e; e.x = __builtin_amdgcn_exp2f(s.x); e.y = __builtin_amdgcn_exp2f(s.y);
    const f32x2 m = v * (q * e), r = v - m;
    f32x2 o; o.x = v.x < 0.f ? m.x : r.x; o.y = v.y < 0.f ? m.y : r.y; return o;
}
__device__ __forceinline__ f32x4 gelu4(f32x4 v) { const f32x2 a = gelu_pk((f32x2){v[0], v[1]}), b = gelu_pk((f32x2){v[2], v[3]}); return (f32x4){a.x, a.y, b.x, b.y}; }
__device__ __forceinline__ float sigm(float v) { return __builtin_amdgcn_rcpf(1.0f + __builtin_amdgcn_exp2f(v * -1.4426950408889634f)); }
__device__ __forceinline__ f32x4 sigm4(f32x4 v) { return (f32x4){sigm(v[0]), sigm(v[1]), sigm(v[2]), sigm(v[3])}; }

template <class Pol>
__device__ __forceinline__ void gemm_run(LAS unsigned char* lds, const Pol& P) {
    constexpr int KB = Pol::FP8 ? Pol::K : Pol::K * 2, nt = KB / (BK * 2);
    const int tid = threadIdx.x, wid = __builtin_amdgcn_readfirstlane(tid >> 6), lane = tid & 63, wr = wid >> 2, wc = wid & 3, fr = lane & 15, fq = lane >> 4;
    unsigned voffA[2], voffB[2]; int Rr[2], Cc[2];
#pragma unroll
    for (int i = 0; i < 2; ++i) { int R, C; stage_rc(tid * 16 + i * 8192, R, C); Rr[i] = R; Cc[i] = C; const int Rb = (R & ~31) + perm32(R & 31);
        voffA[i] = (unsigned)(R * KB + C * 2); voffB[i] = (unsigned)(Rb * KB + C * 2); }
    constexpr unsigned kstep = BK * 2, hstep = HALF * KB;
    const unsigned ldsw = (unsigned)wid * 1024u;
    const int aoff = lds_byte(wr * 64 + fr, fq * (Pol::FP8 ? 16 : 8)), boff = lds_byte(wc * 32 + fr, fq * (Pol::FP8 ? 16 : 8));
#define PG_SA(b, h) (((b) * 2 + (h)) * HTB)
#define PG_SB(b, h) ((4 + (b) * 2 + (h)) * HTB)
#define PG_AOFF(nx, h, i) (Pol::GATHER ? gC[h][i] : (voffA[i] + (unsigned)(h) * hstep))
#define PG_STAGE_A(bufoff, gbase, nx, h) do { _Pragma("unroll") for (int _i = 0; _i < 2; ++_i) \
        __builtin_amdgcn_global_load_lds((const unsigned*)((const char*)(gbase) + PG_AOFF(nx, h, _i)), (LAS unsigned*)(lds + (bufoff) + ldsw + _i * 8192), 16, 0, 0); } while (0)
#define PG_STAGE_B(bufoff, gbase) do { _Pragma("unroll") for (int _i = 0; _i < 2; ++_i) \
        __builtin_amdgcn_global_load_lds((const unsigned*)((const char*)(gbase) + voffB[_i]), (LAS unsigned*)(lds + (bufoff) + ldsw + _i * 8192), 16, 0, 0); } while (0)
#define PG_LD32(p) ({ const i32x4 _lo = *(const LAS i32x4*)(p), _hi = *(const LAS i32x4*)((p) + 16); (i32x8){_lo[0], _lo[1], _lo[2], _lo[3], _hi[0], _hi[1], _hi[2], _hi[3]}; })
#define PG_LDA(dst, b, h) do { if constexpr (Pol::FP8) { _Pragma("unroll") for (int m = 0; m < 4; ++m) dst##_8[m] = PG_LD32(lds + PG_SA(b, h) + aoff + m * 2048); } \
        else { _Pragma("unroll") for (int m = 0; m < 4; ++m) _Pragma("unroll") for (int k = 0; k < 2; ++k) dst[m][k] = *(const LAS bf16x8*)(lds + PG_SA(b, h) + aoff + m * 2048 + k * 1024); } } while (0)
#define PG_LDB(dst, b, h) do { if constexpr (Pol::FP8) { _Pragma("unroll") for (int n = 0; n < 2; ++n) dst##_8[n] = PG_LD32(lds + PG_SB(b, h) + boff + n * 2048); } \
        else { _Pragma("unroll") for (int n = 0; n < 2; ++n) _Pragma("unroll") for (int k = 0; k < 2; ++k) dst[n][k] = *(const LAS bf16x8*)(lds + PG_SB(b, h) + boff + n * 2048 + k * 1024); } } while (0)
#define PG_MMA(ai, bj, At, Bt) do { __builtin_amdgcn_s_setprio(1); \
        if constexpr (Pol::FP8) { _Pragma("unroll") for (int m = 0; m < 4; ++m) _Pragma("unroll") for (int n = 0; n < 2; ++n) \
            acc[ai][bj][m][n] = __builtin_amdgcn_mfma_scale_f32_16x16x128_f8f6f4(Bt##_8[n], At##_8[m], acc[ai][bj][m][n], 0, 0, 0, 0x7F7F7F7F, 0, 0x7F7F7F7F); } \
        else { _Pragma("unroll") for (int m = 0; m < 4; ++m) _Pragma("unroll") for (int n = 0; n < 2; ++n) _Pragma("unroll") for (int k = 0; k < 2; ++k) \
            acc[ai][bj][m][n] = __builtin_amdgcn_mfma_f32_16x16x32_bf16(Bt[n][k], At[m][k], acc[ai][bj][m][n], 0, 0, 0); } \
        __builtin_amdgcn_s_setprio(0); } while (0)
#define PG_WAIT_V(n) asm volatile("s_waitcnt vmcnt(" #n ")" ::: "memory")
#define PG_WAIT_L(n) asm volatile("s_waitcnt lgkmcnt(" #n ")" ::: "memory")
#define PG_BAR __builtin_amdgcn_s_barrier()
#define PG_SCHED __builtin_amdgcn_sched_barrier(0)
    Unit cur, nxt; int ui = 0;
    if (!P.next(0, cur)) return;
    f32x4 acc[2][2][4][2];
#pragma unroll
    for (int a = 0; a < 2; ++a)
#pragma unroll
        for (int b = 0; b < 2; ++b)
#pragma unroll
            for (int m = 0; m < 4; ++m)
#pragma unroll
                for (int n = 0; n < 2; ++n) acc[a][b][m][n] = (f32x4){0.f, 0.f, 0.f, 0.f};
    bf16x8 At[4][2], B0[2][2], B1[2][2];
    i32x8 At_8[4], B0_8[2], B1_8[2];
    unsigned gC[2][2] = {{0u, 0u}, {0u, 0u}};
    const char* cA = P.a_base(cur); const char* cB = P.b_base(cur);
    if constexpr (Pol::ROWTAB) { P.tab_issue(cur, 0); asm volatile("s_waitcnt vmcnt(0)" ::: "memory"); __builtin_amdgcn_s_barrier(); asm volatile("" ::: "memory"); }
    if constexpr (Pol::GATHER) P.a_offsets(cur, Rr, Cc, gC, 0);
    PG_STAGE_B(PG_SB(0, 0), cB); PG_STAGE_B(PG_SB(0, 1), cB + hstep); PG_STAGE_A(PG_SA(0, 0), cA, false, 0); PG_STAGE_A(PG_SA(0, 1), cA, false, 1);
    if (wr == 1) PG_BAR;
    PG_WAIT_V(2); PG_BAR;
    PG_STAGE_B(PG_SB(1, 0), cB + kstep); PG_STAGE_A(PG_SA(1, 0), cA + kstep, false, 0); PG_STAGE_B(PG_SB(1, 1), cB + hstep + kstep);
    PG_WAIT_V(6); PG_BAR;
    for (;;) {
        const bool has_next = P.next(ui + 1, nxt);
        const char* nA = has_next ? P.a_base(nxt) : cA; const char* nB = has_next ? P.b_base(nxt) : cB;
#pragma nounroll
        for (int t = 0; t < nt; t += 2) {
            const bool last = (t == nt - 2);
            if constexpr (Pol::ROWTAB) { if (t == 2 && has_next) P.tab_issue(nxt, (ui + 1) & 1); }
            if constexpr (Pol::HOOK) { if (t == Pol::H1 || t == Pol::H2) P.khook(t, acc, cur, wr, wc, fr, fq); }
            const char* a1 = cA + (size_t)(t + 1) * kstep;
            const char* a2 = last ? nA : cA + (size_t)(t + 2) * kstep; const char* b2 = last ? nB : cB + (size_t)(t + 2) * kstep;
            const char* a3 = a2 + kstep; const char* b3 = b2 + kstep;
            PG_LDB(B0, 0, 0); PG_LDB(B1, 0, 1); PG_SCHED; PG_LDA(At, 0, 0); PG_STAGE_A(PG_SA(1, 1), a1, false, 1);
            if constexpr (Pol::GATHER) { if (last && has_next) P.a_offsets(nxt, Rr, Cc, gC, (ui + 1) & 1); }
            PG_WAIT_V(8); PG_WAIT_L(0); PG_BAR; PG_MMA(0, 0, At, B0); PG_MMA(0, 1, At, B1); PG_BAR; PG_SCHED;
            PG_LDA(At, 0, 1); PG_STAGE_B(PG_SB(0, 0), b2); PG_STAGE_B(PG_SB(0, 1), b2 + hstep); PG_STAGE_A(PG_SA(0, 0), a2, last, 0);
            PG_WAIT_V(8); PG_WAIT_L(0); PG_BAR; PG_MMA(1, 0, At, B0); PG_MMA(1, 1, At, B1); PG_BAR; PG_SCHED;
            PG_LDB(B0, 1, 0); PG_LDB(B1, 1, 1); PG_SCHED; PG_LDA(At, 1, 0); PG_STAGE_A(PG_SA(0, 1), a2, last, 1);
            PG_WAIT_V(8); PG_WAIT_L(0); PG_BAR; PG_MMA(0, 0, At, B0); PG_MMA(0, 1, At, B1); PG_BAR; PG_SCHED;
            PG_LDA(At, 1, 1); PG_STAGE_B(PG_SB(1, 0), b3); PG_STAGE_B(PG_SB(1, 1), b3 + hstep); PG_STAGE_A(PG_SA(1, 0), a3, last, 0);
            PG_WAIT_V(8); PG_WAIT_L(0); PG_BAR; PG_MMA(1, 0, At, B0); PG_MMA(1, 1, At, B1); PG_BAR; PG_SCHED;
        }
        if constexpr (PG_ALIGN) { if (wr == 0) PG_BAR; }
        P.epi(acc, cur, wr, wc, fr, fq, ui & 1);
#ifdef DUP_EPI
        if (Pol::K == DUP_EPI_K) { asm volatile("" ::: "memory"); P.epi(acc, cur, wr, wc, fr, fq, ui & 1); }
#endif
        if (!has_next) break;
#pragma unroll
        for (int a = 0; a < 2; ++a)
#pragma unroll
            for (int b = 0; b < 2; ++b)
#pragma unroll
                for (int m = 0; m < 4; ++m)
#pragma unroll
                    for (int n = 0; n < 2; ++n) acc[a][b][m][n] = (f32x4){0.f, 0.f, 0.f, 0.f};
        cur = nxt; cA = nA; cB = nB; ++ui;
        if constexpr (PG_ALIGN) { if (wr == 1) PG_BAR; }
    }
    PG_WAIT_V(0);
    if constexpr (!PG_ALIGN) { if (wr == 0) PG_BAR; }
    PG_BAR;
#undef PG_SA
#undef PG_SB
#undef PG_AOFF
#undef PG_STAGE_A
#undef PG_STAGE_B
#undef PG_LDA
#undef PG_LD32
#undef PG_LDB
#undef PG_MMA
#undef PG_WAIT_V
#undef PG_WAIT_L
#undef PG_BAR
#undef PG_SCHED
}

__device__ __forceinline__ void glds4_asm(const void* gsrc, unsigned lds_dst) { unsigned keep;
    asm volatile("s_mov_b32 %0, m0\n\ts_mov_b32 m0, %2\n\ts_nop 0\n\tglobal_load_lds_dword %1, off\n\ts_mov_b32 m0, %0" : "=&s"(keep) : "v"(gsrc), "s"(lds_dst) : "memory"); }
__device__ __forceinline__ void glds16_asm(const void* gsrc, unsigned lds_dst) { unsigned keep;
    asm volatile("s_mov_b32 %0, m0\n\ts_mov_b32 m0, %2\n\ts_nop 0\n\tglobal_load_lds_dwordx4 %1, off\n\ts_mov_b32 m0, %0" : "=&s"(keep) : "v"(gsrc), "s"(lds_dst) : "memory"); }
struct PolBase { static constexpr bool GATHER = false, HOOK = false, FP8 = false, ROWTAB = false;
    __device__ __forceinline__ void tab_issue(const Unit&, int) const {} static constexpr int H1 = -1, H2 = -1;
    __device__ __forceinline__ void a_offsets(const Unit&, const int (&)[2], const int (&)[2], unsigned (&)[2][2], int) const {}
    __device__ __forceinline__ void khook(int, f32x4 (&)[2][2][4][2], const Unit&, int, int, int, int) const {} };

constexpr int GQ_OFF = OFF_G * 2;
__device__ __forceinline__ void gq_unpack(const uint2 w, f32x4& g0, f32x4& g1) {
    g0 = (f32x4){(float)(w.x & 0xffu), (float)((w.x >> 8) & 0xffu), (float)((w.x >> 16) & 0xffu), (float)(w.x >> 24)} * (1.0f / 256.0f) + (0.5f / 256.0f);
    g1 = (f32x4){(float)(w.y & 0xffu), (float)((w.y >> 8) & 0xffu), (float)((w.y >> 16) & 0xffu), (float)(w.y >> 24)} * (1.0f / 256.0f) + (0.5f / 256.0f); }
#ifndef P1_FP8_TILES
#define P1_FP8_TILES 0xFFFF0Cu
#endif
static_assert((P1_FP8_TILES & 0xF0u) == 0u, "the q_b / k_b tiles (head rmsnorm, block selection) stay bf16");
static_assert((P1_FP8_TILES & 0xFFF000u) == 0xFFF000u, "the gate tiles are written (as 8-bit codes) by the fp8 policy only");
static_assert((P1_FP8_TILES | 0xFFu) == 0xFFFFFFu, "bf16 weight rows are only prepared for column tiles 0..7");
constexpr int p1_popc(unsigned m) { int n = 0; for (int t = 0; t < 24; ++t) n += (m >> t) & 1u; return n; }
constexpr int P1_NF8 = p1_popc(P1_FP8_TILES), P1_NBF = 24 - P1_NF8;
__device__ __forceinline__ int p1_tile(unsigned mask, int j) { int t = 0;
    for (; t < 24; ++t) if ((mask >> t) & 1u) { if (j == 0) break; --j; }
    return t; }
struct PolP1 : PolBase {
    static constexpr int K = 1024;
    const bf16_t* A; const bf16_t* Bt; bf16_t* PROJ; float* KMP; const float* gq; const float* gk; int G, c;
    __device__ __forceinline__ bool next(int i, Unit& u) const { u.e = 0; u.mt = 0; if (!static_unit((long)i * G + c, T_TOK / 256, P1_NBF, u.pm, u.pn)) return false; u.pn = p1_tile(P1_FP8_TILES ^ 0xFFFFFFu, u.pn); return true; }
    __device__ __forceinline__ const char* a_base(const Unit& u) const { return (const char*)A + (size_t)u.pm * 256 * K * 2; }
    __device__ __forceinline__ const char* b_base(const Unit& u) const { return (const char*)Bt + (size_t)u.pn * 256 * K * 2; }
    __device__ __forceinline__ void epi(const f32x4 (&acc)[2][2][4][2], const Unit& u, int wr, int wc, int fr, int fq, int) const {
        const int row0 = u.pm * 256 + wr * 64 + fr, pn = u.pn;
        if (pn >= 4 && pn < 8) {
            const float* g = (pn < 6) ? gq : gk;
            f32x4 gv[2][2], cs[2][2];
#pragma unroll
            for (int bj = 0; bj < 2; ++bj)
#pragma unroll
                for (int n = 0; n < 2; ++n) { gv[bj][n] = *(const f32x4*)(g + 32 * bj + 8 * fq + 4 * n); cs[bj][n] = (f32x4){0.f, 0.f, 0.f, 0.f}; }
#pragma unroll
            for (int ai = 0; ai < 2; ++ai)
#pragma unroll
                for (int m = 0; m < 4; ++m) {
                    float ss = 0.f;
#pragma unroll
                    for (int bj = 0; bj < 2; ++bj)
#pragma unroll
                        for (int n = 0; n < 2; ++n) { const f32x4 x = acc[ai][bj][m][n]; ss += (x[0] * x[0] + x[1] * x[1]) + (x[2] * x[2] + x[3] * x[3]); }
                    ss += __shfl_xor(ss, 16); ss += __shfl_xor(ss, 32);
                    const float rstd = rsqrtf(ss * (1.0f / 64.0f) + EPS) * ((pn < 6) ? 0.18033688011112042f : 1.0f);
                    bf16_t* rowp = PROJ + (size_t)(row0 + ai * HALF + m * 16) * INW + 1024 + (pn - 4) * 256 + 64 * wc + 8 * fq;
#pragma unroll
                    for (int bj = 0; bj < 2; ++bj) { const f32x4 v0 = acc[ai][bj][m][0] * rstd * gv[bj][0], v1 = acc[ai][bj][m][1] * rstd * gv[bj][1];
                        cs[bj][0] += v0; cs[bj][1] += v1; st16(rowp + 32 * bj, pack8(v0, v1)); }
                }
            if (pn >= 6) {
#pragma unroll
                for (int bj = 0; bj < 2; ++bj)
#pragma unroll
                    for (int n = 0; n < 2; ++n)
#pragma unroll
                        for (int j = 0; j < 4; ++j) { float s = cs[bj][n][j]; s += __shfl_xor(s, 1); s += __shfl_xor(s, 2); s += __shfl_xor(s, 4); s += __shfl_xor(s, 8); cs[bj][n][j] = s; }
                if (fr == 0) {
                    float* kp = KMP + ((size_t)u.pm * 2 + wr) * 512 + (pn - 6) * 256 + 64 * wc + 8 * fq;
#pragma unroll
                    for (int bj = 0; bj < 2; ++bj) { *(f32x4*)(kp + 32 * bj) = cs[bj][0]; *(f32x4*)(kp + 32 * bj + 4) = cs[bj][1]; }
                }
            }
        } else {
            const int col0 = pn * 256 + wc * 32 + 8 * fq;
#pragma unroll
            for (int ai = 0; ai < 2; ++ai)
#pragma unroll
                for (int m = 0; m < 4; ++m) { bf16_t* rowp = PROJ + (size_t)(row0 + ai * HALF + m * 16) * INW + col0;
#pragma unroll
                    for (int bj = 0; bj < 2; ++bj) { f32x4 v0 = acc[ai][bj][m][0], v1 = acc[ai][bj][m][1];
                        if (pn < 4) { v0 = gelu4(v0); v1 = gelu4(v1); } else if (pn >= 12) { v0 = sigm4(v0); v1 = sigm4(v1); }
                        st16(rowp + bj * HALF, pack8(v0, v1)); } }
        }
    }
};

struct PolP1G : PolBase {
    static constexpr int K = 1024; static constexpr bool FP8 = true, GATHER = true;
    const unsigned char* A; const unsigned char* Bt; bf16_t* PROJ; int G, c;
    __device__ __forceinline__ bool next(int i, Unit& u) const { u.e = 0; u.mt = 0; constexpr int NU = T_TOK / 256 * P1_NF8; long L = (long)i * G + c;
        if (G == 256 && NU % 256 == 0 && NU / 256 >= 2) { constexpr int R = NU / 256; if (i < R - 1) L = (long)i * 256 + c; else if (c >= 128 && i < R + 1) L = (long)(R - 1) * 256 + (i - (R - 1)) * 128 + (c - 128); else return false; }
        if (!static_unit(L, T_TOK / 256, P1_NF8, u.pm, u.pn)) return false; u.pn = p1_tile(P1_FP8_TILES, u.pn); return true; }
    __device__ __forceinline__ const char* a_base(const Unit&) const { return (const char*)A; }
    __device__ __forceinline__ const char* b_base(const Unit& u) const { return (const char*)Bt + (size_t)u.pn * 256 * K; }
    __device__ __forceinline__ void a_offsets(const Unit& u, const int (&Rr)[2], const int (&Cc)[2], unsigned (&g)[2][2], int) const {
#pragma unroll
        for (int h = 0; h < 2; ++h)
#pragma unroll
            for (int i = 0; i < 2; ++i) g[h][i] = (unsigned)(u.pm * 256 + h * HALF + Rr[i]) * (unsigned)K + (unsigned)Cc[i] * 2u;
    }
    __device__ __forceinline__ void epi(const f32x4 (&acc)[2][2][4][2], const Unit& u, int wr, int wc, int fr, int fq, int) const {
        const int row0 = u.pm * 256 + wr * 64 + fr, pn = u.pn, col0 = pn * 256 + wc * 32 + 8 * fq;
        if (pn >= 12) {
#pragma unroll
            for (int ai = 0; ai < 2; ++ai)
#pragma unroll
                for (int m = 0; m < 4; ++m) { unsigned char* rowq = (unsigned char*)PROJ + (size_t)(row0 + ai * HALF + m * 16) * (INW * 2) + GQ_OFF + (col0 - OFF_G);
#pragma unroll
                    for (int bj = 0; bj < 2; ++bj) { unsigned w[2] = {0u, 0u};
#pragma unroll
                        for (int n = 0; n < 2; ++n)
#pragma unroll
                            for (int j = 0; j < 4; ++j) { const float g = __builtin_amdgcn_rcpf(1.0f + __builtin_amdgcn_exp2f(acc[ai][bj][m][n][j] * (-1.4426950408889634f * WQ_INV)));
                                w[n] = __builtin_amdgcn_cvt_pk_u8_f32(__builtin_floorf(g * 256.0f), j, w[n]); }
                        st8(rowq + bj * HALF, make_uint2(w[0], w[1])); } }
        } else {
#pragma unroll
            for (int ai = 0; ai < 2; ++ai)
#pragma unroll
                for (int m = 0; m < 4; ++m) { bf16_t* rowp = PROJ + (size_t)(row0 + ai * HALF + m * 16) * INW + col0;
#pragma unroll
                    for (int bj = 0; bj < 2; ++bj) { f32x4 v0 = acc[ai][bj][m][0] * WQ_INV, v1 = acc[ai][bj][m][1] * WQ_INV;
                        if (pn < 4) { v0 = gelu4(v0); v1 = gelu4(v1); }
                        st16(rowp + bj * HALF, pack8(v0, v1)); } }
        }
    }
};
struct PolP3 : PolBase {
    static constexpr int K = 1536; static constexpr bool HOOK = true; static constexpr int H1 = 8, H2 = 16;
    const bf16_t* A; const bf16_t* Bt; const bf16_t* PROJ; bf16_t* MERGED; int G, c;
    __device__ __forceinline__ bool next(int i, Unit& u) const { u.e = 0; u.mt = 0; return static_unit((long)i * G + c, T_TOK / 256, DM / 256, u.pm, u.pn); }
    __device__ __forceinline__ const char* a_base(const Unit& u) const { return (const char*)A + (size_t)u.pm * 256 * K * 2; }
    __device__ __forceinline__ const char* b_base(const Unit& u) const { return (const char*)Bt + (size_t)u.pn * 256 * K * 2; }
    __device__ __forceinline__ void khook(int t, f32x4 (&acc)[2][2][4][2], const Unit& u, int wr, int wc, int fr, int fq) const {
        const int gnum = (t == 8) ? 0 : 1024;
        int zero = 0; asm volatile("" : "+v"(zero));
        const int row0 = u.pm * 256 + wr * 64 + fr + zero, col0 = GQ_OFF + u.pn * 256 + wc * 32 + 8 * fq;
#pragma unroll
        for (int ai = 0; ai < 2; ++ai) {
            uint2 wn[4][2], wd[4][2];
#pragma unroll
            for (int m = 0; m < 4; ++m) { const unsigned char* rowp = (const unsigned char*)PROJ + (size_t)(row0 + ai * HALF + m * 16) * (INW * 2) + col0;
#pragma unroll
                for (int bj = 0; bj < 2; ++bj) { wn[m][bj] = *(const uint2*)(rowp + gnum + bj * HALF); wd[m][bj] = *(const uint2*)(rowp + gnum + 1024 + bj * HALF); } }
#pragma unroll
            for (int m = 0; m < 4; ++m)
#pragma unroll
                for (int bj = 0; bj < 2; ++bj) { f32x4 n0, n1, d0, d1; gq_unpack(wn[m][bj], n0, n1); gq_unpack(wd[m][bj], d0, d1);
#pragma unroll
                    for (int j = 0; j < 4; ++j) { acc[ai][bj][m][0][j] *= n0[j] * __builtin_amdgcn_rcpf(d0[j]); acc[ai][bj][m][1][j] *= n1[j] * __builtin_amdgcn_rcpf(d1[j]); } }
            asm volatile("" ::: "memory");
        }
    }
    __device__ __forceinline__ void epi(const f32x4 (&acc)[2][2][4][2], const Unit& u, int wr, int wc, int fr, int fq, int) const {
        const int row0 = u.pm * 256 + wr * 64 + fr, colt = u.pn * 256 + wc * 32 + 8 * fq;
#pragma unroll
        for (int ai = 0; ai < 2; ++ai)
#pragma unroll
            for (int m = 0; m < 4; ++m) { const size_t r = (size_t)(row0 + ai * HALF + m * 16);
#pragma unroll
                for (int bj = 0; bj < 2; ++bj) { const uint2 wg = *(const uint2*)((const unsigned char*)PROJ + r * (INW * 2) + GQ_OFF + 2048 + colt + bj * HALF); f32x4 g0, g1; gq_unpack(wg, g0, g1);
                    st16(MERGED + r * DM + colt + bj * HALF, pack8(acc[ai][bj][m][0] * g0, acc[ai][bj][m][1] * g1)); }
                if (m == 3) asm volatile("" ::: "memory"); }
    }
};
struct PolP4 : PolBase {
    static constexpr int K = 1024;
    const bf16_t* A; const bf16_t* Bt; const float* x; bf16_t* X1H; unsigned char* X1Q; const float* gffn; int G, c;
    __device__ __forceinline__ bool next(int i, Unit& u) const { u.e = 0; u.mt = 0; return static_unit((long)i * G + c, T_TOK / 256, DM / 256, u.pm, u.pn); }
    __device__ __forceinline__ const char* a_base(const Unit& u) const { return (const char*)A + (size_t)u.pm * 256 * K * 2; }
    __device__ __forceinline__ const char* b_base(const Unit& u) const { return (const char*)Bt + (size_t)u.pn * 256 * K * 2; }
    __device__ __forceinline__ void epi(const f32x4 (&acc)[2][2][4][2], const Unit& u, int wr, int wc, int fr, int fq, int) const {
        const int row0 = u.pm * 256 + wr * 64 + fr, colt = u.pn * 256 + wc * 32 + 8 * fq;
#pragma unroll
        for (int ai = 0; ai < 2; ++ai)
#pragma unroll
            for (int m = 0; m < 4; ++m) { const size_t o = (size_t)(row0 + ai * HALF + m * 16) * DM + colt;
#pragma unroll
                for (int bj = 0; bj < 2; ++bj) { const f32x4 x0 = *(const f32x4*)(x + o + bj * HALF), x1 = *(const f32x4*)(x + o + bj * HALF + 4);
                    const f32x4 v0 = x0 + acc[ai][bj][m][0], v1 = x1 + acc[ai][bj][m][1];
                    st16(X1H + o + bj * HALF, pack8(v0, v1));
                    const f32x4 g0 = *(const f32x4*)(gffn + colt + bj * HALF), g1 = *(const f32x4*)(gffn + colt + bj * HALF + 4);
                    st8(X1Q + o + bj * HALF, pack8_fp8(v0 * g0, v1 * g1)); }
                if (m & 1) asm volatile("" ::: "memory"); }
    }
};
struct GroupTab { const LAS int* tab; __device__ __forceinline__ int cnt(int e) const { return tab[TAB_CNT + e]; } __device__ __forceinline__ int tstart(int e) const { return tab[TAB_TST + e]; }
    __device__ __forceinline__ int tile_e(int vt) const { return tab[TAB_TE + vt]; } __device__ __forceinline__ int NT() const { return tab[TAB_TST + 32]; } };
struct PolP6 : PolBase {
    static constexpr int K = 1024; static constexpr bool GATHER = true, FP8 = true, ROWTAB = true;
    const unsigned char* X1Q; const unsigned char* W1Q; const int* LIST; const float* RSTDS; const float* b1; unsigned char* ACTQ; GroupTab tb; int G, c; LAS unsigned char* rtab;
    __device__ __forceinline__ void tab_issue(const Unit& u, int buf) const {
        const int tid = threadIdx.x;
        if (tid < 256) { const int valid = tb.cnt(u.e) - u.mt * 256, rc = tid < valid ? tid : 0; const size_t o = (size_t)u.e * 32768 + u.mt * 256 + rc;
            const unsigned dst = (unsigned)__builtin_amdgcn_readfirstlane((int)((unsigned)(size_t)rtab + buf * RT_STRIDE + (tid & ~63) * 4));
            glds4_asm(LIST + o, dst); glds4_asm(RSTDS + o, dst + 1024u);
            glds4_asm(b1 + (size_t)u.e * 2048 + u.pn * 128 + (tid < 128 ? tid : 1024 + (tid - 128)), dst + 2048u); }
    }
    __device__ __forceinline__ bool next(int i, Unit& u) const { if (!static_unit((long)i * G + c, tb.NT(), 8, u.pm, u.pn)) return false; u.e = tb.tile_e(u.pm); u.mt = u.pm - tb.tstart(u.e); return true; }
    __device__ __forceinline__ const char* a_base(const Unit&) const { return (const char*)X1Q; }
    __device__ __forceinline__ const char* b_base(const Unit& u) const { return (const char*)W1Q + ((size_t)u.e * 2048 + (size_t)u.pn * 256) * K; }
    __device__ __forceinline__ void a_offsets(const Unit&, const int (&Rr)[2], const int (&Cc)[2], unsigned (&g)[2][2], int buf) const {
        const LAS int* lp = (const LAS int*)(rtab + buf * RT_STRIDE);
#pragma unroll
        for (int h = 0; h < 2; ++h)
#pragma unroll
            for (int i = 0; i < 2; ++i) { const int tok = lp[h * HALF + Rr[i]] >> 2; g[h][i] = (unsigned)tok * (unsigned)K + (unsigned)Cc[i] * 2u; }
    }
    __device__ __forceinline__ void epi(const f32x4 (&acc)[2][2][4][2], const Unit& u, int wr, int wc, int fr, int fq, int buf) const {
        int zero = 0; asm volatile("" : "+v"(zero)); fr += zero;
        const int valid = tb.cnt(u.e) - u.mt * 256, colg = u.pn * 128 + wc * 32 + 8 * fq;
        const LAS float* rp = (const LAS float*)(rtab + buf * RT_STRIDE + 1024); const LAS float* bp = (const LAS float*)(rtab + buf * RT_STRIDE + 2048) + wc * 32 + 8 * fq;
        const f32x4 bg0 = *(const LAS f32x4*)bp, bg1 = *(const LAS f32x4*)(bp + 4), bl0 = *(const LAS f32x4*)(bp + 128), bl1 = *(const LAS f32x4*)(bp + 132);
        float rsv[8];
#pragma unroll
        for (int i = 0; i < 8; ++i) rsv[i] = rp[(i >> 2) * HALF + wr * 64 + (i & 3) * 16 + fr];
#pragma unroll
        for (int i = 0; i < 8; ++i) { const int ai = i >> 2, m = i & 3, r = ai * HALF + wr * 64 + m * 16 + fr; const float rs = (r < valid) ? rsv[i] * WQ_INV : 0.f;
            f32x4 o[2];
#pragma unroll
            for (int n = 0; n < 2; ++n) { const f32x4 gv = acc[ai][0][m][n] * rs + (n ? bg1 : bg0), lv = acc[ai][1][m][n] * rs + (n ? bl1 : bl0);
                f32x4 gg, ll, d;
#pragma unroll
                for (int j = 0; j < 4; ++j) { gg[j] = fminf(gv[j], 7.0f); ll[j] = __builtin_amdgcn_fmed3f(lv[j], -7.0f, 7.0f); }
                const f32x4 e = gg * (-1.702f * 1.4426950408889634f);
#pragma unroll
                for (int j = 0; j < 4; ++j) d[j] = __builtin_amdgcn_exp2f(e[j]);
                d = d + 1.0f;
#pragma unroll
                for (int j = 0; j < 4; ++j) d[j] = __builtin_amdgcn_rcpf(d[j]);
                const f32x4 t = gg * d;
                o[n] = t * ll + t; }
            st8(ACTQ + (size_t)(u.pm * 256 + r) * DFF + colg, pack8_fp8(o[0], o[1])); }
    }
};
struct PolP7 : PolBase {
    static constexpr int K = 1024; static constexpr bool FP8 = true, GATHER = true;
    const unsigned char* ACTQ; const unsigned char* W2Q; const int* LIST; const float* TOPWS; const float* b2; bf16_t* YS; GroupTab tb; int G, c; LAS unsigned char* rtab;
    static constexpr bool ROWTAB = true;
    __device__ __forceinline__ void tab_issue(const Unit& u, int buf) const {
        const int tid = threadIdx.x;
        if (tid < 256) { const int valid = tb.cnt(u.e) - u.mt * 256, rc = tid < valid ? tid : 0; const size_t o = (size_t)u.e * 32768 + u.mt * 256 + rc;
            const unsigned dst = (unsigned)__builtin_amdgcn_readfirstlane((int)((unsigned)(size_t)rtab + buf * RT_STRIDE + (tid & ~63) * 4));
            glds4_asm(LIST + o, dst); glds4_asm(TOPWS + o, dst + 1024u);
            glds4_asm(b2 + (size_t)u.e * 1024 + u.pn * 256 + tid, dst + 2048u); }
    }
    __device__ __forceinline__ bool next(int i, Unit& u) const { if (!static_unit((long)i * G + c, tb.NT(), 4, u.pm, u.pn)) return false; u.e = tb.tile_e(u.pm); u.mt = u.pm - tb.tstart(u.e); return true; }
    __device__ __forceinline__ const char* a_base(const Unit&) const { return (const char*)ACTQ; }
    __device__ __forceinline__ void a_offsets(const Unit& u, const int (&Rr)[2], const int (&Cc)[2], unsigned (&g)[2][2], int) const {
#pragma unroll
        for (int h = 0; h < 2; ++h)
#pragma unroll
            for (int i = 0; i < 2; ++i) g[h][i] = (unsigned)(u.pm * 256 + h * HALF + Rr[i]) * (unsigned)K + (unsigned)Cc[i] * 2u;
    }
    __device__ __forceinline__ const char* b_base(const Unit& u) const { return (const char*)W2Q + ((size_t)u.e * 1024 + (size_t)u.pn * 256) * K; }
    __device__ __forceinline__ void epi(const f32x4 (&acc)[2][2][4][2], const Unit& u, int wr, int wc, int fr, int fq, int buf) const {
        int zero = 0; asm volatile("" : "+v"(zero)); fr += zero;
        const int valid = tb.cnt(u.e) - u.mt * 256, colt = u.pn * 256 + wc * 32 + 8 * fq;
        const LAS float* bp = (const LAS float*)(rtab + buf * RT_STRIDE + 2048) + wc * 32 + 8 * fq; const LAS int* lp = (const LAS int*)(rtab + buf * RT_STRIDE); const LAS float* wp = (const LAS float*)(rtab + buf * RT_STRIDE + 1024);
        int slot[8]; float wv[8];
#pragma unroll
        for (int i = 0; i < 8; ++i) { const int r = (i >> 2) * HALF + wr * 64 + (i & 3) * 16 + fr; const bool ok = r < valid; const int rc = ok ? r : 0; const int sl = lp[rc]; wv[i] = wp[rc]; slot[i] = ok ? sl : -1; }
        f32x4 bv[2][2];
#pragma unroll
        for (int bj = 0; bj < 2; ++bj) { bv[bj][0] = *(const LAS f32x4*)(bp + bj * HALF); bv[bj][1] = *(const LAS f32x4*)(bp + bj * HALF + 4); }
#pragma unroll
        for (int i = 0; i < 8; ++i) { const int ai = i >> 2, m = i & 3;
            if (slot[i] >= 0) { const float w = wv[i] * YQ_SCALE, wq = w * WQ_INV;
#pragma unroll
                for (int bj = 0; bj < 2; ++bj) st8((unsigned char*)YS + (size_t)slot[i] * DM + colt + bj * HALF, pack8_fp8(acc[ai][bj][m][0] * wq + bv[bj][0] * w, acc[ai][bj][m][1] * wq + bv[bj][1] * w)); } }
    }
};
}

__device__ __forceinline__ void grouped_setup(LAS int* tab, const unsigned* cnt) {
    const int tid = threadIdx.x;
    if (tid < 32) tab[TAB_CNT + tid] = (int)__hip_atomic_load(cnt + tid, __ATOMIC_RELAXED, __HIP_MEMORY_SCOPE_AGENT);
    __syncthreads();
    if (tid == 0) { int s = 0; for (int e = 0; e < 32; ++e) { tab[TAB_TST + e] = s; s += (tab[TAB_CNT + e] + 255) >> 8; } tab[TAB_TST + 32] = s; }
    __syncthreads();
    const int NT = tab[TAB_TST + 32];
    for (int vt = tid; vt < NT; vt += NWAVES * 64) { int e = 0; for (int k = 1; k < 32; ++k) if (tab[TAB_TST + k] <= vt) e = k; tab[TAB_TE + vt] = e; }
    __syncthreads();
}

__device__ __forceinline__ void lds_fence() { asm volatile("s_waitcnt lgkmcnt(0)" ::: "memory"); }
template <int MAPK> __device__ __forceinline__ int p0_map(int n) {
    if (MAPK == 1) return (n >= 1024 && n < 2048) ? (n & ~255) + 128 * ((n >> 5) & 1) + 32 * ((n >> 6) & 3) + (n & 31) : n;
    if (MAPK == 2) { const int m = n & 1023; return (m >> 7) * 256 + (n >> 10) * 128 + (m & 127); }
    return n;
}
template <int MAPK, bool Q8 = false> __device__ __forceinline__ void p0_transpose_item(const float* W, int N, bf16_t* WT, int ldo, int koff, const float* gk, LAS float* scr, int item, int lane, int nblk_ = 0) {
    const int nblk = nblk_ ? nblk_ : N / 32, kb = item / nblk, nb = item % nblk, k0 = 64 * kb, n0 = 32 * nb;
    float tv[32];
#pragma unroll
    for (int i = 0; i < 32; ++i) tv[i] = __builtin_nontemporal_load(W + (size_t)(k0 + 2 * i + (lane >> 5)) * N + n0 + (lane & 31));
    if (gk) {
#pragma unroll
        for (int i = 0; i < 32; ++i) tv[i] *= gk[k0 + 2 * i + (lane >> 5)];
    }
#pragma unroll
    for (int i = 0; i < 32; ++i) scr[(2 * i + (lane >> 5)) * 33 + (lane & 31)] = tv[i];
    lds_fence();
    const int c8 = lane & 7;
#pragma unroll
    for (int j = 0; j < 4; ++j) { const int n = (lane >> 3) + 8 * j; const LAS float* s = scr + (8 * c8) * 33 + n;
        if constexpr (Q8) {
            const f32x4 a = (f32x4){s[0 * 33], s[1 * 33], s[2 * 33], s[3 * 33]} * pg::WQ_SCALE, b = (f32x4){s[4 * 33], s[5 * 33], s[6 * 33], s[7 * 33]} * pg::WQ_SCALE;
            *(uint2*)((unsigned char*)WT + (size_t)p0_map<MAPK>(n0 + n) * ldo + koff + k0 + 8 * c8) = pg::pack8_fp8(a, b);
        } else {
        u32x4 o; o.x = pg::cvt_pk_bf16(s[0 * 33], s[1 * 33]); o.y = pg::cvt_pk_bf16(s[2 * 33], s[3 * 33]); o.z = pg::cvt_pk_bf16(s[4 * 33], s[5 * 33]); o.w = pg::cvt_pk_bf16(s[6 * 33], s[7 * 33]);
        *(u32x4*)(WT + (size_t)p0_map<MAPK>(n0 + n) * ldo + koff + k0 + 8 * c8) = o; } }
    lds_fence();
}
__device__ __forceinline__ void p0_rmsnorm_row(const float* xrow, const float* g, bf16_t* orow, int lane) {
    const f32x4* xr = (const f32x4*)xrow;
    f32x4 v[4]; float s = 0.f;
#pragma unroll
    for (int j = 0; j < 4; ++j) { v[j] = xr[lane + 64 * j]; s += (v[j].x * v[j].x + v[j].y * v[j].y) + (v[j].z * v[j].z + v[j].w * v[j].w); }
    const float rstd = rsqrtf(wave_sum(s) * (1.0f / DM) + EPS);
#pragma unroll
    for (int j = 0; j < 4; ++j) { const f32x4 gv = ((const f32x4*)g)[lane + 64 * j];
        unsigned long long o = (unsigned long long)pg::cvt_pk_bf16(v[j].x * rstd * gv.x, v[j].y * rstd * gv.y) | ((unsigned long long)pg::cvt_pk_bf16(v[j].z * rstd * gv.z, v[j].w * rstd * gv.w) << 32);
        ((unsigned long long*)orow)[lane + 64 * j] = o; }
}
struct P0Args { const float *x, *mem, *g_mix, *g_mem, *w_in, *w_br0, *w_br1, *w_br2, *w_out, *w_mem_kv, *w_gate_up, *w_down, *g_ffn, *w_router, *w_spatial;
    bf16_t *HB, *MEMN, *WinT, *WbrT, *WoutT, *WmemT, *W1T, *W2T, *WSB; float* WrT; unsigned char *HBQ, *WINQ; };
__device__ __forceinline__ void p0_prologue(const P0Args a, LAS unsigned char* lds, int G, int c) {
    const int tid = threadIdx.x, lane = tid & 63, wave = __builtin_amdgcn_readfirstlane(tid >> 6);
    LAS float* scr = (LAS float*)(lds + wave * 16384);
    const int gw = c * NWAVES + wave, NGW = G * NWAVES;
    constexpr int I_IN = 16 * 64, I_G = 16 * 192, I_BR = 8 * 32, I_O = 16 * 32, I_1 = 16 * 64, I_2 = 16 * 32;
    constexpr int NITEMS = I_IN + I_G + 3 * I_BR + 2 * I_O;
    for (int it = gw; it < NITEMS; it += NGW) {
        int r = it;
        if (r < I_IN) { p0_transpose_item<1>(a.w_in, INW, a.WinT, DM, 0, nullptr, scr, r, lane, 64); continue; } r -= I_IN;
        if (r < I_G) { p0_transpose_item<0, true>(a.w_in, INW, (bf16_t*)a.WINQ, DM, 0, nullptr, scr, r, lane); continue; } r -= I_G;
        if (r < 3 * I_BR) { const int br = r / I_BR; const float* wsrc = (br == 0) ? a.w_br0 : (br == 1) ? a.w_br1 : a.w_br2; p0_transpose_item<0>(wsrc, DM, a.WbrT, 1536, br * 512, nullptr, scr, r - br * I_BR, lane); continue; } r -= 3 * I_BR;
        if (r < I_O) { p0_transpose_item<0>(a.w_out, DM, a.WoutT, DM, 0, nullptr, scr, r, lane); continue; } r -= I_O;
        p0_transpose_item<0>(a.w_mem_kv, DM, a.WmemT, DM, 0, nullptr, scr, r, lane);
    }
    for (int m = gw; m < T_TOK; m += 2 * NGW) {
        const int m2 = (m + NGW < T_TOK) ? m + NGW : m;
        const f32x4* xa = (const f32x4*)(a.x + (size_t)m * DM); const f32x4* xb = (const f32x4*)(a.x + (size_t)m2 * DM);
        f32x4 va[4], vb[4]; float sa = 0.f, sb = 0.f;
#pragma unroll
        for (int j = 0; j < 4; ++j) { va[j] = __builtin_nontemporal_load(xa + lane + 64 * j); vb[j] = __builtin_nontemporal_load(xb + lane + 64 * j); }
#pragma unroll
        for (int j = 0; j < 4; ++j) { sa += (va[j].x * va[j].x + va[j].y * va[j].y) + (va[j].z * va[j].z + va[j].w * va[j].w); sb += (vb[j].x * vb[j].x + vb[j].y * vb[j].y) + (vb[j].z * vb[j].z + vb[j].w * vb[j].w); }
        const float ra = rsqrtf(wave_sum(sa) * (1.0f / DM) + EPS), rb = rsqrtf(wave_sum(sb) * (1.0f / DM) + EPS);
#pragma unroll
        for (int j = 0; j < 4; ++j) { const f32x4 gv = ((const f32x4*)a.g_mix)[lane + 64 * j];
            ((unsigned long long*)(a.HB + (size_t)m * DM))[lane + 64 * j] = (unsigned long long)pg::cvt_pk_bf16(va[j].x * ra * gv.x, va[j].y * ra * gv.y) | ((unsigned long long)pg::cvt_pk_bf16(va[j].z * ra * gv.z, va[j].w * ra * gv.w) << 32);
            ((unsigned long long*)(a.HB + (size_t)m2 * DM))[lane + 64 * j] = (unsigned long long)pg::cvt_pk_bf16(vb[j].x * rb * gv.x, vb[j].y * rb * gv.y) | ((unsigned long long)pg::cvt_pk_bf16(vb[j].z * rb * gv.z, vb[j].w * rb * gv.w) << 32);
            { int qa = 0, qb = 0; qa = __builtin_amdgcn_cvt_pk_fp8_f32(va[j].x * ra * gv.x, va[j].y * ra * gv.y, qa, false); qa = __builtin_amdgcn_cvt_pk_fp8_f32(va[j].z * ra * gv.z, va[j].w * ra * gv.w, qa, true);
              qb = __builtin_amdgcn_cvt_pk_fp8_f32(vb[j].x * rb * gv.x, vb[j].y * rb * gv.y, qb, false); qb = __builtin_amdgcn_cvt_pk_fp8_f32(vb[j].z * rb * gv.z, vb[j].w * rb * gv.w, qb, true);
              ((int*)(a.HBQ + (size_t)m * DM))[lane + 64 * j] = qa; ((int*)(a.HBQ + (size_t)m2 * DM))[lane + 64 * j] = qb; } }
    }
    for (int m = gw; m < NBATCH * MEML; m += NGW) p0_rmsnorm_row(a.mem + (size_t)m * DM, a.g_mem, a.MEMN + (size_t)m * DM, lane);
    const int gt = c * NWAVES * 64 + tid, NGT = G * NWAVES * 64;
    for (int i = gt; i < 32 * 1024; i += NGT) { const int e = i >> 10, k = i & 1023; const float w = a.w_router[k * 32 + e] * a.g_ffn[k]; a.WrT[i] = w;
        bf16_t* pl = (bf16_t*)(a.WrT + 32 * 1024); const bf16_t hi = f2bf(w); pl[i] = hi; pl[32 * 1024 + i] = f2bf(w - __uint_as_float((unsigned)hi << 16)); }
    for (int i = gt; i < 4 * 128 * 128; i += NGT) { const int s = i & 127, t = (i >> 7) & 127; a.WSB[i] = (s <= t) ? f2bf(a.w_spatial[i]) : (bf16_t)0; }
}
__device__ __forceinline__ void p1_memkv(const bf16_t* MEMN, const bf16_t* WmemT, const float* gk, bf16_t* MKV, int G, int c, LAS unsigned char* lds) {
    int tid_ = threadIdx.x; asm volatile("" : "+v"(tid_));
    const int tid = tid_, lane = tid & 63, wave = __builtin_amdgcn_readfirstlane(tid >> 6), fr = lane & 15, fq = lane >> 4;
    constexpr int LDB = 72;
    for (int unit = c; unit < 128; unit += G) {
        const int rt = unit >> 3, ct = unit & 7;
        f32x4 acc[8];
#pragma unroll
        for (int j = 0; j < 8; ++j) acc[j] = (f32x4){0.f, 0.f, 0.f, 0.f};
        const bf16_t* ap = MEMN + (size_t)(rt * 128 + wave * 16 + fr) * DM + fq * 8;
        const bf16_t* bsrc = WmemT + (size_t)(ct * 128 + (tid >> 3)) * DM + (tid & 7) * 8;
        const int bdst = ((tid >> 3) * LDB + (tid & 7) * 8) * 2;
        u32x4 r0 = *(const u32x4*)bsrc, r1 = *(const u32x4*)(bsrc + (size_t)64 * DM);
        bf16x8 afn[2] = {*(const bf16x8*)ap, *(const bf16x8*)(ap + 32)};
        __syncthreads();
        *(LAS u32x4*)(lds + bdst) = r0; *(LAS u32x4*)(lds + bdst + 64 * LDB * 2) = r1;
        __syncthreads();
#pragma nounroll
        for (int kc = 0; kc < 16; ++kc) {
            const int buf = (kc & 1) * (128 * LDB * 2);
            const bf16x8 afc[2] = {afn[0], afn[1]};
            if (kc + 1 < 16) { r0 = *(const u32x4*)(bsrc + (kc + 1) * 64); r1 = *(const u32x4*)(bsrc + (size_t)64 * DM + (kc + 1) * 64); afn[0] = *(const bf16x8*)(ap + (kc + 1) * 64); afn[1] = *(const bf16x8*)(ap + (kc + 1) * 64 + 32); }
#pragma unroll
            for (int ks = 0; ks < 2; ++ks) { const bf16x8 af = afc[ks];
#pragma unroll
                for (int j = 0; j < 8; ++j) { const bf16x8 bf = *(const LAS bf16x8*)(lds + buf + ((16 * j + fr) * LDB + ks * 32 + fq * 8) * 2); acc[j] = __builtin_amdgcn_mfma_f32_16x16x32_bf16(af, bf, acc[j], 0, 0, 0); } }
            if (kc + 1 < 16) { *(LAS u32x4*)(lds + (buf ^ (128 * LDB * 2)) + bdst) = r0; *(LAS u32x4*)(lds + (buf ^ (128 * LDB * 2)) + bdst + 64 * LDB * 2) = r1; }
            __syncthreads();
        }
        float rstd[4] = {1.f, 1.f, 1.f, 1.f};
        if (ct < 4) {
#pragma unroll
            for (int r = 0; r < 4; ++r) { float ss = 0.f;
#pragma unroll
                for (int j = 0; j < 8; ++j) ss += acc[j][r] * acc[j][r];
                ss += __shfl_xor(ss, 1); ss += __shfl_xor(ss, 2); ss += __shfl_xor(ss, 4); ss += __shfl_xor(ss, 8);
                rstd[r] = rsqrtf(ss * (1.0f / 128.0f) + EPS); }
        }
#pragma unroll
        for (int j = 0; j < 8; ++j) { const float gg = (ct < 4) ? gk[16 * j + fr] : 1.0f;
#pragma unroll
            for (int r = 0; r < 4; ++r) MKV[(size_t)(rt * 128 + wave * 16 + fq * 4 + r) * 1024 + ct * 128 + 16 * j + fr] = f2bf(acc[j][r] * rstd[r] * gg); }
    }
}
__device__ __forceinline__ void p5_router(const bf16_t* X1, const float* WrT, const float* br, int* LIST, float* RSTDS, float* TOPWS, unsigned* cnt, int G, int c, LAS unsigned char* lds) {
    const int tid = threadIdx.x, lane = tid & 63, wave = __builtin_amdgcn_readfirstlane(tid >> 6), r = lane & 15, qd = lane >> 4;
    LAS unsigned* lcnt = (LAS unsigned*)(lds + RING_BYTES + 2048);
    { const bf16_t* pl = (const bf16_t*)(WrT + 32 * 1024);
#pragma unroll 4
      for (int j = 0; j < 16; ++j) { const int g = tid + 512 * j, p = g >> 12, e = (g >> 7) & 31, ch = g & 127;
          *(LAS u32x4*)(lds + p * 65536 + e * 2048 + ((ch ^ (e & 15)) << 4)) = *(const u32x4*)(pl + (size_t)g * 8); } }
    for (int gbase = c * NWAVES; gbase < T_TOK / 16; gbase += G * NWAVES) {
        const int t0 = (gbase + wave) * 16;
        if (tid < 32) lcnt[tid] = 0u;
        __syncthreads();
        const bf16_t* xp = X1 + (size_t)(t0 + r) * DM + 8 * qd;
        f32x4 acc0 = (f32x4){0.f, 0.f, 0.f, 0.f}, acc1 = acc0; float ss = 0.f;
#pragma unroll
        for (int hf = 0; hf < 2; ++hf) {
            u32x4 xa[16];
#pragma unroll
            for (int i = 0; i < 16; ++i) xa[i] = *(const u32x4*)(xp + 32 * (16 * hf + i));
#pragma unroll
            for (int i = 0; i < 16; ++i) { const int it = 16 * hf + i;
                f32x4 a0, a1; pg::unpack8(xa[i], a0, a1);
                ss += (a0[0] * a0[0] + a0[1] * a0[1]) + (a0[2] * a0[2] + a0[3] * a0[3]) + (a1[0] * a1[0] + a1[1] * a1[1]) + (a1[2] * a1[2] + a1[3] * a1[3]);
                const int off = r * 2048 + (((4 * it + qd) ^ r) << 4);
#pragma unroll
                for (int p = 1; p >= 0; --p) { const bf16x8 b0 = *(const LAS bf16x8*)(lds + p * 65536 + off), b1 = *(const LAS bf16x8*)(lds + p * 65536 + 16 * 2048 + off);
                    acc0 = __builtin_amdgcn_mfma_f32_16x16x32_bf16(__builtin_bit_cast(bf16x8, xa[i]), b0, acc0, 0, 0, 0); acc1 = __builtin_amdgcn_mfma_f32_16x16x32_bf16(__builtin_bit_cast(bf16x8, xa[i]), b1, acc1, 0, 0, 0); }
            }
        }
        ss += __shfl_xor(ss, 16); ss += __shfl_xor(ss, 32);
        const float rstd_r = rsqrtf(ss * (1.0f / DM) + EPS);
        const float bias0 = br[r], bias1 = br[16 + r];
        float rs[4], l0[4], l1[4];
#pragma unroll
        for (int g = 0; g < 4; ++g) { rs[g] = __shfl(rstd_r, 4 * qd + g); l0[g] = acc0[g] * rs[g] + bias0; l1[g] = acc1[g] * rs[g] + bias1; }
        float sv[4][4]; int se[4][4];
#pragma unroll
        for (int rank = 0; rank < 4; ++rank)
#pragma unroll
            for (int g = 0; g < 4; ++g) {
                float v = l0[g]; int ix = r; if (l1[g] > v) { v = l1[g]; ix = r + 16; }
#pragma unroll
                for (int o = 1; o < 16; o <<= 1) { const float ov = __shfl_xor(v, o); const int oi = __shfl_xor(ix, o); if (ov > v || (ov == v && oi < ix)) { v = ov; ix = oi; } }
                sv[rank][g] = v; se[rank][g] = ix;
                if (ix == r) l0[g] = -INFINITY; if (ix == r + 16) l1[g] = -INFINITY;
            }
        float wgt[4]; int mye[4]; unsigned lp[4];
        if (r < 4) {
#pragma unroll
            for (int g = 0; g < 4; ++g) {
                const float den = 1.0f + __expf(sv[1][g] - sv[0][g]) + __expf(sv[2][g] - sv[0][g]) + __expf(sv[3][g] - sv[0][g]);
                const float myv = (r == 0) ? sv[0][g] : (r == 1) ? sv[1][g] : (r == 2) ? sv[2][g] : sv[3][g];
                mye[g] = (r == 0) ? se[0][g] : (r == 1) ? se[1][g] : (r == 2) ? se[2][g] : se[3][g];
                wgt[g] = __expf(myv - sv[0][g]) / den;
                lp[g] = __hip_atomic_fetch_add(lcnt + mye[g], 1u, __ATOMIC_RELAXED, __HIP_MEMORY_SCOPE_WORKGROUP);
            }
        }
        __syncthreads();
        if (tid < 32) lcnt[32 + tid] = atomicAdd(cnt + tid, lcnt[tid]);
        __syncthreads();
        if (r < 4) {
#pragma unroll
            for (int g = 0; g < 4; ++g) { const unsigned pos = lcnt[32 + mye[g]] + lp[g]; const int t = t0 + 4 * qd + g;
                LIST[mye[g] * 32768 + pos] = t * 4 + r; RSTDS[mye[g] * 32768 + pos] = rs[g]; TOPWS[mye[g] * 32768 + pos] = wgt[g]; }
        }
        __syncthreads();
    }
}
__device__ __forceinline__ void p8_combine(float* out, const bf16_t* X1H, const bf16_t* YS, int G, int c, float dscale) {
    typedef float f32x2v __attribute__((ext_vector_type(2)));
    const unsigned char* YQ = (const unsigned char*)YS;
    const size_t gt = (size_t)c * NWAVES * 64 + threadIdx.x, NGT = (size_t)G * NWAVES * 64;
    for (size_t i = gt; i < (size_t)T_TOK * DM / 8; i += NGT) {
        const size_t t = i >> 7, c8 = (i & 127) * 8;
        f32x4 o0, o1; pg::unpack8(*(const u32x4*)(X1H + t * DM + c8), o0, o1);
        if (dscale < 0.f) { o0 = *(const f32x4*)(out + t * DM + c8); o1 = *(const f32x4*)(out + t * DM + c8 + 4); }
        f32x4 s0 = (f32x4){0.f, 0.f, 0.f, 0.f}, s1 = s0;
#pragma unroll
        for (int k = 0; k < 4; ++k) { typedef unsigned u32x2v __attribute__((ext_vector_type(2))); const u32x2v w = __builtin_nontemporal_load((const u32x2v*)(YQ + (t * 4 + k) * DM + c8));
            const f32x2v a0 = __builtin_amdgcn_cvt_pk_f32_fp8((int)w.x, false), a1 = __builtin_amdgcn_cvt_pk_f32_fp8((int)w.x, true), b0 = __builtin_amdgcn_cvt_pk_f32_fp8((int)w.y, false), b1 = __builtin_amdgcn_cvt_pk_f32_fp8((int)w.y, true);
            s0 += (f32x4){a0[0], a0[1], a1[0], a1[1]}; s1 += (f32x4){b0[0], b0[1], b1[0], b1[1]}; }
        s0 = s0 * pg::YQ_INV; s1 = s1 * pg::YQ_INV;
        if (dscale < 0.f) { o0 = (o0 - s0) + s0; o1 = (o1 - s1) + s1; } else { o0 = (o0 + s0) * dscale; o1 = (o1 + s1) * dscale; }
        *(f32x4*)(out + t * DM + c8) = o0; *(f32x4*)(out + t * DM + c8 + 4) = o1;
    }
}


struct ConvJob { const float* w1; const float* w2; const float* gf; unsigned char* W1Q; unsigned char* W2Q; LAS float* scr; int item, end, stride; };
constexpr int CV_W1 = NEXP * 32 * 64, CV_W2 = NEXP * 32 * 32, CV_TOTAL = CV_W1 + CV_W2;
__device__ __forceinline__ void conv_issue(const ConvJob& J, float (&tv)[16], int lane) {
    const int h = J.item; const float* src; int N;
    if (h < CV_W1) { const int e = h >> 11, rem = h & 2047, kb = rem >> 6, nb = rem & 63; N = 2048; src = J.w1 + (size_t)e * DM * 2048 + (size_t)(32 * kb) * 2048 + 32 * nb; }
    else { const int h2 = h - CV_W1, e = h2 >> 10, rem = h2 & 1023, kb = rem >> 5, nb = rem & 31; N = 1024; src = J.w2 + (size_t)e * DFF * DM + (size_t)(32 * kb) * 1024 + 32 * nb; }
    src += (size_t)(16 * (lane >> 5)) * N + (lane & 31);
#pragma unroll
    for (int i = 0; i < 16; ++i) tv[i] = __builtin_nontemporal_load(src + (size_t)i * N);
}
__device__ __forceinline__ void conv_finish(ConvJob& J, const float (&tv)[16], int lane) {
    const int h = J.item; const bool is1 = h < CV_W1;
    int e, kb, nb; if (is1) { e = h >> 11; const int rem = h & 2047; kb = rem >> 6; nb = rem & 63; } else { const int h2 = h - CV_W1; e = h2 >> 10; const int rem = h2 & 1023; kb = rem >> 5; nb = rem & 31; }
    const int n = lane & 31, kh = lane >> 5;
    const f32x4 a = (f32x4){tv[0], tv[1], tv[2], tv[3]} * pg::WQ_SCALE, b = (f32x4){tv[4], tv[5], tv[6], tv[7]} * pg::WQ_SCALE;
    const f32x4 c = (f32x4){tv[8], tv[9], tv[10], tv[11]} * pg::WQ_SCALE, d = (f32x4){tv[12], tv[13], tv[14], tv[15]} * pg::WQ_SCALE;
    const uint2 lo = pg::pack8_fp8(a, b), hi2 = pg::pack8_fp8(c, d);
    const int ncol = 32 * nb + n;
    unsigned char* dst = is1 ? J.W1Q + ((size_t)e * 2048 + p0_map<2>(ncol)) * DM + 32 * kb + 16 * kh : J.W2Q + ((size_t)e * 1024 + ncol) * DFF + 32 * kb + 16 * kh;
    *(u32x4*)dst = (u32x4){lo.x, lo.y, hi2.x, hi2.y};
    asm volatile("s_waitcnt lgkmcnt(0)" ::: "memory");
    J.item += J.stride;
}
namespace at {
typedef __attribute__((address_space(3))) const char* lds_cptr;
typedef short s16x4 __attribute__((ext_vector_type(4)));
typedef float f32x16 __attribute__((ext_vector_type(16)));
__device__ __forceinline__ int crow(int r, int hi) { return (r & 3) + 8 * (r >> 2) + 4 * hi; }
__device__ __forceinline__ s16x4 vtr(lds_cptr p) { return __builtin_bit_cast(s16x4, __builtin_amdgcn_ds_read_tr16_b64_v4i16((__attribute__((address_space(3))) s16x4*)p)); }
template <int ND0> __device__ __forceinline__ void qk_step(f32x16& p0, f32x16& p1, lds_cptr kb, int kch2, const bf16x8 (&qr)[ND0]) {
#pragma unroll
    for (int d0 = 0; d0 < ND0; ++d0) {
        const bf16x8 b0 = *(const __attribute__((address_space(3))) bf16x8*)(kb + d0 * kch2);
        const bf16x8 b1 = *(const __attribute__((address_space(3))) bf16x8*)(kb + d0 * kch2 + 512);
        p0 = __builtin_amdgcn_mfma_f32_32x32x16_bf16(b0, qr[d0], p0, 0, 0, 0);
        p1 = __builtin_amdgcn_mfma_f32_32x32x16_bf16(b1, qr[d0], p1, 0, 0, 0);
        if ((d0 & 1) == 1) __builtin_amdgcn_sched_barrier(0);
    }
}
template <int NDB> __device__ __forceinline__ void softmax_step(f32x16& s0, f32x16& s1, float& m, float& l, f32x16 (&o)[NDB], LAS float* wsf, int r32, int hi, u32x4 (&pw)[4]) {
    float tm = fmaxf(s0[0], s1[0]);
#pragma unroll
    for (int r = 1; r < 16; ++r) tm = fmaxf(tm, fmaxf(s0[r], s1[r]));
    tm = fmaxf(tm, __shfl_xor(tm, 32));
    const float mn = fmaxf(m, tm);
    if (__any(mn > m)) {
        const float alpha = __builtin_amdgcn_exp2f(m - mn);
        l *= alpha; m = mn;
        if (hi == 0) wsf[r32] = alpha;
        asm volatile("s_waitcnt lgkmcnt(0)" ::: "memory");
#pragma unroll
        for (int r = 0; r < 16; ++r) { const float f = wsf[crow(r, hi)];
#pragma unroll
            for (int db = 0; db < NDB; ++db) o[db][r] *= f; }
    }
    float sum = 0.f;
#pragma unroll
    for (int r = 0; r < 16; ++r) { s0[r] = __builtin_amdgcn_exp2f(s0[r] - m); s1[r] = __builtin_amdgcn_exp2f(s1[r] - m); sum += s0[r] + s1[r]; }
    l += sum;
    pw[0] = (u32x4){pg::cvt_pk_bf16(s0[0], s0[1]), pg::cvt_pk_bf16(s0[2], s0[3]), pg::cvt_pk_bf16(s0[4], s0[5]), pg::cvt_pk_bf16(s0[6], s0[7])};
    pw[1] = (u32x4){pg::cvt_pk_bf16(s0[8], s0[9]), pg::cvt_pk_bf16(s0[10], s0[11]), pg::cvt_pk_bf16(s0[12], s0[13]), pg::cvt_pk_bf16(s0[14], s0[15])};
    pw[2] = (u32x4){pg::cvt_pk_bf16(s1[0], s1[1]), pg::cvt_pk_bf16(s1[2], s1[3]), pg::cvt_pk_bf16(s1[4], s1[5]), pg::cvt_pk_bf16(s1[6], s1[7])};
    pw[3] = (u32x4){pg::cvt_pk_bf16(s1[8], s1[9]), pg::cvt_pk_bf16(s1[10], s1[11]), pg::cvt_pk_bf16(s1[12], s1[13]), pg::cvt_pk_bf16(s1[14], s1[15])};
}
template <int NDB> __device__ __forceinline__ void softmax_rel_a(f32x16& s0, f32x16& s1, float& m, float& l, f32x16 (&o)[NDB], LAS float* wsf, int r32, int hi) {
    constexpr float THR = 4.0f;
#define AT_MX3(a, b, c) __builtin_fmaxf(__builtin_fmaxf((a), (b)), (c))
    float ta = AT_MX3(s0[0], s0[1], s1[0]), tb = AT_MX3(s0[2], s0[3], s1[1]); ta = AT_MX3(ta, s1[2], s1[3]);
#pragma unroll
    for (int r = 4; r < 16; r += 4) { ta = AT_MX3(ta, s0[r], s0[r + 1]); tb = AT_MX3(tb, s0[r + 2], s0[r + 3]); ta = AT_MX3(ta, s1[r], s1[r + 1]); tb = AT_MX3(tb, s1[r + 2], s1[r + 3]); }
    float rm = __builtin_fmaxf(ta, tb);
    { const auto rr = __builtin_amdgcn_permlane32_swap(__float_as_uint(rm), __float_as_uint(rm), false, false); rm = __builtin_fmaxf(__uint_as_float(rr[0]), __uint_as_float(rr[1])); }
#undef AT_MX3
    if (__any(rm > THR)) {
        const float dl = rm > THR ? rm : 0.f;
        m += dl;
#pragma unroll
        for (int r = 0; r < 16; ++r) { s0[r] -= dl; s1[r] -= dl; }
        const float f = __builtin_amdgcn_exp2f(-dl);
        l *= f;
        if (hi == 0) wsf[r32] = f;
        asm volatile("s_waitcnt lgkmcnt(0)" ::: "memory");
#pragma unroll
        for (int r = 0; r < 16; ++r) { const float g = wsf[crow(r, hi)];
#pragma unroll
            for (int db = 0; db < NDB; ++db) o[db][r] *= g; }
    }
}
template <int NDB> __device__ __forceinline__ void softmax_rel(f32x16& s0, f32x16& s1, float& m, float& l, f32x16 (&o)[NDB], LAS float* wsf, int r32, int hi, u32x4 (&pw)[4]) {
    constexpr float THR = 4.0f;
#define AT_MX3(a, b, c) __builtin_fmaxf(__builtin_fmaxf((a), (b)), (c))
    float ta = AT_MX3(s0[0], s0[1], s1[0]), tb = AT_MX3(s0[2], s0[3], s1[1]); ta = AT_MX3(ta, s1[2], s1[3]);
#pragma unroll
    for (int r = 4; r < 16; r += 4) { ta = AT_MX3(ta, s0[r], s0[r + 1]); tb = AT_MX3(tb, s0[r + 2], s0[r + 3]); ta = AT_MX3(ta, s1[r], s1[r + 1]); tb = AT_MX3(tb, s1[r + 2], s1[r + 3]); }
    float rm = __builtin_fmaxf(ta, tb);
    { const auto rr = __builtin_amdgcn_permlane32_swap(__float_as_uint(rm), __float_as_uint(rm), false, false); rm = __builtin_fmaxf(__uint_as_float(rr[0]), __uint_as_float(rr[1])); }
#undef AT_MX3
    if (__any(rm > THR)) {
        const float dl = rm > THR ? rm : 0.f;
        m += dl;
#pragma unroll
        for (int r = 0; r < 16; ++r) { s0[r] -= dl; s1[r] -= dl; }
        const float f = __builtin_amdgcn_exp2f(-dl);
        l *= f;
        if (hi == 0) wsf[r32] = f;
        asm volatile("s_waitcnt lgkmcnt(0)" ::: "memory");
#pragma unroll
        for (int r = 0; r < 16; ++r) { const float g = wsf[crow(r, hi)];
#pragma unroll
            for (int db = 0; db < NDB; ++db) o[db][r] *= g; }
    }
    float sa = 0.f, sb = 0.f;
#pragma unroll
    for (int r = 0; r < 16; ++r) { s0[r] = __builtin_amdgcn_exp2f(s0[r]); s1[r] = __builtin_amdgcn_exp2f(s1[r]); sa += s0[r]; sb += s1[r]; }
    l += sa + sb;
    pw[0] = (u32x4){pg::cvt_pk_bf16(s0[0], s0[1]), pg::cvt_pk_bf16(s0[2], s0[3]), pg::cvt_pk_bf16(s0[4], s0[5]), pg::cvt_pk_bf16(s0[6], s0[7])};
    pw[1] = (u32x4){pg::cvt_pk_bf16(s0[8], s0[9]), pg::cvt_pk_bf16(s0[10], s0[11]), pg::cvt_pk_bf16(s0[12], s0[13]), pg::cvt_pk_bf16(s0[14], s0[15])};
    pw[2] = (u32x4){pg::cvt_pk_bf16(s1[0], s1[1]), pg::cvt_pk_bf16(s1[2], s1[3]), pg::cvt_pk_bf16(s1[4], s1[5]), pg::cvt_pk_bf16(s1[6], s1[7])};
    pw[3] = (u32x4){pg::cvt_pk_bf16(s1[8], s1[9]), pg::cvt_pk_bf16(s1[10], s1[11]), pg::cvt_pk_bf16(s1[12], s1[13]), pg::cvt_pk_bf16(s1[14], s1[15])};
}
template <int NDB> __device__ __forceinline__ void pv_step(f32x16 (&o)[NDB], const u32x4 (&pw)[4], lds_cptr vb, int vdb_stride) {
#pragma unroll
    for (int db = 0; db < NDB; ++db)
#pragma unroll
        for (int ks = 0; ks < 4; ++ks) {
            const s16x4 lo = vtr(vb + db * vdb_stride + ks * 1024), hh = vtr(vb + db * vdb_stride + ks * 1024 + 512);
            const bf16x8 vf = (bf16x8){lo[0], lo[1], lo[2], lo[3], hh[0], hh[1], hh[2], hh[3]};
            o[db] = __builtin_amdgcn_mfma_f32_32x32x16_bf16(__builtin_bit_cast(bf16x8, pw[ks]), vf, o[db], 0, 0, 0);
            if (ks == 3) __builtin_amdgcn_sched_barrier(0);
        }
}
__device__ __forceinline__ void exp_pv(f32x16& s0, f32x16& s1, float& l, f32x16 (&o)[2], lds_cptr vb) {
    s16x4 vl[2][4], vh[2][4];
#pragma unroll
    for (int db = 0; db < 2; ++db)
#pragma unroll
        for (int ks = 0; ks < 4; ++ks) { vl[db][ks] = vtr(vb + db * 4096 + ks * 1024); vh[db][ks] = vtr(vb + db * 4096 + ks * 1024 + 512); }
    float sa = 0.f, sb = 0.f;
    __builtin_amdgcn_sched_barrier(0);
#pragma unroll
    for (int ks = 0; ks < 4; ++ks) {
        float e[8];
#pragma unroll
        for (int j = 0; j < 8; ++j) e[j] = __builtin_amdgcn_exp2f(ks < 2 ? s0[(ks & 1) * 8 + j] : s1[(ks & 1) * 8 + j]);
        sa += (e[0] + e[1]) + (e[2] + e[3]); sb += (e[4] + e[5]) + (e[6] + e[7]);
        u32x4 pw = (u32x4){pg::cvt_pk_bf16(e[0], e[1]), pg::cvt_pk_bf16(e[2], e[3]), pg::cvt_pk_bf16(e[4], e[5]), pg::cvt_pk_bf16(e[6], e[7])};
        asm volatile("" : "+v"(pw));
#pragma unroll
        for (int db = 0; db < 2; ++db) { const bf16x8 vf = (bf16x8){vl[db][ks][0], vl[db][ks][1], vl[db][ks][2], vl[db][ks][3], vh[db][ks][0], vh[db][ks][1], vh[db][ks][2], vh[db][ks][3]};
            o[db] = __builtin_amdgcn_mfma_f32_32x32x16_bf16(__builtin_bit_cast(bf16x8, pw), vf, o[db], 0, 0, 0); }
        __builtin_amdgcn_sched_barrier(0);
    }
    l += sa + sb;
}
template <int NDB> __device__ __forceinline__ void store_o(const f32x16 (&o)[NDB], float l, LAS float* wsf, int r32, int hi, bf16_t* yrow0  , int ldy) {
    l += __shfl_xor(l, 32);
    if (hi == 0) wsf[r32] = __builtin_amdgcn_rcpf(l);
    asm volatile("s_waitcnt lgkmcnt(0)" ::: "memory");
#pragma unroll
    for (int r = 0; r < 16; ++r) { const int q = crow(r, hi); const float inv = wsf[q];
#pragma unroll
        for (int db = 0; db < NDB; ++db) yrow0[(size_t)q * ldy + db * 32 + r32] = f2bf(o[db][r] * inv); }
    asm volatile("s_waitcnt lgkmcnt(0)" ::: "memory");
}

__device__ __forceinline__ void moba_unit(int b, int h, int jb, const bf16_t* PROJ, const float* KMP, bf16_t* Y, LAS unsigned char* lds, ConvJob& J, float (&tv)[16]) {
    int tid_ = threadIdx.x; asm volatile("" : "+v"(tid_));
    const int tid = tid_, lane = tid & 63, r32 = lane & 31, hi = lane >> 5, w = __builtin_amdgcn_readfirstlane(tid >> 6);
    LAS float* kmean = (LAS float*)(lds + 32768);
    LAS float* wsf = (LAS float*)(lds + 36864) + w * 64;
    const size_t rowbase = (size_t)b * SEQ; const int q0 = jb * 256; const int t = q0 + 32 * w + r32;
    for (int i = tid; i < jb * 64; i += NWAVES * 64) { const int n = i >> 6, d = i & 63; const float* p = KMP + ((size_t)(b * 16 + n) * 2) * 512 + h * 64 + d; kmean[i] = (p[0] + p[512]) * (1.0f / 256.0f); }
    const bf16_t* qp = PROJ + (rowbase + t) * INW + OFF_QB + h * 64 + hi * 8;
    bf16x8 qr[4];
#pragma unroll
    for (int d0 = 0; d0 < 4; ++d0) qr[d0] = *(const bf16x8*)(qp + d0 * 16);
    const bf16_t* kg = PROJ + (rowbase + 8 * w + (lane >> 3)) * INW + OFF_KB + h * 64 + (((lane & 7) ^ ((4 * w + (lane >> 4)) & 7)) << 3);
    const bf16_t* vg = PROJ + (rowbase + 16 * (w & 3) + (lane >> 2)) * INW + OFF_VB + h * 64 + (w >> 2) * 32 + (lane & 3) * 8;
    const unsigned kdst = (unsigned)__builtin_amdgcn_readfirstlane((int)((unsigned)(size_t)lds + w * 1024)), vdst = kdst + 8192u;
    __syncthreads();
    pg::glds16_asm(kg, kdst); pg::glds16_asm(vg, vdst);
    unsigned selmask = 0u;
    {
        float qf[32];
#pragma unroll
        for (int d0 = 0; d0 < 4; ++d0) { f32x4 a, c; pg::unpack8(__builtin_bit_cast(u32x4, qr[d0]), a, c);
#pragma unroll
            for (int j = 0; j < 4; ++j) { qf[d0 * 8 + j] = a[j]; qf[d0 * 8 + 4 + j] = c[j]; } }
        float v0 = -INFINITY, v1 = -INFINITY, v2 = -INFINITY; int i0 = -1, i1 = -1, i2 = -1;
#pragma unroll 4
        for (int n = 0; n < jb; ++n) {
            const LAS float* km = kmean + n * 64 + hi * 8; float g = 0.f;
#pragma unroll
            for (int d0 = 0; d0 < 4; ++d0) { const f32x4 ka = *(const LAS f32x4*)(km + d0 * 16), kc = *(const LAS f32x4*)(km + d0 * 16 + 4);
#pragma unroll
                for (int j = 0; j < 4; ++j) g += qf[d0 * 8 + j] * ka[j] + qf[d0 * 8 + 4 + j] * kc[j]; }
            { const auto rr = __builtin_amdgcn_permlane32_swap(__float_as_uint(g), __float_as_uint(g), false, false); g = __uint_as_float(rr[0]) + __uint_as_float(rr[1]); }
            if (g > v0) { v2 = v1; i2 = i1; v1 = v0; i1 = i0; v0 = g; i0 = n; } else if (g > v1) { v2 = v1; i2 = i1; v1 = g; i1 = n; } else if (g > v2) { v2 = g; i2 = n; }
        }
        if (i0 >= 0) selmask |= 1u << i0; if (i1 >= 0) selmask |= 1u << i1; if (i2 >= 0) selmask |= 1u << i2;
    }
    asm volatile("s_waitcnt vmcnt(0)" ::: "memory");
    __syncthreads();
    const float slope2 = exp2f(-(float)(h + 1)) * 1.4426950408889634f;
    float m = 0.f, l = 0.f; f32x16 o[2];
#pragma unroll
    for (int r = 0; r < 16; ++r) { o[0][r] = 0.f; o[1][r] = 0.f; }
    const int qrel = 32 * w + r32;
    const int NT = 4 * (jb + 1);
    const lds_cptr lb = (lds_cptr)lds;
    const int voff = 8192 + ((lane >> 4) & 1) * 32 + (lane & 3) * 8 + (4 * hi + ((lane & 15) >> 2)) * 64;
#pragma nounroll
    for (int T = 0; T < NT; ++T) {
        const int slot = (T & 1) * 16384;
        const bool cv_issue = (J.item < J.end) && ((T & 1) == 0);
        if (cv_issue) conv_issue(J, tv, lane);
        if (T + 1 < NT) { pg::glds16_asm(kg + (size_t)(T + 1) * 64 * INW, kdst + (unsigned)(slot ^ 16384)); pg::glds16_asm(vg + (size_t)(T + 1) * 64 * INW, vdst + (unsigned)(slot ^ 16384)); }
        const int n = T >> 2, kt = T & 3;
        const bool own = (n == jb);
        const bool sel = own || ((selmask >> n) & 1u);
        const bool need = own ? (64 * kt <= 32 * w + 31) : (__any(sel) != 0);
        if (need) {
            const float lbias = sel ? (slope2 * (float)(T * 64 + 4 * hi - t) - m) : -INFINITY;
            f32x16 s0, s1;
#pragma unroll
            for (int r = 0; r < 16; ++r) { s0[r] = slope2 * (float)((r & 3) + 8 * (r >> 2)) + lbias; s1[r] = slope2 * (float)((r & 3) + 8 * (r >> 2) + 32) + lbias; }
            if (own && 64 * kt + 63 > 32 * w) {
                const int kr = kt * 64 + 4 * hi;
#pragma unroll
                for (int r = 0; r < 16; ++r) { const int kk = kr + (r & 3) + 8 * (r >> 2); if (kk > qrel) s0[r] = -INFINITY; if (kk + 32 > qrel) s1[r] = -INFINITY; }
            }
            bf16x8 kf[8];
#pragma unroll
            for (int d0 = 0; d0 < 4; ++d0) { const lds_cptr kp = lb + slot + r32 * 128 + (((2 * d0 + hi) ^ ((r32 >> 1) & 7)) << 4);
                kf[2 * d0] = *(const __attribute__((address_space(3))) bf16x8*)kp; kf[2 * d0 + 1] = *(const __attribute__((address_space(3))) bf16x8*)(kp + 32 * 128); }
            __builtin_amdgcn_sched_barrier(0);
#pragma unroll
            for (int d0 = 0; d0 < 4; ++d0) { s0 = __builtin_amdgcn_mfma_f32_32x32x16_bf16(kf[2 * d0], qr[d0], s0, 0, 0, 0); s1 = __builtin_amdgcn_mfma_f32_32x32x16_bf16(kf[2 * d0 + 1], qr[d0], s1, 0, 0, 0); }
            __builtin_amdgcn_sched_barrier(0);
            softmax_rel_a<2>(s0, s1, m, l, o, wsf, r32, hi);
            exp_pv(s0, s1, l, o, lb + slot + voff);
        }
        const bool cv_fin = (J.item < J.end) && ((T & 1) == 1);
        if (cv_fin) conv_finish(J, tv, lane);
        if (cv_issue) asm volatile("s_waitcnt vmcnt(0) lgkmcnt(0)" ::: "memory");
        else if (cv_fin) asm volatile("s_waitcnt vmcnt(1) lgkmcnt(0)" ::: "memory");
        else asm volatile("s_waitcnt vmcnt(0) lgkmcnt(0)" ::: "memory");
        __builtin_amdgcn_s_barrier(); asm volatile("" ::: "memory");
    }
    store_o<2>(o, l, wsf, r32, hi, Y + (rowbase + q0 + 32 * w) * 1536 + 512 + h * 64, 1536);
}

__device__ __forceinline__ void mem_units(int b, int h, int qt0, int nqt, const bf16_t* PROJ, const bf16_t* MKV, const float* gq, bf16_t* Y, LAS unsigned char* lds) {
    int tid_ = threadIdx.x; asm volatile("" : "+v"(tid_));
    const int tid = tid_, lane = tid & 63, r32 = lane & 31, hi = lane >> 5, w = __builtin_amdgcn_readfirstlane(tid >> 6);
    LAS float* wsf = (LAS float*)(lds + RING_BYTES + 4096) + w * 64;
    __syncthreads();
#pragma unroll 4
    for (int i = 0; i < 8; ++i) { const int p = tid + 512 * i, key = p >> 4, ch = p & 15;
        const u32x4 wv = *(const u32x4*)(MKV + ((size_t)b * MEML + key) * 1024 + h * 128 + ch * 8); f32x4 a, c; pg::unpack8(wv, a, c);
        const f32x4 g0 = *(const f32x4*)(gq + ch * 8), g1 = *(const f32x4*)(gq + ch * 8 + 4);
        *(LAS u32x4*)(lds + key * 256 + ((ch ^ (key & 15)) << 4)) = pg::pack8(a * g0, c * g1); }
#pragma unroll
    for (int i = 0; i < 8; ++i) { const int p = tid + 512 * i, key = p >> 4, c16 = p & 15;
        const u32x4 wv = *(const u32x4*)(MKV + ((size_t)b * MEML + key) * 1024 + 512 + h * 128 + c16 * 8);
        *(LAS u32x4*)(lds + 65536 + (c16 >> 2) * 16384 + (key >> 4) * 1024 + (key & 15) * 64 + (c16 & 3) * 16) = wv; }
    __syncthreads();
    const lds_cptr lb = (lds_cptr)lds;
    const int voff = 65536 + ((lane >> 4) & 1) * 32 + (lane & 3) * 8 + (4 * hi + ((lane & 15) >> 2)) * 64;
#pragma nounroll
    for (int qi = 0; qi < nqt; ++qi) {
        const size_t row0 = (size_t)b * SEQ + (size_t)(qt0 + qi) * 256 + 32 * w;
        const bf16_t* qp = PROJ + (row0 + r32) * INW + OFF_QM + h * 128 + hi * 8;
        bf16x8 qr[8]; float ss = 0.f;
#pragma unroll
        for (int d0 = 0; d0 < 8; ++d0) { qr[d0] = *(const bf16x8*)(qp + d0 * 16); f32x4 a, c; pg::unpack8(__builtin_bit_cast(u32x4, qr[d0]), a, c);
            ss += (a[0] * a[0] + a[1] * a[1]) + (a[2] * a[2] + a[3] * a[3]) + (c[0] * c[0] + c[1] * c[1]) + (c[2] * c[2] + c[3] * c[3]); }
        ss += __shfl_xor(ss, 32);
        const float cs = rsqrtf(ss * (1.0f / 128.0f) + EPS) * (0.08838834764831845f * 1.4426950408889634f);
        float m = -1e30f, l = 0.f; f32x16 o[4];
#pragma unroll
        for (int r = 0; r < 16; ++r) { o[0][r] = 0.f; o[1][r] = 0.f; o[2][r] = 0.f; o[3][r] = 0.f; }
#pragma nounroll
        for (int kt = 0; kt < 4; ++kt) {
            f32x16 s0, s1;
#pragma unroll
            for (int r = 0; r < 16; ++r) { s0[r] = 0.f; s1[r] = 0.f; }
#pragma unroll
            for (int d0 = 0; d0 < 8; ++d0) {
                const lds_cptr kp = lb + (kt * 64 + r32) * 256 + (((2 * d0 + hi) ^ (r32 & 15)) << 4);
                const bf16x8 b0 = *(const __attribute__((address_space(3))) bf16x8*)kp, b1 = *(const __attribute__((address_space(3))) bf16x8*)(kp + 32 * 256);
                s0 = __builtin_amdgcn_mfma_f32_32x32x16_bf16(b0, qr[d0], s0, 0, 0, 0); s1 = __builtin_amdgcn_mfma_f32_32x32x16_bf16(b1, qr[d0], s1, 0, 0, 0);
                if ((d0 & 1) == 1) __builtin_amdgcn_sched_barrier(0); }
#pragma unroll
            for (int r = 0; r < 16; ++r) { s0[r] *= cs; s1[r] *= cs; }
            u32x4 pw[4];
            softmax_step<4>(s0, s1, m, l, o, wsf, r32, hi, pw);
            pv_step<4>(o, pw, lb + voff + kt * 4096, 16384);
        }
        store_o<4>(o, l, wsf, r32, hi, Y + row0 * 1536 + 1024 + h * 128, 1536);
    }
    __syncthreads();
}
}


__device__ __forceinline__ void sgu_chunk(int chunk, const bf16_t* PROJ, const float* gsv, const bf16_t* WSB, const float* bs, bf16_t* Y, LAS unsigned char* lds) {
    int tid_ = threadIdx.x; asm volatile("" : "+v"(tid_));
    const int tid = tid_, lane = tid & 63, r32 = lane & 31, hi = lane >> 5, w = __builtin_amdgcn_readfirstlane(tid >> 6);
    const int t0 = chunk * 128;
    LAS float* rs = (LAS float*)(lds + 32768);
    { u32x4 wv[16];
#pragma unroll
      for (int i = 0; i < 16; ++i) wv[i] = *(const u32x4*)(PROJ + (size_t)(t0 + w * 16 + i) * INW + OFF_V + lane * 8);
#pragma unroll
      for (int i = 0; i < 16; ++i) { const int tl = w * 16 + i; f32x4 a, b; pg::unpack8(wv[i], a, b);
        float ss = (a[0] * a[0] + a[1] * a[1]) + (a[2] * a[2] + a[3] * a[3]) + (b[0] * b[0] + b[1] * b[1]) + (b[2] * b[2] + b[3] * b[3]);
        ss = wave_sum(ss); if (lane == 0) rs[tl] = rsqrtf(ss * (1.0f / 512.0f) + EPS); } }
    __syncthreads();
    const int tt = w & 3, dh = w >> 2;
    const at::lds_cptr vb = (at::lds_cptr)lds + ((lane >> 4) & 1) * 32 + (lane & 3) * 8 + (4 * hi + ((lane & 15) >> 2)) * 64 + dh * 16384;
#pragma nounroll
    for (int g = 0; g < 4; ++g) {
        { const int c8 = tid & 15; const f32x4 g0 = *(const f32x4*)(gsv + g * 128 + c8 * 8), g1 = *(const f32x4*)(gsv + g * 128 + c8 * 8 + 4);
#pragma unroll
            for (int j = 0; j < 4; ++j) { const int s = (tid >> 4) + 32 * j; const float r = rs[s];
                const u32x4 wv = *(const u32x4*)(PROJ + (size_t)(t0 + s) * INW + OFF_V + g * 128 + c8 * 8); f32x4 a, b; pg::unpack8(wv, a, b);
                *(LAS u32x4*)(lds + (c8 >> 2) * 8192 + (s >> 4) * 1024 + (s & 15) * 64 + (c8 & 3) * 16) = pg::pack8(a * r * g0, b * r * g1); } }
        __syncthreads();
        at::f32x16 o[2];
#pragma unroll
        for (int r = 0; r < 16; ++r) { o[0][r] = 0.f; o[1][r] = 0.f; }
        const bf16_t* wrow = WSB + ((size_t)g * 128 + 32 * tt + r32) * 128 + 4 * hi;
        const int nks = 2 * tt + 2;
        uint2 alo8[8], ahi8[8];
#pragma unroll
        for (int ks = 0; ks < 8; ++ks) { alo8[ks] = *(const uint2*)(wrow + 16 * ks); ahi8[ks] = *(const uint2*)(wrow + 16 * ks + 8); }
#pragma unroll
        for (int ks = 0; ks < 8; ++ks) { if (ks >= nks) break;
            const uint2 alo = alo8[ks], ahi = ahi8[ks];
            const bf16x8 af = __builtin_bit_cast(bf16x8, (u32x4){alo.x, alo.y, ahi.x, ahi.y});
#pragma unroll
            for (int dbl = 0; dbl < 2; ++dbl) { const at::s16x4 lo = at::vtr(vb + dbl * 8192 + ks * 1024), hh = at::vtr(vb + dbl * 8192 + ks * 1024 + 512);
                const bf16x8 vf = (bf16x8){lo[0], lo[1], lo[2], lo[3], hh[0], hh[1], hh[2], hh[3]};
                o[dbl] = __builtin_amdgcn_mfma_f32_32x32x16_bf16(af, vf, o[dbl], 0, 0, 0); }
        }
        LAS float* stg = (LAS float*)(lds + 40960);
#pragma unroll
        for (int r = 0; r < 16; ++r) { const int t = 32 * tt + at::crow(r, hi); const float bias = bs[g * 128 + t];
#pragma unroll
            for (int dbl = 0; dbl < 2; ++dbl) stg[t * 128 + (2 * dh + dbl) * 32 + r32] = o[dbl][r] + bias; }
        __syncthreads();
#pragma unroll
        for (int j = 0; j < 4; ++j) { const int p = tid + 512 * j, t = p >> 4, c8 = (p & 15) * 8; const size_t row = (size_t)(t0 + t);
            const f32x4 m0 = *(const LAS f32x4*)(stg + t * 128 + c8), m1 = *(const LAS f32x4*)(stg + t * 128 + c8 + 4);
            f32x4 u0, u1; pg::unpack8(*(const u32x4*)(PROJ + row * INW + OFF_U + g * 128 + c8), u0, u1);
            *(u32x4*)(Y + row * 1536 + g * 128 + c8) = pg::pack8(u0 * m0, u1 * m1); }
        __syncthreads();
    }
}

struct MArgs { const float* in[24]; float* out; unsigned char* ws; int ph_lo, ph_hi; };
__global__ void __launch_bounds__(NWAVES * 64, 2) mk_fwd(MArgs a) {
    extern __shared__ __attribute__((aligned(16))) unsigned char lds_raw[];
    LAS unsigned char* lds = (LAS unsigned char*)lds_raw;
    const int tid = threadIdx.x;
    for (int u = tid; u < (LDS_BYTES - LDSCTL_OFF) / 4; u += NWAVES * 64) ((LAS unsigned*)(lds + LDSCTL_OFF))[u] = 0u;
    __syncthreads();
    unsigned char* ws = a.ws; unsigned* ctl = (unsigned*)(ws + WS_CTL);
    const int lo = a.ph_lo, hi = a.ph_hi; const int G = gridDim.x, c = blockIdx.x;
    XcdBarrier bar; bar.bar = ctl + CW_BAR; bar.x = 0; bar.st = nullptr;
    if (hi - lo > 1) bar = xcd_barrier_post(ctl + CW_BAR, (volatile LAS unsigned*)(lds + LDSCTL_OFF));
typedef const MArgs __attribute__((address_space(4))) * kargp_t;
    const kargp_t kargs = (kargp_t)__builtin_amdgcn_kernarg_segment_ptr();
#define KA_BEGIN() kargp_t q = kargs; asm volatile("" : "+s"(q))
#ifdef DIAG_PHASE
    if (c == 0 && tid == 0) *(LAS unsigned long long*)(lds + LDSCTL_OFF + 16) = wall_clock64();
#define DIAG_STAMP(k) do { if ((k) == DIAG_PHASE && c == 0 && tid == 0) ctl[CW_DIAG] = (unsigned)(wall_clock64() - *(LAS unsigned long long*)(lds + LDSCTL_OFF + 16)); } while (0)
#else
#define DIAG_STAMP(k) do { } while (0)
#endif
#define IN(k) (lo <= (k) && (k) < hi)
#define BOTH(k) (IN(k) && IN((k) + 1))
    bf16_t *WinT = (bf16_t*)(ws + WS_WIN), *WbrT = (bf16_t*)(ws + WS_WBR), *WoutT = (bf16_t*)(ws + WS_WOUT);
    bf16_t *W1T = (bf16_t*)(ws + WS_W1), *W2T = (bf16_t*)(ws + WS_W2);
    bf16_t *MERGED = (bf16_t*)(ws + WS_MERGED), *X1B = (bf16_t*)(ws + WS_X1B), *HB = (bf16_t*)(ws + WS_HB), *PROJ = (bf16_t*)(ws + WS_PROJ), *Y = (bf16_t*)(ws + WS_Y);
    bf16_t *ACT = (bf16_t*)(ws + WS_ACT), *YS = (bf16_t*)(ws + WS_YS);
    float* KMP = (float*)(ws + WS_KMP); int* LIST = (int*)(ws + WS_LIST); float* RSTDS = (float*)(ws + WS_RSTDS); float* TOPWS = (float*)(ws + WS_TOPWS);

    bf16_t *WmemT = (bf16_t*)(ws + WS_WMEM), *MEMN = (bf16_t*)(ws + WS_MEMN), *MKV = (bf16_t*)(ws + WS_MKV), *WSB = (bf16_t*)(ws + WS_WSB); float* WrT = (float*)(ws + WS_WR);
#if !defined(ONLY) || ONLY == 0
    if (IN(0)) {
        KA_BEGIN();
        {
        P0Args p; p.x = q->in[0]; p.mem = q->in[1]; p.g_mix = q->in[2]; p.g_mem = q->in[9]; p.w_in = q->in[3]; p.w_br0 = q->in[13]; p.w_br1 = q->in[14]; p.w_br2 = q->in[15]; p.w_out = q->in[16];
        p.w_mem_kv = q->in[10]; p.w_gate_up = q->in[20]; p.w_down = q->in[22]; p.g_ffn = q->in[17]; p.w_router = q->in[18]; p.w_spatial = q->in[5];
        p.HBQ = ws + WS_HBQ; p.WINQ = ws + WS_WINQ; p.HB = HB; p.MEMN = MEMN; p.WinT = WinT; p.WbrT = WbrT; p.WoutT = WoutT; p.WmemT = WmemT; p.W1T = W1T; p.W2T = W2T; p.WSB = WSB; p.WrT = WrT;
        p0_prologue(p, lds, G, c);
        }
#if DUP_PHASE == 0
        {
        P0Args p; p.x = q->in[0]; p.mem = q->in[1]; p.g_mix = q->in[2]; p.g_mem = q->in[9]; p.w_in = q->in[3]; p.w_br0 = q->in[13]; p.w_br1 = q->in[14]; p.w_br2 = q->in[15]; p.w_out = q->in[16];
        p.w_mem_kv = q->in[10]; p.w_gate_up = q->in[20]; p.w_down = q->in[22]; p.g_ffn = q->in[17]; p.w_router = q->in[18]; p.w_spatial = q->in[5];
        p.HBQ = ws + WS_HBQ; p.WINQ = ws + WS_WINQ; p.HB = HB; p.MEMN = MEMN; p.WinT = WinT; p.WbrT = WbrT; p.WoutT = WoutT; p.WmemT = WmemT; p.W1T = W1T; p.W2T = W2T; p.WSB = WSB; p.WrT = WrT;
        p0_prologue(p, lds, G, c);
        }
#endif
        if (BOTH(0)) xcd_barrier(bar);
        DIAG_STAMP(0);
    }
#endif
#if !defined(ONLY) || ONLY == 1
    if (IN(1)) {
        KA_BEGIN();
        {
        pg::PolP1 P; P.A = HB; P.Bt = WinT; P.PROJ = PROJ; P.KMP = KMP; P.gq = q->in[7]; P.gk = q->in[8]; P.G = G; P.c = c;
        pg::gemm_run(lds, P);
        { pg::PolP1G Pg; Pg.A = ws + WS_HBQ; Pg.Bt = ws + WS_WINQ; Pg.PROJ = PROJ; Pg.G = G; Pg.c = c; pg::gemm_run(lds, Pg); }
        p1_memkv(MEMN, WmemT, q->in[12], MKV, G, c, lds);
        }
#if DUP_PHASE == 1
        {
        pg::PolP1 P; P.A = HB; P.Bt = WinT; P.PROJ = PROJ; P.KMP = KMP; P.gq = q->in[7]; P.gk = q->in[8]; P.G = G; P.c = c;
        pg::gemm_run(lds, P);
        p1_memkv(MEMN, WmemT, q->in[12], MKV, G, c, lds);
        }
#endif
        if (BOTH(1)) xcd_barrier(bar);
        DIAG_STAMP(1);
    }
#endif
#if !defined(ONLY) || ONLY == 2
    if (IN(2)) {
        KA_BEGIN();
        {
        const int wave = __builtin_amdgcn_readfirstlane(tid >> 6), lane = tid & 63;
        const int vcu = (G % 8 == 0) ? (c % 8) * (G / 8) + c / 8 : c;
        for (int u = vcu; u < 256; u += G) at::mem_units(u >> 5, (u >> 3) & 3, (u & 7) * 2, 2, PROJ, MKV, q->in[11], Y, lds);
#if DUP_P2 == 1
        for (int u = vcu; u < 256; u += G) at::mem_units(u >> 5, (u >> 3) & 3, (u & 7) * 2, 2, PROJ, MKV, q->in[11], Y, lds);
#endif
        ConvJob J; J.w1 = q->in[20]; J.w2 = q->in[22]; J.gf = q->in[17]; J.W1Q = (unsigned char*)W1T; J.W2Q = (unsigned char*)W2T; J.scr = (LAS float*)(lds + 40960 + wave * 4352);
        J.item = c * NWAVES + wave; J.end = CV_TOTAL; J.stride = G * NWAVES; float tv[16];
        for (int u = vcu; u < 256; u += G) { const int bh = u >> 2, s4 = u & 3;
            for (int i = 0; i < 4; ++i) { const int jb = (i == 0) ? 15 - s4 : (i == 1) ? 8 + s4 : (i == 2) ? 7 - s4 : s4; at::moba_unit(bh >> 3, bh & 7, jb, PROJ, KMP, Y, lds, J, tv); } }
#if DUP_P2 == 2
        for (int u = vcu; u < 256; u += G) { const int bh = u >> 2, s4 = u & 3;
            for (int i = 0; i < 4; ++i) { const int jb = (i == 0) ? 15 - s4 : (i == 1) ? 8 + s4 : (i == 2) ? 7 - s4 : s4; at::moba_unit(bh >> 3, bh & 7, jb, PROJ, KMP, Y, lds, J, tv); } }
#endif
        while (J.item < J.end) { conv_issue(J, tv, lane); conv_finish(J, tv, lane); }
        __syncthreads();
        for (int ch = vcu; ch < 256; ch += G) sgu_chunk(ch, PROJ, q->in[4], WSB, q->in[6], Y, lds);
#if DUP_P2 == 3
        for (int ch = vcu; ch < 256; ch += G) sgu_chunk(ch, PROJ, q->in[4], WSB, q->in[6], Y, lds);
#endif
        }
#if DUP_PHASE == 2
        {
        const int wave = __builtin_amdgcn_readfirstlane(tid >> 6), lane = tid & 63;
        const int vcu = (G % 8 == 0) ? (c % 8) * (G / 8) + c / 8 : c;
        for (int u = vcu; u < 256; u += G) at::mem_units(u >> 5, (u >> 3) & 3, (u & 7) * 2, 2, PROJ, MKV, q->in[11], Y, lds);
        for (int u = vcu; u < 256; u += G) { const int bh = u >> 2, s4 = u & 3;
            for (int i = 0; i < 4; ++i) { const int jb = (i == 0) ? 15 - s4 : (i == 1) ? 8 + s4 : (i == 2) ? 7 - s4 : s4; at::moba_unit(bh >> 3, bh & 7, jb, PROJ, KMP, Y, lds, J, tv); } }
        __syncthreads();
        for (int ch = vcu; ch < 256; ch += G) sgu_chunk(ch, PROJ, q->in[4], WSB, q->in[6], Y, lds);
        }
#endif
        if (BOTH(2)) xcd_barrier(bar);
        DIAG_STAMP(2);
    }
#endif
#if !defined(ONLY) || ONLY == 3
    if (IN(3)) {
        KA_BEGIN();
        {
        pg::PolP3 P; P.A = Y; P.Bt = WbrT; P.PROJ = PROJ; P.MERGED = MERGED; P.G = G; P.c = c;
        pg::gemm_run(lds, P);
        }
#if DUP_PHASE == 3
        {
        pg::PolP3 P; P.A = Y; P.Bt = WbrT; P.PROJ = PROJ; P.MERGED = MERGED; P.G = G; P.c = c;
        pg::gemm_run(lds, P);
        }
#endif
        if (BOTH(3)) xcd_barrier(bar);
        DIAG_STAMP(3);
    }
#endif
#if !defined(ONLY) || ONLY == 4
    if (IN(4)) {
        KA_BEGIN();
        {
        pg::PolP4 P; P.A = MERGED; P.Bt = WoutT; P.x = q->in[0]; P.X1H = (bf16_t*)(ws + WS_X1H); P.X1Q = (unsigned char*)X1B; P.gffn = q->in[17]; P.G = G; P.c = c;
        pg::gemm_run(lds, P);
        }
#if DUP_PHASE == 4
        {
        pg::PolP4 P; P.A = MERGED; P.Bt = WoutT; P.x = q->in[0]; P.X1H = (bf16_t*)(ws + WS_X1H); P.X1Q = (unsigned char*)X1B; P.gffn = q->in[17]; P.G = G; P.c = c;
        pg::gemm_run(lds, P);
        }
#endif
        if (BOTH(4)) xcd_barrier(bar);
#ifdef DUP_BAR
        for (int i_ = 0; i_ < DUP_BAR; ++i_) xcd_barrier(bar);
#endif
        DIAG_STAMP(4);
    }
#endif
#if !defined(ONLY) || ONLY == 5
    if (IN(5)) {
        KA_BEGIN();
        {
        p5_router((const bf16_t*)(ws + WS_X1H), WrT, q->in[19], LIST, RSTDS, TOPWS, ctl + CW_CNT, G, c, lds);
        }
#if DUP_PHASE == 5
        {
        p5_router((const bf16_t*)(ws + WS_X1H), WrT, q->in[19], (int*)(ws + WS_SCR), (float*)(ws + WS_SCR + 4 * MiB), (float*)(ws + WS_SCR + 8 * MiB), ctl + 512, G, c, lds);
        }
#endif
        if (BOTH(5)) xcd_barrier(bar);
        DIAG_STAMP(5);
    }
#endif
#if !defined(ONLY) || ONLY == 6
    if (IN(6)) {
        KA_BEGIN();
        {
        grouped_setup((LAS int*)(lds + TAB_OFF), ctl + CW_CNT);
        pg::PolP6 P; P.X1Q = (const unsigned char*)X1B; P.W1Q = (const unsigned char*)W1T; P.LIST = LIST; P.RSTDS = RSTDS; P.b1 = q->in[21]; P.ACTQ = (unsigned char*)ACT; P.tb.tab = (const LAS int*)(lds + TAB_OFF); P.G = G; P.c = c; P.rtab = lds + RTAB_OFF;
        pg::gemm_run(lds, P);
        }
#if DUP_PHASE == 6
        {
        grouped_setup((LAS int*)(lds + TAB_OFF), ctl + CW_CNT);
        pg::PolP6 P; P.X1Q = (const unsigned char*)X1B; P.W1Q = (const unsigned char*)W1T; P.LIST = LIST; P.RSTDS = RSTDS; P.b1 = q->in[21]; P.ACTQ = (unsigned char*)ACT; P.tb.tab = (const LAS int*)(lds + TAB_OFF); P.G = G; P.c = c; P.rtab = lds + RTAB_OFF;
        pg::gemm_run(lds, P);
        }
#endif
        if (BOTH(6)) xcd_barrier(bar);
        DIAG_STAMP(6);
    }
#endif
#if !defined(ONLY) || ONLY == 7
    if (IN(7)) {
        KA_BEGIN();
        {
        grouped_setup((LAS int*)(lds + TAB_OFF), ctl + CW_CNT);
        pg::PolP7 P; P.ACTQ = (const unsigned char*)ACT; P.W2Q = (const unsigned char*)W2T; P.LIST = LIST; P.TOPWS = TOPWS; P.b2 = q->in[23]; P.YS = YS; P.tb.tab = (const LAS int*)(lds + TAB_OFF); P.G = G; P.c = c; P.rtab = lds + RTAB_OFF;
        pg::gemm_run(lds, P);
        }
#if DUP_PHASE == 7
        {
        grouped_setup((LAS int*)(lds + TAB_OFF), ctl + CW_CNT);
        pg::PolP7 P; P.ACTQ = (const unsigned char*)ACT; P.W2Q = (const unsigned char*)W2T; P.LIST = LIST; P.TOPWS = TOPWS; P.b2 = q->in[23]; P.YS = YS; P.tb.tab = (const LAS int*)(lds + TAB_OFF); P.G = G; P.c = c; P.rtab = lds + RTAB_OFF;
        pg::gemm_run(lds, P);
        }
#endif
        if (BOTH(7)) xcd_barrier(bar);
        DIAG_STAMP(7);
    }
#endif
#if !defined(ONLY) || ONLY == 8
    if (IN(8)) { KA_BEGIN();
#ifdef DIAG_PHASE
        p8_combine(q->out, (const bf16_t*)(ws + WS_X1H), YS, G, c, 1.0f + sqrtf((float)ctl[CW_DIAG] * 1e-5f));
#else
        p8_combine(q->out, (const bf16_t*)(ws + WS_X1H), YS, G, c, 1.0f);
#if DUP_PHASE == 8
        p8_combine(q->out, (const bf16_t*)(ws + WS_X1H), YS, G, c, -1.0f);
#endif
#endif
    }
#endif
#undef IN
#undef BOTH
}

static int g_grid = 0;
static void launch_mk(const MArgs& base, int lo, int hi, hipStream_t stream) {
    MArgs a = base; a.ph_lo = lo; a.ph_hi = hi;
    hipLaunchKernelGGL(mk_fwd, dim3(g_grid), dim3(NWAVES * 64), LDS_BYTES, stream, a);
}
extern "C" void kernel_launch(void* const* d_in, const int* in_sizes, int n_in, void* d_out, int out_size, void* d_ws, size_t ws_size, hipStream_t stream) {
    if (n_in != 24 || ws_size < WS_END) { fprintf(stderr, "kernel_launch: unexpected n_in %d or ws %zu\n", n_in, ws_size); return; }
    if (g_grid == 0) {
        int dev = 0, cus = 0, per_cu = 0;
        (void)hipGetDevice(&dev); (void)hipDeviceGetAttribute(&cus, hipDeviceAttributeMultiprocessorCount, dev);
        if (hipFuncSetAttribute((const void*)mk_fwd, hipFuncAttributeMaxDynamicSharedMemorySize, LDS_BYTES) != hipSuccess) fprintf(stderr, "kernel_launch: hipFuncSetAttribute failed\n");
        if (hipOccupancyMaxActiveBlocksPerMultiprocessor(&per_cu, (const void*)mk_fwd, NWAVES * 64, LDS_BYTES) != hipSuccess || per_cu < 1) fprintf(stderr, "kernel_launch: occupancy query says %d\n", per_cu);
        (void)hipGetLastError();
        g_grid = cus > 0 ? cus : 256;
    }
    unsigned char* ws = (unsigned char*)d_ws; float* out = (float*)d_out;
    MArgs base{}; for (int i = 0; i < 24; ++i) base.in[i] = (const float*)d_in[i]; base.out = out; base.ws = ws;

    (void)hipMemsetAsync(ws + WS_CTL, 0, 1 * MiB, stream);
    launch_mk(base, 0, 9, stream);
}
```
